# Optimizing an MI355X kernel written in HIP

```python
import math
import jax
import jax.numpy as jnp
from jax import lax

D_MODEL = 2048
BATCH = 16
SEQ = 256
DEPTH = 4
DEC_BATCH = 8
DEC_SEQ = 2048
PAST_LEN = 512

GRID_W = 64
HEAD_DIM = 128
ATT_HEADS = 8
ATT_KV_HEADS = 2
ATT_GROUP = ATT_HEADS // ATT_KV_HEADS
WINDOW = 128
ATT_BLOCK = 128
AXIS_DIM = HEAD_DIM // 2
ROPE_BASE = 10000.0
DN_HEADS = 4
DN_KEY_DIM = 128
DN_VAL_DIM = 128
DN_CHUNK = 64
CONV_K = 5
SGU_GROUPS = 4
SGU_DIM = 128
SGU_CHUNK = 128
D_FF = 4 * D_MODEL
EPS = 1e-6
NEG_INF = -1e30

ATT_Q = ATT_HEADS * HEAD_DIM
ATT_KV = ATT_KV_HEADS * HEAD_DIM
DN_QK = DN_HEADS * DN_KEY_DIM
DN_V = DN_HEADS * DN_VAL_DIM
DN_AB = 4 * DN_HEADS
SGU_W = SGU_GROUPS * SGU_DIM
IN_WIDTHS = (ATT_Q, ATT_KV, ATT_KV, DN_QK, DN_QK, DN_V, DN_V, DN_AB, SGU_W, SGU_W)
D_IN = ATT_Q + 2 * ATT_KV + 2 * DN_QK + 2 * DN_V + DN_AB + 2 * SGU_W
D_MIX = ATT_Q + DN_V + SGU_W
DN_CONV_W = 2 * DN_QK + DN_V

kernel_name = 'hybrid_diffusion_prefix_step'


def rmsnorm(x, g):
    xf = x.astype(jnp.float32)
    y = xf * lax.rsqrt(jnp.mean(xf * xf, axis=-1, keepdims=True) + EPS)
    return (y * g.astype(jnp.float32)).astype(x.dtype)


def l2norm(x):
    xf = x.astype(jnp.float32)
    return xf * lax.rsqrt(jnp.sum(xf * xf, axis=-1, keepdims=True) + EPS)


def split_in(z):
    idx, acc = [], 0
    for w in IN_WIDTHS[:-1]:
        acc += w
        idx.append(acc)
    return jnp.split(z, idx, axis=-1)


def axial_rope(T):
    rows = T // GRID_W
    row = jnp.repeat(jnp.arange(rows, dtype=jnp.float32), GRID_W)
    col = jnp.tile(jnp.arange(GRID_W, dtype=jnp.float32), rows)
    inv = ROPE_BASE ** (-jnp.arange(0, AXIS_DIM, 2, dtype=jnp.float32) / AXIS_DIM)
    ar = row[:, None] * inv[None, :]
    ac = col[:, None] * inv[None, :]
    ang = jnp.concatenate([ar, ar, ac, ac], axis=-1)
    return jnp.cos(ang), jnp.sin(ang)


def apply_rope(x, cos, sin):
    shape = (x.shape[1],) + (1,) * (x.ndim - 3) + (HEAD_DIM,)
    xf = x.astype(jnp.float32)
    x1, x2, x3, x4 = jnp.split(xf, 4, axis=-1)
    rot = jnp.concatenate([-x2, x1, -x4, x3], axis=-1)
    return (xf * cos.reshape(shape) + rot * sin.reshape(shape)).astype(x.dtype)


def sink_logits(sink, B):
    s = sink.astype(jnp.float32).reshape(ATT_KV_HEADS, ATT_GROUP)[None, :, :, None, None]
    return jnp.broadcast_to(s, (B, ATT_KV_HEADS, ATT_GROUP, ATT_BLOCK, 1))


def to_blocks(q):
    B, T = q.shape[:2]
    return jnp.moveaxis(q.reshape((B, T // ATT_BLOCK, ATT_BLOCK) + q.shape[2:]), 1, 0)


def from_blocks(o):
    nb, B = o.shape[:2]
    return jnp.moveaxis(o, 0, 1).reshape(B, nb * ATT_BLOCK, ATT_Q)


def context_attention(q, k, v, sink):
    B = q.shape[0]
    scale = HEAD_DIM ** -0.5
    s0 = sink_logits(sink, B)

    def block(q_i):
        s = jnp.einsum('bqkgd,blkd->bkgql', q_i, k).astype(jnp.float32) * scale
        p = jax.nn.softmax(jnp.concatenate([s0, s], axis=-1), axis=-1)[..., 1:]
        return jnp.einsum('bkgql,blkd->bqkgd', p.astype(v.dtype), v)

    return from_blocks(lax.map(block, to_blocks(q)))


def latent_attention(q, k, v, k_ctx, v_ctx, sink):
    B, T = q.shape[:2]
    L = k_ctx.shape[1]
    scale = HEAD_DIM ** -0.5
    s0 = sink_logits(sink, B)
    pad = ((0, 0), (ATT_BLOCK, ATT_BLOCK), (0, 0), (0, 0))
    kp = jnp.pad(k, pad)
    vp = jnp.pad(v, pad)
    offs = jnp.arange(3 * ATT_BLOCK) - ATT_BLOCK
    rel = offs[None, :] - jnp.arange(ATT_BLOCK)[:, None]

    def block(args):
        i, q_i = args
        start = i * ATT_BLOCK
        k_i = lax.dynamic_slice_in_dim(kp, start, 3 * ATT_BLOCK, axis=1)
        v_i = lax.dynamic_slice_in_dim(vp, start, 3 * ATT_BLOCK, axis=1)
        kpos = start + offs
        valid = (jnp.abs(rel) <= WINDOW) & ((kpos >= 0) & (kpos < T))[None, :]
        s_c = jnp.einsum('bqkgd,blkd->bkgql', q_i, k_ctx).astype(jnp.float32) * scale
        s_w = jnp.einsum('bqkgd,bjkd->bkgqj', q_i, k_i).astype(jnp.float32) * scale
        s_w = jnp.where(valid, s_w, NEG_INF)
        p = jax.nn.softmax(jnp.concatenate([s0, s_c, s_w], axis=-1), axis=-1)
        p_c = p[..., 1:1 + L].astype(v.dtype)
        p_w = p[..., 1 + L:].astype(v.dtype)
        return (jnp.einsum('bkgql,blkd->bqkgd', p_c, v_ctx)
                + jnp.einsum('bkgqj,bjkd->bqkgd', p_w, v_i))

    nb = T // ATT_BLOCK
    return from_blocks(lax.map(block, (jnp.arange(nb), to_blocks(q))))


def short_conv(x, w):
    return lax.conv_general_dilated(
        x, w[:, None, :].astype(x.dtype), window_strides=(1,),
        padding=[(CONV_K // 2, CONV_K // 2)],
        dimension_numbers=('NWC', 'WIO', 'NWC'),
        feature_group_count=x.shape[-1])


def gated_delta_rule(q, k, v, g, beta, S0):
    B, T, H, DK = q.shape
    DV = v.shape[-1]
    C = DN_CHUNK
    n = T // C

    def chunks(t):
        return jnp.moveaxis(t.reshape((B, n, C, H) + t.shape[3:]), 3, 1)

    qc = chunks(q.astype(jnp.float32)) * (DK ** -0.5)
    kc = chunks(k.astype(jnp.float32))
    vc = chunks(v.astype(jnp.float32))
    gc = jnp.cumsum(chunks(g.astype(jnp.float32)), axis=-1)
    bc = chunks(beta.astype(jnp.float32))
    incl = jnp.tril(jnp.ones((C, C), dtype=bool))
    strict = jnp.tril(jnp.ones((C, C), dtype=bool), -1)
    diff = gc[..., :, None] - gc[..., None, :]
    decay = jnp.where(incl, jnp.exp(jnp.where(incl, diff, 0.0)), 0.0)
    kk = jnp.einsum('bhnid,bhnjd->bhnij', kc * bc[..., None], kc) * decay
    a = jnp.where(strict, kk, 0.0) + jnp.eye(C, dtype=jnp.float32)
    rhs = jnp.concatenate([vc * bc[..., None], kc * (bc * jnp.exp(gc))[..., None]], axis=-1)
    sol = lax.linalg.triangular_solve(a, rhs, left_side=True, lower=True, unit_diagonal=True)
    u, w = sol[..., :DV], sol[..., DV:]
    qk = jnp.where(incl, jnp.einsum('bhnid,bhnjd->bhnij', qc, kc) * decay, 0.0)
    q_dec = qc * jnp.exp(gc)[..., None]
    k_dec = kc * jnp.exp(gc[..., -1:] - gc)[..., None]
    g_last = jnp.exp(gc[..., -1])
    xs = tuple(jnp.moveaxis(t, 2, 0) for t in (u, w, qk, q_dec, k_dec, g_last))

    def step(S, inp):
        u_i, w_i, qk_i, qd_i, kd_i, gl_i = inp
        v_new = u_i - jnp.einsum('bhcd,bhde->bhce', w_i, S)
        o = jnp.einsum('bhcd,bhde->bhce', qd_i, S) + jnp.einsum('bhij,bhje->bhie', qk_i, v_new)
        S = S * gl_i[..., None, None] + jnp.einsum('bhcd,bhce->bhde', kd_i, v_new)
        return S, o

    S, o = lax.scan(step, S0.astype(jnp.float32), xs)
    o = jnp.moveaxis(jnp.moveaxis(o, 0, 2), 1, 3).reshape(B, T, H, DV)
    return o, S


def deltanet_mixer(dq, dk, dv, dz, dab, lp, S0):
    B, T = dq.shape[:2]
    qkv = jax.nn.silu(short_conv(jnp.concatenate([dq, dk, dv], axis=-1), lp['conv_w']))
    q, k, v = jnp.split(qkv, [DN_QK, 2 * DN_QK], axis=-1)
    q = l2norm(q.reshape(B, T, DN_HEADS, DN_KEY_DIM))
    k = l2norm(k.reshape(B, T, DN_HEADS, DN_KEY_DIM))
    v = v.reshape(B, T, DN_HEADS, DN_VAL_DIM).astype(jnp.float32)
    ab = dab.astype(jnp.float32).reshape(B, T, 2, 2, DN_HEADS)
    a_rate = jnp.exp(lp['dn_a_log'].astype(jnp.float32))
    g = -a_rate * jax.nn.softplus(ab[:, :, :, 0] + lp['dn_dt_bias'].astype(jnp.float32))
    beta = jax.nn.sigmoid(ab[:, :, :, 1])
    o_f, s_f = gated_delta_rule(q, k, v, g[:, :, 0], beta[:, :, 0], S0[:, 0])
    flip = lambda t: jnp.flip(t, axis=1)
    o_b, s_b = gated_delta_rule(flip(q), flip(k), flip(v), flip(g[:, :, 1]), flip(beta[:, :, 1]), S0[:, 1])
    o = o_f + flip(o_b)
    z = jax.nn.silu(dz.astype(jnp.float32).reshape(B, T, DN_HEADS, DN_VAL_DIM))
    o = rmsnorm(o, lp['dn_norm_g']) * z
    return o.reshape(B, T, DN_V).astype(dq.dtype), jnp.stack([s_f, s_b], axis=1)


def sgu_mixer(su, sv, lp):
    B, T = su.shape[:2]
    n = T // SGU_CHUNK
    u = jax.nn.gelu(su)
    v = jax.nn.gelu(sv).reshape(B, n, SGU_CHUNK, SGU_GROUPS, SGU_DIM)
    v = rmsnorm(v, lp['sgu_norm_g'].reshape(SGU_GROUPS, SGU_DIM))
    mixed = jnp.einsum('gpq,bnqgc->bnpgc', lp['sgu_w'], v) + lp['sgu_b'].T[None, None, :, :, None]
    return u * mixed.reshape(B, T, SGU_W)


def token_mixers(h, lp, ctx, rope):
    B, T = h.shape[:2]
    aq, ak, av, dq, dk, dv, dz, dab, su, sv = split_in(h @ lp['w_in'])
    q = aq.reshape(B, T, ATT_KV_HEADS, ATT_GROUP, HEAD_DIM)
    k = ak.reshape(B, T, ATT_KV_HEADS, HEAD_DIM)
    v = av.reshape(B, T, ATT_KV_HEADS, HEAD_DIM)
    if ctx is None:
        o_att = context_attention(q, k, v, lp['attn_sink'])
        s0 = jnp.zeros((B, 2, DN_HEADS, DN_KEY_DIM, DN_VAL_DIM), jnp.float32)
    else:
        k_ctx, v_ctx, s0 = ctx
        cos, sin = rope
        o_att = latent_attention(apply_rope(q, cos, sin), apply_rope(k, cos, sin), v,
                                 k_ctx, v_ctx, lp['attn_sink'])
    o_dn, s_fin = deltanet_mixer(dq, dk, dv, dz, dab, lp, s0)
    o_sgu = sgu_mixer(su, sv, lp)
    out = jnp.concatenate([o_att.astype(h.dtype), o_dn, o_sgu.astype(h.dtype)], axis=-1) @ lp['w_out']
    ctx_out = (k, v, s_fin) if ctx is None else None
    return out, ctx_out


def trunk_layer(x, cond, lp, ctx, rope):
    mod = jax.nn.silu(cond) @ lp['w_mod'] + lp['b_mod']
    sh1, sc1, g1, sh2, sc2, g2 = jnp.split(mod, 6, axis=-1)
    h = rmsnorm(x, lp['norm1_g']) * (1 + sc1) + sh1
    mix, ctx_out = token_mixers(h, lp, ctx, rope)
    x = x + g1 * mix
    h = rmsnorm(x, lp['norm2_g']) * (1 + sc2) + sh2
    x = x + g2 * (jnp.square(jax.nn.relu(h @ lp['w_ff1'])) @ lp['w_ff2'])
    return x, ctx_out


def setup_inputs(seed: int = 0) -> dict:
    key = jax.random.key(seed)
    ks = jax.random.split(key, 24)
    f32 = jnp.float32

    def nrm(k, shape, scale):
        return jax.random.normal(k, shape, f32) * scale

    dt = jnp.exp(jax.random.uniform(ks[14], (DEPTH, 2, DN_HEADS), f32, math.log(1e-3), math.log(1e-1)))
    return {
        'x_prompt': nrm(ks[0], (BATCH, SEQ, D_MODEL), 1.0),
        'x_sample': nrm(ks[1], (DEC_BATCH, DEC_SEQ, D_MODEL), 1.0),
        'cache_attn_k': nrm(ks[2], (DEC_BATCH, DEPTH, PAST_LEN, ATT_KV_HEADS, HEAD_DIM), 1.0),
        'cache_attn_v': nrm(ks[3], (DEC_BATCH, DEPTH, PAST_LEN, ATT_KV_HEADS, HEAD_DIM), 1.0),
        'state_delta': nrm(ks[4], (DEC_BATCH, DEPTH, 2, DN_HEADS, DN_KEY_DIM, DN_VAL_DIM), 0.1),
        'c': nrm(ks[5], (DEC_BATCH, D_MODEL), 1.0),
        'c_ctx': nrm(ks[6], (D_MODEL,), 1.0),
        'norm1_g': 1.0 + nrm(ks[7], (DEPTH, D_MODEL), 0.01),
        'w_mod': nrm(ks[8], (DEPTH, D_MODEL, 6 * D_MODEL), 0.5 * D_MODEL ** -0.5),
        'b_mod': nrm(ks[9], (DEPTH, 6 * D_MODEL), 0.01),
        'w_in': nrm(ks[10], (DEPTH, D_MODEL, D_IN), D_MODEL ** -0.5),
        'conv_w': nrm(ks[11], (DEPTH, CONV_K, DN_CONV_W), CONV_K ** -0.5),
        'attn_sink': nrm(ks[12], (DEPTH, ATT_HEADS), 0.5),
        'dn_a_log': jnp.log(jax.random.uniform(ks[13], (DEPTH, 2, DN_HEADS), f32, 1.0, 16.0)),
        'dn_dt_bias': dt + jnp.log(-jnp.expm1(-dt)),
        'dn_norm_g': 1.0 + nrm(ks[15], (DEPTH, DN_VAL_DIM), 0.01),
        'sgu_norm_g': 1.0 + nrm(ks[16], (DEPTH, SGU_W), 0.01),
        'sgu_w': nrm(ks[17], (DEPTH, SGU_GROUPS, SGU_CHUNK, SGU_CHUNK), SGU_CHUNK ** -0.5),
        'sgu_b': 1.0 + nrm(ks[18], (DEPTH, SGU_GROUPS, SGU_CHUNK), 0.01),
        'w_out': nrm(ks[19], (DEPTH, D_MIX, D_MODEL), D_MIX ** -0.5),
        'norm2_g': 1.0 + nrm(ks[20], (DEPTH, D_MODEL), 0.01),
        'w_ff1': nrm(ks[21], (DEPTH, D_MODEL, D_FF), D_MODEL ** -0.5),
        'w_ff2': nrm(ks[22], (DEPTH, D_FF, D_MODEL), D_FF ** -0.5),
        'final_norm_g': 1.0 + nrm(ks[23], (D_MODEL,), 0.01),
    }


def reference(x_prompt, x_sample, cache_attn_k, cache_attn_v, state_delta, c, c_ctx,
              norm1_g, w_mod, b_mod, w_in, conv_w, attn_sink, dn_a_log, dn_dt_bias,
              dn_norm_g, sgu_norm_g, sgu_w, sgu_b, w_out, norm2_g, w_ff1, w_ff2, final_norm_g):
    def layer_params(l):
        return {'norm1_g': norm1_g[l], 'w_mod': w_mod[l], 'b_mod': b_mod[l], 'w_in': w_in[l],
                'conv_w': conv_w[l], 'attn_sink': attn_sink[l], 'dn_a_log': dn_a_log[l],
                'dn_dt_bias': dn_dt_bias[l], 'dn_norm_g': dn_norm_g[l], 'sgu_norm_g': sgu_norm_g[l],
                'sgu_w': sgu_w[l], 'sgu_b': sgu_b[l], 'w_out': w_out[l], 'norm2_g': norm2_g[l],
                'w_ff1': w_ff1[l], 'w_ff2': w_ff2[l]}

    x = x_prompt
    cond_ctx = c_ctx[None, None, :]
    ks, vs, ss = [], [], []
    for l in range(DEPTH):
        x, (k_l, v_l, s_l) = trunk_layer(x, cond_ctx, layer_params(l), None, None)
        ks.append(k_l)
        vs.append(v_l)
        ss.append(s_l)
    y_prompt = rmsnorm(x, final_norm_g)
    new_attn_k = jnp.stack(ks, axis=1)
    new_attn_v = jnp.stack(vs, axis=1)
    new_delta = jnp.stack(ss, axis=1)

    rope = axial_rope(x_sample.shape[1])
    x = x_sample
    cond = c[:, None, :]
    for l in range(DEPTH):
        ctx = (cache_attn_k[:, l], cache_attn_v[:, l], state_delta[:, l])
        x, _ = trunk_layer(x, cond, layer_params(l), ctx, rope)
    y_sample = rmsnorm(x, final_norm_g)
    return (y_prompt, y_sample, new_attn_k, new_attn_v, new_delta)
```

```cpp
#include <hip/hip_runtime.h>
#include <cstdio>
#include <cstdint>
namespace pg8 {
#define PG8_LAS __attribute__((address_space(3)))
typedef unsigned short bf16_t;
typedef short bf16x8 __attribute__((ext_vector_type(8)));
typedef float f32x4 __attribute__((ext_vector_type(4)));
typedef unsigned u32x4 __attribute__((ext_vector_type(4)));
constexpr int BM = 256, BK = 64, HALF = 128, HTB = HALF * BK * 2  , STAGE_BYTES = 8 * HTB, NXCD = 8, WGM = 8;

__host__ __device__ __forceinline__ int lds_byte(int r, int c) { const int st = (r >> 4) * 2 + (c >> 5), rr = r & 15, cc = c & 31, ob = rr * 64 + cc * 2; return st * 1024 + (ob ^ (((ob >> 9) & 1) << 5)); }
__host__ __device__ __forceinline__ void stage_rc(int b, int& R, int& C) { const int st = b / 1024, sb = b % 1024, swz = sb ^ (((sb >> 9) & 1) << 5); R = (st >> 1) * 16 + swz / 64; C = (st & 1) * 32 + (swz % 64) / 2; }
__host__ __device__ __forceinline__ int perm32(int rho) { const int n = rho >> 4, i = rho & 15; return 8 * (i >> 2) + 4 * n + (i & 3); }

struct Unit { int pm, pn; };
struct Gemm { const bf16_t* A; const bf16_t* Bt; int M, N, K; };

struct StaticOrder {
    int nM, nN, nwg, G, c;
    __host__ __device__ void init(int M, int N, int G_, int c_) { nM = M / BM; nN = N / BM; nwg = nM * nN; G = G_; c = c_; }
    __host__ __device__ bool next(int i, Unit& u) const {
        const long L = (long)i * G + c; if (L >= nwg) return false;
        int wgid = (int)L; { const int q = nwg / NXCD, r = nwg % NXCD, xcd = wgid % NXCD, off = wgid / NXCD; wgid = (xcd < r ? xcd * (q + 1) : r * (q + 1) + (xcd - r) * q) + off; }
        const int nig = WGM * nN, gid = wgid / nig, fm = gid * WGM, gsz = (nM - fm) < WGM ? (nM - fm) : WGM;
        u.pm = fm + ((wgid % nig) % gsz); u.pn = (wgid % nig) / gsz; return true;
    }
    __device__ __forceinline__ void a_ready(const Unit&) const {}
    __device__ __forceinline__ void done(const Unit&) const {}
};


__device__ __forceinline__ unsigned cvt_pk_bf16(float lo, float hi) { unsigned r; asm volatile("v_cvt_pk_bf16_f32 %0, %1, %2" : "=v"(r) : "v"(lo), "v"(hi)); return r; }
__device__ __forceinline__ int cond_of(int rowt) { return rowt < 4096 ? 8 : ((rowt - 4096) >> 11); }
struct EpiZ {
    static constexpr bool PERM = true, AFTER_DRAIN = false;
    bf16_t* O; int ldc; float* outk; float* outv; const float* ssq; const float* bw;
    __device__ __forceinline__ void operator()(const f32x4 (&acc)[2][2][4][2], const Unit& u, int wr, int wc, int fr, int fq) const {
        asm volatile("" : "+v"(fr), "+v"(fq));
        const int rowt = u.pm * BM, row0 = rowt + wr * 64 + fr; const int col0 = u.pn * BM + wc * 32 + 8 * fq;
        const bool kv = (u.pm < 16) && (u.pn == 4 || u.pn == 5);
        float* ob = (u.pn == 4 ? outk : outv) + (size_t)u.pm * (4 * 65536) + wc * 32 + 8 * fq;
        const float* bp = bw + (size_t)cond_of(rowt) * ldc + col0; f32x4 bv[2][2];
#pragma unroll
        for (int bj = 0; bj < 2; ++bj)
#pragma unroll
            for (int n = 0; n < 2; ++n) bv[bj][n] = *(const f32x4*)(bp + bj * HALF + 4 * n);
#pragma unroll
        for (int ai = 0; ai < 2; ++ai)
#pragma unroll
            for (int m = 0; m < 4; ++m) { const int rl = wr * 64 + fr + ai * HALF + m * 16; bf16_t* rowp = O + (size_t)(row0 + ai * HALF + m * 16) * ldc + col0;
                const float rs = __builtin_amdgcn_rsqf(ssq[rowt + rl] * (1.f / 2048.f) + 1e-6f);
#pragma unroll
                for (int bj = 0; bj < 2; ++bj) { const f32x4 v0 = acc[ai][bj][m][0] * rs + bv[bj][0], v1 = acc[ai][bj][m][1] * rs + bv[bj][1];
                    u32x4 w; w.x = cvt_pk_bf16(v0[0], v0[1]); w.y = cvt_pk_bf16(v0[2], v0[3]); w.z = cvt_pk_bf16(v1[0], v1[1]); w.w = cvt_pk_bf16(v1[2], v1[3]);
                    *(u32x4*)(rowp + bj * HALF) = w;
                    if (kv) { float* p = ob + (size_t)rl * 256 + bj * HALF; *(f32x4*)p = v0; *(f32x4*)(p + 4) = v1; } } }
    }
};
struct EpiRelu2 {
    static constexpr bool PERM = true, AFTER_DRAIN = false;
    bf16_t* O; int ldc; const float* ssq; const float* bw;
    __device__ __forceinline__ void operator()(const f32x4 (&acc)[2][2][4][2], const Unit& u, int wr, int wc, int fr, int fq) const {
        asm volatile("" : "+v"(fr), "+v"(fq));
        const int rowt = u.pm * BM, row0 = rowt + wr * 64 + fr; const int col0 = u.pn * BM + wc * 32 + 8 * fq;
        const float* bp = bw + (size_t)cond_of(rowt) * ldc + col0; f32x4 bv[2][2];
#pragma unroll
        for (int bj = 0; bj < 2; ++bj)
#pragma unroll
            for (int n = 0; n < 2; ++n) bv[bj][n] = *(const f32x4*)(bp + bj * HALF + 4 * n);
#pragma unroll
        for (int ai = 0; ai < 2; ++ai)
#pragma unroll
            for (int m = 0; m < 4; ++m) { bf16_t* rowp = O + (size_t)(row0 + ai * HALF + m * 16) * ldc + col0;
                const float rs = __builtin_amdgcn_rsqf(ssq[row0 + ai * HALF + m * 16] * (1.f / 2048.f) + 1e-6f);
#pragma unroll
                for (int bj = 0; bj < 2; ++bj) { f32x4 v0 = acc[ai][bj][m][0] * rs + bv[bj][0], v1 = acc[ai][bj][m][1] * rs + bv[bj][1];
#pragma unroll
                    for (int j = 0; j < 4; ++j) { const float a = fmaxf(v0[j], 0.f), b = fmaxf(v1[j], 0.f); v0[j] = a * a; v1[j] = b * b; }
                    u32x4 w; w.x = cvt_pk_bf16(v0[0], v0[1]); w.y = cvt_pk_bf16(v0[2], v0[3]); w.z = cvt_pk_bf16(v1[0], v1[1]); w.w = cvt_pk_bf16(v1[2], v1[3]);
                    *(u32x4*)(rowp + bj * HALF) = w; } }
    }
};
struct EpiRes {
    static constexpr bool PERM = true, AFTER_DRAIN = false;
    const float* xin0; const float* xin1; float* xout; const float* gate; const float* anext; bf16_t* xa; float* ssq;
    __device__ __forceinline__ void operator()(const f32x4 (&acc)[2][2][4][2], const Unit& u, int wr, int wc, int fr, int fq) const {
        asm volatile("" : "+v"(fr), "+v"(fq));
        const int rowt = u.pm * BM, col0 = u.pn * BM + wc * 32 + 8 * fq; const int cond = cond_of(rowt);
        const float* xb = rowt < 4096 ? xin0 + (size_t)rowt * 2048 : xin1 + (size_t)(rowt - 4096) * 2048; float* ob = xout + (size_t)rowt * 2048; bf16_t* ab = xa + (size_t)rowt * 2048;
        const float* g = gate + (size_t)cond * 12288 + col0; f32x4 gv[2][2], av[2][2];
#pragma unroll
        for (int bj = 0; bj < 2; ++bj)
#pragma unroll
            for (int n = 0; n < 2; ++n) { gv[bj][n] = *(const f32x4*)(g + bj * HALF + 4 * n); av[bj][n] = anext ? *(const f32x4*)(anext + (size_t)cond * 12288 + col0 + bj * HALF + 4 * n) : (f32x4){0.f, 0.f, 0.f, 0.f}; }
        const unsigned offb = (unsigned)((wr * 64 + fr) * 2048 + col0) * 4u;
#pragma unroll
        for (int ai = 0; ai < 2; ++ai)
#pragma unroll
            for (int m = 0; m < 4; ++m) { unsigned voff = offb + (unsigned)(ai * HALF + m * 16) * 8192u; asm volatile("" : "+v"(voff));
                const char* xp = (const char*)xb + voff; char* op = (char*)ob + voff; char* ap = (char*)ab + (voff >> 1); float ss = 0.f;
#pragma unroll
                for (int bj = 0; bj < 2; ++bj) { const f32x4 x0 = *(const f32x4*)(xp + bj * 512), x1 = *(const f32x4*)(xp + bj * 512 + 16);
                    const f32x4 y0 = x0 + gv[bj][0] * acc[ai][bj][m][0], y1 = x1 + gv[bj][1] * acc[ai][bj][m][1];
                    *(f32x4*)(op + bj * 512) = y0; *(f32x4*)(op + bj * 512 + 16) = y1;
                    ss += (y0[0] * y0[0] + y0[1] * y0[1]) + (y0[2] * y0[2] + y0[3] * y0[3]) + (y1[0] * y1[0] + y1[1] * y1[1]) + (y1[2] * y1[2] + y1[3] * y1[3]);
                    if (anext) { const f32x4 a0 = y0 * av[bj][0], a1 = y1 * av[bj][1];
                        u32x4 w; w.x = cvt_pk_bf16(a0[0], a0[1]); w.y = cvt_pk_bf16(a0[2], a0[3]); w.z = cvt_pk_bf16(a1[0], a1[1]); w.w = cvt_pk_bf16(a1[2], a1[3]); *(u32x4*)(ap + bj * 256) = w; } }
                ss += __shfl_xor(ss, 16); ss += __shfl_xor(ss, 32);
                if (fq == 0) __hip_atomic_fetch_add(ssq + rowt + wr * 64 + fr + ai * HALF + m * 16, ss, __ATOMIC_RELAXED, __HIP_MEMORY_SCOPE_AGENT);
                asm volatile("" ::: "memory"); }
    }
};
template <class Epi, class Sched, bool ALIGN_EPI = false, bool SP2 = false>
__device__ __forceinline__ void gemm_phase(PG8_LAS unsigned char* lds, const Gemm g, const Sched& S, const Epi& E) {
    int tid_ = threadIdx.x; asm volatile("" : "+v"(tid_));
    const int tid = tid_, wid = __builtin_amdgcn_readfirstlane(tid >> 6), lane = tid & 63, wr = wid >> 2, wc = wid & 3, fr = lane & 15, fq = lane >> 4;
    const int K = g.K, nt = K / BK;
    unsigned voffA[2], voffB[2];
#pragma unroll
    for (int i = 0; i < 2; ++i) { int R, C; stage_rc(tid * 16 + i * 8192, R, C); const int Rb = Epi::PERM ? ((R & ~31) + perm32(R & 31)) : R;
        voffA[i] = (unsigned)(R * K + C) * 2u; voffB[i] = (unsigned)(Rb * K + C) * 2u; }
    const size_t kstep = (size_t)(BK * 2);
    const size_t hstep = (size_t)HALF * K * 2;
    const size_t tstep = 2 * hstep;
    const unsigned ldsw = (unsigned)wid * 1024u;
    const int aoff = lds_byte(wr * 64 + fr, fq * 8), boff = lds_byte(wc * 32 + fr, fq * 8);
#define PG8_SA(b, h) (((b) * 2 + (h)) * HTB)
#define PG8_SB(b, h) ((4 + (b) * 2 + (h)) * HTB)
#define PG8_STAGE(bufoff, gbase, voff) do { _Pragma("unroll") for (int _i = 0; _i < 2; ++_i) \
        __builtin_amdgcn_global_load_lds((const unsigned*)((const char*)(gbase) + (voff)[_i]), (PG8_LAS unsigned*)(lds + (bufoff) + ldsw + _i * 8192), 16, 0, 0); } while (0)
#define PG8_LDA(dst, b, h) do { _Pragma("unroll") for (int m = 0; m < 4; ++m) _Pragma("unroll") for (int k = 0; k < 2; ++k) dst[m][k] = *(const PG8_LAS bf16x8*)(lds + PG8_SA(b, h) + aoff + m * 2048 + k * 1024); } while (0)
#define PG8_LDB(dst, b, h) do { _Pragma("unroll") for (int n = 0; n < 2; ++n) _Pragma("unroll") for (int k = 0; k < 2; ++k) dst[n][k] = *(const PG8_LAS bf16x8*)(lds + PG8_SB(b, h) + boff + n * 2048 + k * 1024); } while (0)
#define PG8_MMA(ai, bj, At, Bt) do { __builtin_amdgcn_s_setprio(1); _Pragma("unroll") for (int m = 0; m < 4; ++m) _Pragma("unroll") for (int n = 0; n < 2; ++n) _Pragma("unroll") for (int k = 0; k < 2; ++k) \
        acc[ai][bj][m][n] = __builtin_amdgcn_mfma_f32_16x16x32_bf16(Bt[n][k], At[m][k], acc[ai][bj][m][n], 0, 0, 0); __builtin_amdgcn_s_setprio(0); } while (0)
#define PG8_WAIT_V(n) asm volatile("s_waitcnt vmcnt(" #n ")" ::: "memory")
#define PG8_WAIT_L(n) asm volatile("s_waitcnt lgkmcnt(" #n ")" ::: "memory")
#define PG8_BAR __builtin_amdgcn_s_barrier()
#define PG8_SCHED __builtin_amdgcn_sched_barrier(0)
    Unit cur, nxt; int ui = 0;
    if (!S.next(0, cur)) return;
    f32x4 acc[2][2][4][2];
#pragma unroll
    for (int a = 0; a < 2; ++a)
#pragma unroll
        for (int b = 0; b < 2; ++b)
#pragma unroll
            for (int m = 0; m < 4; ++m)
#pragma unroll
                for (int n = 0; n < 2; ++n) acc[a][b][m][n] = (f32x4){0.f, 0.f, 0.f, 0.f};
    bf16x8 At[4][2], B0[2][2], B1[2][2];
    const char* cA = (const char*)g.A + (size_t)cur.pm * tstep; const char* cB = (const char*)g.Bt + (size_t)cur.pn * tstep;
    S.a_ready(cur);
    if constexpr (SP2) {
        PG8_STAGE(PG8_SB(0, 0), cB, voffB); PG8_STAGE(PG8_SB(0, 1), cB + hstep, voffB); PG8_STAGE(PG8_SA(0, 0), cA, voffA); PG8_STAGE(PG8_SA(0, 1), cA + hstep, voffA);
        if (wr == 1) PG8_BAR;
        PG8_WAIT_V(2); PG8_BAR;
        PG8_STAGE(PG8_SB(1, 0), cB + kstep, voffB); PG8_STAGE(PG8_SA(1, 0), cA + kstep, voffA); PG8_STAGE(PG8_SB(1, 1), cB + hstep + kstep, voffB);
        PG8_WAIT_V(6); PG8_BAR;
    } else {
        PG8_STAGE(PG8_SB(0, 0), cB, voffB); PG8_STAGE(PG8_SA(0, 0), cA, voffA); PG8_STAGE(PG8_SB(0, 1), cB + hstep, voffB); PG8_STAGE(PG8_SA(0, 1), cA + hstep, voffA);
        if (wr == 1) PG8_BAR;
        PG8_WAIT_V(4); PG8_BAR;
        PG8_STAGE(PG8_SB(1, 0), cB + kstep, voffB); PG8_STAGE(PG8_SA(1, 0), cA + kstep, voffA); PG8_STAGE(PG8_SB(1, 1), cB + hstep + kstep, voffB);
        PG8_WAIT_V(6); PG8_BAR;
    }
    for (;;) {
        const bool has_next = S.next(ui + 1, nxt);
        const char* nA = has_next ? (const char*)g.A + (size_t)nxt.pm * tstep : cA; const char* nB = has_next ? (const char*)g.Bt + (size_t)nxt.pn * tstep : cB;
        for (int t = 0; t < nt; t += 2) {
            const bool last = (t == nt - 2);
            const char* a1 = cA + (size_t)(t + 1) * kstep;
            const char* a2 = last ? nA : cA + (size_t)(t + 2) * kstep; const char* b2 = last ? nB : cB + (size_t)(t + 2) * kstep;
            const char* a3 = a2 + kstep; const char* b3 = b2 + kstep;
            if (last && has_next) S.a_ready(nxt);
            if constexpr (SP2) {
            PG8_LDB(B0, 0, 0); PG8_LDB(B1, 0, 1); PG8_SCHED; PG8_LDA(At, 0, 0); PG8_STAGE(PG8_SA(1, 1), a1 + hstep, voffA);
            PG8_WAIT_V(8); PG8_WAIT_L(0); PG8_BAR; PG8_MMA(0, 0, At, B0); PG8_MMA(0, 1, At, B1); PG8_BAR; PG8_SCHED;
            PG8_LDA(At, 0, 1); PG8_STAGE(PG8_SB(0, 0), b2, voffB); PG8_STAGE(PG8_SB(0, 1), b2 + hstep, voffB); PG8_STAGE(PG8_SA(0, 0), a2, voffA);
            PG8_WAIT_V(8); PG8_WAIT_L(0); PG8_BAR; PG8_MMA(1, 0, At, B0); PG8_MMA(1, 1, At, B1); PG8_BAR; PG8_SCHED;
            PG8_LDB(B0, 1, 0); PG8_LDB(B1, 1, 1); PG8_SCHED; PG8_LDA(At, 1, 0); PG8_STAGE(PG8_SA(0, 1), a2 + hstep, voffA);
            PG8_WAIT_V(8); PG8_WAIT_L(0); PG8_BAR; PG8_MMA(0, 0, At, B0); PG8_MMA(0, 1, At, B1); PG8_BAR; PG8_SCHED;
            PG8_LDA(At, 1, 1); PG8_STAGE(PG8_SB(1, 0), b3, voffB); PG8_STAGE(PG8_SB(1, 1), b3 + hstep, voffB); PG8_STAGE(PG8_SA(1, 0), a3, voffA);
            PG8_WAIT_V(8); PG8_WAIT_L(0); PG8_BAR; PG8_MMA(1, 0, At, B0); PG8_MMA(1, 1, At, B1); PG8_BAR; PG8_SCHED;
            } else {
            PG8_LDB(B0, 0, 0); PG8_SCHED; PG8_LDA(At, 0, 0); PG8_STAGE(PG8_SA(1, 1), a1 + hstep, voffA);
            PG8_WAIT_L(8); PG8_BAR; PG8_WAIT_L(0); PG8_MMA(0, 0, At, B0); PG8_BAR; PG8_SCHED;
            PG8_LDB(B1, 0, 1); PG8_STAGE(PG8_SB(0, 0), b2, voffB);
            PG8_BAR; PG8_WAIT_L(0); PG8_MMA(0, 1, At, B1); PG8_BAR;
            PG8_LDA(At, 0, 1); PG8_STAGE(PG8_SA(0, 0), a2, voffA);
            PG8_BAR; PG8_WAIT_L(0); PG8_MMA(1, 0, At, B0); PG8_BAR; PG8_SCHED;
            PG8_STAGE(PG8_SB(0, 1), b2 + hstep, voffB);
            PG8_WAIT_V(6); PG8_BAR; PG8_MMA(1, 1, At, B1); PG8_BAR;
            PG8_LDB(B0, 1, 0); PG8_SCHED; PG8_LDA(At, 1, 0); PG8_STAGE(PG8_SA(0, 1), a2 + hstep, voffA);
            PG8_WAIT_L(8); PG8_BAR; PG8_WAIT_L(0); PG8_MMA(0, 0, At, B0); PG8_BAR; PG8_SCHED;
            PG8_LDB(B1, 1, 1); PG8_STAGE(PG8_SB(1, 0), b3, voffB);
            PG8_BAR; PG8_WAIT_L(0); PG8_MMA(0, 1, At, B1); PG8_BAR;
            PG8_LDA(At, 1, 1); PG8_STAGE(PG8_SA(1, 0), a3, voffA);
            PG8_BAR; PG8_WAIT_L(0); PG8_MMA(1, 0, At, B0); PG8_BAR; PG8_SCHED;
            PG8_STAGE(PG8_SB(1, 1), b3 + hstep, voffB);
            PG8_WAIT_V(6); PG8_BAR; PG8_MMA(1, 1, At, B1); PG8_BAR;
            }
        }
        if constexpr (ALIGN_EPI) { if (wr == 0) PG8_BAR; }
        if constexpr (!Epi::AFTER_DRAIN) { E(acc, cur, wr, wc, fr, fq); S.done(cur); }
        if (!has_next) break;
#pragma unroll
        for (int a = 0; a < 2; ++a)
#pragma unroll
            for (int b = 0; b < 2; ++b)
#pragma unroll
                for (int m = 0; m < 4; ++m)
#pragma unroll
                    for (int n = 0; n < 2; ++n) acc[a][b][m][n] = (f32x4){0.f, 0.f, 0.f, 0.f};
        cur = nxt; cA = nA; cB = nB; ++ui;
        if constexpr (ALIGN_EPI) { if (wr == 1) PG8_BAR; }
    }
    PG8_WAIT_V(0);
    if constexpr (!ALIGN_EPI) { if (wr == 0) PG8_BAR; }
    PG8_BAR;
    if constexpr (Epi::AFTER_DRAIN) { E.fused(acc, cur, wr, wc, fr, fq, lds, wid, lane); S.done(cur); }
#undef PG8_SA
#undef PG8_SB
#undef PG8_STAGE
#undef PG8_LDA
#undef PG8_LDB
#undef PG8_MMA
#undef PG8_WAIT_V
#undef PG8_WAIT_L
#undef PG8_BAR
#undef PG8_SCHED
}
}


constexpr int D = 2048, NCTX = 4096, NLAT = 16384, M = NCTX + NLAT, DEPTH = 4;
constexpr int DIN = 4624, DINP = 4864, DFF = 8192;
constexpr int C_AQ = 0, C_AK = 1024, C_AV = 1280, C_DQ = 1536, C_DK = 2048, C_DV = 2560, C_DZ = 3072, C_DAB = 3584, C_SU = 3600, C_SV = 4112;
constexpr int NWAVES = 8;
constexpr float EPS = 1e-6f;
constexpr size_t O_Y = 0, O_K = (size_t)M * D, O_V = O_K + 4194304, O_DELTA = O_V + 4194304, O_END = O_DELTA + 8388608;
constexpr size_t MiB = 1u << 20;
constexpr size_t WS_CTL = 0, CTL_ZERO_BYTES = 1 * MiB;
static_assert((16384 + 9 * 20480) * 4 <= 1 * 1048576, "ssq inside the memset region");
constexpr size_t WS_MOD = 1 * MiB, WS_ROPE = 3 * MiB, WS_CK = 4 * MiB, WS_CV = 12 * MiB;
constexpr size_t WS_WIN = 20 * MiB, WS_WOUT = 96 * MiB, WS_WFF1 = 128 * MiB, WS_WFF2 = 256 * MiB;
constexpr size_t WS_X = 384 * MiB, WS_HB = 544 * MiB, WS_ZB = 624 * MiB, WS_ODIR = 816 * MiB, WS_DN = 944 * MiB, WS_BW = 1088 * MiB, WS_XA = 1090 * MiB, WS_END = 1170 * MiB;
constexpr int BW_L = 9 * (DINP + DFF);
constexpr int CW_SSQ = 16384;
constexpr size_t DN_BLK = 116736, DN_DIR0 = 32768, DN_DIRSZ = 41984;
static_assert(WS_DN + 1280 * DN_BLK <= WS_END, "dn scratch");
constexpr int CW_BAR = 4096, CW_ATT = 8192;
constexpr int LDSCTL_OFF = 153600, LDS_BYTES = 154624;

#define GAS __attribute__((address_space(1)))
#define LAS __attribute__((address_space(3)))
typedef unsigned short bf16;
typedef unsigned v4u __attribute__((ext_vector_type(4)));
typedef unsigned v2u __attribute__((ext_vector_type(2)));
typedef float f32x4 __attribute__((ext_vector_type(4)));
typedef float f32x2 __attribute__((ext_vector_type(2)));
typedef float f32x16 __attribute__((ext_vector_type(16)));
typedef short bf16x8 __attribute__((ext_vector_type(8)));
typedef short s16x4 __attribute__((ext_vector_type(4)));
typedef LAS unsigned char* ldsp;
#define LDS_WAIT() asm volatile("s_waitcnt lgkmcnt(0)" ::: "memory")
#define VM_WAIT() asm volatile("s_waitcnt vmcnt(0)" ::: "memory")
__device__ __forceinline__ unsigned pk2(float lo, float hi) { unsigned r; asm volatile("v_cvt_pk_bf16_f32 %0, %1, %2" : "=v"(r) : "v"(lo), "v"(hi)); return r; }
__device__ __forceinline__ float bflo(unsigned w) { return __uint_as_float(w << 16); }
__device__ __forceinline__ float bfhi(unsigned w) { return __uint_as_float(w & 0xffff0000u); }
__device__ __forceinline__ float bf2f(bf16 b) { return __uint_as_float((unsigned)b << 16); }
__device__ __forceinline__ float wave_sum(float v) {
#pragma unroll
    for (int o = 1; o < 64; o <<= 1) v += __shfl_xor(v, o);
    return v;
}
__device__ __forceinline__ int crow(int r, int hi) { return (r & 3) + 8 * (r >> 2) + 4 * hi; }
__device__ __forceinline__ float silu_f(float x) { return x / (1.f + __expf(-x)); }
__device__ __forceinline__ float gelu_tanh(float x) { const float y = 0.7978845608028654f * (x + 0.044715f * x * x * x); const float e = __expf(2.f * y); return 0.5f * x * (2.f - 2.f / (1.f + e)); }
template <int S> __device__ __forceinline__ bf16x8 pack8(const f32x16& v) {
    v4u w; w.x = pk2(v[8 * S + 0], v[8 * S + 1]); w.y = pk2(v[8 * S + 2], v[8 * S + 3]); w.z = pk2(v[8 * S + 4], v[8 * S + 5]); w.w = pk2(v[8 * S + 6], v[8 * S + 7]);
    return __builtin_bit_cast(bf16x8, w);
}
__device__ __forceinline__ f32x16 mma_lds(ldsp A, int sa, ldsp B, int sb, int nk, int lane, f32x16 acc) {
    ldsp ap = A + (lane & 31) * sa + (lane >> 5) * 16; ldsp bp = B + (lane & 31) * sb + (lane >> 5) * 16;
#pragma unroll 4
    for (int k = 0; k < nk; ++k) { const bf16x8 a = *(const LAS bf16x8*)(ap + k * 32); const bf16x8 b = *(const LAS bf16x8*)(bp + k * 32); acc = __builtin_amdgcn_mfma_f32_32x32x16_bf16(a, b, acc, 0, 0, 0); }
    return acc;
}

#define XB_TMO      128
#define XB_XCNT(j)  (256  + 64 * (j))
#define XB_XSUB(j)  (1280 + 64 * (j))
#define XB_XGEN(j)  (2304 + 64 * (j))
#define XB_TOP      3328
#define XB_TOPGEN   3392
#define XCD_BAR_WORDS 3456
#define XB_SPIN_CAP (1u << 18)
#define LAS __attribute__((address_space(3)))

__device__ __forceinline__ unsigned xb_ld(unsigned* p)              { return __hip_atomic_load(p, __ATOMIC_RELAXED, __HIP_MEMORY_SCOPE_AGENT); }
__device__ __forceinline__ unsigned xb_add(unsigned* p, unsigned v) { return __hip_atomic_fetch_add(p, v, __ATOMIC_RELAXED, __HIP_MEMORY_SCOPE_AGENT); }
__device__ __forceinline__ unsigned xb_xcc_id() { return (unsigned)__builtin_amdgcn_s_getreg((3 << 11) | 20) & 0xFu; }
#define XB_SPIN(cond, bar) do { unsigned _sp = 0; while (cond) { __builtin_amdgcn_s_sleep(1); \
    if ((++_sp & 255u) == 0u) { if (xb_ld(&(bar)[XB_TMO])) break; if (_sp > XB_SPIN_CAP) { atomicAdd(&(bar)[XB_TMO], 1u); break; } } } } while (0)

struct XcdBarrier {
    unsigned* bar; unsigned x;
    volatile LAS unsigned* st;
};

__device__ __forceinline__ XcdBarrier xcd_barrier_post(unsigned* bar, volatile LAS unsigned* st) {
    XcdBarrier b; b.bar = bar; b.x = xb_xcc_id(); b.st = st;
    if (threadIdx.x == 0) (void)xb_add(&bar[XB_XCNT(b.x)], 1u);
    return b;
}
__device__ __forceinline__ void xcd_barrier_complete(unsigned* bar, unsigned x, unsigned& nloc, unsigned& nx) {
    const unsigned G = gridDim.x * gridDim.y * gridDim.z;
    unsigned sum, cnt, mine, sp = 0u;
    for (;;) {
        sum = 0u; cnt = 0u; mine = 0u;
#pragma unroll
        for (unsigned j = 0; j < 16; ++j) { const unsigned c = xb_ld(&bar[XB_XCNT(j)]); sum += c; cnt += (c > 0u) ? 1u : 0u; mine = (j == x) ? c : mine; }
        if (sum == G) break;
        __builtin_amdgcn_s_sleep(1);
        if ((++sp & 255u) == 0u) { if (xb_ld(&bar[XB_TMO])) break; if (sp > XB_SPIN_CAP) { atomicAdd(&bar[XB_TMO], 1u); break; } }
    }
    nloc = mine > 0u ? mine : 1u; nx = cnt > 0u ? cnt : 1u;
}

__device__ __forceinline__ void xcd_barrier(const XcdBarrier& b) {
    asm volatile("s_waitcnt vmcnt(0)" ::: "memory");
    __syncthreads();
    if (threadIdx.x == 0) {
        unsigned* bar = b.bar;
        __builtin_amdgcn_s_waitcnt(0);
        unsigned nloc = b.st[0], nx = b.st[1];
        if (nloc == 0u) { xcd_barrier_complete(bar, b.x, nloc, nx); b.st[0] = nloc; b.st[1] = nx; }
        const unsigned old = xb_add(&bar[XB_XSUB(b.x)], 1u);
        const unsigned gen = old / nloc;
        if (old + 1u == (gen + 1u) * nloc) {
            __builtin_amdgcn_fence(__ATOMIC_RELEASE, "agent");
            asm volatile("s_waitcnt vmcnt(0)" ::: "memory");
            const unsigned og = xb_add(&bar[XB_TOP], 1u);
            const unsigned tg = og / nx;
            if (og + 1u == (tg + 1u) * nx) xb_add(&bar[XB_TOPGEN], 1u);
            else XB_SPIN(xb_ld(&bar[XB_TOPGEN]) == tg, bar);
            __builtin_amdgcn_fence(__ATOMIC_ACQUIRE, "agent");
            xb_add(&bar[XB_XGEN(b.x)], 1u);
            asm volatile("s_waitcnt vmcnt(0)" ::: "memory");
        } else {
            XB_SPIN(xb_ld(&bar[XB_XGEN(b.x)]) == gen, bar);
            __builtin_amdgcn_fence(__ATOMIC_ACQUIRE, "agent");
            asm volatile("s_waitcnt vmcnt(0)" ::: "memory");
        }
    }
    __syncthreads();
}


__device__ __forceinline__ void p0_transpose_item(const float* W, int K, int N, bf16* WT, LAS float* scr, int item, int lane) {
    const int nblk = (N + 31) / 32, kb = item / nblk, nb = item % nblk, k0 = 64 * kb, n0 = 32 * nb; const bool okn = (n0 + (lane & 31)) < N;
#pragma unroll 8
    for (int i = 0; i < 32; ++i) { const int kk = 2 * i + (lane >> 5); scr[kk * 33 + (lane & 31)] = okn ? W[(size_t)(k0 + kk) * N + n0 + (lane & 31)] : 0.f; }
    LDS_WAIT(); asm volatile("" ::: "memory");
    const int c = lane & 7;
#pragma unroll
    for (int j = 0; j < 4; ++j) { const int n = (lane >> 3) + 8 * j; const LAS float* s = scr + (8 * c) * 33 + n;
        v4u o; o.x = pk2(s[0 * 33], s[1 * 33]); o.y = pk2(s[2 * 33], s[3 * 33]); o.z = pk2(s[4 * 33], s[5 * 33]); o.w = pk2(s[6 * 33], s[7 * 33]);
        *(GAS v4u*)(WT + (size_t)(n0 + n) * K + k0 + 8 * c) = o; }
    LDS_WAIT(); asm volatile("" ::: "memory");
}
struct P0Args { const float *c, *c_ctx, *norm1_g, *norm2_g, *w_mod, *b_mod, *w_in, *w_out, *w_ff1, *w_ff2, *cache_k, *cache_v; unsigned char* ws; };
constexpr int T_IN = 32 * 145, T_OUT = 32 * 64, T_F1 = 32 * 256, T_F2 = 128 * 64, T_L = T_IN + T_OUT + T_F1 + T_F2;
__device__ __forceinline__ void transpose_layer(const float* w_in, const float* w_out, const float* w_ff1, const float* w_ff2, unsigned char* ws, int l, LAS float* scr, int wi0, int wstride, int lane) {
    asm volatile("" : "+v"(lane));
    for (int wi = wi0; wi < T_L; wi += wstride) {
        int r = wi;
        if (r < T_IN) { p0_transpose_item(w_in + (size_t)l * 2048 * DIN, 2048, DIN, (bf16*)(ws + WS_WIN) + (size_t)l * DINP * 2048, scr, r, lane); continue; } r -= T_IN;
        if (r < T_OUT) { p0_transpose_item(w_out + (size_t)l * 2048 * 2048, 2048, 2048, (bf16*)(ws + WS_WOUT) + (size_t)l * 2048 * 2048, scr, r, lane); continue; } r -= T_OUT;
        if (r < T_F1) { p0_transpose_item(w_ff1 + (size_t)l * 2048 * DFF, 2048, DFF, (bf16*)(ws + WS_WFF1) + (size_t)l * DFF * 2048, scr, r, lane); continue; } r -= T_F1;
        p0_transpose_item(w_ff2 + (size_t)l * DFF * 2048, DFF, 2048, (bf16*)(ws + WS_WFF2) + (size_t)l * 2048 * DFF, scr, r, lane);
    }
}
__device__ __forceinline__ void p0_prologue(const P0Args& a, ldsp lds, int tid, int lane, int wave, int G) {
    asm volatile("" : "+v"(tid), "+v"(lane));
    LAS float* silu_t = (LAS float*)lds;
    LAS float* scr = (LAS float*)(lds + 73728 + wave * 8448);
    constexpr int N_MOD = 96;
    constexpr int N_CVT = 512, N_ROPE = 256, N_ITEMS = N_MOD + N_CVT + N_ROPE;
    if ((int)blockIdx.x < N_MOD) {
        for (int i = tid; i < 9 * 2048; i += NWAVES * 64) { const float x = i < 8 * 2048 ? a.c[i] : a.c_ctx[i - 8 * 2048]; silu_t[i] = x / (1.f + expf(-x)); }
        __syncthreads();
    }
    float* MOD = (float*)(a.ws + WS_MOD);
    for (int it = blockIdx.x; it < N_ITEMS; it += G) {
        if (it < N_MOD) {
            const int wi = it * 8 + wave, l = wi / 192, cb = wi % 192, j = cb * 64 + lane;
            float acc[9];
#pragma unroll
            for (int c = 0; c < 9; ++c) acc[c] = 0.f;
            const float* wp = a.w_mod + (size_t)l * 2048 * 12288 + j;
            for (int k0 = 0; k0 < 2048; k0 += 32) {
                float w[32];
#pragma unroll
                for (int i = 0; i < 32; ++i) w[i] = wp[(size_t)(k0 + i) * 12288];
#pragma unroll
                for (int c = 0; c < 9; ++c)
#pragma unroll
                    for (int i4 = 0; i4 < 8; ++i4) { const f32x4 s = *(const LAS f32x4*)(silu_t + c * 2048 + k0 + 4 * i4);
                        acc[c] += s.x * w[4 * i4] + s.y * w[4 * i4 + 1] + s.z * w[4 * i4 + 2] + s.w * w[4 * i4 + 3]; }
            }
            const int slot = j >> 11, col = j & 2047; const float bm = a.b_mod[l * 12288 + j];
            const float gn = slot == 1 ? a.norm1_g[l * 2048 + col] : (slot == 4 ? a.norm2_g[l * 2048 + col] : 0.f);
#pragma unroll
            for (int c = 0; c < 9; ++c) { float v = acc[c] + bm; if (slot == 1 || slot == 4) v = gn * (1.f + v); MOD[(size_t)(l * 9 + c) * 12288 + j] = v; }
        } else if (it < N_MOD + N_CVT) {
            const int ci = it - N_MOD;
#pragma unroll
            for (int s = 0; s < 4; ++s) { const size_t e8 = (size_t)ci * 2048 + s * 512 + tid; const bool isv = e8 >= 524288; const size_t j8 = isv ? e8 - 524288 : e8;
                const float* src = (isv ? a.cache_v : a.cache_k) + j8 * 8; const f32x4 x0 = *(const f32x4*)src, x1 = *(const f32x4*)(src + 4);
                v4u o; o.x = pk2(x0.x, x0.y); o.y = pk2(x0.z, x0.w); o.z = pk2(x1.x, x1.y); o.w = pk2(x1.z, x1.w);
                *(v4u*)((bf16*)(a.ws + (isv ? WS_CV : WS_CK)) + j8 * 8) = o; }
        } else {
            const int e = (it - N_MOD - N_CVT) * 512 + tid, t = e >> 6, i = e & 63;
            const float inv = powf(10000.f, -(float)(2 * (i & 31)) / 64.f); const float pos = i < 32 ? (float)(t >> 6) : (float)(t & 63); const float ang = pos * inv;
            ((float*)(a.ws + WS_ROPE))[e] = cosf(ang); ((float*)(a.ws + WS_ROPE))[131072 + e] = sinf(ang);
        }
    }
#pragma unroll 1
    for (int l = 0; l < DEPTH; ++l) transpose_layer(a.w_in, a.w_out, a.w_ff1, a.w_ff2, a.ws, l, scr, blockIdx.x * NWAVES + wave, G * NWAVES, lane);
}
__device__ __forceinline__ void p0b_bias(unsigned char* ws, ldsp lds, int tid, int lane, int wave, int G) {
    asm volatile("" : "+v"(tid), "+v"(lane));
    LAS float* sh = (LAS float*)lds;
    const float* MOD = (const float*)(ws + WS_MOD); float* BW = (float*)(ws + WS_BW);
    constexpr int NB1 = DINP / 64, NB2 = DFF / 64, NBL = NB1 + NB2;
    int cur = -1;
    for (int it = blockIdx.x; it < DEPTH * NBL; it += G) {
        const int l = it / NBL, r = it % NBL, which = r >= NB1 ? 1 : 0, rb = which ? r - NB1 : r, key = l * 2 + which;
        if (key != cur) { __syncthreads(); cur = key;
            for (int i = tid; i < 9 * 2048; i += NWAVES * 64) sh[i] = MOD[(size_t)(l * 9 + (i >> 11)) * 12288 + (which ? 3 : 0) * 2048 + (i & 2047)];
            __syncthreads(); }
        const bf16* WT = which ? (const bf16*)(ws + WS_WFF1) + (size_t)l * DFF * 2048 : (const bf16*)(ws + WS_WIN) + (size_t)l * DINP * 2048;
        const int ldb = which ? DFF : DINP; float* bwp = BW + (size_t)l * BW_L + (which ? 9 * DINP : 0);
#pragma unroll 1
        for (int rr = 0; rr < 8; ++rr) { const int n = rb * 64 + wave * 8 + rr; const bf16* wr_ = WT + (size_t)n * 2048 + lane * 8;
            float w[32];
#pragma unroll
            for (int j = 0; j < 4; ++j) { const v4u q = *(const v4u*)(wr_ + 512 * j); w[8 * j] = bflo(q.x); w[8 * j + 1] = bfhi(q.x); w[8 * j + 2] = bflo(q.y); w[8 * j + 3] = bfhi(q.y); w[8 * j + 4] = bflo(q.z); w[8 * j + 5] = bfhi(q.z); w[8 * j + 6] = bflo(q.w); w[8 * j + 7] = bfhi(q.w); }
            float res = 0.f;
#pragma unroll 1
            for (int c = 0; c < 9; ++c) { float s = 0.f;
#pragma unroll
                for (int j = 0; j < 4; ++j) { const f32x4 s0 = *(const LAS f32x4*)(sh + c * 2048 + 512 * j + lane * 8), s1 = *(const LAS f32x4*)(sh + c * 2048 + 512 * j + lane * 8 + 4);
                    s += s0.x * w[8 * j] + s0.y * w[8 * j + 1] + s0.z * w[8 * j + 2] + s0.w * w[8 * j + 3] + s1.x * w[8 * j + 4] + s1.y * w[8 * j + 5] + s1.z * w[8 * j + 6] + s1.w * w[8 * j + 7]; }
                s = wave_sum(s); res = (lane == c) ? s : res; }
            if (lane < 9) bwp[(size_t)lane * ldb + n] = res; }
    }
    __syncthreads();
}

template <bool FINAL>
__device__ __forceinline__ void norm_phase(const float* x0, const float* x1, const float* modA, bf16* xa, float* ssq, float* outf, int lane, int wave, int G) {
    asm volatile("" : "+v"(lane)); asm volatile("" : "+s"(wave), "+s"(G));
    const int rpw = (M + G - 1) / G, r0 = blockIdx.x * rpw, r1 = min(M, r0 + rpw);
    f32x4 A[8]; int cur = -1;
    for (int r = r0 + wave; r < r1; r += NWAVES) {
        const int cond = FINAL ? 0 : (r < NCTX ? 8 : ((r - NCTX) >> 11));
        if (cond != cur) { cur = cond;
#pragma unroll
            for (int j = 0; j < 8; ++j) A[j] = *(const f32x4*)(modA + (size_t)cond * 12288 + 4 * lane + 256 * j); }
        const float* xr = r < NCTX ? x0 + (size_t)r * D : x1 + (size_t)(r - NCTX) * D;
        f32x4 v[8]; float ss = 0.f;
#pragma unroll
        for (int j = 0; j < 8; ++j) { v[j] = *(const f32x4*)(xr + 4 * lane + 256 * j); ss += (v[j].x * v[j].x + v[j].y * v[j].y) + (v[j].z * v[j].z + v[j].w * v[j].w); }
        ss = wave_sum(ss);
        if (FINAL) { const float rstd = rsqrtf(ss * (1.f / D) + EPS);
#pragma unroll
            for (int j = 0; j < 8; ++j) *(f32x4*)(outf + (size_t)r * D + 4 * lane + 256 * j) = v[j] * rstd * A[j];
        } else {
#pragma unroll
            for (int j = 0; j < 8; ++j) { const f32x4 y = v[j] * A[j]; v2u o; o.x = pk2(y.x, y.y); o.y = pk2(y.z, y.w); *(v2u*)(xa + (size_t)r * D + 4 * lane + 256 * j) = o; }
            if (lane == 0) ssq[r] = ss;
        }
    }
}

constexpr int P_KT = 0, P_QT = 17408, P_KTT = 34816, P_VT = 53248, P_T1 = 71680, P_T2 = 71680 + 18432, P_AM = 108544, P_GL = 141312;
struct LayerP { const float *conv_w, *a_log, *dt_bias, *dn_norm_g, *sgu_norm_g, *sgu_w, *sgu_b, *sink; };
__device__ __forceinline__ void dn_prep_unit(const LayerP& P, const bf16* zb, unsigned char* dn, ldsp lds, int gchunk, int h, int tid, int lane, int wave) {
    asm volatile("" : "+v"(tid), "+v"(lane));
    const bool isctx = gchunk < 64; const int pc = isctx ? (gchunk & 3) : ((gchunk - 64) & 31); const int T = isctx ? 256 : 2048;
    const long grow0 = (long)gchunk * 64; unsigned char* blk = dn + (size_t)(gchunk * 4 + h) * DN_BLK;
    LAS float* GL = (LAS float*)(lds + P_GL);
    if (wave == 0) {
        const bf16* zr = zb + (size_t)(grow0 + lane) * DINP + C_DAB;
#pragma unroll
        for (int d = 0; d < 2; ++d) {
            const float alpha = bf2f(zr[d * 8 + h]), braw = bf2f(zr[d * 8 + 4 + h]);
            const float xr = alpha + P.dt_bias[d * 4 + h]; const float sp = fmaxf(xr, 0.f) + log1pf(expf(-fabsf(xr)));
            const float g = -expf(P.a_log[d * 4 + h]) * sp; const float beta = 1.f / (1.f + expf(-braw));
            float gc = g;
#pragma unroll
            for (int o = 1; o < 64; o <<= 1) { const float t = (d == 0) ? __shfl_up(gc, o) : __shfl_down(gc, o); const bool ok = (d == 0) ? (lane >= o) : (lane + o < 64); gc += ok ? t : 0.f; }
            const float gl = wave_sum(g); const float eg = expf(gc), egl = expf(gl - gc);
            GL[d * 64 + lane] = gc; GL[128 + d * 64 + lane] = beta; GL[256 + d * 64 + lane] = beta * eg;
            float* gv = (float*)(blk + DN_DIR0 + d * DN_DIRSZ + 40960);
            gv[lane] = eg; gv[64 + lane] = egl; if (lane == 0) gv[128] = expf(gl);
        }
    }
    {
        const float* cw = P.conv_w; const int cq = h * 128 + 2 * lane;
        f32x2 wq[5], wk[5], wv[5];
#pragma unroll
        for (int j = 0; j < 5; ++j) { wq[j] = *(const f32x2*)(cw + j * 1536 + cq); wk[j] = *(const f32x2*)(cw + j * 1536 + 512 + cq); wv[j] = *(const f32x2*)(cw + j * 1536 + 1024 + cq); }
        unsigned xq[12], xk[12], xv[12];
#pragma unroll
        for (int rr = 0; rr < 12; ++rr) { const int tl = 8 * wave - 2 + rr, tpos = pc * 64 + tl; const bool ok = tpos >= 0 && tpos < T;
            const bf16* zr = zb + (grow0 + tl) * (long)DINP + h * 128 + 2 * lane;
            xq[rr] = ok ? *(const unsigned*)(zr + C_DQ) : 0u; xk[rr] = ok ? *(const unsigned*)(zr + C_DK) : 0u; xv[rr] = ok ? *(const unsigned*)(zr + C_DV) : 0u; }
        float k0s[8], k1s[8], v0s[8], v1s[8];
        LAS bf16* Kt = (LAS bf16*)(lds + P_KT); LAS bf16* Qt = (LAS bf16*)(lds + P_QT);
#pragma unroll
        for (int tt = 0; tt < 8; ++tt) {
            float q0 = 0.f, q1 = 0.f, k0 = 0.f, k1 = 0.f, v0 = 0.f, v1 = 0.f;
#pragma unroll
            for (int j = 0; j < 5; ++j) { q0 += bflo(xq[tt + j]) * wq[j].x; q1 += bfhi(xq[tt + j]) * wq[j].y; k0 += bflo(xk[tt + j]) * wk[j].x; k1 += bfhi(xk[tt + j]) * wk[j].y;
                v0 += bflo(xv[tt + j]) * wv[j].x; v1 += bfhi(xv[tt + j]) * wv[j].y; }
            q0 = silu_f(q0); q1 = silu_f(q1); k0 = silu_f(k0); k1 = silu_f(k1); v0 = silu_f(v0); v1 = silu_f(v1);
            const float rq = rsqrtf(wave_sum(q0 * q0 + q1 * q1) + EPS) * 0.08838834764831845f, rk = rsqrtf(wave_sum(k0 * k0 + k1 * k1) + EPS);
            q0 *= rq; q1 *= rq; k0 *= rk; k1 *= rk;
            const int t = 8 * wave + tt;
            *(LAS unsigned*)(Qt + t * 136 + 2 * lane) = pk2(q0, q1); *(LAS unsigned*)(Kt + t * 136 + 2 * lane) = pk2(k0, k1);
            k0s[tt] = k0; k1s[tt] = k1; v0s[tt] = v0; v1s[tt] = v1;
        }
        LAS bf16* KT = (LAS bf16*)(lds + P_KTT); LAS bf16* VT = (LAS bf16*)(lds + P_VT);
        v4u o;
        o.x = pk2(k0s[0], k0s[1]); o.y = pk2(k0s[2], k0s[3]); o.z = pk2(k0s[4], k0s[5]); o.w = pk2(k0s[6], k0s[7]); *(LAS v4u*)(KT + (2 * lane) * 72 + 8 * wave) = o;
        o.x = pk2(k1s[0], k1s[1]); o.y = pk2(k1s[2], k1s[3]); o.z = pk2(k1s[4], k1s[5]); o.w = pk2(k1s[6], k1s[7]); *(LAS v4u*)(KT + (2 * lane + 1) * 72 + 8 * wave) = o;
        o.x = pk2(v0s[0], v0s[1]); o.y = pk2(v0s[2], v0s[3]); o.z = pk2(v0s[4], v0s[5]); o.w = pk2(v0s[6], v0s[7]); *(LAS v4u*)(VT + (2 * lane) * 72 + 8 * wave) = o;
        o.x = pk2(v1s[0], v1s[1]); o.y = pk2(v1s[2], v1s[3]); o.z = pk2(v1s[4], v1s[5]); o.w = pk2(v1s[6], v1s[7]); *(LAS v4u*)(VT + (2 * lane + 1) * 72 + 8 * wave) = o;
    }
    __syncthreads();
    {
        const int hh = lane >> 5, cl = lane & 31; LAS float* AM = (LAS float*)(lds + P_AM);
        f32x16 acc = {};
        if (wave < 4) {
            const int rt = wave >> 1, ct = wave & 1;
            acc = mma_lds(lds + P_KT + 32 * rt * 272, 272, lds + P_KT + 32 * ct * 272, 272, 8, lane, acc);
            const int c = 32 * ct + cl; const float g0c = GL[c], g1c = GL[64 + c];
#pragma unroll
            for (int r = 0; r < 16; ++r) { const int rr = 32 * rt + crow(r, hh); const float v = acc[r];
                if (rr > c) AM[rr * 64 + c] = GL[128 + rr] * v * expf(GL[rr] - g0c);
                if (rr < c) AM[4096 + (63 - rr) * 64 + (63 - c)] = GL[192 + rr] * v * expf(GL[64 + rr] - g1c); }
        } else {
            const int cb = (wave - 4) >> 1, it = (wave - 4) & 1;
            acc = mma_lds(lds + P_KT + 32 * cb * 272, 272, lds + P_QT + 32 * it * 272, 272, 8, lane, acc);
            const int i = 32 * it + cl; const float g0i = GL[i], g1i = GL[64 + i];
            f32x16 a0, a1;
#pragma unroll
            for (int r = 0; r < 16; ++r) { const int c = 32 * cb + crow(r, hh); const float v = acc[r];
                a0[r] = (i >= c) ? v * expf(fminf(g0i - GL[c], 0.f)) : 0.f; a1[r] = (i <= c) ? v * expf(fminf(g1i - GL[64 + c], 0.f)) : 0.f; }
            unsigned char* q0p = blk + DN_DIR0 + 32768 + ((cb * 2 + it) * 2) * 1024 + lane * 16; unsigned char* q1p = q0p + DN_DIRSZ;
            *(bf16x8*)(q0p) = pack8<0>(a0); *(bf16x8*)(q0p + 1024) = pack8<1>(a0); *(bf16x8*)(q1p) = pack8<0>(a1); *(bf16x8*)(q1p + 1024) = pack8<1>(a1);
        }
    }
    __syncthreads();
    if (wave < 2) {
        const int dir = wave; const LAS float* Am = (const LAS float*)(lds + P_AM) + dir * 4096;
        float Tr[64];
#pragma unroll
        for (int i = 0; i < 64; ++i) {
            float a0 = (lane == i) ? 1.f : 0.f, a1 = 0.f, a2 = 0.f, a3 = 0.f;
#pragma unroll
            for (int jb = 0; jb < i; jb += 4) { const f32x4 a4 = *(const LAS f32x4*)(Am + i * 64 + jb);
                if (jb + 0 < i) a0 -= a4.x * Tr[jb + 0]; if (jb + 1 < i) a1 -= a4.y * Tr[jb + 1]; if (jb + 2 < i) a2 -= a4.z * Tr[jb + 2]; if (jb + 3 < i) a3 -= a4.w * Tr[jb + 3]; }
            Tr[i] = (a0 + a1) + (a2 + a3); asm volatile("" ::: "memory");
        }
        const int j = dir ? 63 - lane : lane; const float s1 = GL[256 + dir * 64 + j], s2 = GL[128 + dir * 64 + j];
        LAS bf16* T1 = (LAS bf16*)(lds + P_T1) + dir * 4608; LAS bf16* T2 = (LAS bf16*)(lds + P_T2) + dir * 4608;
#pragma unroll
        for (int ii = 0; ii < 64; ++ii) { const int i = dir ? 63 - ii : ii; T1[i * 72 + j] = (bf16)(pk2(Tr[ii] * s1, 0.f) & 0xffffu); T2[i * 72 + j] = (bf16)(pk2(Tr[ii] * s2, 0.f) & 0xffffu); }
    } else {
        const int hh = lane >> 5, rl = lane & 31;
        for (int b = wave - 2; b < 32; b += 6) {
            v2u lo, hi;
            if (b < 16) { const int it = b >> 3, db = (b >> 1) & 3, s = b & 1; const LAS bf16* p = (const LAS bf16*)(lds + P_QT) + (32 * it + rl) * 136 + 32 * db + 16 * s + 4 * hh; lo = *(const LAS v2u*)p; hi = *(const LAS v2u*)(p + 8); }
            else { const int bb = b - 16, dt = bb >> 2, cb = (bb >> 1) & 1, s = bb & 1; const LAS bf16* p = (const LAS bf16*)(lds + P_KTT) + (32 * dt + rl) * 72 + 32 * cb + 16 * s + 4 * hh; lo = *(const LAS v2u*)p; hi = *(const LAS v2u*)(p + 8); }
            v4u o; o.x = lo.x; o.y = lo.y; o.z = hi.x; o.w = hi.y;
            *(v4u*)(blk + (size_t)b * 1024 + lane * 16) = o;
        }
    }
    __syncthreads();
#pragma unroll 1
    for (int tix = wave; tix < 32; tix += 8) {
        const int dir = tix >> 4, kind = (tix >> 3) & 1, idx = tix & 7; f32x16 acc = {};
        unsigned char* dst;
        if (kind == 0) { const int ct = idx >> 2, es = idx & 3;
            acc = mma_lds(lds + P_T2 + dir * 9216 + 32 * ct * 144, 144, lds + P_VT + 32 * es * 144, 144, 4, lane, acc);
            dst = blk + DN_DIR0 + dir * DN_DIRSZ + ((ct * 4 + es) * 2) * 1024 + lane * 16;
        } else { const int db = idx >> 1, ct = idx & 1;
            acc = mma_lds(lds + P_KTT + 32 * db * 144, 144, lds + P_T1 + dir * 9216 + 32 * ct * 144, 144, 4, lane, acc);
#pragma unroll
            for (int r = 0; r < 16; ++r) acc[r] = -acc[r];
            dst = blk + DN_DIR0 + dir * DN_DIRSZ + 16384 + ((db * 2 + ct) * 2) * 1024 + lane * 16;
        }
        *(bf16x8*)dst = pack8<0>(acc); *(bf16x8*)(dst + 1024) = pack8<1>(acc);
    }
    __syncthreads();
}

__device__ __forceinline__ void sgu_unit(const LayerP& P, const bf16* zb, bf16* mix, ldsp lds, int rc, int g, int tid, int lane, int wave) {
    asm volatile("" : "+v"(tid), "+v"(lane));
    const size_t grow0 = (size_t)rc * 128; LAS bf16* Wl = (LAS bf16*)lds; LAS bf16* Vt = (LAS bf16*)(lds + 34816);
    {
        const float gn0 = P.sgu_norm_g[g * 128 + 2 * lane], gn1 = P.sgu_norm_g[g * 128 + 2 * lane + 1];
        float v0[16], v1[16];
#pragma unroll
        for (int qq = 0; qq < 16; ++qq) { const unsigned w = *(const unsigned*)(zb + (grow0 + 16 * wave + qq) * DINP + C_SV + g * 128 + 2 * lane);
            const float a = gelu_tanh(bflo(w)), b = gelu_tanh(bfhi(w)); const float r = rsqrtf(wave_sum(a * a + b * b) * (1.f / 128.f) + EPS); v0[qq] = a * r * gn0; v1[qq] = b * r * gn1; }
        v4u o;
        o.x = pk2(v0[0], v0[1]); o.y = pk2(v0[2], v0[3]); o.z = pk2(v0[4], v0[5]); o.w = pk2(v0[6], v0[7]); *(LAS v4u*)(Vt + (2 * lane) * 136 + 16 * wave) = o;
        o.x = pk2(v0[8], v0[9]); o.y = pk2(v0[10], v0[11]); o.z = pk2(v0[12], v0[13]); o.w = pk2(v0[14], v0[15]); *(LAS v4u*)(Vt + (2 * lane) * 136 + 16 * wave + 8) = o;
        o.x = pk2(v1[0], v1[1]); o.y = pk2(v1[2], v1[3]); o.z = pk2(v1[4], v1[5]); o.w = pk2(v1[6], v1[7]); *(LAS v4u*)(Vt + (2 * lane + 1) * 136 + 16 * wave) = o;
        o.x = pk2(v1[8], v1[9]); o.y = pk2(v1[10], v1[11]); o.z = pk2(v1[12], v1[13]); o.w = pk2(v1[14], v1[15]); *(LAS v4u*)(Vt + (2 * lane + 1) * 136 + 16 * wave + 8) = o;
    }
    {
        const int p = tid >> 2, q0 = (tid & 3) * 32; const float* src = P.sgu_w + ((size_t)g * 128 + p) * 128 + q0;
#pragma unroll
        for (int j = 0; j < 4; ++j) { const f32x4 x0 = *(const f32x4*)(src + 8 * j), x1 = *(const f32x4*)(src + 8 * j + 4);
            v4u o; o.x = pk2(x0.x, x0.y); o.y = pk2(x0.z, x0.w); o.z = pk2(x1.x, x1.y); o.w = pk2(x1.z, x1.w); *(LAS v4u*)(Wl + p * 136 + q0 + 8 * j) = o; }
    }
    __syncthreads();
    {
        const int pt = wave >> 1, hh = lane >> 5, cl = lane & 31;
#pragma unroll
        for (int cc = 0; cc < 2; ++cc) { const int ct = 2 * (wave & 1) + cc; f32x16 acc = {};
            acc = mma_lds(lds + 32 * pt * 272, 272, lds + 34816 + 32 * ct * 272, 272, 8, lane, acc);
            const int c = 32 * ct + cl;
#pragma unroll
            for (int r = 0; r < 16; ++r) { const int p = 32 * pt + crow(r, hh); const size_t row = grow0 + p;
                const float su = bf2f(zb[row * DINP + C_SU + g * 128 + c]); const float o = gelu_tanh(su) * (acc[r] + P.sgu_b[g * 128 + p]);
                mix[row * D + 1536 + g * 128 + c] = (bf16)(pk2(o, 0.f) & 0xffffu); } }
    }
    __syncthreads();
}

__device__ __forceinline__ void rope_item(bf16* zb, const float* ropet, int ri, int lane, int wave) {
    asm volatile("" : "+v"(lane));
#pragma unroll 1
    for (int tt = wave; tt < 64; tt += 8) {
        const int tl = ri * 64 + tt, t = tl & 2047; bf16* zr = zb + (size_t)(NCTX + tl) * DINP;
        const int hf = (lane >> 4) & 1, ip = (lane & 15) * 2; const f32x2 cs = *(const f32x2*)(ropet + t * 64 + 32 * hf + ip), sn = *(const f32x2*)(ropet + 131072 + t * 64 + 32 * hf + ip);
#pragma unroll
        for (int ps = 0; ps < 5; ++ps) { const int hv = ps * 2 + (lane >> 5); bf16* p = zr + (hv < 8 ? C_AQ + hv * 128 : C_AK + (hv - 8) * 128) + 64 * hf + ip;
            const unsigned wa = *(const unsigned*)p, wb = *(const unsigned*)(p + 32); const float a0 = bflo(wa), a1 = bfhi(wa), b0 = bflo(wb), b1 = bfhi(wb);
            *(unsigned*)p = pk2(a0 * cs.x - b0 * sn.x, a1 * cs.y - b1 * sn.y); *(unsigned*)(p + 32) = pk2(b0 * cs.x + a0 * sn.x, b1 * cs.y + a1 * sn.y); }
    }
}

constexpr int SC_BUF = 58368, SC_XCH = 116736;
__device__ __forceinline__ void glds16(const void* g, ldsp l) { __builtin_amdgcn_global_load_lds((const unsigned*)g, (LAS unsigned*)l, 16, 0, 0); }
__device__ __forceinline__ void scan_dma(const unsigned char* blk, int dir, ldsp buf, int lane, int wave) {
    const unsigned char* db = blk + DN_DIR0 + dir * DN_DIRSZ;
#pragma unroll
    for (int i = 0; i < 8; ++i) { const int k = wave + 8 * i; if (k >= 57) break;
        const unsigned char* src = k < 16 ? db + 16384 + k * 1024 : (k < 32 ? blk + (k - 16) * 1024 : (k < 40 ? db + 32768 + (k - 32) * 1024 : (k < 56 ? blk + 16384 + (k - 40) * 1024 : db + 40960)));
        glds16(src + lane * 16, buf + k * 1024);
    }
}
__device__ __forceinline__ void scan_chain(const unsigned char* dn, const float* state0, float* state_out, float* odir, ldsp lds, int isctx, int b, int h, int dir, int lane, int wave) {
    asm volatile("" : "+v"(lane));
    const int es = wave & 3, ch = wave >> 2, hh = lane >> 5, cl = lane & 31; const int nch = isctx ? 4 : 32; const int gch0 = isctx ? b * 4 : 64 + b * 32;
    f32x16 S[4];
#pragma unroll
    for (int db = 0; db < 4; ++db)
#pragma unroll
        for (int r = 0; r < 16; ++r) S[db][r] = state0 ? state0[(size_t)(32 * db + crow(r, hh)) * 128 + 32 * es + cl] : 0.f;
#define BLKOF(n) (dn + (size_t)((gch0 + (dir ? nch - 1 - (n) : (n))) * 4 + h) * DN_BLK)
    bf16x8 Un0, Un1;
    { const unsigned char* blk = BLKOF(0); scan_dma(blk, dir, lds, lane, wave);
      const unsigned char* up = blk + DN_DIR0 + dir * DN_DIRSZ + ((ch * 4 + es) * 2) * 1024 + lane * 16; Un0 = *(const bf16x8*)up; Un1 = *(const bf16x8*)(up + 1024); }
#pragma unroll 1
    for (int n = 0; n < nch; ++n) {
        VM_WAIT(); __builtin_amdgcn_s_barrier(); asm volatile("" ::: "memory");
        const bf16x8 U0 = Un0, U1 = Un1;
        if (n + 1 < nch) { const unsigned char* blk = BLKOF(n + 1); scan_dma(blk, dir, lds + ((n + 1) & 1) * SC_BUF, lane, wave);
            const unsigned char* up = blk + DN_DIR0 + dir * DN_DIRSZ + ((ch * 4 + es) * 2) * 1024 + lane * 16; Un0 = *(const bf16x8*)up; Un1 = *(const bf16x8*)(up + 1024); }
        ldsp buf = lds + (n & 1) * SC_BUF; ldsp fl = buf + lane * 16;
        bf16x8 Sb[4][2];
#pragma unroll
        for (int db = 0; db < 4; ++db) { Sb[db][0] = pack8<0>(S[db]); Sb[db][1] = pack8<1>(S[db]); }
        f32x16 vn;
        { const v4u a = __builtin_bit_cast(v4u, U0), c = __builtin_bit_cast(v4u, U1);
          vn[0] = bflo(a.x); vn[1] = bfhi(a.x); vn[2] = bflo(a.y); vn[3] = bfhi(a.y); vn[4] = bflo(a.z); vn[5] = bfhi(a.z); vn[6] = bflo(a.w); vn[7] = bfhi(a.w);
          vn[8] = bflo(c.x); vn[9] = bfhi(c.x); vn[10] = bflo(c.y); vn[11] = bfhi(c.y); vn[12] = bflo(c.z); vn[13] = bfhi(c.z); vn[14] = bflo(c.w); vn[15] = bfhi(c.w); }
#pragma unroll
        for (int db = 0; db < 4; ++db)
#pragma unroll
            for (int s = 0; s < 2; ++s) { const bf16x8 a = *(const LAS bf16x8*)(fl + ((db * 2 + ch) * 2 + s) * 1024); vn = __builtin_amdgcn_mfma_f32_32x32x16_bf16(a, Sb[db][s], vn, 0, 0, 0); }
        { const LAS float* egl = (const LAS float*)(buf + 57344 + 256) + 32 * ch + 4 * hh; f32x16 vs;
#pragma unroll
          for (int q = 0; q < 4; ++q) { const f32x4 e = *(const LAS f32x4*)(egl + 8 * q); vs[4 * q] = vn[4 * q] * e.x; vs[4 * q + 1] = vn[4 * q + 1] * e.y; vs[4 * q + 2] = vn[4 * q + 2] * e.z; vs[4 * q + 3] = vn[4 * q + 3] * e.w; }
          ldsp xw = lds + SC_XCH + ((es * 2 + ch) * 4) * 1024 + lane * 16;
          *(LAS bf16x8*)(xw) = pack8<0>(vn); *(LAS bf16x8*)(xw + 1024) = pack8<1>(vn); *(LAS bf16x8*)(xw + 2048) = pack8<0>(vs); *(LAS bf16x8*)(xw + 3072) = pack8<1>(vs); }
        f32x16 oa = {};
#pragma unroll
        for (int db = 0; db < 4; ++db)
#pragma unroll
            for (int s = 0; s < 2; ++s) { const bf16x8 a = *(const LAS bf16x8*)(fl + 16384 + ((ch * 4 + db) * 2 + s) * 1024); oa = __builtin_amdgcn_mfma_f32_32x32x16_bf16(a, Sb[db][s], oa, 0, 0, 0); }
        { const LAS float* eg = (const LAS float*)(buf + 57344) + 32 * ch + 4 * hh;
#pragma unroll
          for (int q = 0; q < 4; ++q) { const f32x4 e = *(const LAS f32x4*)(eg + 8 * q); oa[4 * q] *= e.x; oa[4 * q + 1] *= e.y; oa[4 * q + 2] *= e.z; oa[4 * q + 3] *= e.w; } }
        LDS_WAIT(); __builtin_amdgcn_s_barrier(); asm volatile("" ::: "memory");
        bf16x8 V1[2][2], V2[2][2];
#pragma unroll
        for (int cb = 0; cb < 2; ++cb) { ldsp xr = lds + SC_XCH + ((es * 2 + cb) * 4) * 1024 + lane * 16;
            V1[cb][0] = *(const LAS bf16x8*)(xr); V1[cb][1] = *(const LAS bf16x8*)(xr + 1024); V2[cb][0] = *(const LAS bf16x8*)(xr + 2048); V2[cb][1] = *(const LAS bf16x8*)(xr + 3072); }
#pragma unroll
        for (int cb = 0; cb < 2; ++cb)
#pragma unroll
            for (int s = 0; s < 2; ++s) { const bf16x8 a = *(const LAS bf16x8*)(fl + 32768 + ((cb * 2 + ch) * 2 + s) * 1024); oa = __builtin_amdgcn_mfma_f32_32x32x16_bf16(a, V1[cb][s], oa, 0, 0, 0); }
        { const int pc = dir ? nch - 1 - n : n; float* op = odir + ((size_t)(gch0 + pc) * 64 + 32 * ch) * 512 + h * 128 + 32 * es + cl;
#pragma unroll
          for (int r = 0; r < 16; ++r) op[(size_t)crow(r, hh) * 512] = oa[r]; }
        { const float gl = *(const LAS float*)(buf + 57344 + 512);
#pragma unroll
          for (int db = 0; db < 4; ++db) {
#pragma unroll
              for (int r = 0; r < 16; ++r) S[db][r] *= gl;
#pragma unroll
              for (int cb = 0; cb < 2; ++cb)
#pragma unroll
                  for (int s = 0; s < 2; ++s) { const bf16x8 a = *(const LAS bf16x8*)(fl + 40960 + ((db * 2 + cb) * 2 + s) * 1024); S[db] = __builtin_amdgcn_mfma_f32_32x32x16_bf16(a, V2[cb][s], S[db], 0, 0, 0); } } }
    }
    if (state_out && ch == 0) {
#pragma unroll
        for (int db = 0; db < 4; ++db)
#pragma unroll
            for (int r = 0; r < 16; ++r) state_out[(size_t)(32 * db + crow(r, hh)) * 128 + 32 * es + cl] = S[db][r];
    }
    VM_WAIT(); LDS_WAIT(); __builtin_amdgcn_s_barrier(); asm volatile("" ::: "memory");
#undef BLKOF
}

#define KSWZ(row, colB) ((row) * 256 + ((colB) ^ (((row) & 7) << 4)))
#define SBAR() __builtin_amdgcn_sched_barrier(0)
__device__ __forceinline__ int v_st(int k, int c) { const int kk = (k & ~0xC) | ((k & 4) << 1) | ((k & 8) >> 1); return ((kk >> 3) * 4 + (c >> 5)) * 512 + ((kk & 7) * 32 + (c & 31)) * 2; }
__device__ __forceinline__ int v_rd_base(int lane) { return ((lane & 3) << 3) | (((lane >> 2) & 3) << 6) | (((lane >> 4) & 1) << 5) | (((lane >> 5) & 1) << 8); }
constexpr int v_rd_off(int d0, int ks, int half) { return d0 * 512 + ks * 4096 + half * 2048; }
template <int OFF> __device__ __forceinline__ s16x4 tr_read(int vb) { s16x4 r; asm volatile("ds_read_b64_tr_b16 %0, %1 offset:%2" : "=&v"(r) : "v"(vb), "i"(OFF) : "memory"); return r; }
template <int D0> __device__ __forceinline__ void pv_one(f32x16& od, int vb, bf16x8 pa0, bf16x8 pa1, bf16x8 pa2, bf16x8 pa3) {
    const s16x4 l0 = tr_read<v_rd_off(D0, 0, 0)>(vb), h0 = tr_read<v_rd_off(D0, 0, 1)>(vb), l1 = tr_read<v_rd_off(D0, 1, 0)>(vb), h1 = tr_read<v_rd_off(D0, 1, 1)>(vb);
    const s16x4 l2 = tr_read<v_rd_off(D0, 2, 0)>(vb), h2 = tr_read<v_rd_off(D0, 2, 1)>(vb), l3 = tr_read<v_rd_off(D0, 3, 0)>(vb), h3 = tr_read<v_rd_off(D0, 3, 1)>(vb);
    asm volatile("s_waitcnt lgkmcnt(0)" ::: "memory"); SBAR();
#define PKV(L, H) (bf16x8){L[0], L[1], L[2], L[3], H[0], H[1], H[2], H[3]}
    od = __builtin_amdgcn_mfma_f32_32x32x16_bf16(pa0, PKV(l0, h0), od, 0, 0, 0);
    od = __builtin_amdgcn_mfma_f32_32x32x16_bf16(pa1, PKV(l1, h1), od, 0, 0, 0);
    od = __builtin_amdgcn_mfma_f32_32x32x16_bf16(pa2, PKV(l2, h2), od, 0, 0, 0);
    od = __builtin_amdgcn_mfma_f32_32x32x16_bf16(pa3, PKV(l3, h3), od, 0, 0, 0);
#undef PKV
}
__device__ __forceinline__ void qkt(f32x16& p0, f32x16& p1, ldsp Ks, const bf16x8* qr, int r32, int hi) {
    p0 = f32x16{}; p1 = f32x16{};
#pragma unroll
    for (int d0 = 0; d0 < 8; ++d0) { const int cb = (d0 * 16 + hi * 8) * 2;
        const bf16x8 b0 = *(const LAS bf16x8*)(Ks + KSWZ(r32, cb)); const bf16x8 b1 = *(const LAS bf16x8*)(Ks + KSWZ(32 + r32, cb));
        p0 = __builtin_amdgcn_mfma_f32_32x32x16_bf16(b0, qr[d0], p0, 0, 0, 0); p1 = __builtin_amdgcn_mfma_f32_32x32x16_bf16(b1, qr[d0], p1, 0, 0, 0); }
}
struct AttnP { const bf16* zb; const bf16* ck; const bf16* cv; bf16* mix; const float* sink; int l; };
__device__ __forceinline__ void attn_unit(const AttnP& A, ldsp lds, int u, int tid, int lane, int wave) {
    asm volatile("" : "+v"(tid), "+v"(lane));
    constexpr float C = 0.08838834764831845f * 1.4426950408889634f;
    const int r32 = lane & 31, hi = lane >> 5;
    const bool lat = u < 512; int b, head, q0, T; size_t rowbase;
    if (lat) { q0 = (u & 7) * 256; head = (u >> 3) & 7; b = u >> 6; rowbase = NCTX + (size_t)b * 2048; T = 2048; }
    else { const int uu = u - 512; head = uu & 7; b = uu >> 3; q0 = 0; rowbase = (size_t)b * 256; T = 256; }
    const int kvh = head >> 2, nct = lat ? 8 : 0;
    const int ws = lat ? max(0, q0 - 128) / 64 : 0, we = lat ? min(T, q0 + 384) / 64 : 4, NT = nct + (we - ws);
    const int qw = q0 + 32 * wave;
    ldsp V_lds = lds, K_lds = lds + 32768; LAS float* al = (LAS float*)(lds + 65536) + wave * 64;
    bf16x8 qr[8];
    { const bf16* Qw = A.zb + (rowbase + qw + r32) * DINP + C_AQ + head * 128 + hi * 8;
#pragma unroll
      for (int d0 = 0; d0 < 8; ++d0) qr[d0] = *(const bf16x8*)(Qw + d0 * 16); }
    float m_reg = A.sink[head] * 1.4426950408889634f, l_reg = 1.f; f32x16 o[4] = {};
    const int sr = tid >> 4, sc = (tid & 15) * 8, vst0 = v_st(sr, sc), vst1 = v_st(32 + sr, sc);
    const int vb0 = (int)(unsigned)(size_t)V_lds + v_rd_base(lane);
    bf16x8 ks0, ks1, vs0, vs1;
#define ALOAD(j) do { const bf16 *kp, *vp; size_t st; if ((j) < nct) { kp = A.ck + ((size_t)(b * 4 + A.l) * 512 + (j) * 64) * 256 + kvh * 128; vp = A.cv + ((size_t)(b * 4 + A.l) * 512 + (j) * 64) * 256 + kvh * 128; st = 256; } \
        else { const size_t r0 = rowbase + (size_t)(ws + (j) - nct) * 64; kp = A.zb + r0 * DINP + C_AK + kvh * 128; vp = A.zb + r0 * DINP + C_AV + kvh * 128; st = DINP; } \
        ks0 = *(const bf16x8*)(kp + sr * st + sc); ks1 = *(const bf16x8*)(kp + (32 + sr) * st + sc); vs0 = *(const bf16x8*)(vp + sr * st + sc); vs1 = *(const bf16x8*)(vp + (32 + sr) * st + sc); } while (0)
#define AWRITE(bb) do { *(LAS bf16x8*)(V_lds + (bb) * 16384 + vst0) = vs0; *(LAS bf16x8*)(V_lds + (bb) * 16384 + vst1) = vs1; \
        *(LAS bf16x8*)(K_lds + (bb) * 16384 + KSWZ(sr, sc * 2)) = ks0; *(LAS bf16x8*)(K_lds + (bb) * 16384 + KSWZ(32 + sr, sc * 2)) = ks1; } while (0)
    ALOAD(0); AWRITE(0); __syncthreads();
#pragma unroll 1
    for (int j = 0; j < NT; ++j) {
        if (j + 1 < NT) ALOAD(j + 1);
        bool active = true, needmask = false; int kpos0 = 0;
        if (lat && j >= nct) { kpos0 = (ws + j - nct) * 64; active = (kpos0 + 63 >= qw - 128) && (kpos0 <= qw + 31 + 128); needmask = !((kpos0 >= qw + 31 - 128) && (kpos0 + 63 <= qw + 128)); }
        if (active) {
            f32x16 p0, p1;
            qkt(p0, p1, K_lds + (j & 1) * 16384, qr, r32, hi);
            if (needmask) { const int q = qw + r32;
#pragma unroll
                for (int r = 0; r < 16; ++r) { const int k0 = kpos0 + crow(r, hi) - q, k1 = k0 + 32; if (k0 > 128 || k0 < -128) p0[r] = -1e30f; if (k1 > 128 || k1 < -128) p1[r] = -1e30f; } }
            float pmax = p0[0];
#pragma unroll
            for (int r = 1; r < 16; ++r) pmax = fmaxf(pmax, p0[r]);
#pragma unroll
            for (int r = 0; r < 16; ++r) pmax = fmaxf(pmax, p1[r]);
            { auto rr = __builtin_amdgcn_permlane32_swap(__float_as_uint(pmax), __float_as_uint(pmax), false, false); pmax = fmaxf(__uint_as_float(rr[0]), __uint_as_float(rr[1])); }
            const float mn = fmaxf(m_reg, pmax * C), alpha = __builtin_amdgcn_exp2f(m_reg - mn); m_reg = mn;
            float ps = 0.f;
#pragma unroll
            for (int r = 0; r < 16; ++r) { p0[r] = __builtin_amdgcn_exp2f(fmaf(p0[r], C, -mn)); p1[r] = __builtin_amdgcn_exp2f(fmaf(p1[r], C, -mn)); ps += p0[r] + p1[r]; }
            { auto rr = __builtin_amdgcn_permlane32_swap(__float_as_uint(ps), __float_as_uint(ps), false, false); ps = __uint_as_float(rr[0]) + __uint_as_float(rr[1]); }
            l_reg = l_reg * alpha + ps;
            if (__any(alpha < 1.f)) { if (hi == 0) al[r32] = alpha; LDS_WAIT();
#pragma unroll
                for (int d = 0; d < 4; ++d)
#pragma unroll
                    for (int r = 0; r < 16; ++r) o[d][r] *= al[crow(r, hi)]; }
            bf16x8 pa0, pa1, pa2, pa3;
#define PK4(P, BASE, OUT) do { unsigned a0 = pk2(P[BASE + 0], P[BASE + 1]), a1 = pk2(P[BASE + 2], P[BASE + 3]); unsigned b0 = pk2(P[BASE + 4], P[BASE + 5]), b1 = pk2(P[BASE + 6], P[BASE + 7]); \
    auto r0 = __builtin_amdgcn_permlane32_swap(a0, b0, false, false); auto r1 = __builtin_amdgcn_permlane32_swap(a1, b1, false, false); \
    v4u w = {r0[0], r1[0], r0[1], r1[1]}; OUT = __builtin_bit_cast(bf16x8, w); } while (0)
            PK4(p0, 0, pa0); PK4(p0, 8, pa1); PK4(p1, 0, pa2); PK4(p1, 8, pa3);
#undef PK4
            const int vb = vb0 + (j & 1) * 16384;
            pv_one<0>(o[0], vb, pa0, pa1, pa2, pa3); pv_one<1>(o[1], vb, pa0, pa1, pa2, pa3); pv_one<2>(o[2], vb, pa0, pa1, pa2, pa3); pv_one<3>(o[3], vb, pa0, pa1, pa2, pa3);
        }
        if (j + 1 < NT) AWRITE((j + 1) & 1);
        __syncthreads();
    }
#undef ALOAD
#undef AWRITE
    if (hi == 0) al[r32] = l_reg; LDS_WAIT();
    bf16* Ow = A.mix + (rowbase + qw) * D + head * 128 + r32;
#pragma unroll
    for (int r = 0; r < 16; ++r) { const int orow = crow(r, hi); const float rl = __builtin_amdgcn_rcpf(al[orow]);
#pragma unroll
        for (int d0 = 0; d0 < 4; ++d0) Ow[(size_t)orow * D + d0 * 32] = (bf16)(pk2(o[d0][r] * rl, 0.f) & 0xffffu); }
}

#ifndef PROBE_DUP
#define PROBE_DUP 0
#endif
struct Args { const float* in[24]; float* out; unsigned char* ws; int ph_lo, ph_hi; };
constexpr int NPH = 31;
__global__ void __launch_bounds__(NWAVES * 64, 2) fwd(Args args) {
    extern __shared__ __attribute__((aligned(16))) unsigned char lds_raw[];
    ldsp lds = (ldsp)lds_raw;
    volatile LAS unsigned* MISC = (volatile LAS unsigned*)(lds + LDSCTL_OFF);
    const int tid = threadIdx.x, lane = tid & 63, wave = __builtin_amdgcn_readfirstlane(tid >> 6), G = gridDim.x;
    unsigned char* ws = args.ws; unsigned* ctl = (unsigned*)(ws + WS_CTL);
    for (int u = tid; u < (LDS_BYTES - LDSCTL_OFF) / 4; u += NWAVES * 64) MISC[u] = 0u;
    __syncthreads();
    const int lo = args.ph_lo, hi = args.ph_hi; const bool multi = (hi - lo) > 1;
    XcdBarrier bar; bar.bar = ctl + CW_BAR; bar.x = 0; bar.st = nullptr;
    if (multi) bar = xcd_barrier_post(ctl + CW_BAR, MISC + 8);
#define IN(k) (lo <= (k) && (k) < hi)
#define DUPBAR() do { if (multi) { XcdBarrier b2_ = bar; asm volatile("" : "+s"(b2_.bar)); xcd_barrier(b2_); } } while (0)
#define SEAM(k) do { if (IN(k) && IN((k) + 1)) { XcdBarrier b2_ = bar; asm volatile("" : "+s"(b2_.bar)); xcd_barrier(b2_); } } while (0)
    const float *x_prompt = args.in[0], *x_sample = args.in[1], *cache_k = args.in[2], *cache_v = args.in[3], *state_delta = args.in[4], *c_in = args.in[5], *c_ctx = args.in[6];
    const float *norm1_g = args.in[7], *w_mod = args.in[8], *b_mod = args.in[9], *w_in = args.in[10], *conv_w = args.in[11], *attn_sink = args.in[12], *dn_a_log = args.in[13], *dn_dt_bias = args.in[14];
    const float *dn_norm_g = args.in[15], *sgu_norm_g = args.in[16], *sgu_w = args.in[17], *sgu_b = args.in[18], *w_out = args.in[19], *norm2_g = args.in[20], *w_ff1 = args.in[21], *w_ff2 = args.in[22], *final_norm_g = args.in[23];
    float* out = args.out;
    float* MOD = (float*)(ws + WS_MOD); float* XB = (float*)(ws + WS_X); bf16* HB = (bf16*)(ws + WS_HB); bf16* ZB = (bf16*)(ws + WS_ZB); bf16* FB = ZB; bf16* XA = (bf16*)(ws + WS_XA);
    float* ODIR = (float*)(ws + WS_ODIR); unsigned char* DN = ws + WS_DN; float* SSQ = (float*)(ctl + CW_SSQ); const float* BW = (const float*)(ws + WS_BW);

    if (IN(0)) {
        P0Args pa{c_in, c_ctx, norm1_g, norm2_g, w_mod, b_mod, w_in, w_out, w_ff1, w_ff2, cache_k, cache_v, ws};
        p0_prologue(pa, lds, tid, lane, wave, G);
        __syncthreads();
#if PROBE_DUP & 4
        p0_prologue(pa, lds, tid, lane, wave, G); __syncthreads();
#endif
    }
    SEAM(0);
    if (IN(1)) {
        p0b_bias(ws, lds, tid, lane, wave, G);
        norm_phase<false>(x_prompt, x_sample, MOD + 1 * 2048, XA, SSQ, nullptr, lane, wave, G);
    }
    SEAM(1);
#pragma unroll 1
    for (int l = 0; l < DEPTH; ++l) {
        const int pb = 2 + 7 * l;
        const float* modl = MOD + (size_t)l * 9 * 12288;
        const float* xa0 = l == 0 ? x_prompt : XB; const float* xa1 = l == 0 ? x_sample : XB + (size_t)NCTX * D;
        if (IN(pb + 0)) {
            const bf16* gA = XA; const bf16* gB = (const bf16*)(ws + WS_WIN) + (size_t)l * DINP * 2048; asm volatile("" : "+s"(gA), "+s"(gB));
            pg8::Gemm g{gA, gB, M, DINP, 2048}; pg8::StaticOrder S; S.init(M, DINP, G, (int)blockIdx.x);
            pg8::EpiZ E{ZB, DINP, out + O_K + (size_t)l * 65536, out + O_V + (size_t)l * 65536, SSQ + (size_t)(2 * l) * M, BW + (size_t)l * BW_L};
            pg8::gemm_phase<pg8::EpiZ, pg8::StaticOrder, true, true>(lds, g, S, E);
        }
        SEAM(pb + 0);
        LayerP LP{conv_w + (size_t)l * 5 * 1536, dn_a_log + l * 8, dn_dt_bias + l * 8, dn_norm_g + l * 128, sgu_norm_g + l * 512, sgu_w + (size_t)l * 4 * 128 * 128, sgu_b + l * 512, attn_sink + l * 8};
        if (IN(pb + 1)) {
            for (int it = blockIdx.x; it < 1280 + 640 + 256; it += G) {
                if (it < 1280) dn_prep_unit(LP, ZB, DN, lds, it >> 2, it & 3, tid, lane, wave);
                else if (it < 1920) sgu_unit(LP, ZB, HB, lds, (it - 1280) >> 2, (it - 1280) & 3, tid, lane, wave);
                else rope_item(ZB, (const float*)(ws + WS_ROPE), it - 1920, lane, wave);
            }
        }
#if PROBE_DUP & 16
        if (IN(pb + 1)) { DUPBAR();
            for (int it = blockIdx.x; it < 1280 + 640; it += G) {
                if (it < 1280) dn_prep_unit(LP, ZB, DN, lds, it >> 2, it & 3, tid, lane, wave);
                else sgu_unit(LP, ZB, HB, lds, (it - 1280) >> 2, (it - 1280) & 3, tid, lane, wave);
            } }
#endif
        SEAM(pb + 1);
        if (IN(pb + 2)) {
            for (int cu = blockIdx.x; cu < 192; cu += G) {
                const bool isctx = cu >= 64; const int cc = isctx ? cu - 64 : cu; const int b = cc >> 3, h = (cc >> 1) & 3, dir = cc & 1;
                const float* s0 = isctx ? nullptr : state_delta + ((((size_t)b * 4 + l) * 2 + dir) * 4 + h) * 16384;
                float* so = isctx ? out + O_DELTA + ((((size_t)b * 4 + l) * 2 + dir) * 4 + h) * 16384 : nullptr;
                scan_chain(DN, s0, so, ODIR + (size_t)dir * M * 512, lds, isctx ? 1 : 0, b, h, dir, lane, wave);
            }
            AttnP AP{ZB, (const bf16*)(ws + WS_CK), (const bf16*)(ws + WS_CV), HB, LP.sink, l};
            for (;;) {
                if (tid == 0) MISC[0] = atomicAdd(ctl + CW_ATT + 64 * l, 1u);
                __syncthreads(); const int u = (int)MISC[0]; __syncthreads();
                if (u >= 640) break;
                attn_unit(AP, lds, u, tid, lane, wave);
            }
        }
#if PROBE_DUP & 2
        if (IN(pb + 2)) { DUPBAR();
            for (int cu = blockIdx.x; cu < 192; cu += G) {
                const bool isctx = cu >= 64; const int cc = isctx ? cu - 64 : cu; const int b = cc >> 3, h = (cc >> 1) & 3, dir = cc & 1;
                const float* s0 = isctx ? nullptr : state_delta + ((((size_t)b * 4 + l) * 2 + dir) * 4 + h) * 16384;
                float* so = isctx ? out + O_DELTA + ((((size_t)b * 4 + l) * 2 + dir) * 4 + h) * 16384 : nullptr;
                scan_chain(DN, s0, so, ODIR + (size_t)dir * M * 512, lds, isctx ? 1 : 0, b, h, dir, lane, wave);
            }
            AttnP AP{ZB, (const bf16*)(ws + WS_CK), (const bf16*)(ws + WS_CV), HB, LP.sink, l};
            for (;;) {
                if (tid == 0) MISC[0] = atomicAdd(ctl + CW_ATT + 64 * (l + 4), 1u);
                __syncthreads(); const int u = (int)MISC[0]; __syncthreads();
                if (u >= 640) break;
                attn_unit(AP, lds, u, tid, lane, wave);
            } }
#endif
        SEAM(pb + 2);
        if (IN(pb + 3)) {
            int ln = threadIdx.x & 63; asm volatile("" : "+v"(ln));
            const float gn0 = LP.dn_norm_g[2 * ln], gn1 = LP.dn_norm_g[2 * ln + 1];
            for (int it = blockIdx.x * NWAVES + wave; it < M * 4; it += G * NWAVES) { const size_t row = it >> 2; const int hh = it & 3;
                const f32x2 a = *(const f32x2*)(ODIR + row * 512 + hh * 128 + 2 * ln), b2 = *(const f32x2*)(ODIR + (size_t)M * 512 + row * 512 + hh * 128 + 2 * ln);
                const float o0 = a.x + b2.x, o1 = a.y + b2.y; const float r = rsqrtf(wave_sum(o0 * o0 + o1 * o1) * (1.f / 128.f) + EPS);
                const unsigned z = *(const unsigned*)(ZB + row * DINP + C_DZ + hh * 128 + 2 * ln);
                *(unsigned*)(HB + row * D + 1024 + hh * 128 + 2 * ln) = pk2(o0 * r * gn0 * silu_f(bflo(z)), o1 * r * gn1 * silu_f(bfhi(z))); }
        }
        SEAM(pb + 3);
        if (IN(pb + 4)) {
            const bf16* gA = HB; const bf16* gB = (const bf16*)(ws + WS_WOUT) + (size_t)l * 2048 * 2048; asm volatile("" : "+s"(gA), "+s"(gB));
            pg8::Gemm g{gA, gB, M, 2048, 2048}; pg8::StaticOrder S; S.init(M, 2048, G, (int)blockIdx.x);
            pg8::EpiRes E{xa0, xa1, XB, modl + 2 * 2048, modl + 4 * 2048, XA, SSQ + (size_t)(2 * l + 1) * M};
            pg8::gemm_phase<pg8::EpiRes, pg8::StaticOrder, true, true>(lds, g, S, E);
        }
        SEAM(pb + 4);
        if (IN(pb + 5)) {
            const bf16* gA = XA; const bf16* gB = (const bf16*)(ws + WS_WFF1) + (size_t)l * DFF * 2048; asm volatile("" : "+s"(gA), "+s"(gB));
            pg8::Gemm g{gA, gB, M, DFF, 2048}; pg8::StaticOrder S; S.init(M, DFF, G, (int)blockIdx.x);
            pg8::EpiRelu2 E{FB, DFF, SSQ + (size_t)(2 * l + 1) * M, BW + (size_t)l * BW_L + 9 * DINP};
            pg8::gemm_phase<pg8::EpiRelu2, pg8::StaticOrder, true, true>(lds, g, S, E);
        }
        SEAM(pb + 5);
        if (IN(pb + 6)) {
            const bf16* gA = FB; const bf16* gB = (const bf16*)(ws + WS_WFF2) + (size_t)l * 2048 * DFF; asm volatile("" : "+s"(gA), "+s"(gB));
            pg8::Gemm g{gA, gB, M, 2048, DFF}; pg8::StaticOrder S; S.init(M, 2048, G, (int)blockIdx.x);
            pg8::EpiRes E{XB, XB + (size_t)NCTX * D, XB, modl + 5 * 2048, l + 1 < DEPTH ? modl + 9 * 12288 + 1 * 2048 : nullptr, XA, SSQ + (size_t)(2 * l + 2) * M};
            pg8::gemm_phase<pg8::EpiRes, pg8::StaticOrder, true, true>(lds, g, S, E);
        }
        SEAM(pb + 6);
    }
    if (IN(30)) norm_phase<true>(XB, XB + (size_t)NCTX * D, final_norm_g, nullptr, nullptr, out + O_Y, lane, wave, G);
#undef IN
#undef SEAM
#undef DUPBAR
}

#ifndef MK_ONE_LAUNCH
#define MK_ONE_LAUNCH 1
#endif
extern "C" void kernel_launch(void* const* d_in, const int* in_sizes, int n_in, void* d_out, int out_size, void* d_ws, size_t ws_size, hipStream_t stream) {
    static int grid = 0;
    if (grid == 0) {
        if (n_in != 24 || (size_t)out_size != O_END || ws_size < WS_END) { fprintf(stderr, "kernel_launch: unexpected shapes: n_in %d out %d ws %zu (need %zu)\n", n_in, out_size, ws_size, (size_t)WS_END); grid = -1; return; }
        int dev = 0, cus = 0, per_cu = 0;
        if (hipGetDevice(&dev) != hipSuccess || hipDeviceGetAttribute(&cus, hipDeviceAttributeMultiprocessorCount, dev) != hipSuccess) { grid = -1; return; }
        if (hipFuncSetAttribute((const void*)fwd, hipFuncAttributeMaxDynamicSharedMemorySize, LDS_BYTES) != hipSuccess) { fprintf(stderr, "kernel_launch: hipFuncSetAttribute failed\n"); grid = -1; return; }
        if (hipOccupancyMaxActiveBlocksPerMultiprocessor(&per_cu, (const void*)fwd, NWAVES * 64, LDS_BYTES) != hipSuccess || per_cu < 1) fprintf(stderr, "kernel_launch: occupancy query reports %d\n", per_cu);
        (void)hipGetLastError();
        grid = cus;
    }
    if (grid < 0) return;
    (void)hipMemsetAsync((char*)d_ws + WS_CTL, 0, CTL_ZERO_BYTES, stream);
    Args a{};
    for (int i = 0; i < 24; ++i) a.in[i] = (const float*)d_in[i];
    a.out = (float*)d_out; a.ws = (unsigned char*)d_ws;
#if MK_ONE_LAUNCH
    a.ph_lo = 0; a.ph_hi = NPH;
    hipLaunchKernelGGL(fwd, dim3(grid), dim3(NWAVES * 64), LDS_BYTES, stream, a);
#else
    for (int p = 0; p < NPH; ++p) { a.ph_lo = p; a.ph_hi = p + 1; hipLaunchKernelGGL(fwd, dim3(grid), dim3(NWAVES * 64), LDS_BYTES, stream, a); }
#endif
    const hipError_t le = hipPeekAtLastError();
    if (le != hipSuccess) fprintf(stderr, "kernel_launch: launch failed: %s\n", hipGetErrorName(le));
}
```

```cpp
#include <hip/hip_runtime.h>
#include <cstdio>
#include <cstdint>
namespace pg8 {
#define PG8_LAS __attribute__((address_space(3)))
typedef unsigned short bf16_t;
typedef short bf16x8 __attribute__((ext_vector_type(8)));
typedef float f32x4 __attribute__((ext_vector_type(4)));
typedef unsigned u32x4 __attribute__((ext_vector_type(4)));
constexpr int BM = 256, BK = 64, HALF = 128, HTB = HALF * BK * 2  , STAGE_BYTES = 8 * HTB, NXCD = 8, WGM = 8;

__host__ __device__ __forceinline__ int lds_byte(int r, int c) { const int st = (r >> 4) * 2 + (c >> 5), rr = r & 15, cc = c & 31, ob = rr * 64 + cc * 2; return st * 1024 + (ob ^ (((ob >> 9) & 1) << 5)); }
__host__ __device__ __forceinline__ void stage_rc(int b, int& R, int& C) { const int st = b / 1024, sb = b % 1024, swz = sb ^ (((sb >> 9) & 1) << 5); R = (st >> 1) * 16 + swz / 64; C = (st & 1) * 32 + (swz % 64) / 2; }
__host__ __device__ __forceinline__ int perm32(int rho) { const int n = rho >> 4, i = rho & 15; return 8 * (i >> 2) + 4 * n + (i & 3); }

struct Unit { int pm, pn; };
struct Gemm { const bf16_t* A; const bf16_t* Bt; int M, N, K; };

struct StaticOrder {
    int nM, nN, nwg, G, c;
    __host__ __device__ void init(int M, int N, int G_, int c_) { nM = M / BM; nN = N / BM; nwg = nM * nN; G = G_; c = c_; }
    __host__ __device__ bool next(int i, Unit& u) const {
        const long L = (long)i * G + c; if (L >= nwg) return false;
        int wgid = (int)L; { const int q = nwg / NXCD, r = nwg % NXCD, xcd = wgid % NXCD, off = wgid / NXCD; wgid = (xcd < r ? xcd * (q + 1) : r * (q + 1) + (xcd - r) * q) + off; }
        const int nig = WGM * nN, gid = wgid / nig, fm = gid * WGM, gsz = (nM - fm) < WGM ? (nM - fm) : WGM;
        u.pm = fm + ((wgid % nig) % gsz); u.pn = (wgid % nig) / gsz; return true;
    }
    __device__ __forceinline__ void a_ready(const Unit&) const {}
    __device__ __forceinline__ void done(const Unit&) const {}
};


typedef float f32x2c __attribute__((ext_vector_type(2))); typedef __bf16 bf16x2c __attribute__((ext_vector_type(2)));
__device__ __forceinline__ unsigned cvt_pk_bf16(float lo, float hi) { const f32x2c v = {lo, hi}; return __builtin_bit_cast(unsigned, __builtin_convertvector(v, bf16x2c)); }
__device__ __forceinline__ int cond_of(int rowt) { return rowt < 4096 ? 8 : ((rowt - 4096) >> 11); }
struct EpiZ {
    static constexpr bool PERM = true, AFTER_DRAIN = false;
    bf16_t* O; int ldc; float* outk; float* outv; const float* ssq; const float* bw;
    __device__ __forceinline__ void operator()(const f32x4 (&acc)[2][2][4][2], const Unit& u, int wr, int wc, int fr, int fq) const {
        asm volatile("" : "+v"(fr), "+v"(fq));
        const int rowt = u.pm * BM, row0 = rowt + wr * 64 + fr; const int col0 = u.pn * BM + wc * 32 + 8 * fq;
        const bool kv = (u.pm < 16) && (u.pn == 4 || u.pn == 5);
        float* ob = (u.pn == 4 ? outk : outv) + (size_t)u.pm * (4 * 65536) + wc * 32 + 8 * fq;
        const float* bp = bw + (size_t)cond_of(rowt) * ldc + col0; f32x4 bv[2][2];
#pragma unroll
        for (int bj = 0; bj < 2; ++bj)
#pragma unroll
            for (int n = 0; n < 2; ++n) bv[bj][n] = *(const f32x4*)(bp + bj * HALF + 4 * n);
#pragma unroll
        for (int ai = 0; ai < 2; ++ai)
#pragma unroll
            for (int m = 0; m < 4; ++m) { const int rl = wr * 64 + fr + ai * HALF + m * 16; bf16_t* rowp = O + (size_t)(row0 + ai * HALF + m * 16) * ldc + col0;
                const float rs = __builtin_amdgcn_rsqf(ssq[rowt + rl] * (1.f / 2048.f) + 1e-6f);
#pragma unroll
                for (int bj = 0; bj < 2; ++bj) { const f32x4 v0 = acc[ai][bj][m][0] * rs + bv[bj][0], v1 = acc[ai][bj][m][1] * rs + bv[bj][1];
                    u32x4 w; w.x = cvt_pk_bf16(v0[0], v0[1]); w.y = cvt_pk_bf16(v0[2], v0[3]); w.z = cvt_pk_bf16(v1[0], v1[1]); w.w = cvt_pk_bf16(v1[2], v1[3]);
                    *(u32x4*)(rowp + bj * HALF) = w;
                    if (kv) { float* p = ob + (size_t)rl * 256 + bj * HALF; *(f32x4*)p = v0; *(f32x4*)(p + 4) = v1; } } }
    }
};
struct EpiRelu2 {
    static constexpr bool PERM = true, AFTER_DRAIN = false;
    bf16_t* O; int ldc; const float* ssq; const float* bw;
    __device__ __forceinline__ void operator()(const f32x4 (&acc)[2][2][4][2], const Unit& u, int wr, int wc, int fr, int fq) const {
        asm volatile("" : "+v"(fr), "+v"(fq));
        const int rowt = u.pm * BM, row0 = rowt + wr * 64 + fr; const int col0 = u.pn * BM + wc * 32 + 8 * fq;
        const float* bp = bw + (size_t)cond_of(rowt) * ldc + col0; f32x4 bv[2][2];
#pragma unroll
        for (int bj = 0; bj < 2; ++bj)
#pragma unroll
            for (int n = 0; n < 2; ++n) bv[bj][n] = *(const f32x4*)(bp + bj * HALF + 4 * n);
#pragma unroll
        for (int ai = 0; ai < 2; ++ai)
#pragma unroll
            for (int m = 0; m < 4; ++m) { bf16_t* rowp = O + (size_t)(row0 + ai * HALF + m * 16) * ldc + col0;
                const float rs = __builtin_amdgcn_rsqf(ssq[row0 + ai * HALF + m * 16] * (1.f / 2048.f) + 1e-6f);
#pragma unroll
                for (int bj = 0; bj < 2; ++bj) { f32x4 v0 = acc[ai][bj][m][0] * rs + bv[bj][0], v1 = acc[ai][bj][m][1] * rs + bv[bj][1];
#pragma unroll
                    for (int j = 0; j < 4; ++j) { const float a = fmaxf(v0[j], 0.f), b = fmaxf(v1[j], 0.f); v0[j] = a * a; v1[j] = b * b; }
                    u32x4 w; w.x = cvt_pk_bf16(v0[0], v0[1]); w.y = cvt_pk_bf16(v0[2], v0[3]); w.z = cvt_pk_bf16(v1[0], v1[1]); w.w = cvt_pk_bf16(v1[2], v1[3]);
                    *(u32x4*)(rowp + bj * HALF) = w; } }
    }
};
struct EpiRes {
    static constexpr bool PERM = true, AFTER_DRAIN = false;
    const float* xin0; const float* xin1; float* xout; const float* gate; const float* anext; bf16_t* xa; float* ssq;
    __device__ __forceinline__ void operator()(const f32x4 (&acc)[2][2][4][2], const Unit& u, int wr, int wc, int fr, int fq) const {
        asm volatile("" : "+v"(fr), "+v"(fq));
        const int rowt = u.pm * BM, col0 = u.pn * BM + wc * 32 + 8 * fq; const int cond = cond_of(rowt);
        const float* xb = rowt < 4096 ? xin0 + (size_t)rowt * 2048 : xin1 + (size_t)(rowt - 4096) * 2048; float* ob = xout + (size_t)rowt * 2048; bf16_t* ab = xa + (size_t)rowt * 2048;
        const float* g = gate + (size_t)cond * 12288 + col0; f32x4 gv[2][2], av[2][2];
#pragma unroll
        for (int bj = 0; bj < 2; ++bj)
#pragma unroll
            for (int n = 0; n < 2; ++n) { gv[bj][n] = *(const f32x4*)(g + bj * HALF + 4 * n); av[bj][n] = anext ? *(const f32x4*)(anext + (size_t)cond * 12288 + col0 + bj * HALF + 4 * n) : (f32x4){0.f, 0.f, 0.f, 0.f}; }
        const unsigned offb = (unsigned)((wr * 64 + fr) * 2048 + col0) * 4u;
#pragma unroll
        for (int ai = 0; ai < 2; ++ai)
#pragma unroll
            for (int m = 0; m < 4; ++m) { unsigned voff = offb + (unsigned)(ai * HALF + m * 16) * 8192u; asm volatile("" : "+v"(voff));
                const char* xp = (const char*)xb + voff; char* op = (char*)ob + voff; char* ap = (char*)ab + (voff >> 1); float ss = 0.f;
#pragma unroll
                for (int bj = 0; bj < 2; ++bj) { const f32x4 x0 = *(const f32x4*)(xp + bj * 512), x1 = *(const f32x4*)(xp + bj * 512 + 16);
                    const f32x4 y0 = x0 + gv[bj][0] * acc[ai][bj][m][0], y1 = x1 + gv[bj][1] * acc[ai][bj][m][1];
                    *(f32x4*)(op + bj * 512) = y0; *(f32x4*)(op + bj * 512 + 16) = y1;
                    ss += (y0[0] * y0[0] + y0[1] * y0[1]) + (y0[2] * y0[2] + y0[3] * y0[3]) + (y1[0] * y1[0] + y1[1] * y1[1]) + (y1[2] * y1[2] + y1[3] * y1[3]);
                    if (anext) { const f32x4 a0 = y0 * av[bj][0], a1 = y1 * av[bj][1];
                        u32x4 w; w.x = cvt_pk_bf16(a0[0], a0[1]); w.y = cvt_pk_bf16(a0[2], a0[3]); w.z = cvt_pk_bf16(a1[0], a1[1]); w.w = cvt_pk_bf16(a1[2], a1[3]); *(u32x4*)(ap + bj * 256) = w; } }
                ss += __shfl_xor(ss, 16); ss += __shfl_xor(ss, 32);
                if (fq == 0) __hip_atomic_fetch_add(ssq + rowt + wr * 64 + fr + ai * HALF + m * 16, ss, __ATOMIC_RELAXED, __HIP_MEMORY_SCOPE_AGENT);
                asm volatile("" ::: "memory"); }
    }
};
template <class Epi, class Sched, bool ALIGN_EPI = false, bool SP2 = false>
__device__ __forceinline__ void gemm_phase(PG8_LAS unsigned char* lds, const Gemm g, const Sched& S, const Epi& E, const int wave_in) {
    int tid_; asm volatile("v_mbcnt_lo_u32_b32 %0, -1, 0\n\tv_mbcnt_hi_u32_b32 %0, -1, %0" : "=v"(tid_)); tid_ |= (wave_in << 6);
    const int tid = tid_, wid = __builtin_amdgcn_readfirstlane(tid >> 6), lane = tid & 63, wr = wid >> 2, wc = wid & 3, fr = lane & 15, fq = lane >> 4;
    const int K = g.K, nt = K / BK;
    unsigned voffA[2], voffB[2];
#pragma unroll
    for (int i = 0; i < 2; ++i) { int R, C; stage_rc(tid * 16 + i * 8192, R, C); const int Rb = Epi::PERM ? ((R & ~31) + perm32(R & 31)) : R;
        voffA[i] = (unsigned)(R * K + C) * 2u; voffB[i] = (unsigned)(Rb * K + C) * 2u; }
    const size_t kstep = (size_t)(BK * 2);
    const size_t hstep = (size_t)HALF * K * 2;
    const size_t tstep = 2 * hstep;
    const unsigned ldsw = (unsigned)wid * 1024u;
    const int aoff = lds_byte(wr * 64 + fr, fq * 8), boff = lds_byte(wc * 32 + fr, fq * 8);
#define PG8_SA(b, h) (((b) * 2 + (h)) * HTB)
#define PG8_SB(b, h) ((4 + (b) * 2 + (h)) * HTB)
#define PG8_STAGE(bufoff, gbase, voff) do { _Pragma("unroll") for (int _i = 0; _i < 2; ++_i) \
        __builtin_amdgcn_global_load_lds((const unsigned*)((const char*)(gbase) + (voff)[_i]), (PG8_LAS unsigned*)(lds + (bufoff) + ldsw + _i * 8192), 16, 0, 0); } while (0)
#define PG8_LDA(dst, b, h) do { _Pragma("unroll") for (int m = 0; m < 4; ++m) _Pragma("unroll") for (int k = 0; k < 2; ++k) dst[m][k] = *(const PG8_LAS bf16x8*)(lds + PG8_SA(b, h) + aoff + m * 2048 + k * 1024); } while (0)
#define PG8_LDB(dst, b, h) do { _Pragma("unroll") for (int n = 0; n < 2; ++n) _Pragma("unroll") for (int k = 0; k < 2; ++k) dst[n][k] = *(const PG8_LAS bf16x8*)(lds + PG8_SB(b, h) + boff + n * 2048 + k * 1024); } while (0)
#define PG8_MMA(ai, bj, At, Bt) do { __builtin_amdgcn_s_setprio(1); _Pragma("unroll") for (int m = 0; m < 4; ++m) _Pragma("unroll") for (int n = 0; n < 2; ++n) _Pragma("unroll") for (int k = 0; k < 2; ++k) \
        acc[ai][bj][m][n] = __builtin_amdgcn_mfma_f32_16x16x32_bf16(Bt[n][k], At[m][k], acc[ai][bj][m][n], 0, 0, 0); __builtin_amdgcn_s_setprio(0); } while (0)
#define PG8_WAIT_V(n) asm volatile("s_waitcnt vmcnt(" #n ")" ::: "memory")
#define PG8_WAIT_L(n) asm volatile("s_waitcnt lgkmcnt(" #n ")" ::: "memory")
#define PG8_BAR __builtin_amdgcn_s_barrier()
#define PG8_SCHED __builtin_amdgcn_sched_barrier(0)
    Unit cur, nxt; int ui = 0;
    if (!S.next(0, cur)) return;
    f32x4 acc[2][2][4][2];
#pragma unroll
    for (int a = 0; a < 2; ++a)
#pragma unroll
        for (int b = 0; b < 2; ++b)
#pragma unroll
            for (int m = 0; m < 4; ++m)
#pragma unroll
                for (int n = 0; n < 2; ++n) acc[a][b][m][n] = (f32x4){0.f, 0.f, 0.f, 0.f};
    bf16x8 At[4][2], B0[2][2], B1[2][2];
    const char* cA = (const char*)g.A + (size_t)cur.pm * tstep; const char* cB = (const char*)g.Bt + (size_t)cur.pn * tstep;
    S.a_ready(cur);
    if constexpr (SP2) {
        PG8_STAGE(PG8_SB(0, 0), cB, voffB); PG8_STAGE(PG8_SB(0, 1), cB + hstep, voffB); PG8_STAGE(PG8_SA(0, 0), cA, voffA); PG8_STAGE(PG8_SA(0, 1), cA + hstep, voffA);
        if (wr == 1) PG8_BAR;
        PG8_WAIT_V(2); PG8_BAR;
        PG8_STAGE(PG8_SB(1, 0), cB + kstep, voffB); PG8_STAGE(PG8_SA(1, 0), cA + kstep, voffA); PG8_STAGE(PG8_SB(1, 1), cB + hstep + kstep, voffB);
        PG8_WAIT_V(6); PG8_BAR;
    } else {
        PG8_STAGE(PG8_SB(0, 0), cB, voffB); PG8_STAGE(PG8_SA(0, 0), cA, voffA); PG8_STAGE(PG8_SB(0, 1), cB + hstep, voffB); PG8_STAGE(PG8_SA(0, 1), cA + hstep, voffA);
        if (wr == 1) PG8_BAR;
        PG8_WAIT_V(4); PG8_BAR;
        PG8_STAGE(PG8_SB(1, 0), cB + kstep, voffB); PG8_STAGE(PG8_SA(1, 0), cA + kstep, voffA); PG8_STAGE(PG8_SB(1, 1), cB + hstep + kstep, voffB);
        PG8_WAIT_V(6); PG8_BAR;
    }
    for (;;) {
        const bool has_next = S.next(ui + 1, nxt);
        const char* nA = has_next ? (const char*)g.A + (size_t)nxt.pm * tstep : cA; const char* nB = has_next ? (const char*)g.Bt + (size_t)nxt.pn * tstep : cB;
        for (int t = 0; t < nt; t += 2) {
            const bool last = (t == nt - 2);
            const char* a1 = cA + (size_t)(t + 1) * kstep;
            const char* a2 = last ? nA : cA + (size_t)(t + 2) * kstep; const char* b2 = last ? nB : cB + (size_t)(t + 2) * kstep;
            const char* a3 = a2 + kstep; const char* b3 = b2 + kstep;
            if (last && has_next) S.a_ready(nxt);
            if constexpr (SP2) {
            PG8_LDB(B0, 0, 0); PG8_LDB(B1, 0, 1); PG8_SCHED; PG8_LDA(At, 0, 0); PG8_STAGE(PG8_SA(1, 1), a1 + hstep, voffA);
            PG8_WAIT_V(8); PG8_WAIT_L(0); PG8_BAR; PG8_MMA(0, 0, At, B0); PG8_MMA(0, 1, At, B1); PG8_BAR; PG8_SCHED;
            PG8_LDA(At, 0, 1); PG8_STAGE(PG8_SB(0, 0), b2, voffB); PG8_STAGE(PG8_SB(0, 1), b2 + hstep, voffB); PG8_STAGE(PG8_SA(0, 0), a2, voffA);
            PG8_WAIT_V(8); PG8_WAIT_L(0); PG8_BAR; PG8_MMA(1, 0, At, B0); PG8_MMA(1, 1, At, B1); PG8_BAR; PG8_SCHED;
            PG8_LDB(B0, 1, 0); PG8_LDB(B1, 1, 1); PG8_SCHED; PG8_LDA(At, 1, 0); PG8_STAGE(PG8_SA(0, 1), a2 + hstep, voffA);
            PG8_WAIT_V(8); PG8_WAIT_L(0); PG8_BAR; PG8_MMA(0, 0, At, B0); PG8_MMA(0, 1, At, B1); PG8_BAR; PG8_SCHED;
            PG8_LDA(At, 1, 1); PG8_STAGE(PG8_SB(1, 0), b3, voffB); PG8_STAGE(PG8_SB(1, 1), b3 + hstep, voffB); PG8_STAGE(PG8_SA(1, 0), a3, voffA);
            PG8_WAIT_V(8); PG8_WAIT_L(0); PG8_BAR; PG8_MMA(1, 0, At, B0); PG8_MMA(1, 1, At, B1); PG8_BAR; PG8_SCHED;
            } else {
            PG8_LDB(B0, 0, 0); PG8_SCHED; PG8_LDA(At, 0, 0); PG8_STAGE(PG8_SA(1, 1), a1 + hstep, voffA);
            PG8_WAIT_L(8); PG8_BAR; PG8_WAIT_L(0); PG8_MMA(0, 0, At, B0); PG8_BAR; PG8_SCHED;
            PG8_LDB(B1, 0, 1); PG8_STAGE(PG8_SB(0, 0), b2, voffB);
            PG8_BAR; PG8_WAIT_L(0); PG8_MMA(0, 1, At, B1); PG8_BAR;
            PG8_LDA(At, 0, 1); PG8_STAGE(PG8_SA(0, 0), a2, voffA);
            PG8_BAR; PG8_WAIT_L(0); PG8_MMA(1, 0, At, B0); PG8_BAR; PG8_SCHED;
            PG8_STAGE(PG8_SB(0, 1), b2 + hstep, voffB);
            PG8_WAIT_V(6); PG8_BAR; PG8_MMA(1, 1, At, B1); PG8_BAR;
            PG8_LDB(B0, 1, 0); PG8_SCHED; PG8_LDA(At, 1, 0); PG8_STAGE(PG8_SA(0, 1), a2 + hstep, voffA);
            PG8_WAIT_L(8); PG8_BAR; PG8_WAIT_L(0); PG8_MMA(0, 0, At, B0); PG8_BAR; PG8_SCHED;
            PG8_LDB(B1, 1, 1); PG8_STAGE(PG8_SB(1, 0), b3, voffB);
            PG8_BAR; PG8_WAIT_L(0); PG8_MMA(0, 1, At, B1); PG8_BAR;
            PG8_LDA(At, 1, 1); PG8_STAGE(PG8_SA(1, 0), a3, voffA);
            PG8_BAR; PG8_WAIT_L(0); PG8_MMA(1, 0, At, B0); PG8_BAR; PG8_SCHED;
            PG8_STAGE(PG8_SB(1, 1), b3 + hstep, voffB);
            PG8_WAIT_V(6); PG8_BAR; PG8_MMA(1, 1, At, B1); PG8_BAR;
            }
        }
        if constexpr (ALIGN_EPI) { if (wr == 0) PG8_BAR; }
        if constexpr (!Epi::AFTER_DRAIN) { E(acc, cur, wr, wc, fr, fq); S.done(cur); }
        if (!has_next) break;
#pragma unroll
        for (int a = 0; a < 2; ++a)
#pragma unroll
            for (int b = 0; b < 2; ++b)
#pragma unroll
                for (int m = 0; m < 4; ++m)
#pragma unroll
                    for (int n = 0; n < 2; ++n) acc[a][b][m][n] = (f32x4){0.f, 0.f, 0.f, 0.f};
        cur = nxt; cA = nA; cB = nB; ++ui;
        if constexpr (ALIGN_EPI) { if (wr == 1) PG8_BAR; }
    }
    PG8_WAIT_V(0);
    if constexpr (!ALIGN_EPI) { if (wr == 0) PG8_BAR; }
    PG8_BAR;
    if constexpr (Epi::AFTER_DRAIN) { E.fused(acc, cur, wr, wc, fr, fq, lds, wid, lane); S.done(cur); }
#undef PG8_SA
#undef PG8_SB
#undef PG8_STAGE
#undef PG8_LDA
#undef PG8_LDB
#undef PG8_MMA
#undef PG8_WAIT_V
#undef PG8_WAIT_L
#undef PG8_BAR
#undef PG8_SCHED
}
}


constexpr int D = 2048, NCTX = 4096, NLAT = 16384, M = NCTX + NLAT, DEPTH = 4;
constexpr int DIN = 4624, DINP = 4864, DFF = 8192;
constexpr int C_AQ = 0, C_AK = 1024, C_AV = 1280, C_DQ = 1536, C_DK = 2048, C_DV = 2560, C_DZ = 3072, C_DAB = 3584, C_SU = 3600, C_SV = 4112;
constexpr int NWAVES = 8;
constexpr float EPS = 1e-6f;
constexpr size_t O_Y = 0, O_K = (size_t)M * D, O_V = O_K + 4194304, O_DELTA = O_V + 4194304, O_END = O_DELTA + 8388608;
constexpr size_t MiB = 1u << 20;
constexpr size_t WS_CTL = 0, CTL_ZERO_BYTES = 1 * MiB;
static_assert((16384 + 9 * 20480) * 4 <= 1 * 1048576, "ssq inside the memset region");
constexpr size_t WS_MOD = 1 * MiB, WS_ROPE = 3 * MiB, WS_CK = 4 * MiB, WS_CV = 12 * MiB;
constexpr size_t WS_WIN = 20 * MiB, WS_WOUT = 96 * MiB, WS_WFF1 = 128 * MiB, WS_WFF2 = 256 * MiB;
constexpr size_t WS_X = 384 * MiB, WS_HB = 544 * MiB, WS_ZB = 624 * MiB, WS_ODIR = 816 * MiB, WS_DN = 944 * MiB, WS_BW = 1088 * MiB, WS_XA = 1090 * MiB, WS_END = 1170 * MiB;
constexpr int BW_L = 9 * (DINP + DFF);
constexpr int CW_SSQ = 16384;
constexpr size_t DN_BLK = 116736, DN_DIR0 = 32768, DN_DIRSZ = 41984;
static_assert(WS_DN + 1280 * DN_BLK <= WS_END, "dn scratch");
constexpr int CW_BAR = 4096, CW_ATT = 8192, CW_PART = 204800;
constexpr int LDSCTL_OFF = 153600, LDS_BYTES = 154624;

#define GAS __attribute__((address_space(1)))
#define LAS __attribute__((address_space(3)))
typedef unsigned short bf16;
typedef unsigned v4u __attribute__((ext_vector_type(4)));
typedef unsigned v2u __attribute__((ext_vector_type(2)));
typedef float f32x4 __attribute__((ext_vector_type(4)));
typedef float f32x2 __attribute__((ext_vector_type(2)));
typedef float f32x16 __attribute__((ext_vector_type(16)));
typedef short bf16x8 __attribute__((ext_vector_type(8)));
typedef short s16x4 __attribute__((ext_vector_type(4)));
typedef LAS unsigned char* ldsp;
#define LDS_WAIT() asm volatile("s_waitcnt lgkmcnt(0)" ::: "memory")
#define VM_WAIT() asm volatile("s_waitcnt vmcnt(0)" ::: "memory")
__device__ __forceinline__ unsigned pk2(float lo, float hi) { return pg8::cvt_pk_bf16(lo, hi); }
__device__ __forceinline__ float bflo(unsigned w) { return __uint_as_float(w << 16); }
__device__ __forceinline__ float bfhi(unsigned w) { return __uint_as_float(w & 0xffff0000u); }
__device__ __forceinline__ float bf2f(bf16 b) { return __uint_as_float((unsigned)b << 16); }
__device__ __forceinline__ float wave_sum(float v) {
#define WS_DPP(ctrl, rmask) __builtin_bit_cast(float, __builtin_amdgcn_update_dpp(0, __builtin_bit_cast(int, v), ctrl, rmask, 0xF, false))
    v += WS_DPP(0xB1, 0xF);
    v += WS_DPP(0x4E, 0xF);
    v += WS_DPP(0x141, 0xF);
    v += WS_DPP(0x140, 0xF);
    v += WS_DPP(0x142, 0xA);
    v += WS_DPP(0x143, 0xC);
#undef WS_DPP
    return __builtin_bit_cast(float, __builtin_amdgcn_ds_bpermute(63 * 4, __builtin_bit_cast(int, v)));
}
__device__ __forceinline__ int crow(int r, int hi) { return (r & 3) + 8 * (r >> 2) + 4 * hi; }
__device__ __forceinline__ float silu_f(float x) { return x * __builtin_amdgcn_rcpf(1.f + __expf(-x)); }
__device__ __forceinline__ float gelu_tanh(float x) { const float y = 0.7978845608028654f * (x + 0.044715f * x * x * x); const float e = __expf(2.f * y); return x * (1.f - __builtin_amdgcn_rcpf(1.f + e)); }
template <int S> __device__ __forceinline__ bf16x8 pack8(const f32x16& v) {
    v4u w; w.x = pk2(v[8 * S + 0], v[8 * S + 1]); w.y = pk2(v[8 * S + 2], v[8 * S + 3]); w.z = pk2(v[8 * S + 4], v[8 * S + 5]); w.w = pk2(v[8 * S + 6], v[8 * S + 7]);
    return __builtin_bit_cast(bf16x8, w);
}
__device__ __forceinline__ f32x16 mma_lds(ldsp A, int sa, ldsp B, int sb, int nk, int lane, f32x16 acc) {
    ldsp ap = A + (lane & 31) * sa + (lane >> 5) * 16; ldsp bp = B + (lane & 31) * sb + (lane >> 5) * 16;
#pragma unroll 4
    for (int k = 0; k < nk; ++k) { const bf16x8 a = *(const LAS bf16x8*)(ap + k * 32); const bf16x8 b = *(const LAS bf16x8*)(bp + k * 32); acc = __builtin_amdgcn_mfma_f32_32x32x16_bf16(a, b, acc, 0, 0, 0); }
    return acc;
}

#define XB_TMO      128
#define XB_XCNT(j)  (256  + 64 * (j))
#define XB_XSUB(j)  (1280 + 64 * (j))
#define XB_XGEN(j)  (2304 + 64 * (j))
#define XB_TOP      3328
#define XB_TOPGEN   3392
#define XCD_BAR_WORDS 3456
#define XB_SPIN_CAP (1u << 18)
#define LAS __attribute__((address_space(3)))

__device__ __forceinline__ unsigned xb_ld(unsigned* p)              { return __hip_atomic_load(p, __ATOMIC_RELAXED, __HIP_MEMORY_SCOPE_AGENT); }
__device__ __forceinline__ unsigned xb_add(unsigned* p, unsigned v) { return __hip_atomic_fetch_add(p, v, __ATOMIC_RELAXED, __HIP_MEMORY_SCOPE_AGENT); }
__device__ __forceinline__ unsigned xb_xcc_id() { return (unsigned)__builtin_amdgcn_s_getreg((3 << 11) | 20) & 0xFu; }
#define XB_SPIN(cond, bar) do { unsigned _sp = 0; while (cond) { __builtin_amdgcn_s_sleep(1); \
    if ((++_sp & 255u) == 0u) { if (xb_ld(&(bar)[XB_TMO])) break; if (_sp > XB_SPIN_CAP) { atomicAdd(&(bar)[XB_TMO], 1u); break; } } } } while (0)

struct XcdBarrier {
    unsigned* bar; unsigned x; bool t0;
    volatile LAS unsigned* st;
};

__device__ __forceinline__ XcdBarrier xcd_barrier_post(unsigned* bar, volatile LAS unsigned* st) {
    XcdBarrier b; b.bar = bar; b.x = xb_xcc_id(); b.st = st; b.t0 = (threadIdx.x == 0);
    if (threadIdx.x == 0) (void)xb_add(&bar[XB_XCNT(b.x)], 1u);
    return b;
}
__device__ __forceinline__ void xcd_barrier_complete(unsigned* bar, unsigned x, unsigned& nloc, unsigned& nx) {
    const unsigned G = gridDim.x * gridDim.y * gridDim.z;
    unsigned sum, cnt, mine, sp = 0u;
    for (;;) {
        sum = 0u; cnt = 0u; mine = 0u;
#pragma unroll
        for (unsigned j = 0; j < 16; ++j) { const unsigned c = xb_ld(&bar[XB_XCNT(j)]); sum += c; cnt += (c > 0u) ? 1u : 0u; mine = (j == x) ? c : mine; }
        if (sum == G) break;
        __builtin_amdgcn_s_sleep(1);
        if ((++sp & 255u) == 0u) { if (xb_ld(&bar[XB_TMO])) break; if (sp > XB_SPIN_CAP) { atomicAdd(&bar[XB_TMO], 1u); break; } }
    }
    nloc = mine > 0u ? mine : 1u; nx = cnt > 0u ? cnt : 1u;
}

__device__ __forceinline__ void xcd_barrier(const XcdBarrier& b) {
    asm volatile("s_waitcnt vmcnt(0)" ::: "memory");
    __syncthreads();
    if (b.t0) {
        unsigned* bar = b.bar;
        __builtin_amdgcn_s_waitcnt(0);
        unsigned nloc = b.st[0], nx = b.st[1];
        if (nloc == 0u) { xcd_barrier_complete(bar, b.x, nloc, nx); b.st[0] = nloc; b.st[1] = nx; }
        const unsigned old = xb_add(&bar[XB_XSUB(b.x)], 1u);
        const unsigned gen = old / nloc;
        if (old + 1u == (gen + 1u) * nloc) {
            __builtin_amdgcn_fence(__ATOMIC_RELEASE, "agent");
            asm volatile("s_waitcnt vmcnt(0)" ::: "memory");
            const unsigned og = xb_add(&bar[XB_TOP], 1u);
            const unsigned tg = og / nx;
            if (og + 1u == (tg + 1u) * nx) xb_add(&bar[XB_TOPGEN], 1u);
            else XB_SPIN(xb_ld(&bar[XB_TOPGEN]) == tg, bar);
            __builtin_amdgcn_fence(__ATOMIC_ACQUIRE, "agent");
            xb_add(&bar[XB_XGEN(b.x)], 1u);
            asm volatile("s_waitcnt vmcnt(0)" ::: "memory");
        } else {
            XB_SPIN(xb_ld(&bar[XB_XGEN(b.x)]) == gen, bar);
            __builtin_amdgcn_fence(__ATOMIC_ACQUIRE, "agent");
            asm volatile("s_waitcnt vmcnt(0)" ::: "memory");
        }
    }
    __syncthreads();
}


__device__ __forceinline__ void p0_transpose_item(const float* W, int K, int N, bf16* WT, LAS float* scr, int item, int lane) {
    const int nblk = (N + 31) / 32, kb = item / nblk, nb = item % nblk, k0 = 64 * kb, n0 = 32 * nb; const bool okn = (n0 + (lane & 31)) < N;
#pragma unroll 8
    for (int i = 0; i < 32; ++i) { const int kk = 2 * i + (lane >> 5); scr[kk * 33 + (lane & 31)] = okn ? W[(size_t)(k0 + kk) * N + n0 + (lane & 31)] : 0.f; }
    LDS_WAIT(); asm volatile("" ::: "memory");
    const int c = lane & 7;
#pragma unroll
    for (int j = 0; j < 4; ++j) { const int n = (lane >> 3) + 8 * j; const LAS float* s = scr + (8 * c) * 33 + n;
        v4u o; o.x = pk2(s[0 * 33], s[1 * 33]); o.y = pk2(s[2 * 33], s[3 * 33]); o.z = pk2(s[4 * 33], s[5 * 33]); o.w = pk2(s[6 * 33], s[7 * 33]);
        *(GAS v4u*)(WT + (size_t)(n0 + n) * K + k0 + 8 * c) = o; }
    LDS_WAIT(); asm volatile("" ::: "memory");
}
struct P0Args { const float *c, *c_ctx, *norm1_g, *norm2_g, *w_mod, *b_mod, *w_in, *w_out, *w_ff1, *w_ff2, *cache_k, *cache_v; unsigned char* ws; };
constexpr int T_IN = 32 * 145, T_OUT = 32 * 64, T_F1 = 32 * 256, T_F2 = 128 * 64, T_L = T_IN + T_OUT + T_F1 + T_F2;
__device__ __forceinline__ void transpose_layer(const float* w_in, const float* w_out, const float* w_ff1, const float* w_ff2, unsigned char* ws, int l, LAS float* scr, int wi0, int wstride, int lane) {
    asm volatile("" : "+v"(lane));
    for (int wi = wi0; wi < T_L; wi += wstride) {
        int r = wi;
        if (r < T_IN) { p0_transpose_item(w_in + (size_t)l * 2048 * DIN, 2048, DIN, (bf16*)(ws + WS_WIN) + (size_t)l * DINP * 2048, scr, r, lane); continue; } r -= T_IN;
        if (r < T_OUT) { p0_transpose_item(w_out + (size_t)l * 2048 * 2048, 2048, 2048, (bf16*)(ws + WS_WOUT) + (size_t)l * 2048 * 2048, scr, r, lane); continue; } r -= T_OUT;
        if (r < T_F1) { p0_transpose_item(w_ff1 + (size_t)l * 2048 * DFF, 2048, DFF, (bf16*)(ws + WS_WFF1) + (size_t)l * DFF * 2048, scr, r, lane); continue; } r -= T_F1;
        p0_transpose_item(w_ff2 + (size_t)l * DFF * 2048, DFF, 2048, (bf16*)(ws + WS_WFF2) + (size_t)l * 2048 * DFF, scr, r, lane);
    }
}
__device__ __forceinline__ void p0_prologue(const P0Args& a, ldsp lds, int tid, int lane, int wave, int G) {
    asm volatile("" : "+v"(tid), "+v"(lane));
    LAS float* silu_t = (LAS float*)lds;
    LAS float* scr = (LAS float*)(lds + 73728 + wave * 8448);
    constexpr int N_MOD = 96;
    constexpr int N_CVT = 512, N_ROPE = 256, N_ITEMS = N_MOD + N_CVT + N_ROPE;
    if ((int)blockIdx.x < N_MOD) {
        for (int i = tid; i < 9 * 2048; i += NWAVES * 64) { const float x = i < 8 * 2048 ? a.c[i] : a.c_ctx[i - 8 * 2048]; silu_t[i] = x / (1.f + expf(-x)); }
        __syncthreads();
    }
    float* MOD = (float*)(a.ws + WS_MOD);
    for (int it = blockIdx.x; it < N_ITEMS; it += G) {
        if (it < N_MOD) {
            const int wi = it * 8 + wave, l = wi / 192, cb = wi % 192, j = cb * 64 + lane;
            float acc[9];
#pragma unroll
            for (int c = 0; c < 9; ++c) acc[c] = 0.f;
            const float* wp = a.w_mod + (size_t)l * 2048 * 12288 + j;
            for (int k0 = 0; k0 < 2048; k0 += 32) {
                float w[32];
#pragma unroll
                for (int i = 0; i < 32; ++i) w[i] = wp[(size_t)(k0 + i) * 12288];
#pragma unroll
                for (int c = 0; c < 9; ++c)
#pragma unroll
                    for (int i4 = 0; i4 < 8; ++i4) { const f32x4 s = *(const LAS f32x4*)(silu_t + c * 2048 + k0 + 4 * i4);
                        acc[c] += s.x * w[4 * i4] + s.y * w[4 * i4 + 1] + s.z * w[4 * i4 + 2] + s.w * w[4 * i4 + 3]; }
            }
            const int slot = j >> 11, col = j & 2047; const float bm = a.b_mod[l * 12288 + j];
            const float gn = slot == 1 ? a.norm1_g[l * 2048 + col] : (slot == 4 ? a.norm2_g[l * 2048 + col] : 0.f);
#pragma unroll
            for (int c = 0; c < 9; ++c) { float v = acc[c] + bm; if (slot == 1 || slot == 4) v = gn * (1.f + v); MOD[(size_t)(l * 9 + c) * 12288 + j] = v; }
        } else if (it < N_MOD + N_CVT) {
            const int ci = it - N_MOD;
#pragma unroll
            for (int s = 0; s < 4; ++s) { const size_t e8 = (size_t)ci * 2048 + s * 512 + tid; const bool isv = e8 >= 524288; const size_t j8 = isv ? e8 - 524288 : e8;
                const float* src = (isv ? a.cache_v : a.cache_k) + j8 * 8; const f32x4 x0 = *(const f32x4*)src, x1 = *(const f32x4*)(src + 4);
                v4u o; o.x = pk2(x0.x, x0.y); o.y = pk2(x0.z, x0.w); o.z = pk2(x1.x, x1.y); o.w = pk2(x1.z, x1.w);
                *(v4u*)((bf16*)(a.ws + (isv ? WS_CV : WS_CK)) + j8 * 8) = o; }
        } else {
            const int e = (it - N_MOD - N_CVT) * 512 + tid, t = e >> 6, i = e & 63;
            const float inv = powf(10000.f, -(float)(2 * (i & 31)) / 64.f); const float pos = i < 32 ? (float)(t >> 6) : (float)(t & 63); const float ang = pos * inv;
            ((float*)(a.ws + WS_ROPE))[e] = cosf(ang); ((float*)(a.ws + WS_ROPE))[131072 + e] = sinf(ang);
        }
    }
#pragma unroll 1
    for (int l = 0; l < DEPTH; ++l) transpose_layer(a.w_in, a.w_out, a.w_ff1, a.w_ff2, a.ws, l, scr, blockIdx.x * NWAVES + wave, G * NWAVES, lane);
}
__device__ __forceinline__ void p0b_bias(unsigned char* ws, ldsp lds, int tid, int lane, int wave, int G) {
    asm volatile("" : "+v"(tid), "+v"(lane));
    LAS float* sh = (LAS float*)lds;
    const float* MOD = (const float*)(ws + WS_MOD); float* BW = (float*)(ws + WS_BW);
    constexpr int NB1 = DINP / 64, NB2 = DFF / 64, NBL = NB1 + NB2;
    int cur = -1;
    for (int it = blockIdx.x; it < DEPTH * NBL; it += G) {
        const int l = it / NBL, r = it % NBL, which = r >= NB1 ? 1 : 0, rb = which ? r - NB1 : r, key = l * 2 + which;
        if (key != cur) { __syncthreads(); cur = key;
            for (int i = tid; i < 9 * 2048; i += NWAVES * 64) sh[i] = MOD[(size_t)(l * 9 + (i >> 11)) * 12288 + (which ? 3 : 0) * 2048 + (i & 2047)];
            __syncthreads(); }
        const bf16* WT = which ? (const bf16*)(ws + WS_WFF1) + (size_t)l * DFF * 2048 : (const bf16*)(ws + WS_WIN) + (size_t)l * DINP * 2048;
        const int ldb = which ? DFF : DINP; float* bwp = BW + (size_t)l * BW_L + (which ? 9 * DINP : 0);
#pragma unroll 1
        for (int rr = 0; rr < 8; ++rr) { const int n = rb * 64 + wave * 8 + rr; const bf16* wr_ = WT + (size_t)n * 2048 + lane * 8;
            float w[32];
#pragma unroll
            for (int j = 0; j < 4; ++j) { const v4u q = *(const v4u*)(wr_ + 512 * j); w[8 * j] = bflo(q.x); w[8 * j + 1] = bfhi(q.x); w[8 * j + 2] = bflo(q.y); w[8 * j + 3] = bfhi(q.y); w[8 * j + 4] = bflo(q.z); w[8 * j + 5] = bfhi(q.z); w[8 * j + 6] = bflo(q.w); w[8 * j + 7] = bfhi(q.w); }
            float res = 0.f;
#pragma unroll 1
            for (int c = 0; c < 9; ++c) { float s = 0.f;
#pragma unroll
                for (int j = 0; j < 4; ++j) { const f32x4 s0 = *(const LAS f32x4*)(sh + c * 2048 + 512 * j + lane * 8), s1 = *(const LAS f32x4*)(sh + c * 2048 + 512 * j + lane * 8 + 4);
                    s += s0.x * w[8 * j] + s0.y * w[8 * j + 1] + s0.z * w[8 * j + 2] + s0.w * w[8 * j + 3] + s1.x * w[8 * j + 4] + s1.y * w[8 * j + 5] + s1.z * w[8 * j + 6] + s1.w * w[8 * j + 7]; }
                s = wave_sum(s); res = (lane == c) ? s : res; }
            if (lane < 9) bwp[(size_t)lane * ldb + n] = res; }
    }
    __syncthreads();
}

template <bool FINAL>
__device__ __forceinline__ void norm_phase(const float* x0, const float* x1, const float* modA, bf16* xa, float* ssq, float* outf, int lane, int wave, int G) {
    asm volatile("" : "+v"(lane)); asm volatile("" : "+s"(wave), "+s"(G));
    const int rpw = (M + G - 1) / G, r0 = blockIdx.x * rpw, r1 = min(M, r0 + rpw);
    f32x4 A[8]; int cur = -1;
    for (int r = r0 + wave; r < r1; r += NWAVES) {
        const int cond = FINAL ? 0 : (r < NCTX ? 8 : ((r - NCTX) >> 11));
        if (cond != cur) { cur = cond;
#pragma unroll
            for (int j = 0; j < 8; ++j) A[j] = *(const f32x4*)(modA + (size_t)cond * 12288 + 4 * lane + 256 * j); }
        const float* xr = r < NCTX ? x0 + (size_t)r * D : x1 + (size_t)(r - NCTX) * D;
        f32x4 v[8]; float ss = 0.f;
#pragma unroll
        for (int j = 0; j < 8; ++j) { v[j] = *(const f32x4*)(xr + 4 * lane + 256 * j); ss += (v[j].x * v[j].x + v[j].y * v[j].y) + (v[j].z * v[j].z + v[j].w * v[j].w); }
        ss = wave_sum(ss);
        if (FINAL) { const float rstd = rsqrtf(ss * (1.f / D) + EPS);
#pragma unroll
            for (int j = 0; j < 8; ++j) *(f32x4*)(outf + (size_t)r * D + 4 * lane + 256 * j) = v[j] * rstd * A[j];
        } else {
#pragma unroll
            for (int j = 0; j < 8; ++j) { const f32x4 y = v[j] * A[j]; v2u o; o.x = pk2(y.x, y.y); o.y = pk2(y.z, y.w); *(v2u*)(xa + (size_t)r * D + 4 * lane + 256 * j) = o; }
            if (lane == 0) ssq[r] = ss;
        }
    }
}

#ifndef PROBE_DUP
#define PROBE_DUP 0
#endif
constexpr int P_KT = 0, P_QT = 17408, P_KTT = 34816, P_VT = 53248, P_T1 = 71680, P_T2 = 71680 + 18432, P_AM = 108544, P_GL = 141312;
struct LayerP { const float *conv_w, *a_log, *dt_bias, *dn_norm_g, *sgu_norm_g, *sgu_w, *sgu_b, *sink; };
__device__ __forceinline__ void dn_prep_unit(const LayerP& P, const bf16* zb, unsigned char* dn, ldsp lds, int gchunk, int h, int tid, int lane, int wave) {
    asm volatile("" : "+v"(tid), "+v"(lane));
    const bool isctx = gchunk < 64; const int pc = isctx ? (gchunk & 3) : ((gchunk - 64) & 31); const int T = isctx ? 256 : 2048;
    const long grow0 = (long)gchunk * 64; unsigned char* blk = dn + (size_t)(gchunk * 4 + h) * DN_BLK;
    LAS float* GL = (LAS float*)(lds + P_GL);
    for (int rep_ = 0; rep_ < ((PROBE_DUP & 1024) ? 2 : 1); ++rep_) {
    if (wave == 0) {
        const bf16* zr = zb + (size_t)(grow0 + lane) * DINP + C_DAB;
#pragma unroll
        for (int d = 0; d < 2; ++d) {
            const float alpha = bf2f(zr[d * 8 + h]), braw = bf2f(zr[d * 8 + 4 + h]);
            const float xr = alpha + P.dt_bias[d * 4 + h]; const float sp = fmaxf(xr, 0.f) + log1pf(expf(-fabsf(xr)));
            const float g = -expf(P.a_log[d * 4 + h]) * sp; const float beta = 1.f / (1.f + expf(-braw));
            float gc = g;
#pragma unroll
            for (int o = 1; o < 64; o <<= 1) { const int src = (d == 0) ? lane - o : lane + o;
                const float t = __builtin_bit_cast(float, __builtin_amdgcn_ds_bpermute((src & 63) << 2, __builtin_bit_cast(int, gc))); const bool ok = (d == 0) ? (lane >= o) : (lane + o < 64); gc += ok ? t : 0.f; }
            const float gl = wave_sum(g); const float eg = expf(gc), egl = expf(gl - gc);
            GL[d * 64 + lane] = gc; GL[128 + d * 64 + lane] = beta; GL[256 + d * 64 + lane] = beta * eg;
            float* gv = (float*)(blk + DN_DIR0 + d * DN_DIRSZ + 40960);
            gv[lane] = eg; gv[64 + lane] = egl; if (lane == 0) gv[128] = expf(gl);
        }
    }
    {
        const float* cw = P.conv_w; const int cq = h * 128 + 2 * lane;
        f32x2 wq[5], wk[5], wv[5];
#pragma unroll
        for (int j = 0; j < 5; ++j) { wq[j] = *(const f32x2*)(cw + j * 1536 + cq); wk[j] = *(const f32x2*)(cw + j * 1536 + 512 + cq); wv[j] = *(const f32x2*)(cw + j * 1536 + 1024 + cq); }
        unsigned xq[12], xk[12], xv[12];
#pragma unroll
        for (int rr = 0; rr < 12; ++rr) { const int tl = 8 * wave - 2 + rr, tpos = pc * 64 + tl; const bool ok = tpos >= 0 && tpos < T;
            const bf16* zr = zb + (grow0 + tl) * (long)DINP + h * 128 + 2 * lane;
            xq[rr] = ok ? *(const unsigned*)(zr + C_DQ) : 0u; xk[rr] = ok ? *(const unsigned*)(zr + C_DK) : 0u; xv[rr] = ok ? *(const unsigned*)(zr + C_DV) : 0u; }
        float k0s[8], k1s[8], v0s[8], v1s[8];
        LAS bf16* Kt = (LAS bf16*)(lds + P_KT); LAS bf16* Qt = (LAS bf16*)(lds + P_QT);
#pragma unroll
        for (int tt = 0; tt < 8; ++tt) {
            float q0 = 0.f, q1 = 0.f, k0 = 0.f, k1 = 0.f, v0 = 0.f, v1 = 0.f;
#pragma unroll
            for (int j = 0; j < 5; ++j) { q0 += bflo(xq[tt + j]) * wq[j].x; q1 += bfhi(xq[tt + j]) * wq[j].y; k0 += bflo(xk[tt + j]) * wk[j].x; k1 += bfhi(xk[tt + j]) * wk[j].y;
                v0 += bflo(xv[tt + j]) * wv[j].x; v1 += bfhi(xv[tt + j]) * wv[j].y; }
            q0 = silu_f(q0); q1 = silu_f(q1); k0 = silu_f(k0); k1 = silu_f(k1); v0 = silu_f(v0); v1 = silu_f(v1);
            const float rq = rsqrtf(wave_sum(q0 * q0 + q1 * q1) + EPS) * 0.08838834764831845f, rk = rsqrtf(wave_sum(k0 * k0 + k1 * k1) + EPS);
            q0 *= rq; q1 *= rq; k0 *= rk; k1 *= rk;
            const int t = 8 * wave + tt;
            *(LAS unsigned*)(Qt + t * 136 + 2 * lane) = pk2(q0, q1); *(LAS unsigned*)(Kt + t * 136 + 2 * lane) = pk2(k0, k1);
            k0s[tt] = k0; k1s[tt] = k1; v0s[tt] = v0; v1s[tt] = v1;
        }
        LAS bf16* KT = (LAS bf16*)(lds + P_KTT); LAS bf16* VT = (LAS bf16*)(lds + P_VT);
        v4u o;
        o.x = pk2(k0s[0], k0s[1]); o.y = pk2(k0s[2], k0s[3]); o.z = pk2(k0s[4], k0s[5]); o.w = pk2(k0s[6], k0s[7]); *(LAS v4u*)(KT + (2 * lane) * 72 + 8 * wave) = o;
        o.x = pk2(k1s[0], k1s[1]); o.y = pk2(k1s[2], k1s[3]); o.z = pk2(k1s[4], k1s[5]); o.w = pk2(k1s[6], k1s[7]); *(LAS v4u*)(KT + (2 * lane + 1) * 72 + 8 * wave) = o;
        o.x = pk2(v0s[0], v0s[1]); o.y = pk2(v0s[2], v0s[3]); o.z = pk2(v0s[4], v0s[5]); o.w = pk2(v0s[6], v0s[7]); *(LAS v4u*)(VT + (2 * lane) * 72 + 8 * wave) = o;
        o.x = pk2(v1s[0], v1s[1]); o.y = pk2(v1s[2], v1s[3]); o.z = pk2(v1s[4], v1s[5]); o.w = pk2(v1s[6], v1s[7]); *(LAS v4u*)(VT + (2 * lane + 1) * 72 + 8 * wave) = o;
    }
    __syncthreads();
    }
    for (int rep_ = 0; rep_ < ((PROBE_DUP & 4096) ? 2 : 1); ++rep_) {
    {
        const int hh = lane >> 5, cl = lane & 31; LAS float* AM = (LAS float*)(lds + P_AM);
        f32x16 acc = {};
        if (wave < 4) {
            const int rt = wave >> 1, ct = wave & 1;
            acc = mma_lds(lds + P_KT + 32 * rt * 272, 272, lds + P_KT + 32 * ct * 272, 272, 8, lane, acc);
            const int c = 32 * ct + cl; const float g0c = GL[c], g1c = GL[64 + c];
#pragma unroll
            for (int q = 0; q < 4; ++q) { const int r0 = 32 * rt + 8 * q + 4 * hh;
                const f32x4 g0 = *(const LAS f32x4*)(GL + r0), g1 = *(const LAS f32x4*)(GL + 64 + r0), b0 = *(const LAS f32x4*)(GL + 128 + r0), b1 = *(const LAS f32x4*)(GL + 192 + r0);
#pragma unroll
                for (int e = 0; e < 4; ++e) { const int rr = r0 + e; const float v = acc[4 * q + e];
                    if (rr > c) AM[rr * 64 + c] = b0[e] * v * __expf(g0[e] - g0c);
                    if (rr < c) AM[4096 + (63 - rr) * 64 + (63 - c)] = b1[e] * v * __expf(g1[e] - g1c); } }
        } else {
            const int cb = (wave - 4) >> 1, it = (wave - 4) & 1;
            acc = mma_lds(lds + P_KT + 32 * cb * 272, 272, lds + P_QT + 32 * it * 272, 272, 8, lane, acc);
            const int i = 32 * it + cl; const float g0i = GL[i], g1i = GL[64 + i];
            f32x16 a0, a1;
#pragma unroll
            for (int q = 0; q < 4; ++q) { const int c0 = 32 * cb + 8 * q + 4 * hh; const f32x4 g0 = *(const LAS f32x4*)(GL + c0), g1 = *(const LAS f32x4*)(GL + 64 + c0);
#pragma unroll
                for (int e = 0; e < 4; ++e) { const int c = c0 + e; const float v = acc[4 * q + e];
                    a0[4 * q + e] = (i >= c) ? v * __expf(fminf(g0i - g0[e], 0.f)) : 0.f; a1[4 * q + e] = (i <= c) ? v * __expf(fminf(g1i - g1[e], 0.f)) : 0.f; } }
            unsigned char* q0p = blk + DN_DIR0 + 32768 + ((cb * 2 + it) * 2) * 1024 + lane * 16; unsigned char* q1p = q0p + DN_DIRSZ;
            *(bf16x8*)(q0p) = pack8<0>(a0); *(bf16x8*)(q0p + 1024) = pack8<1>(a0); *(bf16x8*)(q1p) = pack8<0>(a1); *(bf16x8*)(q1p + 1024) = pack8<1>(a1);
        }
    }
    __syncthreads();
    }
    for (int rep_ = 0; rep_ < ((PROBE_DUP & 2048) ? 2 : 1); ++rep_) {
    if (wave < 2) {
        const int dir = wave; const LAS float* Am = (const LAS float*)(lds + P_AM) + dir * 4096;
        float Tr[64]; f32x4 cA[16], cB[16];
#define SOLVE_LOAD(dst, i_) do { _Pragma("unroll") for (int q = 0; q < 16; ++q) if (4 * q < (i_)) dst[q] = *(const LAS f32x4*)(Am + (i_) * 64 + 4 * q); } while (0)
#define SOLVE_ROW(src, i_) do { float a0 = (lane == (i_)) ? 1.f : 0.f, a1 = 0.f, a2 = 0.f, a3 = 0.f; \
            _Pragma("unroll") for (int q = 0; q < 16; ++q) { const int jb = 4 * q; \
                if (jb + 0 < (i_)) a0 -= src[q].x * Tr[jb + 0]; if (jb + 1 < (i_)) a1 -= src[q].y * Tr[jb + 1]; if (jb + 2 < (i_)) a2 -= src[q].z * Tr[jb + 2]; if (jb + 3 < (i_)) a3 -= src[q].w * Tr[jb + 3]; } \
            Tr[i_] = (a0 + a1) + (a2 + a3); } while (0)
        Tr[0] = (lane == 0) ? 1.f : 0.f;
        SOLVE_LOAD(cA, 1);
#pragma unroll
        for (int i = 1; i < 64; i += 2) {
            if (i + 1 < 64) SOLVE_LOAD(cB, i + 1);
            asm volatile("" ::: "memory");
            SOLVE_ROW(cA, i);
            if (i + 2 < 64) SOLVE_LOAD(cA, i + 2);
            asm volatile("" ::: "memory");
            if (i + 1 < 64) SOLVE_ROW(cB, i + 1);
        }
#undef SOLVE_LOAD
#undef SOLVE_ROW
        const int j = dir ? 63 - lane : lane; const float s1 = GL[256 + dir * 64 + j], s2 = GL[128 + dir * 64 + j];
        LAS bf16* T1 = (LAS bf16*)(lds + P_T1) + dir * 4608; LAS bf16* T2 = (LAS bf16*)(lds + P_T2) + dir * 4608;
#pragma unroll
        for (int ii = 0; ii < 64; ++ii) { const int i = dir ? 63 - ii : ii; T1[i * 72 + j] = (bf16)(pk2(Tr[ii] * s1, 0.f) & 0xffffu); T2[i * 72 + j] = (bf16)(pk2(Tr[ii] * s2, 0.f) & 0xffffu); }
    } else {
        const int hh = lane >> 5, rl = lane & 31;
        for (int b = wave - 2; b < 32; b += 6) {
            v2u lo, hi;
            if (b < 16) { const int it = b >> 3, db = (b >> 1) & 3, s = b & 1; const LAS bf16* p = (const LAS bf16*)(lds + P_QT) + (32 * it + rl) * 136 + 32 * db + 16 * s + 4 * hh; lo = *(const LAS v2u*)p; hi = *(const LAS v2u*)(p + 8); }
            else { const int bb = b - 16, dt = bb >> 2, cb = (bb >> 1) & 1, s = bb & 1; const LAS bf16* p = (const LAS bf16*)(lds + P_KTT) + (32 * dt + rl) * 72 + 32 * cb + 16 * s + 4 * hh; lo = *(const LAS v2u*)p; hi = *(const LAS v2u*)(p + 8); }
            v4u o; o.x = lo.x; o.y = lo.y; o.z = hi.x; o.w = hi.y;
            *(v4u*)(blk + (size_t)b * 1024 + lane * 16) = o;
        }
    }
    __syncthreads();
    }
    for (int rep_ = 0; rep_ < ((PROBE_DUP & 8192) ? 2 : 1); ++rep_) {
#pragma unroll 1
    for (int tix = wave; tix < 32; tix += 8) {
        const int dir = tix >> 4, kind = (tix >> 3) & 1, idx = tix & 7; f32x16 acc = {};
        unsigned char* dst;
        if (kind == 0) { const int ct = idx >> 2, es = idx & 3;
            acc = mma_lds(lds + P_T2 + dir * 9216 + 32 * ct * 144, 144, lds + P_VT + 32 * es * 144, 144, 4, lane, acc);
            dst = blk + DN_DIR0 + dir * DN_DIRSZ + ((ct * 4 + es) * 2) * 1024 + lane * 16;
        } else { const int db = idx >> 1, ct = idx & 1;
            acc = mma_lds(lds + P_KTT + 32 * db * 144, 144, lds + P_T1 + dir * 9216 + 32 * ct * 144, 144, 4, lane, acc);
#pragma unroll
            for (int r = 0; r < 16; ++r) acc[r] = -acc[r];
            dst = blk + DN_DIR0 + dir * DN_DIRSZ + 16384 + ((db * 2 + ct) * 2) * 1024 + lane * 16;
        }
        *(bf16x8*)dst = pack8<0>(acc); *(bf16x8*)(dst + 1024) = pack8<1>(acc);
    }
    __syncthreads();
    }
}

__device__ __forceinline__ void sgu_unit(const LayerP& P, const bf16* zb, bf16* mix, ldsp lds, int rc, int g, bool load_w, int tid, int lane, int wave) {
    asm volatile("" : "+v"(tid), "+v"(lane));
    const size_t grow0 = (size_t)rc * 128; LAS bf16* Wl = (LAS bf16*)lds; LAS bf16* Vt = (LAS bf16*)(lds + 34816);
    {
        const float gn0 = P.sgu_norm_g[g * 128 + 2 * lane], gn1 = P.sgu_norm_g[g * 128 + 2 * lane + 1];
        float v0[16], v1[16];
#pragma unroll
        for (int qq = 0; qq < 16; ++qq) { const unsigned w = *(const unsigned*)(zb + (grow0 + 16 * wave + qq) * DINP + C_SV + g * 128 + 2 * lane);
            const float a = gelu_tanh(bflo(w)), b = gelu_tanh(bfhi(w)); const float r = rsqrtf(wave_sum(a * a + b * b) * (1.f / 128.f) + EPS); v0[qq] = a * r * gn0; v1[qq] = b * r * gn1; }
        v4u o;
        o.x = pk2(v0[0], v0[1]); o.y = pk2(v0[2], v0[3]); o.z = pk2(v0[4], v0[5]); o.w = pk2(v0[6], v0[7]); *(LAS v4u*)(Vt + (2 * lane) * 136 + 16 * wave) = o;
        o.x = pk2(v0[8], v0[9]); o.y = pk2(v0[10], v0[11]); o.z = pk2(v0[12], v0[13]); o.w = pk2(v0[14], v0[15]); *(LAS v4u*)(Vt + (2 * lane) * 136 + 16 * wave + 8) = o;
        o.x = pk2(v1[0], v1[1]); o.y = pk2(v1[2], v1[3]); o.z = pk2(v1[4], v1[5]); o.w = pk2(v1[6], v1[7]); *(LAS v4u*)(Vt + (2 * lane + 1) * 136 + 16 * wave) = o;
        o.x = pk2(v1[8], v1[9]); o.y = pk2(v1[10], v1[11]); o.z = pk2(v1[12], v1[13]); o.w = pk2(v1[14], v1[15]); *(LAS v4u*)(Vt + (2 * lane + 1) * 136 + 16 * wave + 8) = o;
    }
    if (load_w) {
        const int p = tid >> 2, q0 = (tid & 3) * 32; const float* src = P.sgu_w + ((size_t)g * 128 + p) * 128 + q0;
#pragma unroll
        for (int j = 0; j < 4; ++j) { const f32x4 x0 = *(const f32x4*)(src + 8 * j), x1 = *(const f32x4*)(src + 8 * j + 4);
            v4u o; o.x = pk2(x0.x, x0.y); o.y = pk2(x0.z, x0.w); o.z = pk2(x1.x, x1.y); o.w = pk2(x1.z, x1.w); *(LAS v4u*)(Wl + p * 136 + q0 + 8 * j) = o; }
    }
    __syncthreads();
    {
        const int pt = wave >> 1, hh = lane >> 5, cl = lane & 31; LAS float* Ms = (LAS float*)(lds + 69632 + wave * 8704);
#pragma unroll
        for (int cc = 0; cc < 2; ++cc) { const int ct = 2 * (wave & 1) + cc; f32x16 acc = {};
            acc = mma_lds(lds + 32 * pt * 272, 272, lds + 34816 + 32 * ct * 272, 272, 8, lane, acc);
#pragma unroll
            for (int q = 0; q < 4; ++q) { const f32x4 bq = *(const f32x4*)(P.sgu_b + g * 128 + 32 * pt + 8 * q + 4 * hh);
#pragma unroll
                for (int e = 0; e < 4; ++e) Ms[(8 * q + 4 * hh + e) * 68 + 32 * cc + cl] = acc[4 * q + e] + bq[e]; } }
        LDS_WAIT(); asm volatile("" ::: "memory");
        const int row = lane >> 1, c0 = (lane & 1) * 32; const size_t grow = grow0 + 32 * pt + row; const int gcol = g * 128 + 64 * (wave & 1) + c0;
        const bf16* sup = zb + grow * DINP + C_SU + gcol; bf16* op = mix + grow * D + 1536 + gcol;
#pragma unroll
        for (int j = 0; j < 4; ++j) { const v4u su = *(const v4u*)(sup + 8 * j); const f32x4 m0 = *(const LAS f32x4*)(Ms + row * 68 + c0 + 8 * j), m1 = *(const LAS f32x4*)(Ms + row * 68 + c0 + 8 * j + 4);
            v4u o; o.x = pk2(gelu_tanh(bflo(su.x)) * m0.x, gelu_tanh(bfhi(su.x)) * m0.y); o.y = pk2(gelu_tanh(bflo(su.y)) * m0.z, gelu_tanh(bfhi(su.y)) * m0.w);
            o.z = pk2(gelu_tanh(bflo(su.z)) * m1.x, gelu_tanh(bfhi(su.z)) * m1.y); o.w = pk2(gelu_tanh(bflo(su.w)) * m1.z, gelu_tanh(bfhi(su.w)) * m1.w);
            *(v4u*)(op + 8 * j) = o; }
    }
    __syncthreads();
}

__device__ __forceinline__ void rope_item(bf16* zb, const float* ropet, int ri, int lane, int wave) {
    asm volatile("" : "+v"(lane));
#pragma unroll 1
    for (int tt = wave; tt < 64; tt += 8) {
        const int tl = ri * 64 + tt, t = tl & 2047; bf16* zr = zb + (size_t)(NCTX + tl) * DINP;
        const int hf = (lane >> 4) & 1, ip = (lane & 15) * 2; const f32x2 cs = *(const f32x2*)(ropet + t * 64 + 32 * hf + ip), sn = *(const f32x2*)(ropet + 131072 + t * 64 + 32 * hf + ip);
#pragma unroll
        for (int ps = 0; ps < 5; ++ps) { const int hv = ps * 2 + (lane >> 5); bf16* p = zr + (hv < 8 ? C_AQ + hv * 128 : C_AK + (hv - 8) * 128) + 64 * hf + ip;
            const unsigned wa = *(const unsigned*)p, wb = *(const unsigned*)(p + 32); const float a0 = bflo(wa), a1 = bfhi(wa), b0 = bflo(wb), b1 = bfhi(wb);
            *(unsigned*)p = pk2(a0 * cs.x - b0 * sn.x, a1 * cs.y - b1 * sn.y); *(unsigned*)(p + 32) = pk2(b0 * cs.x + a0 * sn.x, b1 * cs.y + a1 * sn.y); }
    }
}

constexpr int SC_BUF = 58368;
__device__ __forceinline__ void glds16(const void* g, ldsp l) { __builtin_amdgcn_global_load_lds((const unsigned*)g, (LAS unsigned*)l, 16, 0, 0); }
__device__ __forceinline__ void scan_dma4(const unsigned char* blk, int dir, ldsp buf, int lane, int lw) {
    const unsigned lo = (unsigned)lane * 16u;
#pragma unroll
    for (int i = 0; i < 15; ++i) { const int k = lw + 4 * i;
        if (i < 14 || lw == 0) { const unsigned char* ub = blk + (size_t)k * 1024 + (k >= 32 ? 16384 + dir * (int)DN_DIRSZ : 0); glds16(ub + lo, buf + k * 1024); } }
}
__device__ __forceinline__ void scan_chain(const unsigned char* dn, const float* state0, float* state_out, float* odir, ldsp lds, int isctx, int b, int h, int dir, int lane, int wave) {
    asm volatile("" : "+v"(lane));
    const int hh = lane >> 5, cl = lane & 31; const int nch = isctx ? 4 : 32; const int gch0 = isctx ? b * 4 : 64 + b * 32;
#define BLKOF(n) (dn + (size_t)((gch0 + (dir ? nch - 1 - (n) : (n))) * 4 + h) * DN_BLK)
    if (wave >= 4) {
        scan_dma4(BLKOF(0), dir, lds, lane, wave - 4);
#pragma unroll 1
        for (int n = 0; n < nch; ++n) {
            VM_WAIT(); __builtin_amdgcn_s_barrier(); asm volatile("" ::: "memory");
            if (n + 1 < nch) scan_dma4(BLKOF(n + 1), dir, lds + ((n + 1) & 1) * SC_BUF, lane, wave - 4);
        }
        VM_WAIT(); __builtin_amdgcn_s_barrier(); asm volatile("" ::: "memory");
        return;
    }
    const int es = wave;
    f32x16 S[4];
#pragma unroll
    for (int db = 0; db < 4; ++db) S[db] = f32x16{};
    if (state0) { const float* sp = state0 + (4 * hh) * 128 + 32 * es + cl;
#pragma unroll
        for (int db = 0; db < 4; ++db)
#pragma unroll
            for (int r = 0; r < 16; ++r) S[db][r] = sp[(32 * db + (r & 3) + 8 * (r >> 2)) * 128]; }
#define UPTR(n) (BLKOF(n) + DN_DIR0 + dir * DN_DIRSZ + (es * 2) * 1024 + lane * 16)
    bf16x8 Un[2][2];
    { const unsigned char* up = UPTR(0);
#pragma unroll
      for (int ct = 0; ct < 2; ++ct) { Un[ct][0] = *(const bf16x8*)(up + ct * 8192); Un[ct][1] = *(const bf16x8*)(up + ct * 8192 + 1024); } }
#define SBAR_() __builtin_amdgcn_sched_barrier(0)
#pragma unroll 1
    for (int n = 0; n < nch; ++n) {
        VM_WAIT(); __builtin_amdgcn_s_barrier(); asm volatile("" ::: "memory");
        f32x16 vn[2];
#pragma unroll
        for (int ct = 0; ct < 2; ++ct) { const v4u a = __builtin_bit_cast(v4u, Un[ct][0]), c = __builtin_bit_cast(v4u, Un[ct][1]);
          vn[ct][0] = bflo(a.x); vn[ct][1] = bfhi(a.x); vn[ct][2] = bflo(a.y); vn[ct][3] = bfhi(a.y); vn[ct][4] = bflo(a.z); vn[ct][5] = bfhi(a.z); vn[ct][6] = bflo(a.w); vn[ct][7] = bfhi(a.w);
          vn[ct][8] = bflo(c.x); vn[ct][9] = bfhi(c.x); vn[ct][10] = bflo(c.y); vn[ct][11] = bfhi(c.y); vn[ct][12] = bflo(c.z); vn[ct][13] = bfhi(c.z); vn[ct][14] = bflo(c.w); vn[ct][15] = bfhi(c.w); }
        if (n + 1 < nch) { const unsigned char* up = UPTR(n + 1);
#pragma unroll
            for (int ct = 0; ct < 2; ++ct) { Un[ct][0] = *(const bf16x8*)(up + ct * 8192); Un[ct][1] = *(const bf16x8*)(up + ct * 8192 + 1024); } }
        ldsp buf = lds + (n & 1) * SC_BUF; ldsp fl = buf + lane * 16;
        bf16x8 Sb[4][2];
#pragma unroll
        for (int db = 0; db < 4; ++db) { Sb[db][0] = pack8<0>(S[db]); Sb[db][1] = pack8<1>(S[db]); }
        f32x16 oa[2];
#pragma unroll
        for (int ct = 0; ct < 2; ++ct) {
            bf16x8 Anw[8], Aq[8];
#pragma unroll
            for (int k = 0; k < 8; ++k) { Anw[k] = *(const LAS bf16x8*)(fl + 32768 + (((k >> 1) * 2 + ct) * 2 + (k & 1)) * 1024); Aq[k] = *(const LAS bf16x8*)(fl + ((ct * 4 + (k >> 1)) * 2 + (k & 1)) * 1024); }
            oa[ct] = f32x16{};
            LDS_WAIT(); SBAR_();
#pragma unroll
            for (int k = 0; k < 8; ++k) { vn[ct] = __builtin_amdgcn_mfma_f32_32x32x16_bf16(Anw[k], Sb[k >> 1][k & 1], vn[ct], 0, 0, 0); oa[ct] = __builtin_amdgcn_mfma_f32_32x32x16_bf16(Aq[k], Sb[k >> 1][k & 1], oa[ct], 0, 0, 0); }
            SBAR_();
        }
        bf16x8 V1[2][2], V2[2][2];
        { const float gl = *(const LAS float*)(buf + 57344 + 512);
#pragma unroll
          for (int ct = 0; ct < 2; ++ct) { const LAS float* egl = (const LAS float*)(buf + 57344 + 256) + 32 * ct + 4 * hh; const LAS float* eg = (const LAS float*)(buf + 57344) + 32 * ct + 4 * hh;
            f32x16 vs;
#pragma unroll
            for (int q = 0; q < 4; ++q) { const f32x4 e = *(const LAS f32x4*)(egl + 8 * q), g = *(const LAS f32x4*)(eg + 8 * q);
                vs[4 * q] = vn[ct][4 * q] * e.x; vs[4 * q + 1] = vn[ct][4 * q + 1] * e.y; vs[4 * q + 2] = vn[ct][4 * q + 2] * e.z; vs[4 * q + 3] = vn[ct][4 * q + 3] * e.w;
                oa[ct][4 * q] *= g.x; oa[ct][4 * q + 1] *= g.y; oa[ct][4 * q + 2] *= g.z; oa[ct][4 * q + 3] *= g.w; }
            V1[ct][0] = pack8<0>(vn[ct]); V1[ct][1] = pack8<1>(vn[ct]); V2[ct][0] = pack8<0>(vs); V2[ct][1] = pack8<1>(vs); }
#pragma unroll
          for (int db = 0; db < 4; ++db)
#pragma unroll
              for (int r = 0; r < 16; ++r) S[db][r] *= gl; }
        SBAR_();
        { bf16x8 Aqk[8];
#pragma unroll
          for (int k = 0; k < 8; ++k) Aqk[k] = *(const LAS bf16x8*)(fl + 49152 + k * 1024);
          LDS_WAIT(); SBAR_();
#pragma unroll
          for (int cb = 0; cb < 2; ++cb)
#pragma unroll
              for (int s = 0; s < 2; ++s) { oa[0] = __builtin_amdgcn_mfma_f32_32x32x16_bf16(Aqk[(cb * 2 + 0) * 2 + s], V1[cb][s], oa[0], 0, 0, 0); oa[1] = __builtin_amdgcn_mfma_f32_32x32x16_bf16(Aqk[(cb * 2 + 1) * 2 + s], V1[cb][s], oa[1], 0, 0, 0); }
          SBAR_(); }
#pragma unroll
        for (int half = 0; half < 2; ++half) { bf16x8 Akt[8];
#pragma unroll
            for (int k = 0; k < 8; ++k) Akt[k] = *(const LAS bf16x8*)(fl + 16384 + (half * 8 + k) * 1024);
            LDS_WAIT(); SBAR_();
#pragma unroll
            for (int k = 0; k < 4; ++k) { S[2 * half] = __builtin_amdgcn_mfma_f32_32x32x16_bf16(Akt[k], V2[k >> 1][k & 1], S[2 * half], 0, 0, 0);
                S[2 * half + 1] = __builtin_amdgcn_mfma_f32_32x32x16_bf16(Akt[4 + k], V2[k >> 1][k & 1], S[2 * half + 1], 0, 0, 0); }
            SBAR_(); }
        { const int pc = dir ? nch - 1 - n : n;
#pragma unroll
          for (int ct = 0; ct < 2; ++ct) { unsigned ob = (unsigned)((((gch0 + pc) * 64 + 32 * ct + 4 * hh) * 512 + h * 128 + 32 * es + cl) * 4); asm volatile("" : "+v"(ob));
#pragma unroll
              for (int r = 0; r < 16; ++r) *(float*)((char*)odir + (ob + (unsigned)(((r & 3) + 8 * (r >> 2)) * 2048))) = oa[ct][r]; } }
    }
#undef SBAR_
    if (state_out) {
#pragma unroll
        for (int db = 0; db < 4; ++db)
#pragma unroll
            for (int r = 0; r < 16; ++r) state_out[(size_t)(32 * db + crow(r, hh)) * 128 + 32 * es + cl] = S[db][r];
    }
    VM_WAIT(); LDS_WAIT(); __builtin_amdgcn_s_barrier(); asm volatile("" ::: "memory");
#undef BLKOF
#undef UPTR
}

#define KSWZ(row, colB) ((row) * 256 + ((colB) ^ (((row) & 7) << 4)))
#define SBAR() __builtin_amdgcn_sched_barrier(0)
__device__ __forceinline__ int v_st(int k, int c) { const int kk = (k & ~0xC) | ((k & 4) << 1) | ((k & 8) >> 1); return ((kk >> 3) * 4 + (c >> 5)) * 512 + ((kk & 7) * 32 + (c & 31)) * 2; }
__device__ __forceinline__ int v_rd_base(int lane) { return ((lane & 3) << 3) | (((lane >> 2) & 3) << 6) | (((lane >> 4) & 1) << 5) | (((lane >> 5) & 1) << 8); }
constexpr int v_rd_off(int d0, int ks, int half) { return d0 * 512 + ks * 4096 + half * 2048; }
template <int OFF> __device__ __forceinline__ s16x4 tr_read(int vb) { s16x4 r; asm volatile("ds_read_b64_tr_b16 %0, %1 offset:%2" : "=&v"(r) : "v"(vb), "i"(OFF) : "memory"); return r; }
template <int D0> __device__ __forceinline__ void pv_one(f32x16& od, int vb, bf16x8 pa0, bf16x8 pa1, bf16x8 pa2, bf16x8 pa3) {
    const s16x4 l0 = tr_read<v_rd_off(D0, 0, 0)>(vb), h0 = tr_read<v_rd_off(D0, 0, 1)>(vb), l1 = tr_read<v_rd_off(D0, 1, 0)>(vb), h1 = tr_read<v_rd_off(D0, 1, 1)>(vb);
    const s16x4 l2 = tr_read<v_rd_off(D0, 2, 0)>(vb), h2 = tr_read<v_rd_off(D0, 2, 1)>(vb), l3 = tr_read<v_rd_off(D0, 3, 0)>(vb), h3 = tr_read<v_rd_off(D0, 3, 1)>(vb);
    asm volatile("s_waitcnt lgkmcnt(0)" ::: "memory"); SBAR();
#define PKV(L, H) (bf16x8){L[0], L[1], L[2], L[3], H[0], H[1], H[2], H[3]}
    od = __builtin_amdgcn_mfma_f32_32x32x16_bf16(pa0, PKV(l0, h0), od, 0, 0, 0);
    od = __builtin_amdgcn_mfma_f32_32x32x16_bf16(pa1, PKV(l1, h1), od, 0, 0, 0);
    od = __builtin_amdgcn_mfma_f32_32x32x16_bf16(pa2, PKV(l2, h2), od, 0, 0, 0);
    od = __builtin_amdgcn_mfma_f32_32x32x16_bf16(pa3, PKV(l3, h3), od, 0, 0, 0);
#undef PKV
}
__device__ __forceinline__ void qkt(f32x16& p0, f32x16& p1, ldsp Ks, const bf16x8* qr, int r32, int hi) {
    p0 = f32x16{}; p1 = f32x16{};
#pragma unroll
    for (int d0 = 0; d0 < 8; ++d0) { const int cb = (d0 * 16 + hi * 8) * 2;
        const bf16x8 b0 = *(const LAS bf16x8*)(Ks + KSWZ(r32, cb)); const bf16x8 b1 = *(const LAS bf16x8*)(Ks + KSWZ(32 + r32, cb));
        p0 = __builtin_amdgcn_mfma_f32_32x32x16_bf16(b0, qr[d0], p0, 0, 0, 0); p1 = __builtin_amdgcn_mfma_f32_32x32x16_bf16(b1, qr[d0], p1, 0, 0, 0); }
}
struct AttnP { const bf16* zb; const bf16* ck; const bf16* cv; bf16* mix; const float* sink; int l; };
__device__ __forceinline__ void attn_unit(const AttnP& A, ldsp lds, int u, int tid, int lane, int wave) {
    asm volatile("" : "+v"(tid), "+v"(lane));
    constexpr float C = 0.08838834764831845f * 1.4426950408889634f;
    const int r32 = lane & 31, hi = lane >> 5;
    const bool lat = u < 512; int b, head, q0, T; size_t rowbase;
    if (lat) { q0 = (u & 7) * 256; head = (u >> 3) & 7; b = u >> 6; rowbase = NCTX + (size_t)b * 2048; T = 2048; }
    else { const int uu = u - 512; head = uu & 7; b = uu >> 3; q0 = 0; rowbase = (size_t)b * 256; T = 256; }
    const int kvh = head >> 2, nct = lat ? 8 : 0;
    const int ws = lat ? max(0, q0 - 128) / 64 : 0, we = lat ? min(T, q0 + 384) / 64 : 4, NT = nct + (we - ws);
    const int qw = q0 + 32 * wave;
    ldsp V_lds = lds, K_lds = lds + 32768; LAS float* al = (LAS float*)(lds + 65536) + wave * 64;
    bf16x8 qr[8];
    { const bf16* Qw = A.zb + (rowbase + qw + r32) * DINP + C_AQ + head * 128 + hi * 8;
#pragma unroll
      for (int d0 = 0; d0 < 8; ++d0) qr[d0] = *(const bf16x8*)(Qw + d0 * 16); }
    float m_reg = A.sink[head] * 1.4426950408889634f, l_reg = 1.f; f32x16 o[4] = {};
    const int sr = tid >> 4, sc = (tid & 15) * 8, vst0 = v_st(sr, sc), vst1 = v_st(32 + sr, sc);
    const int vb0 = (int)(unsigned)(size_t)V_lds + v_rd_base(lane);
    bf16x8 ks0, ks1, vs0, vs1;
#define ALOAD(j) do { const bf16 *kp, *vp; size_t st; if ((j) < nct) { kp = A.ck + ((size_t)(b * 4 + A.l) * 512 + (j) * 64) * 256 + kvh * 128; vp = A.cv + ((size_t)(b * 4 + A.l) * 512 + (j) * 64) * 256 + kvh * 128; st = 256; } \
        else { const size_t r0 = rowbase + (size_t)(ws + (j) - nct) * 64; kp = A.zb + r0 * DINP + C_AK + kvh * 128; vp = A.zb + r0 * DINP + C_AV + kvh * 128; st = DINP; } \
        ks0 = *(const bf16x8*)(kp + sr * st + sc); ks1 = *(const bf16x8*)(kp + (32 + sr) * st + sc); vs0 = *(const bf16x8*)(vp + sr * st + sc); vs1 = *(const bf16x8*)(vp + (32 + sr) * st + sc); } while (0)
#define AWRITE(bb) do { *(LAS bf16x8*)(V_lds + (bb) * 16384 + vst0) = vs0; *(LAS bf16x8*)(V_lds + (bb) * 16384 + vst1) = vs1; \
        *(LAS bf16x8*)(K_lds + (bb) * 16384 + KSWZ(sr, sc * 2)) = ks0; *(LAS bf16x8*)(K_lds + (bb) * 16384 + KSWZ(32 + sr, sc * 2)) = ks1; } while (0)
    ALOAD(0); AWRITE(0); __syncthreads();
#pragma unroll 1
    for (int j = 0; j < NT; ++j) {
        if (j + 1 < NT) ALOAD(j + 1);
        bool active = true, needmask = false; int kpos0 = 0;
        if (lat && j >= nct) { kpos0 = (ws + j - nct) * 64; active = (kpos0 + 63 >= qw - 128) && (kpos0 <= qw + 31 + 128); needmask = !((kpos0 >= qw + 31 - 128) && (kpos0 + 63 <= qw + 128)); }
        if (active) {
            f32x16 p0, p1;
            qkt(p0, p1, K_lds + (j & 1) * 16384, qr, r32, hi);
            if (needmask) { const int q = qw + r32;
#pragma unroll
                for (int r = 0; r < 16; ++r) { const int k0 = kpos0 + crow(r, hi) - q, k1 = k0 + 32; if (k0 > 128 || k0 < -128) p0[r] = -1e30f; if (k1 > 128 || k1 < -128) p1[r] = -1e30f; } }
            float pmax = p0[0];
#pragma unroll
            for (int r = 1; r < 16; ++r) pmax = fmaxf(pmax, p0[r]);
#pragma unroll
            for (int r = 0; r < 16; ++r) pmax = fmaxf(pmax, p1[r]);
            { auto rr = __builtin_amdgcn_permlane32_swap(__float_as_uint(pmax), __float_as_uint(pmax), false, false); pmax = fmaxf(__uint_as_float(rr[0]), __uint_as_float(rr[1])); }
            const float mn = fmaxf(m_reg, pmax * C), alpha = __builtin_amdgcn_exp2f(m_reg - mn); m_reg = mn;
            float ps = 0.f;
#pragma unroll
            for (int r = 0; r < 16; ++r) { p0[r] = __builtin_amdgcn_exp2f(fmaf(p0[r], C, -mn)); p1[r] = __builtin_amdgcn_exp2f(fmaf(p1[r], C, -mn)); ps += p0[r] + p1[r]; }
            { auto rr = __builtin_amdgcn_permlane32_swap(__float_as_uint(ps), __float_as_uint(ps), false, false); ps = __uint_as_float(rr[0]) + __uint_as_float(rr[1]); }
            l_reg = l_reg * alpha + ps;
            if (__any(alpha < 1.f)) { if (hi == 0) al[r32] = alpha; LDS_WAIT();
#pragma unroll
                for (int d = 0; d < 4; ++d)
#pragma unroll
                    for (int r = 0; r < 16; ++r) o[d][r] *= al[crow(r, hi)]; }
            bf16x8 pa0, pa1, pa2, pa3;
#define PK4(P, BASE, OUT) do { unsigned a0 = pk2(P[BASE + 0], P[BASE + 1]), a1 = pk2(P[BASE + 2], P[BASE + 3]); unsigned b0 = pk2(P[BASE + 4], P[BASE + 5]), b1 = pk2(P[BASE + 6], P[BASE + 7]); \
    auto r0 = __builtin_amdgcn_permlane32_swap(a0, b0, false, false); auto r1 = __builtin_amdgcn_permlane32_swap(a1, b1, false, false); \
    v4u w = {r0[0], r1[0], r0[1], r1[1]}; OUT = __builtin_bit_cast(bf16x8, w); } while (0)
            PK4(p0, 0, pa0); PK4(p0, 8, pa1); PK4(p1, 0, pa2); PK4(p1, 8, pa3);
#undef PK4
            const int vb = vb0 + (j & 1) * 16384;
            pv_one<0>(o[0], vb, pa0, pa1, pa2, pa3); pv_one<1>(o[1], vb, pa0, pa1, pa2, pa3); pv_one<2>(o[2], vb, pa0, pa1, pa2, pa3); pv_one<3>(o[3], vb, pa0, pa1, pa2, pa3);
        }
        if (j + 1 < NT) AWRITE((j + 1) & 1);
        __syncthreads();
    }
#undef ALOAD
#undef AWRITE
    if (hi == 0) al[r32] = l_reg; LDS_WAIT();
    bf16* Ow = A.mix + (rowbase + qw) * D + head * 128 + r32;
#pragma unroll
    for (int r = 0; r < 16; ++r) { const int orow = crow(r, hi); const float rl = __builtin_amdgcn_rcpf(al[orow]);
#pragma unroll
        for (int d0 = 0; d0 < 4; ++d0) Ow[(size_t)orow * D + d0 * 32] = (bf16)(pk2(o[d0][r] * rl, 0.f) & 0xffffu); }
}

#ifndef PROBE_DUP
#define PROBE_DUP 0
#endif
#ifndef PROBE_T
#define PROBE_T 0
#endif
__device__ __forceinline__ int lane_l() { int t; asm volatile("v_mbcnt_lo_u32_b32 %0, -1, 0\n\tv_mbcnt_hi_u32_b32 %0, -1, %0" : "=v"(t)); return t; }
struct Args { const float* in[24]; float* out; unsigned char* ws; int ph_lo, ph_hi; };
constexpr int NPH = 31;
__global__ void __launch_bounds__(NWAVES * 64, 2) fwd(Args args) {
    extern __shared__ __attribute__((aligned(16))) unsigned char lds_raw[];
    ldsp lds = (ldsp)lds_raw;
    volatile LAS unsigned* MISC = (volatile LAS unsigned*)(lds + LDSCTL_OFF);
    const int wave = __builtin_amdgcn_readfirstlane((int)threadIdx.x >> 6), G = gridDim.x;
#define tid ((wave << 6) | lane_l())
#define lane lane_l()
    unsigned char* ws = args.ws; unsigned* ctl = (unsigned*)(ws + WS_CTL);
    for (int u = tid; u < (LDS_BYTES - LDSCTL_OFF) / 4; u += NWAVES * 64) MISC[u] = 0u;
    __syncthreads();
    const int lo = args.ph_lo, hi = args.ph_hi; const bool multi = (hi - lo) > 1;
    XcdBarrier bar; bar.bar = ctl + CW_BAR; bar.x = 0; bar.st = nullptr; bar.t0 = false;
    if (multi) bar = xcd_barrier_post(ctl + CW_BAR, MISC + 8);
#define IN(k) (lo <= (k) && (k) < hi)
    unsigned long long tacc_ = 0, t0_ = 0;
#define PH_T0(bit) do { if (PROBE_T & (bit)) t0_ = __builtin_amdgcn_s_memrealtime(); } while (0)
#define PH_T1(bit) do { if (PROBE_T & (bit)) tacc_ += __builtin_amdgcn_s_memrealtime() - t0_; } while (0)
#define DUPBAR() do { if (multi) { XcdBarrier b2_ = bar; b2_.t0 = (wave == 0) && (lane_l() == 0); asm volatile("" : "+s"(b2_.bar)); xcd_barrier(b2_); } } while (0)
#if PROBE_DUP & 512
#define SEAM(k) do { if (IN(k) && IN((k) + 1)) { XcdBarrier b2_ = bar; b2_.t0 = (wave == 0) && (lane_l() == 0); asm volatile("" : "+s"(b2_.bar)); xcd_barrier(b2_); xcd_barrier(b2_); } } while (0)
#else
#define SEAM(k) do { if (IN(k) && IN((k) + 1)) { XcdBarrier b2_ = bar; b2_.t0 = (wave == 0) && (lane_l() == 0); asm volatile("" : "+s"(b2_.bar)); xcd_barrier(b2_); } } while (0)
#endif
    const float *x_prompt = args.in[0], *x_sample = args.in[1], *cache_k = args.in[2], *cache_v = args.in[3], *state_delta = args.in[4], *c_in = args.in[5], *c_ctx = args.in[6];
    const float *norm1_g = args.in[7], *w_mod = args.in[8], *b_mod = args.in[9], *w_in = args.in[10], *conv_w = args.in[11], *attn_sink = args.in[12], *dn_a_log = args.in[13], *dn_dt_bias = args.in[14];
    const float *dn_norm_g = args.in[15], *sgu_norm_g = args.in[16], *sgu_w = args.in[17], *sgu_b = args.in[18], *w_out = args.in[19], *norm2_g = args.in[20], *w_ff1 = args.in[21], *w_ff2 = args.in[22], *final_norm_g = args.in[23];
    float* out = args.out;
    float* MOD = (float*)(ws + WS_MOD); float* XB = (float*)(ws + WS_X); bf16* HB = (bf16*)(ws + WS_HB); bf16* ZB = (bf16*)(ws + WS_ZB); bf16* FB = ZB; bf16* XA = (bf16*)(ws + WS_XA);
    float* ODIR = (float*)(ws + WS_ODIR); unsigned char* DN = ws + WS_DN; float* SSQ = (float*)(ctl + CW_SSQ); const float* BW = (const float*)(ws + WS_BW);

    PH_T0(1);
    if (IN(0)) {
        P0Args pa{c_in, c_ctx, norm1_g, norm2_g, w_mod, b_mod, w_in, w_out, w_ff1, w_ff2, cache_k, cache_v, ws};
        p0_prologue(pa, lds, tid, lane, wave, G);
        __syncthreads();
#if PROBE_DUP & 4
        p0_prologue(pa, lds, tid, lane, wave, G); __syncthreads();
#endif
    }
    SEAM(0); PH_T1(1); PH_T0(2);
    if (IN(1)) {
        p0b_bias(ws, lds, tid, lane, wave, G);
        norm_phase<false>(x_prompt, x_sample, MOD + 1 * 2048, XA, SSQ, nullptr, lane, wave, G);
    }
    SEAM(1); PH_T1(2);
#pragma unroll 1
    for (int l = 0; l < DEPTH; ++l) {
        const int pb = 2 + 7 * l;
        const float* modl = MOD + (size_t)l * 9 * 12288;
        const float* xa0 = l == 0 ? x_prompt : XB; const float* xa1 = l == 0 ? x_sample : XB + (size_t)NCTX * D;
        if (l == 0) PH_T0(4);
        if (IN(pb + 0)) {
            const bf16* gA = XA; const bf16* gB = (const bf16*)(ws + WS_WIN) + (size_t)l * DINP * 2048; asm volatile("" : "+s"(gA), "+s"(gB));
            pg8::Gemm g{gA, gB, M, DINP, 2048}; pg8::StaticOrder S; S.init(M, DINP, G, (int)blockIdx.x);
            pg8::EpiZ E{ZB, DINP, out + O_K + (size_t)l * 65536, out + O_V + (size_t)l * 65536, SSQ + (size_t)(2 * l) * M, BW + (size_t)l * BW_L};
            pg8::gemm_phase<pg8::EpiZ, pg8::StaticOrder, true, true>(lds, g, S, E, wave);
        }
        SEAM(pb + 0); PH_T1(4); PH_T0(8);
        LayerP LP{conv_w + (size_t)l * 5 * 1536, dn_a_log + l * 8, dn_dt_bias + l * 8, dn_norm_g + l * 128, sgu_norm_g + l * 512, sgu_w + (size_t)l * 4 * 128 * 128, sgu_b + l * 512, attn_sink + l * 8};
        if (IN(pb + 1)) {
            int wg_ = -1;
            for (int it = blockIdx.x; it < 1280 + 640 + 256; it += G) {
                if (it < 1280) dn_prep_unit(LP, ZB, DN, lds, it >> 2, it & 3, tid, lane, wave);
                else if (it < 1920) { const int g_ = (it - 1280) & 3; sgu_unit(LP, ZB, HB, lds, (it - 1280) >> 2, g_, g_ != wg_, tid, lane, wave); wg_ = g_; }
                else rope_item(ZB, (const float*)(ws + WS_ROPE), it - 1920, lane, wave);
            }
        }
#if PROBE_DUP & 16
        if (IN(pb + 1)) { DUPBAR();
            for (int it = blockIdx.x; it < 1280 + 640; it += G) {
                if (it < 1280) dn_prep_unit(LP, ZB, DN, lds, it >> 2, it & 3, tid, lane, wave);
                else sgu_unit(LP, ZB, HB, lds, (it - 1280) >> 2, (it - 1280) & 3, true, tid, lane, wave);
            } }
#endif
#if PROBE_DUP & 32
        if (IN(pb + 1)) { DUPBAR(); for (int it = blockIdx.x; it < 1280; it += G) dn_prep_unit(LP, ZB, DN, lds, it >> 2, it & 3, tid, lane, wave); }
#endif
        SEAM(pb + 1); PH_T1(8); PH_T0(16);
        if (IN(pb + 2)) {
            for (int cu = blockIdx.x; cu < 192; cu += G) {
                const bool isctx = cu >= 64; const int cc = isctx ? cu - 64 : cu; const int b = cc >> 3, h = (cc >> 1) & 3, dir = cc & 1;
                const float* s0 = isctx ? nullptr : state_delta + ((((size_t)b * 4 + l) * 2 + dir) * 4 + h) * 16384;
                float* so = isctx ? out + O_DELTA + ((((size_t)b * 4 + l) * 2 + dir) * 4 + h) * 16384 : nullptr;
                scan_chain(DN, s0, so, ODIR + (size_t)dir * M * 512, lds, isctx ? 1 : 0, b, h, dir, lane, wave);
            }
            AttnP AP{ZB, (const bf16*)(ws + WS_CK), (const bf16*)(ws + WS_CV), HB, LP.sink, l};
            for (;;) {
                if (tid == 0) MISC[0] = atomicAdd(ctl + CW_ATT + 64 * l, 1u);
                __syncthreads(); const int u = (int)MISC[0]; __syncthreads();
                if (u >= 640) break;
                attn_unit(AP, lds, u, tid, lane, wave);
            }
        }
#if PROBE_DUP & 128
        if (IN(pb + 2)) { DUPBAR();
            for (int cu = blockIdx.x; cu < 192; cu += G) {
                const bool isctx = cu >= 64; const int cc = isctx ? cu - 64 : cu; const int b = cc >> 3, h = (cc >> 1) & 3, dir = cc & 1;
                const float* s0 = isctx ? nullptr : state_delta + ((((size_t)b * 4 + l) * 2 + dir) * 4 + h) * 16384;
                float* so = isctx ? out + O_DELTA + ((((size_t)b * 4 + l) * 2 + dir) * 4 + h) * 16384 : nullptr;
                scan_chain(DN, s0, so, ODIR + (size_t)dir * M * 512, lds, isctx ? 1 : 0, b, h, dir, lane, wave);
            } }
#endif
#if PROBE_DUP & 256
        if (IN(pb + 2)) { DUPBAR();
            AttnP AP{ZB, (const bf16*)(ws + WS_CK), (const bf16*)(ws + WS_CV), HB, LP.sink, l};
            for (;;) {
                if (tid == 0) MISC[0] = atomicAdd(ctl + CW_ATT + 64 * (l + 4), 1u);
                __syncthreads(); const int u = (int)MISC[0]; __syncthreads();
                if (u >= 640) break;
                attn_unit(AP, lds, u, tid, lane, wave);
            } }
#endif
#if PROBE_DUP & 2
        if (IN(pb + 2)) { DUPBAR();
            for (int cu = blockIdx.x; cu < 192; cu += G) {
                const bool isctx = cu >= 64; const int cc = isctx ? cu - 64 : cu; const int b = cc >> 3, h = (cc >> 1) & 3, dir = cc & 1;
                const float* s0 = isctx ? nullptr : state_delta + ((((size_t)b * 4 + l) * 2 + dir) * 4 + h) * 16384;
                float* so = isctx ? out + O_DELTA + ((((size_t)b * 4 + l) * 2 + dir) * 4 + h) * 16384 : nullptr;
                scan_chain(DN, s0, so, ODIR + (size_t)dir * M * 512, lds, isctx ? 1 : 0, b, h, dir, lane, wave);
            }
            AttnP AP{ZB, (const bf16*)(ws + WS_CK), (const bf16*)(ws + WS_CV), HB, LP.sink, l};
            for (;;) {
                if (tid == 0) MISC[0] = atomicAdd(ctl + CW_ATT + 64 * (l + 4), 1u);
                __syncthreads(); const int u = (int)MISC[0]; __syncthreads();
                if (u >= 640) break;
                attn_unit(AP, lds, u, tid, lane, wave);
            } }
#endif
        SEAM(pb + 2); PH_T1(16); PH_T0(32);
        if (IN(pb + 3)) {
            const int ln = lane_l();
            const float gn0 = LP.dn_norm_g[2 * ln], gn1 = LP.dn_norm_g[2 * ln + 1];
            for (int it = blockIdx.x * NWAVES + wave; it < M * 4; it += G * NWAVES) { const size_t row = it >> 2; const int hh = it & 3;
                const f32x2 a = *(const f32x2*)(ODIR + row * 512 + hh * 128 + 2 * ln), b2 = *(const f32x2*)(ODIR + (size_t)M * 512 + row * 512 + hh * 128 + 2 * ln);
                const float o0 = a.x + b2.x, o1 = a.y + b2.y; const float r = rsqrtf(wave_sum(o0 * o0 + o1 * o1) * (1.f / 128.f) + EPS);
                const unsigned z = *(const unsigned*)(ZB + row * DINP + C_DZ + hh * 128 + 2 * ln);
                *(unsigned*)(HB + row * D + 1024 + hh * 128 + 2 * ln) = pk2(o0 * r * gn0 * silu_f(bflo(z)), o1 * r * gn1 * silu_f(bfhi(z))); }
        }
        SEAM(pb + 3); PH_T1(32); PH_T0(64);
        if (IN(pb + 4)) {
            const bf16* gA = HB; const bf16* gB = (const bf16*)(ws + WS_WOUT) + (size_t)l * 2048 * 2048; asm volatile("" : "+s"(gA), "+s"(gB));
            pg8::Gemm g{gA, gB, M, 2048, 2048};
            pg8::EpiRes E{xa0, xa1, XB, modl + 2 * 2048, modl + 4 * 2048, XA, SSQ + (size_t)(2 * l + 1) * M};
            pg8::StaticOrder S; S.init(M, 2048, G, (int)blockIdx.x);
            pg8::gemm_phase<pg8::EpiRes, pg8::StaticOrder, true, true>(lds, g, S, E, wave);
        }
        SEAM(pb + 4); PH_T1(64); PH_T0(128);
        if (IN(pb + 5)) {
            const bf16* gA = XA; const bf16* gB = (const bf16*)(ws + WS_WFF1) + (size_t)l * DFF * 2048; asm volatile("" : "+s"(gA), "+s"(gB));
            pg8::Gemm g{gA, gB, M, DFF, 2048}; pg8::StaticOrder S; S.init(M, DFF, G, (int)blockIdx.x);
            pg8::EpiRelu2 E{FB, DFF, SSQ + (size_t)(2 * l + 1) * M, BW + (size_t)l * BW_L + 9 * DINP};
            pg8::gemm_phase<pg8::EpiRelu2, pg8::StaticOrder, true, true>(lds, g, S, E, wave);
        }
        SEAM(pb + 5); PH_T1(128); PH_T0(256);
        if (IN(pb + 6)) {
            const bf16* gA = FB; const bf16* gB = (const bf16*)(ws + WS_WFF2) + (size_t)l * 2048 * DFF; asm volatile("" : "+s"(gA), "+s"(gB));
            pg8::Gemm g{gA, gB, M, 2048, DFF};
            pg8::EpiRes E{XB, XB + (size_t)NCTX * D, XB, modl + 5 * 2048, l + 1 < DEPTH ? modl + 9 * 12288 + 1 * 2048 : nullptr, XA, SSQ + (size_t)(2 * l + 2) * M};
            pg8::StaticOrder S; S.init(M, 2048, G, (int)blockIdx.x);
            pg8::gemm_phase<pg8::EpiRes, pg8::StaticOrder, true, true>(lds, g, S, E, wave);
        }
        SEAM(pb + 6); PH_T1(256); PH_T0(4);
    }
    PH_T0(512);
    if (IN(30)) norm_phase<true>(XB, XB + (size_t)NCTX * D, final_norm_g, nullptr, nullptr, out + O_Y, lane, wave, G);
    PH_T1(512);
    if (PROBE_T && blockIdx.x == 0) { const unsigned long long te_ = __builtin_amdgcn_s_memrealtime() + 4ull * tacc_; while (__builtin_amdgcn_s_memrealtime() < te_) __builtin_amdgcn_s_sleep(64); }
#undef IN
#undef SEAM
#undef DUPBAR
#undef tid
#undef lane
}

#ifndef MK_ONE_LAUNCH
#define MK_ONE_LAUNCH 1
#endif
extern "C" void kernel_launch(void* const* d_in, const int* in_sizes, int n_in, void* d_out, int out_size, void* d_ws, size_t ws_size, hipStream_t stream) {
    static int grid = 0;
    if (grid == 0) {
        if (n_in != 24 || (size_t)out_size != O_END || ws_size < WS_END) { fprintf(stderr, "kernel_launch: unexpected shapes: n_in %d out %d ws %zu (need %zu)\n", n_in, out_size, ws_size, (size_t)WS_END); grid = -1; return; }
        int dev = 0, cus = 0, per_cu = 0;
        if (hipGetDevice(&dev) != hipSuccess || hipDeviceGetAttribute(&cus, hipDeviceAttributeMultiprocessorCount, dev) != hipSuccess) { grid = -1; return; }
        if (hipFuncSetAttribute((const void*)fwd, hipFuncAttributeMaxDynamicSharedMemorySize, LDS_BYTES) != hipSuccess) { fprintf(stderr, "kernel_launch: hipFuncSetAttribute failed\n"); grid = -1; return; }
        if (hipOccupancyMaxActiveBlocksPerMultiprocessor(&per_cu, (const void*)fwd, NWAVES * 64, LDS_BYTES) != hipSuccess || per_cu < 1) fprintf(stderr, "kernel_launch: occupancy query reports %d\n", per_cu);
        (void)hipGetLastError();
        grid = cus;
    }
    if (grid < 0) return;
    (void)hipMemsetAsync((char*)d_ws + WS_CTL, 0, CTL_ZERO_BYTES, stream);
    for (int l = 0; l < DEPTH; ++l) (void)hipMemsetAsync((char*)d_ws + WS_WIN + ((size_t)l * DINP + 4640) * 2048 * 2, 0, (size_t)(DINP - 4640) * 2048 * 2, stream);
    Args a{};
    for (int i = 0; i < 24; ++i) a.in[i] = (const float*)d_in[i];
    a.out = (float*)d_out; a.ws = (unsigned char*)d_ws;
#if MK_ONE_LAUNCH
    a.ph_lo = 0; a.ph_hi = NPH;
    hipLaunchKernelGGL(fwd, dim3(grid), dim3(NWAVES * 64), LDS_BYTES, stream, a);
#else
    for (int p = 0; p < NPH; ++p) { a.ph_lo = p; a.ph_hi = p + 1; hipLaunchKernelGGL(fwd, dim3(grid), dim3(NWAVES * 64), LDS_BYTES, stream, a); }
#endif
    const hipError_t le = hipPeekAtLastError();
    if (le != hipSuccess) fprintf(stderr, "kernel_launch: launch failed: %s\n", hipGetErrorName(le));
}
```

```cpp
#include <hip/hip_runtime.h>
#include <cstdio>
#include <cstdint>
namespace pg8 {
#define PG8_LAS __attribute__((address_space(3)))
typedef unsigned short bf16_t;
typedef short bf16x8 __attribute__((ext_vector_type(8)));
typedef float f32x4 __attribute__((ext_vector_type(4)));
typedef unsigned u32x4 __attribute__((ext_vector_type(4)));
constexpr int BM = 256, BK = 64, HALF = 128, HTB = HALF * BK * 2  , STAGE_BYTES = 8 * HTB, NXCD = 8, WGM = 8;

__host__ __device__ __forceinline__ int lds_byte(int r, int c) { const int st = (r >> 4) * 2 + (c >> 5), rr = r & 15, cc = c & 31, ob = rr * 64 + cc * 2; return st * 1024 + (ob ^ (((ob >> 9) & 1) << 5)); }
__host__ __device__ __forceinline__ void stage_rc(int b, int& R, int& C) { const int st = b / 1024, sb = b % 1024, swz = sb ^ (((sb >> 9) & 1) << 5); R = (st >> 1) * 16 + swz / 64; C = (st & 1) * 32 + (swz % 64) / 2; }
__host__ __device__ __forceinline__ int perm32(int rho) { const int n = rho >> 4, i = rho & 15; return 8 * (i >> 2) + 4 * n + (i & 3); }

struct Unit { int pm, pn; };
struct Gemm { const bf16_t* A; const bf16_t* Bt; int M, N, K; };

struct StaticOrder {
    int nM, nN, nwg, G, c;
    __host__ __device__ void init(int M, int N, int G_, int c_) { nM = M / BM; nN = N / BM; nwg = nM * nN; G = G_; c = c_; }
    __host__ __device__ bool next(int i, Unit& u) const {
        const long L = (long)i * G + c; if (L >= nwg) return false;
        int wgid = (int)L; { const int q = nwg / NXCD, r = nwg % NXCD, xcd = wgid % NXCD, off = wgid / NXCD; wgid = (xcd < r ? xcd * (q + 1) : r * (q + 1) + (xcd - r) * q) + off; }
        const int nig = WGM * nN, gid = wgid / nig, fm = gid * WGM, gsz = (nM - fm) < WGM ? (nM - fm) : WGM;
        u.pm = fm + ((wgid % nig) % gsz); u.pn = (wgid % nig) / gsz; return true;
    }
    __device__ __forceinline__ void a_ready(const Unit&) const {}
    __device__ __forceinline__ void done(const Unit&) const {}
};


typedef float f32x2c __attribute__((ext_vector_type(2))); typedef __bf16 bf16x2c __attribute__((ext_vector_type(2)));
__device__ __forceinline__ unsigned cvt_pk_bf16(float lo, float hi) { const f32x2c v = {lo, hi}; return __builtin_bit_cast(unsigned, __builtin_convertvector(v, bf16x2c)); }
__device__ __forceinline__ int cond_of(int rowt) { return rowt < 4096 ? 8 : ((rowt - 4096) >> 11); }
struct EpiZ {
    static constexpr bool PERM = true, AFTER_DRAIN = false;
    bf16_t* O; int ldc; float* outk; float* outv; const float* ssq; const float* bw;
    __device__ __forceinline__ void operator()(const f32x4 (&acc)[2][2][4][2], const Unit& u, int wr, int wc, int fr, int fq) const {
        asm volatile("" : "+v"(fr), "+v"(fq));
        const int rowt = u.pm * BM, row0 = rowt + wr * 64 + fr; const int col0 = u.pn * BM + wc * 32 + 8 * fq;
        const bool kv = (u.pm < 16) && (u.pn == 4 || u.pn == 5);
        float* ob = (u.pn == 4 ? outk : outv) + (size_t)u.pm * (4 * 65536) + wc * 32 + 8 * fq;
        const float* bp = bw + (size_t)cond_of(rowt) * ldc + col0; f32x4 bv[2][2];
#pragma unroll
        for (int bj = 0; bj < 2; ++bj)
#pragma unroll
            for (int n = 0; n < 2; ++n) bv[bj][n] = *(const f32x4*)(bp + bj * HALF + 4 * n);
#pragma unroll
        for (int ai = 0; ai < 2; ++ai)
#pragma unroll
            for (int m = 0; m < 4; ++m) { const int rl = wr * 64 + fr + ai * HALF + m * 16; bf16_t* rowp = O + (size_t)(row0 + ai * HALF + m * 16) * ldc + col0;
                const float rs = __builtin_amdgcn_rsqf(ssq[rowt + rl] * (1.f / 2048.f) + 1e-6f);
#pragma unroll
                for (int bj = 0; bj < 2; ++bj) { const f32x4 v0 = acc[ai][bj][m][0] * rs + bv[bj][0], v1 = acc[ai][bj][m][1] * rs + bv[bj][1];
                    u32x4 w; w.x = cvt_pk_bf16(v0[0], v0[1]); w.y = cvt_pk_bf16(v0[2], v0[3]); w.z = cvt_pk_bf16(v1[0], v1[1]); w.w = cvt_pk_bf16(v1[2], v1[3]);
                    *(u32x4*)(rowp + bj * HALF) = w;
                    if (kv) { float* p = ob + (size_t)rl * 256 + bj * HALF; *(f32x4*)p = v0; *(f32x4*)(p + 4) = v1; } } }
    }
};
struct EpiRelu2 {
    static constexpr bool PERM = true, AFTER_DRAIN = false;
    bf16_t* O; int ldc; const float* ssq; const float* bw;
    __device__ __forceinline__ void operator()(const f32x4 (&acc)[2][2][4][2], const Unit& u, int wr, int wc, int fr, int fq) const {
        asm volatile("" : "+v"(fr), "+v"(fq));
        const int rowt = u.pm * BM, row0 = rowt + wr * 64 + fr; const int col0 = u.pn * BM + wc * 32 + 8 * fq;
        const float* bp = bw + (size_t)cond_of(rowt) * ldc + col0; f32x4 bv[2][2];
#pragma unroll
        for (int bj = 0; bj < 2; ++bj)
#pragma unroll
            for (int n = 0; n < 2; ++n) bv[bj][n] = *(const f32x4*)(bp + bj * HALF + 4 * n);
#pragma unroll
        for (int ai = 0; ai < 2; ++ai)
#pragma unroll
            for (int m = 0; m < 4; ++m) { bf16_t* rowp = O + (size_t)(row0 + ai * HALF + m * 16) * ldc + col0;
                const float rs = __builtin_amdgcn_rsqf(ssq[row0 + ai * HALF + m * 16] * (1.f / 2048.f) + 1e-6f);
#pragma unroll
                for (int bj = 0; bj < 2; ++bj) { f32x4 v0 = acc[ai][bj][m][0] * rs + bv[bj][0], v1 = acc[ai][bj][m][1] * rs + bv[bj][1];
#pragma unroll
                    for (int j = 0; j < 4; ++j) { const float a = fmaxf(v0[j], 0.f), b = fmaxf(v1[j], 0.f); v0[j] = a * a; v1[j] = b * b; }
                    u32x4 w; w.x = cvt_pk_bf16(v0[0], v0[1]); w.y = cvt_pk_bf16(v0[2], v0[3]); w.z = cvt_pk_bf16(v1[0], v1[1]); w.w = cvt_pk_bf16(v1[2], v1[3]);
                    *(u32x4*)(rowp + bj * HALF) = w; } }
    }
};
struct EpiRes {
    static constexpr bool PERM = true, AFTER_DRAIN = false;
    const float* xin0; const float* xin1; float* xout; const float* gate; const float* anext; bf16_t* xa; float* ssq;
    __device__ __forceinline__ void operator()(const f32x4 (&acc)[2][2][4][2], const Unit& u, int wr, int wc, int fr, int fq) const {
        asm volatile("" : "+v"(fr), "+v"(fq));
        const int rowt = u.pm * BM, col0 = u.pn * BM + wc * 32 + 8 * fq; const int cond = cond_of(rowt);
        const float* xb = rowt < 4096 ? xin0 + (size_t)rowt * 2048 : xin1 + (size_t)(rowt - 4096) * 2048; float* ob = xout + (size_t)rowt * 2048; bf16_t* ab = xa + (size_t)rowt * 2048;
        const float* g = gate + (size_t)cond * 12288 + col0; f32x4 gv[2][2], av[2][2];
#pragma unroll
        for (int bj = 0; bj < 2; ++bj)
#pragma unroll
            for (int n = 0; n < 2; ++n) { gv[bj][n] = *(const f32x4*)(g + bj * HALF + 4 * n); av[bj][n] = anext ? *(const f32x4*)(anext + (size_t)cond * 12288 + col0 + bj * HALF + 4 * n) : (f32x4){0.f, 0.f, 0.f, 0.f}; }
        const unsigned offb = (unsigned)((wr * 64 + fr) * 2048 + col0) * 4u;
#pragma unroll
        for (int ai = 0; ai < 2; ++ai)
#pragma unroll
            for (int m = 0; m < 4; ++m) { unsigned voff = offb + (unsigned)(ai * HALF + m * 16) * 8192u; asm volatile("" : "+v"(voff));
                const char* xp = (const char*)xb + voff; char* op = (char*)ob + voff; char* ap = (char*)ab + (voff >> 1); float ss = 0.f;
#pragma unroll
                for (int bj = 0; bj < 2; ++bj) { const f32x4 x0 = *(const f32x4*)(xp + bj * 512), x1 = *(const f32x4*)(xp + bj * 512 + 16);
                    const f32x4 y0 = x0 + gv[bj][0] * acc[ai][bj][m][0], y1 = x1 + gv[bj][1] * acc[ai][bj][m][1];
                    *(f32x4*)(op + bj * 512) = y0; *(f32x4*)(op + bj * 512 + 16) = y1;
                    ss += (y0[0] * y0[0] + y0[1] * y0[1]) + (y0[2] * y0[2] + y0[3] * y0[3]) + (y1[0] * y1[0] + y1[1] * y1[1]) + (y1[2] * y1[2] + y1[3] * y1[3]);
                    if (anext) { const f32x4 a0 = y0 * av[bj][0], a1 = y1 * av[bj][1];
                        u32x4 w; w.x = cvt_pk_bf16(a0[0], a0[1]); w.y = cvt_pk_bf16(a0[2], a0[3]); w.z = cvt_pk_bf16(a1[0], a1[1]); w.w = cvt_pk_bf16(a1[2], a1[3]); *(u32x4*)(ap + bj * 256) = w; } }
                ss += __shfl_xor(ss, 16); ss += __shfl_xor(ss, 32);
                if (fq == 0) __hip_atomic_fetch_add(ssq + rowt + wr * 64 + fr + ai * HALF + m * 16, ss, __ATOMIC_RELAXED, __HIP_MEMORY_SCOPE_AGENT);
                asm volatile("" ::: "memory"); }
    }
};
template <class Epi, class Sched, bool ALIGN_EPI = false, bool SP2 = false>
__device__ __forceinline__ void gemm_phase(PG8_LAS unsigned char* lds, const Gemm g, const Sched& S, const Epi& E, const int wave_in) {
    int tid_; asm volatile("v_mbcnt_lo_u32_b32 %0, -1, 0\n\tv_mbcnt_hi_u32_b32 %0, -1, %0" : "=v"(tid_)); tid_ |= (wave_in << 6);
    const int tid = tid_, wid = __builtin_amdgcn_readfirstlane(tid >> 6), lane = tid & 63, wr = wid >> 2, wc = wid & 3, fr = lane & 15, fq = lane >> 4;
    const int K = g.K, nt = K / BK;
    unsigned voffA[2], voffB[2];
#pragma unroll
    for (int i = 0; i < 2; ++i) { int R, C; stage_rc(tid * 16 + i * 8192, R, C); const int Rb = Epi::PERM ? ((R & ~31) + perm32(R & 31)) : R;
        voffA[i] = (unsigned)(R * K + C) * 2u; voffB[i] = (unsigned)(Rb * K + C) * 2u; }
    const size_t kstep = (size_t)(BK * 2);
    const size_t hstep = (size_t)HALF * K * 2;
    const size_t tstep = 2 * hstep;
    const unsigned ldsw = (unsigned)wid * 1024u;
    const int aoff = lds_byte(wr * 64 + fr, fq * 8), boff = lds_byte(wc * 32 + fr, fq * 8);
#define PG8_SA(b, h) (((b) * 2 + (h)) * HTB)
#define PG8_SB(b, h) ((4 + (b) * 2 + (h)) * HTB)
#define PG8_STAGE(bufoff, gbase, voff) do { _Pragma("unroll") for (int _i = 0; _i < 2; ++_i) \
        __builtin_amdgcn_global_load_lds((const unsigned*)((const char*)(gbase) + (voff)[_i]), (PG8_LAS unsigned*)(lds + (bufoff) + ldsw + _i * 8192), 16, 0, 0); } while (0)
#define PG8_LDA(dst, b, h) do { _Pragma("unroll") for (int m = 0; m < 4; ++m) _Pragma("unroll") for (int k = 0; k < 2; ++k) dst[m][k] = *(const PG8_LAS bf16x8*)(lds + PG8_SA(b, h) + aoff + m * 2048 + k * 1024); } while (0)
#define PG8_LDB(dst, b, h) do { _Pragma("unroll") for (int n = 0; n < 2; ++n) _Pragma("unroll") for (int k = 0; k < 2; ++k) dst[n][k] = *(const PG8_LAS bf16x8*)(lds + PG8_SB(b, h) + boff + n * 2048 + k * 1024); } while (0)
#define PG8_MMA(ai, bj, At, Bt) do { __builtin_amdgcn_s_setprio(1); _Pragma("unroll") for (int m = 0; m < 4; ++m) _Pragma("unroll") for (int n = 0; n < 2; ++n) _Pragma("unroll") for (int k = 0; k < 2; ++k) \
        acc[ai][bj][m][n] = __builtin_amdgcn_mfma_f32_16x16x32_bf16(Bt[n][k], At[m][k], acc[ai][bj][m][n], 0, 0, 0); __builtin_amdgcn_s_setprio(0); } while (0)
#define PG8_WAIT_V(n) asm volatile("s_waitcnt vmcnt(" #n ")" ::: "memory")
#define PG8_WAIT_L(n) asm volatile("s_waitcnt lgkmcnt(" #n ")" ::: "memory")
#define PG8_BAR __builtin_amdgcn_s_barrier()
#define PG8_SCHED __builtin_amdgcn_sched_barrier(0)
    Unit cur, nxt; int ui = 0;
    if (!S.next(0, cur)) return;
    f32x4 acc[2][2][4][2];
#pragma unroll
    for (int a = 0; a < 2; ++a)
#pragma unroll
        for (int b = 0; b < 2; ++b)
#pragma unroll
            for (int m = 0; m < 4; ++m)
#pragma unroll
                for (int n = 0; n < 2; ++n) acc[a][b][m][n] = (f32x4){0.f, 0.f, 0.f, 0.f};
    bf16x8 At[4][2], B0[2][2], B1[2][2];
    const char* cA = (const char*)g.A + (size_t)cur.pm * tstep; const char* cB = (const char*)g.Bt + (size_t)cur.pn * tstep;
    S.a_ready(cur);
    if constexpr (SP2) {
        PG8_STAGE(PG8_SB(0, 0), cB, voffB); PG8_STAGE(PG8_SB(0, 1), cB + hstep, voffB); PG8_STAGE(PG8_SA(0, 0), cA, voffA); PG8_STAGE(PG8_SA(0, 1), cA + hstep, voffA);
        if (wr == 1) PG8_BAR;
        PG8_WAIT_V(2); PG8_BAR;
        PG8_STAGE(PG8_SB(1, 0), cB + kstep, voffB); PG8_STAGE(PG8_SA(1, 0), cA + kstep, voffA); PG8_STAGE(PG8_SB(1, 1), cB + hstep + kstep, voffB);
        PG8_WAIT_V(6); PG8_BAR;
    } else {
        PG8_STAGE(PG8_SB(0, 0), cB, voffB); PG8_STAGE(PG8_SA(0, 0), cA, voffA); PG8_STAGE(PG8_SB(0, 1), cB + hstep, voffB); PG8_STAGE(PG8_SA(0, 1), cA + hstep, voffA);
        if (wr == 1) PG8_BAR;
        PG8_WAIT_V(4); PG8_BAR;
        PG8_STAGE(PG8_SB(1, 0), cB + kstep, voffB); PG8_STAGE(PG8_SA(1, 0), cA + kstep, voffA); PG8_STAGE(PG8_SB(1, 1), cB + hstep + kstep, voffB);
        PG8_WAIT_V(6); PG8_BAR;
    }
    for (;;) {
        const bool has_next = S.next(ui + 1, nxt);
        const char* nA = has_next ? (const char*)g.A + (size_t)nxt.pm * tstep : cA; const char* nB = has_next ? (const char*)g.Bt + (size_t)nxt.pn * tstep : cB;
        for (int t = 0; t < nt; t += 2) {
            const bool last = (t == nt - 2);
            const char* a1 = cA + (size_t)(t + 1) * kstep;
            const char* a2 = last ? nA : cA + (size_t)(t + 2) * kstep; const char* b2 = last ? nB : cB + (size_t)(t + 2) * kstep;
            const char* a3 = a2 + kstep; const char* b3 = b2 + kstep;
            if (last && has_next) S.a_ready(nxt);
            if constexpr (SP2) {
            PG8_LDB(B0, 0, 0); PG8_LDB(B1, 0, 1); PG8_SCHED; PG8_LDA(At, 0, 0); PG8_STAGE(PG8_SA(1, 1), a1 + hstep, voffA);
            PG8_WAIT_V(8); PG8_WAIT_L(0); PG8_BAR; PG8_MMA(0, 0, At, B0); PG8_MMA(0, 1, At, B1); PG8_BAR; PG8_SCHED;
            PG8_LDA(At, 0, 1); PG8_STAGE(PG8_SB(0, 0), b2, voffB); PG8_STAGE(PG8_SB(0, 1), b2 + hstep, voffB); PG8_STAGE(PG8_SA(0, 0), a2, voffA);
            PG8_WAIT_V(8); PG8_WAIT_L(0); PG8_BAR; PG8_MMA(1, 0, At, B0); PG8_MMA(1, 1, At, B1); PG8_BAR; PG8_SCHED;
            PG8_LDB(B0, 1, 0); PG8_LDB(B1, 1, 1); PG8_SCHED; PG8_LDA(At, 1, 0); PG8_STAGE(PG8_SA(0, 1), a2 + hstep, voffA);
            PG8_WAIT_V(8); PG8_WAIT_L(0); PG8_BAR; PG8_MMA(0, 0, At, B0); PG8_MMA(0, 1, At, B1); PG8_BAR; PG8_SCHED;
            PG8_LDA(At, 1, 1); PG8_STAGE(PG8_SB(1, 0), b3, voffB); PG8_STAGE(PG8_SB(1, 1), b3 + hstep, voffB); PG8_STAGE(PG8_SA(1, 0), a3, voffA);
            PG8_WAIT_V(8); PG8_WAIT_L(0); PG8_BAR; PG8_MMA(1, 0, At, B0); PG8_MMA(1, 1, At, B1); PG8_BAR; PG8_SCHED;
            } else {
            PG8_LDB(B0, 0, 0); PG8_SCHED; PG8_LDA(At, 0, 0); PG8_STAGE(PG8_SA(1, 1), a1 + hstep, voffA);
            PG8_WAIT_L(8); PG8_BAR; PG8_WAIT_L(0); PG8_MMA(0, 0, At, B0); PG8_BAR; PG8_SCHED;
            PG8_LDB(B1, 0, 1); PG8_STAGE(PG8_SB(0, 0), b2, voffB);
            PG8_BAR; PG8_WAIT_L(0); PG8_MMA(0, 1, At, B1); PG8_BAR;
            PG8_LDA(At, 0, 1); PG8_STAGE(PG8_SA(0, 0), a2, voffA);
            PG8_BAR; PG8_WAIT_L(0); PG8_MMA(1, 0, At, B0); PG8_BAR; PG8_SCHED;
            PG8_STAGE(PG8_SB(0, 1), b2 + hstep, voffB);
            PG8_WAIT_V(6); PG8_BAR; PG8_MMA(1, 1, At, B1); PG8_BAR;
            PG8_LDB(B0, 1, 0); PG8_SCHED; PG8_LDA(At, 1, 0); PG8_STAGE(PG8_SA(0, 1), a2 + hstep, voffA);
            PG8_WAIT_L(8); PG8_BAR; PG8_WAIT_L(0); PG8_MMA(0, 0, At, B0); PG8_BAR; PG8_SCHED;
            PG8_LDB(B1, 1, 1); PG8_STAGE(PG8_SB(1, 0), b3, voffB);
            PG8_BAR; PG8_WAIT_L(0); PG8_MMA(0, 1, At, B1); PG8_BAR;
            PG8_LDA(At, 1, 1); PG8_STAGE(PG8_SA(1, 0), a3, voffA);
            PG8_BAR; PG8_WAIT_L(0); PG8_MMA(1, 0, At, B0); PG8_BAR; PG8_SCHED;
            PG8_STAGE(PG8_SB(1, 1), b3 + hstep, voffB);
            PG8_WAIT_V(6); PG8_BAR; PG8_MMA(1, 1, At, B1); PG8_BAR;
            }
        }
        if constexpr (ALIGN_EPI) { if (wr == 0) PG8_BAR; }
        if constexpr (!Epi::AFTER_DRAIN) { E(acc, cur, wr, wc, fr, fq); S.done(cur); }
        if (!has_next) break;
#pragma unroll
        for (int a = 0; a < 2; ++a)
#pragma unroll
            for (int b = 0; b < 2; ++b)
#pragma unroll
                for (int m = 0; m < 4; ++m)
#pragma unroll
                    for (int n = 0; n < 2; ++n) acc[a][b][m][n] = (f32x4){0.f, 0.f, 0.f, 0.f};
        cur = nxt; cA = nA; cB = nB; ++ui;
        if constexpr (ALIGN_EPI) { if (wr == 1) PG8_BAR; }
    }
    PG8_WAIT_V(0);
    if constexpr (!ALIGN_EPI) { if (wr == 0) PG8_BAR; }
    PG8_BAR;
    if constexpr (Epi::AFTER_DRAIN) { E.fused(acc, cur, wr, wc, fr, fq, lds, wid, lane); S.done(cur); }
#undef PG8_SA
#undef PG8_SB
#undef PG8_STAGE
#undef PG8_LDA
#undef PG8_LDB
#undef PG8_MMA
#undef PG8_WAIT_V
#undef PG8_WAIT_L
#undef PG8_BAR
#undef PG8_SCHED
}
}


constexpr int D = 2048, NCTX = 4096, NLAT = 16384, M = NCTX + NLAT, DEPTH = 4;
constexpr int DIN = 4624, DINP = 4864, DFF = 8192;
constexpr int C_AQ = 0, C_AK = 1024, C_AV = 1280, C_DQ = 1536, C_DK = 2048, C_DV = 2560, C_DZ = 3072, C_DAB = 3584, C_SU = 3600, C_SV = 4112;
constexpr int NWAVES = 8;
constexpr float EPS = 1e-6f;
constexpr size_t O_Y = 0, O_K = (size_t)M * D, O_V = O_K + 4194304, O_DELTA = O_V + 4194304, O_END = O_DELTA + 8388608;
constexpr size_t MiB = 1u << 20;
constexpr size_t WS_CTL = 0, CTL_ZERO_BYTES = 1 * MiB;
static_assert((16384 + 9 * 20480) * 4 <= 1 * 1048576, "ssq inside the memset region");
constexpr size_t WS_MOD = 1 * MiB, WS_ROPE = 3 * MiB, WS_CK = 4 * MiB, WS_CV = 12 * MiB;
constexpr size_t WS_WIN = 20 * MiB, WS_WOUT = 96 * MiB, WS_WFF1 = 128 * MiB, WS_WFF2 = 256 * MiB;
constexpr size_t WS_X = 384 * MiB, WS_HB = 544 * MiB, WS_ZB = 624 * MiB, WS_ODIR = 816 * MiB, WS_DN = 944 * MiB, WS_BW = 1088 * MiB, WS_XA = 1090 * MiB, WS_END = 1170 * MiB;
constexpr int BW_L = 9 * (DINP + DFF);
constexpr int CW_SSQ = 16384;
constexpr size_t DN_BLK = 116736, DN_DIR0 = 32768, DN_DIRSZ = 41984;
static_assert(WS_DN + 1280 * DN_BLK <= WS_END, "dn scratch");
constexpr int CW_BAR = 4096, CW_ATT = 8192, CW_PART = 204800;
constexpr int LDSCTL_OFF = 153600, LDS_BYTES = 154624;

#define GAS __attribute__((address_space(1)))
#define LAS __attribute__((address_space(3)))
typedef unsigned short bf16;
typedef unsigned v4u __attribute__((ext_vector_type(4)));
typedef unsigned v2u __attribute__((ext_vector_type(2)));
typedef float f32x4 __attribute__((ext_vector_type(4)));
typedef float f32x2 __attribute__((ext_vector_type(2)));
typedef float f32x16 __attribute__((ext_vector_type(16)));
typedef short bf16x8 __attribute__((ext_vector_type(8)));
typedef short s16x4 __attribute__((ext_vector_type(4)));
typedef LAS unsigned char* ldsp;
#define LDS_WAIT() asm volatile("s_waitcnt lgkmcnt(0)" ::: "memory")
#define VM_WAIT() asm volatile("s_waitcnt vmcnt(0)" ::: "memory")
__device__ __forceinline__ unsigned pk2(float lo, float hi) { return pg8::cvt_pk_bf16(lo, hi); }
__device__ __forceinline__ float bflo(unsigned w) { return __uint_as_float(w << 16); }
__device__ __forceinline__ float bfhi(unsigned w) { return __uint_as_float(w & 0xffff0000u); }
__device__ __forceinline__ float bf2f(bf16 b) { return __uint_as_float((unsigned)b << 16); }
__device__ __forceinline__ float wave_sum(float v) {
#define WS_DPP(ctrl, rmask) __builtin_bit_cast(float, __builtin_amdgcn_update_dpp(0, __builtin_bit_cast(int, v), ctrl, rmask, 0xF, false))
    v += WS_DPP(0xB1, 0xF);
    v += WS_DPP(0x4E, 0xF);
    v += WS_DPP(0x141, 0xF);
    v += WS_DPP(0x140, 0xF);
    v += WS_DPP(0x142, 0xA);
    v += WS_DPP(0x143, 0xC);
#undef WS_DPP
    return __builtin_bit_cast(float, __builtin_amdgcn_ds_bpermute(63 * 4, __builtin_bit_cast(int, v)));
}
__device__ __forceinline__ int crow(int r, int hi) { return (r & 3) + 8 * (r >> 2) + 4 * hi; }
__device__ __forceinline__ float silu_f(float x) { return x * __builtin_amdgcn_rcpf(1.f + __expf(-x)); }
__device__ __forceinline__ float gelu_tanh(float x) { const float y = 0.7978845608028654f * (x + 0.044715f * x * x * x); const float e = __expf(2.f * y); return x * (1.f - __builtin_amdgcn_rcpf(1.f + e)); }
template <int S> __device__ __forceinline__ bf16x8 pack8(const f32x16& v) {
    v4u w; w.x = pk2(v[8 * S + 0], v[8 * S + 1]); w.y = pk2(v[8 * S + 2], v[8 * S + 3]); w.z = pk2(v[8 * S + 4], v[8 * S + 5]); w.w = pk2(v[8 * S + 6], v[8 * S + 7]);
    return __builtin_bit_cast(bf16x8, w);
}
__device__ __forceinline__ f32x16 mma_lds(ldsp A, int sa, ldsp B, int sb, int nk, int lane, f32x16 acc) {
    ldsp ap = A + (lane & 31) * sa + (lane >> 5) * 16; ldsp bp = B + (lane & 31) * sb + (lane >> 5) * 16;
#pragma unroll 4
    for (int k = 0; k < nk; ++k) { const bf16x8 a = *(const LAS bf16x8*)(ap + k * 32); const bf16x8 b = *(const LAS bf16x8*)(bp + k * 32); acc = __builtin_amdgcn_mfma_f32_32x32x16_bf16(a, b, acc, 0, 0, 0); }
    return acc;
}

#define XB_TMO      128
#define XB_XCNT(j)  (256  + 64 * (j))
#define XB_XSUB(j)  (1280 + 64 * (j))
#define XB_XGEN(j)  (2304 + 64 * (j))
#define XB_TOP      3328
#define XB_TOPGEN   3392
#define XCD_BAR_WORDS 3456
#define XB_SPIN_CAP (1u << 18)
#define LAS __attribute__((address_space(3)))

__device__ __forceinline__ unsigned xb_ld(unsigned* p)              { return __hip_atomic_load(p, __ATOMIC_RELAXED, __HIP_MEMORY_SCOPE_AGENT); }
__device__ __forceinline__ unsigned xb_add(unsigned* p, unsigned v) { return __hip_atomic_fetch_add(p, v, __ATOMIC_RELAXED, __HIP_MEMORY_SCOPE_AGENT); }
__device__ __forceinline__ unsigned xb_xcc_id() { return (unsigned)__builtin_amdgcn_s_getreg((3 << 11) | 20) & 0xFu; }
#define XB_SPIN(cond, bar) do { unsigned _sp = 0; while (cond) { __builtin_amdgcn_s_sleep(1); \
    if ((++_sp & 255u) == 0u) { if (xb_ld(&(bar)[XB_TMO])) break; if (_sp > XB_SPIN_CAP) { atomicAdd(&(bar)[XB_TMO], 1u); break; } } } } while (0)

struct XcdBarrier {
    unsigned* bar; unsigned x; bool t0;
    volatile LAS unsigned* st;
};

__device__ __forceinline__ XcdBarrier xcd_barrier_post(unsigned* bar, volatile LAS unsigned* st) {
    XcdBarrier b; b.bar = bar; b.x = xb_xcc_id(); b.st = st; b.t0 = (threadIdx.x == 0);
    if (threadIdx.x == 0) (void)xb_add(&bar[XB_XCNT(b.x)], 1u);
    return b;
}
__device__ __forceinline__ void xcd_barrier_complete(unsigned* bar, unsigned x, unsigned& nloc, unsigned& nx) {
    const unsigned G = gridDim.x * gridDim.y * gridDim.z;
    unsigned sum, cnt, mine, sp = 0u;
    for (;;) {
        sum = 0u; cnt = 0u; mine = 0u;
#pragma unroll
        for (unsigned j = 0; j < 16; ++j) { const unsigned c = xb_ld(&bar[XB_XCNT(j)]); sum += c; cnt += (c > 0u) ? 1u : 0u; mine = (j == x) ? c : mine; }
        if (sum == G) break;
        __builtin_amdgcn_s_sleep(1);
        if ((++sp & 255u) == 0u) { if (xb_ld(&bar[XB_TMO])) break; if (sp > XB_SPIN_CAP) { atomicAdd(&bar[XB_TMO], 1u); break; } }
    }
    nloc = mine > 0u ? mine : 1u; nx = cnt > 0u ? cnt : 1u;
}

__device__ __forceinline__ void xcd_barrier(const XcdBarrier& b) {
    asm volatile("s_waitcnt vmcnt(0)" ::: "memory");
    __syncthreads();
    if (b.t0) {
        unsigned* bar = b.bar;
        __builtin_amdgcn_s_waitcnt(0);
        unsigned nloc = b.st[0], nx = b.st[1];
        if (nloc == 0u) { xcd_barrier_complete(bar, b.x, nloc, nx); b.st[0] = nloc; b.st[1] = nx; }
        const unsigned old = xb_add(&bar[XB_XSUB(b.x)], 1u);
        const unsigned gen = old / nloc;
        if (old + 1u == (gen + 1u) * nloc) {
            __builtin_amdgcn_fence(__ATOMIC_RELEASE, "agent");
            asm volatile("s_waitcnt vmcnt(0)" ::: "memory");
            const unsigned og = xb_add(&bar[XB_TOP], 1u);
            const unsigned tg = og / nx;
            if (og + 1u == (tg + 1u) * nx) xb_add(&bar[XB_TOPGEN], 1u);
            else XB_SPIN(xb_ld(&bar[XB_TOPGEN]) == tg, bar);
            __builtin_amdgcn_fence(__ATOMIC_ACQUIRE, "agent");
            xb_add(&bar[XB_XGEN(b.x)], 1u);
            asm volatile("s_waitcnt vmcnt(0)" ::: "memory");
        } else {
            XB_SPIN(xb_ld(&bar[XB_XGEN(b.x)]) == gen, bar);
            __builtin_amdgcn_fence(__ATOMIC_ACQUIRE, "agent");
            asm volatile("s_waitcnt vmcnt(0)" ::: "memory");
        }
    }
    __syncthreads();
}


__device__ __forceinline__ void p0_transpose_item(const float* W, int K, int N, bf16* WT, LAS float* scr, int item, int lane) {
    const int nblk = (N + 31) / 32, kb = item / nblk, nb = item % nblk, k0 = 64 * kb, n0 = 32 * nb; const bool okn = (n0 + (lane & 31)) < N;
#pragma unroll 16
    for (int i = 0; i < 32; ++i) { const int kk = 2 * i + (lane >> 5); scr[kk * 33 + (lane & 31)] = okn ? W[(size_t)(k0 + kk) * N + n0 + (lane & 31)] : 0.f; }
    LDS_WAIT(); asm volatile("" ::: "memory");
    const int c = lane & 7;
#pragma unroll
    for (int j = 0; j < 4; ++j) { const int n = (lane >> 3) + 8 * j; const LAS float* s = scr + (8 * c) * 33 + n;
        v4u o; o.x = pk2(s[0 * 33], s[1 * 33]); o.y = pk2(s[2 * 33], s[3 * 33]); o.z = pk2(s[4 * 33], s[5 * 33]); o.w = pk2(s[6 * 33], s[7 * 33]);
        *(GAS v4u*)(WT + (size_t)(n0 + n) * K + k0 + 8 * c) = o; }
    LDS_WAIT(); asm volatile("" ::: "memory");
}
struct P0Args { const float *c, *c_ctx, *norm1_g, *norm2_g, *w_mod, *b_mod, *w_in, *w_out, *w_ff1, *w_ff2, *cache_k, *cache_v; unsigned char* ws; };
constexpr int T_IN = 32 * 145, T_OUT = 32 * 64, T_F1 = 32 * 256, T_F2 = 128 * 64, T_L = T_IN + T_OUT + T_F1 + T_F2;
__device__ __forceinline__ void transpose_layer(const float* w_in, const float* w_out, const float* w_ff1, const float* w_ff2, unsigned char* ws, int l, LAS float* scr, int wi0, int wstride, int lane) {
    asm volatile("" : "+v"(lane));
    for (int wi = wi0; wi < T_L; wi += wstride) {
        int r = wi;
        if (r < T_IN) { p0_transpose_item(w_in + (size_t)l * 2048 * DIN, 2048, DIN, (bf16*)(ws + WS_WIN) + (size_t)l * DINP * 2048, scr, r, lane); continue; } r -= T_IN;
        if (r < T_OUT) { p0_transpose_item(w_out + (size_t)l * 2048 * 2048, 2048, 2048, (bf16*)(ws + WS_WOUT) + (size_t)l * 2048 * 2048, scr, r, lane); continue; } r -= T_OUT;
        if (r < T_F1) { p0_transpose_item(w_ff1 + (size_t)l * 2048 * DFF, 2048, DFF, (bf16*)(ws + WS_WFF1) + (size_t)l * DFF * 2048, scr, r, lane); continue; } r -= T_F1;
        p0_transpose_item(w_ff2 + (size_t)l * DFF * 2048, DFF, 2048, (bf16*)(ws + WS_WFF2) + (size_t)l * 2048 * DFF, scr, r, lane);
    }
}
__device__ __forceinline__ void p0_prologue(const P0Args& a, ldsp lds, unsigned* queue, volatile LAS unsigned* misc, int tid, int lane, int wave, int G) {
    asm volatile("" : "+v"(tid), "+v"(lane));
    LAS float* silu_t = (LAS float*)lds;
    LAS float* scr = (LAS float*)(lds + 73728 + wave * 8448);
    constexpr int N_MOD = 96;
    constexpr int N_CVT = 512, N_ROPE = 256, N_TR = DEPTH * T_L / 8, N_ITEMS = N_MOD + N_CVT + N_ROPE + N_TR;
    static_assert((DEPTH * T_L) % 8 == 0, "transposes");
    bool have_silu = false;
    float* MOD = (float*)(a.ws + WS_MOD);
    for (;;) {
        if (tid == 0) misc[0] = atomicAdd(queue, 1u);
        __syncthreads(); const int it = (int)misc[0]; __syncthreads();
        if (it >= N_ITEMS) break;
        if (it < N_MOD) {
            if (!have_silu) { have_silu = true;
                for (int i = tid; i < 9 * 2048; i += NWAVES * 64) { const float x = i < 8 * 2048 ? a.c[i] : a.c_ctx[i - 8 * 2048]; silu_t[i] = x / (1.f + expf(-x)); }
                __syncthreads(); }
            const int wi = it * 8 + wave, l = wi / 192, cb = wi % 192, j = cb * 64 + lane;
            float acc[9];
#pragma unroll
            for (int c = 0; c < 9; ++c) acc[c] = 0.f;
            const float* wp = a.w_mod + (size_t)l * 2048 * 12288 + j;
            for (int k0 = 0; k0 < 2048; k0 += 32) {
                float w[32];
#pragma unroll
                for (int i = 0; i < 32; ++i) w[i] = wp[(size_t)(k0 + i) * 12288];
#pragma unroll
                for (int c = 0; c < 9; ++c)
#pragma unroll
                    for (int i4 = 0; i4 < 8; ++i4) { const f32x4 s = *(const LAS f32x4*)(silu_t + c * 2048 + k0 + 4 * i4);
                        acc[c] += s.x * w[4 * i4] + s.y * w[4 * i4 + 1] + s.z * w[4 * i4 + 2] + s.w * w[4 * i4 + 3]; }
            }
            const int slot = j >> 11, col = j & 2047; const float bm = a.b_mod[l * 12288 + j];
            const float gn = slot == 1 ? a.norm1_g[l * 2048 + col] : (slot == 4 ? a.norm2_g[l * 2048 + col] : 0.f);
#pragma unroll
            for (int c = 0; c < 9; ++c) { float v = acc[c] + bm; if (slot == 1 || slot == 4) v = gn * (1.f + v); MOD[(size_t)(l * 9 + c) * 12288 + j] = v; }
        } else if (it < N_MOD + N_CVT) {
            const int ci = it - N_MOD;
#pragma unroll
            for (int s = 0; s < 4; ++s) { const size_t e8 = (size_t)ci * 2048 + s * 512 + tid; const bool isv = e8 >= 524288; const size_t j8 = isv ? e8 - 524288 : e8;
                const float* src = (isv ? a.cache_v : a.cache_k) + j8 * 8; const f32x4 x0 = *(const f32x4*)src, x1 = *(const f32x4*)(src + 4);
                v4u o; o.x = pk2(x0.x, x0.y); o.y = pk2(x0.z, x0.w); o.z = pk2(x1.x, x1.y); o.w = pk2(x1.z, x1.w);
                *(v4u*)((bf16*)(a.ws + (isv ? WS_CV : WS_CK)) + j8 * 8) = o; }
        } else if (it < N_MOD + N_CVT + N_ROPE) {
            const int e = (it - N_MOD - N_CVT) * 512 + tid, t = e >> 6, i = e & 63;
            const float inv = powf(10000.f, -(float)(2 * (i & 31)) / 64.f); const float pos = i < 32 ? (float)(t >> 6) : (float)(t & 63); const float ang = pos * inv;
            ((float*)(a.ws + WS_ROPE))[e] = cosf(ang); ((float*)(a.ws + WS_ROPE))[131072 + e] = sinf(ang);
        } else {
            const int wi = (it - N_MOD - N_CVT - N_ROPE) * 8 + wave, l = wi / T_L;
            transpose_layer(a.w_in, a.w_out, a.w_ff1, a.w_ff2, a.ws, l, scr, wi % T_L, T_L, lane);
        }
    }
}
__device__ __forceinline__ void p0b_bias(unsigned char* ws, ldsp lds, int tid, int lane, int wave, int G) {
    asm volatile("" : "+v"(tid), "+v"(lane));
    LAS float* sh = (LAS float*)lds;
    const float* MOD = (const float*)(ws + WS_MOD); float* BW = (float*)(ws + WS_BW);
    constexpr int NB1 = DINP / 64, NB2 = DFF / 64, NBL = NB1 + NB2;
    int cur = -1;
    for (int it = blockIdx.x; it < DEPTH * NBL; it += G) {
        const int l = it / NBL, r = it % NBL, which = r >= NB1 ? 1 : 0, rb = which ? r - NB1 : r, key = l * 2 + which;
        if (key != cur) { __syncthreads(); cur = key;
            for (int i = tid; i < 9 * 2048; i += NWAVES * 64) sh[i] = MOD[(size_t)(l * 9 + (i >> 11)) * 12288 + (which ? 3 : 0) * 2048 + (i & 2047)];
            __syncthreads(); }
        const bf16* WT = which ? (const bf16*)(ws + WS_WFF1) + (size_t)l * DFF * 2048 : (const bf16*)(ws + WS_WIN) + (size_t)l * DINP * 2048;
        const int ldb = which ? DFF : DINP; float* bwp = BW + (size_t)l * BW_L + (which ? 9 * DINP : 0);
#pragma unroll 1
        for (int rr = 0; rr < 8; rr += 2) { const int n = rb * 64 + wave * 8 + rr; const bf16* wr_ = WT + (size_t)n * 2048 + lane * 8;
            v4u q[2][4];
#pragma unroll
            for (int u = 0; u < 2; ++u)
#pragma unroll
                for (int j = 0; j < 4; ++j) q[u][j] = *(const v4u*)(wr_ + (size_t)u * 2048 + 512 * j);
            float res0 = 0.f, res1 = 0.f;
#pragma unroll 1
            for (int c = 0; c < 9; ++c) { float s0 = 0.f, s1 = 0.f;
#pragma unroll
                for (int j = 0; j < 4; ++j) { const f32x4 a0 = *(const LAS f32x4*)(sh + c * 2048 + 512 * j + lane * 8), a1 = *(const LAS f32x4*)(sh + c * 2048 + 512 * j + lane * 8 + 4);
                    s0 += a0.x * bflo(q[0][j].x) + a0.y * bfhi(q[0][j].x) + a0.z * bflo(q[0][j].y) + a0.w * bfhi(q[0][j].y) + a1.x * bflo(q[0][j].z) + a1.y * bfhi(q[0][j].z) + a1.z * bflo(q[0][j].w) + a1.w * bfhi(q[0][j].w);
                    s1 += a0.x * bflo(q[1][j].x) + a0.y * bfhi(q[1][j].x) + a0.z * bflo(q[1][j].y) + a0.w * bfhi(q[1][j].y) + a1.x * bflo(q[1][j].z) + a1.y * bfhi(q[1][j].z) + a1.z * bflo(q[1][j].w) + a1.w * bfhi(q[1][j].w); }
                s0 = wave_sum(s0); s1 = wave_sum(s1); res0 = (lane == c) ? s0 : res0; res1 = (lane == c) ? s1 : res1; }
            if (lane < 9) { bwp[(size_t)lane * ldb + n] = res0; bwp[(size_t)lane * ldb + n + 1] = res1; } }
    }
    __syncthreads();
}

template <bool FINAL>
__device__ __forceinline__ void norm_phase(const float* x0, const float* x1, const float* modA, bf16* xa, float* ssq, float* outf, int lane, int wave, int G) {
    asm volatile("" : "+v"(lane)); asm volatile("" : "+s"(wave), "+s"(G));
    const int rpw = (M + G - 1) / G, r0 = blockIdx.x * rpw, r1 = min(M, r0 + rpw);
    f32x4 A[8]; int cur = -1;
    for (int r = r0 + wave; r < r1; r += NWAVES) {
        const int cond = FINAL ? 0 : (r < NCTX ? 8 : ((r - NCTX) >> 11));
        if (cond != cur) { cur = cond;
#pragma unroll
            for (int j = 0; j < 8; ++j) A[j] = *(const f32x4*)(modA + (size_t)cond * 12288 + 4 * lane + 256 * j); }
        const float* xr = r < NCTX ? x0 + (size_t)r * D : x1 + (size_t)(r - NCTX) * D;
        f32x4 v[8]; float ss = 0.f;
#pragma unroll
        for (int j = 0; j < 8; ++j) { v[j] = *(const f32x4*)(xr + 4 * lane + 256 * j); ss += (v[j].x * v[j].x + v[j].y * v[j].y) + (v[j].z * v[j].z + v[j].w * v[j].w); }
        ss = wave_sum(ss);
        if (FINAL) { const float rstd = rsqrtf(ss * (1.f / D) + EPS);
#pragma unroll
            for (int j = 0; j < 8; ++j) *(f32x4*)(outf + (size_t)r * D + 4 * lane + 256 * j) = v[j] * rstd * A[j];
        } else {
#pragma unroll
            for (int j = 0; j < 8; ++j) { const f32x4 y = v[j] * A[j]; v2u o; o.x = pk2(y.x, y.y); o.y = pk2(y.z, y.w); *(v2u*)(xa + (size_t)r * D + 4 * lane + 256 * j) = o; }
            if (lane == 0) ssq[r] = ss;
        }
    }
}

#ifndef PROBE_DUP
#define PROBE_DUP 0
#endif
constexpr int P_KT = 0, P_QT = 17408, P_KTT = 34816, P_VT = 53248, P_T1 = 71680, P_T2 = 71680 + 18432, P_AM = 108544, P_GL = 141312;
struct LayerP { const float *conv_w, *a_log, *dt_bias, *dn_norm_g, *sgu_norm_g, *sgu_w, *sgu_b, *sink; };
__device__ __forceinline__ void dn_prep_unit(const LayerP& P, const bf16* zb, unsigned char* dn, ldsp lds, int gchunk, int h, int tid, int lane, int wave) {
    asm volatile("" : "+v"(tid), "+v"(lane));
    const bool isctx = gchunk < 64; const int pc = isctx ? (gchunk & 3) : ((gchunk - 64) & 31); const int T = isctx ? 256 : 2048;
    const long grow0 = (long)gchunk * 64; unsigned char* blk = dn + (size_t)(gchunk * 4 + h) * DN_BLK;
    LAS float* GL = (LAS float*)(lds + P_GL);
    for (int rep_ = 0; rep_ < ((PROBE_DUP & 1024) ? 2 : 1); ++rep_) {
    if (wave == 0) {
        const bf16* zr = zb + (size_t)(grow0 + lane) * DINP + C_DAB;
#pragma unroll
        for (int d = 0; d < 2; ++d) {
            const float alpha = bf2f(zr[d * 8 + h]), braw = bf2f(zr[d * 8 + 4 + h]);
            const float xr = alpha + P.dt_bias[d * 4 + h]; const float sp = fmaxf(xr, 0.f) + log1pf(expf(-fabsf(xr)));
            const float g = -expf(P.a_log[d * 4 + h]) * sp; const float beta = 1.f / (1.f + expf(-braw));
            float gc = g;
#pragma unroll
            for (int o = 1; o < 64; o <<= 1) { const int src = (d == 0) ? lane - o : lane + o;
                const float t = __builtin_bit_cast(float, __builtin_amdgcn_ds_bpermute((src & 63) << 2, __builtin_bit_cast(int, gc))); const bool ok = (d == 0) ? (lane >= o) : (lane + o < 64); gc += ok ? t : 0.f; }
            const float gl = wave_sum(g); const float eg = expf(gc), egl = expf(gl - gc);
            GL[d * 64 + lane] = gc; GL[128 + d * 64 + lane] = beta; GL[256 + d * 64 + lane] = beta * eg;
            float* gv = (float*)(blk + DN_DIR0 + d * DN_DIRSZ + 40960);
            gv[lane] = eg; gv[64 + lane] = egl; if (lane == 0) gv[128] = expf(gl);
        }
    }
    {
        const float* cw = P.conv_w; const int cq = h * 128 + 2 * lane;
        f32x2 wq[5], wk[5], wv[5];
#pragma unroll
        for (int j = 0; j < 5; ++j) { wq[j] = *(const f32x2*)(cw + j * 1536 + cq); wk[j] = *(const f32x2*)(cw + j * 1536 + 512 + cq); wv[j] = *(const f32x2*)(cw + j * 1536 + 1024 + cq); }
        unsigned xq[12], xk[12], xv[12];
#pragma unroll
        for (int rr = 0; rr < 12; ++rr) { const int tl = 8 * wave - 2 + rr, tpos = pc * 64 + tl; const bool ok = tpos >= 0 && tpos < T;
            const bf16* zr = zb + (grow0 + tl) * (long)DINP + h * 128 + 2 * lane;
            xq[rr] = ok ? *(const unsigned*)(zr + C_DQ) : 0u; xk[rr] = ok ? *(const unsigned*)(zr + C_DK) : 0u; xv[rr] = ok ? *(const unsigned*)(zr + C_DV) : 0u; }
        float k0s[8], k1s[8], v0s[8], v1s[8];
        LAS bf16* Kt = (LAS bf16*)(lds + P_KT); LAS bf16* Qt = (LAS bf16*)(lds + P_QT);
#pragma unroll
        for (int tt = 0; tt < 8; ++tt) {
            float q0 = 0.f, q1 = 0.f, k0 = 0.f, k1 = 0.f, v0 = 0.f, v1 = 0.f;
#pragma unroll
            for (int j = 0; j < 5; ++j) { q0 += bflo(xq[tt + j]) * wq[j].x; q1 += bfhi(xq[tt + j]) * wq[j].y; k0 += bflo(xk[tt + j]) * wk[j].x; k1 += bfhi(xk[tt + j]) * wk[j].y;
                v0 += bflo(xv[tt + j]) * wv[j].x; v1 += bfhi(xv[tt + j]) * wv[j].y; }
            q0 = silu_f(q0); q1 = silu_f(q1); k0 = silu_f(k0); k1 = silu_f(k1); v0 = silu_f(v0); v1 = silu_f(v1);
            const float rq = rsqrtf(wave_sum(q0 * q0 + q1 * q1) + EPS) * 0.08838834764831845f, rk = rsqrtf(wave_sum(k0 * k0 + k1 * k1) + EPS);
            q0 *= rq; q1 *= rq; k0 *= rk; k1 *= rk;
            const int t = 8 * wave + tt;
            *(LAS unsigned*)(Qt + t * 136 + 2 * lane) = pk2(q0, q1); *(LAS unsigned*)(Kt + t * 136 + 2 * lane) = pk2(k0, k1);
            k0s[tt] = k0; k1s[tt] = k1; v0s[tt] = v0; v1s[tt] = v1;
        }
        LAS bf16* KT = (LAS bf16*)(lds + P_KTT); LAS bf16* VT = (LAS bf16*)(lds + P_VT);
        v4u o;
        o.x = pk2(k0s[0], k0s[1]); o.y = pk2(k0s[2], k0s[3]); o.z = pk2(k0s[4], k0s[5]); o.w = pk2(k0s[6], k0s[7]); *(LAS v4u*)(KT + (2 * lane) * 72 + 8 * wave) = o;
        o.x = pk2(k1s[0], k1s[1]); o.y = pk2(k1s[2], k1s[3]); o.z = pk2(k1s[4], k1s[5]); o.w = pk2(k1s[6], k1s[7]); *(LAS v4u*)(KT + (2 * lane + 1) * 72 + 8 * wave) = o;
        o.x = pk2(v0s[0], v0s[1]); o.y = pk2(v0s[2], v0s[3]); o.z = pk2(v0s[4], v0s[5]); o.w = pk2(v0s[6], v0s[7]); *(LAS v4u*)(VT + (2 * lane) * 72 + 8 * wave) = o;
        o.x = pk2(v1s[0], v1s[1]); o.y = pk2(v1s[2], v1s[3]); o.z = pk2(v1s[4], v1s[5]); o.w = pk2(v1s[6], v1s[7]); *(LAS v4u*)(VT + (2 * lane + 1) * 72 + 8 * wave) = o;
    }
    __syncthreads();
    }
    for (int rep_ = 0; rep_ < ((PROBE_DUP & 4096) ? 2 : 1); ++rep_) {
    {
        const int hh = lane >> 5, cl = lane & 31; LAS float* AM = (LAS float*)(lds + P_AM);
        f32x16 acc = {};
        if (wave < 4) {
            const int rt = wave >> 1, ct = wave & 1;
            acc = mma_lds(lds + P_KT + 32 * rt * 272, 272, lds + P_KT + 32 * ct * 272, 272, 8, lane, acc);
            const int c = 32 * ct + cl; const float g0c = GL[c], g1c = GL[64 + c];
#pragma unroll
            for (int q = 0; q < 4; ++q) { const int r0 = 32 * rt + 8 * q + 4 * hh;
                const f32x4 g0 = *(const LAS f32x4*)(GL + r0), g1 = *(const LAS f32x4*)(GL + 64 + r0), b0 = *(const LAS f32x4*)(GL + 128 + r0), b1 = *(const LAS f32x4*)(GL + 192 + r0);
#pragma unroll
                for (int e = 0; e < 4; ++e) { const int rr = r0 + e; const float v = acc[4 * q + e];
                    if (rr > c) AM[rr * 64 + c] = b0[e] * v * __expf(g0[e] - g0c);
                    if (rr < c) AM[4096 + (63 - rr) * 64 + (63 - c)] = b1[e] * v * __expf(g1[e] - g1c); } }
        } else {
            const int cb = (wave - 4) >> 1, it = (wave - 4) & 1;
            acc = mma_lds(lds + P_KT + 32 * cb * 272, 272, lds + P_QT + 32 * it * 272, 272, 8, lane, acc);
            const int i = 32 * it + cl; const float g0i = GL[i], g1i = GL[64 + i];
            f32x16 a0, a1;
#pragma unroll
            for (int q = 0; q < 4; ++q) { const int c0 = 32 * cb + 8 * q + 4 * hh; const f32x4 g0 = *(const LAS f32x4*)(GL + c0), g1 = *(const LAS f32x4*)(GL + 64 + c0);
#pragma unroll
                for (int e = 0; e < 4; ++e) { const int c = c0 + e; const float v = acc[4 * q + e];
                    a0[4 * q + e] = (i >= c) ? v * __expf(fminf(g0i - g0[e], 0.f)) : 0.f; a1[4 * q + e] = (i <= c) ? v * __expf(fminf(g1i - g1[e], 0.f)) : 0.f; } }
            unsigned char* q0p = blk + DN_DIR0 + 32768 + ((cb * 2 + it) * 2) * 1024 + lane * 16; unsigned char* q1p = q0p + DN_DIRSZ;
            *(bf16x8*)(q0p) = pack8<0>(a0); *(bf16x8*)(q0p + 1024) = pack8<1>(a0); *(bf16x8*)(q1p) = pack8<0>(a1); *(bf16x8*)(q1p + 1024) = pack8<1>(a1);
        }
    }
    __syncthreads();
    }
    for (int rep_ = 0; rep_ < ((PROBE_DUP & 2048) ? 2 : 1); ++rep_) {
    if (wave < 2) {
        const int dir = wave; const LAS float* Am = (const LAS float*)(lds + P_AM) + dir * 4096;
        float Tr[64]; f32x4 cA[16], cB[16];
#define SOLVE_LOAD(dst, i_) do { _Pragma("unroll") for (int q = 0; q < 16; ++q) if (4 * q < (i_)) dst[q] = *(const LAS f32x4*)(Am + (i_) * 64 + 4 * q); } while (0)
#define SOLVE_ROW(src, i_) do { float a0 = (lane == (i_)) ? 1.f : 0.f, a1 = 0.f, a2 = 0.f, a3 = 0.f; \
            _Pragma("unroll") for (int q = 0; q < 16; ++q) { const int jb = 4 * q; \
                if (jb + 0 < (i_)) a0 -= src[q].x * Tr[jb + 0]; if (jb + 1 < (i_)) a1 -= src[q].y * Tr[jb + 1]; if (jb + 2 < (i_)) a2 -= src[q].z * Tr[jb + 2]; if (jb + 3 < (i_)) a3 -= src[q].w * Tr[jb + 3]; } \
            Tr[i_] = (a0 + a1) + (a2 + a3); } while (0)
        Tr[0] = (lane == 0) ? 1.f : 0.f;
        SOLVE_LOAD(cA, 1);
#pragma unroll
        for (int i = 1; i < 64; i += 2) {
            if (i + 1 < 64) SOLVE_LOAD(cB, i + 1);
            asm volatile("" ::: "memory");
            SOLVE_ROW(cA, i);
            if (i + 2 < 64) SOLVE_LOAD(cA, i + 2);
            asm volatile("" ::: "memory");
            if (i + 1 < 64) SOLVE_ROW(cB, i + 1);
        }
#undef SOLVE_LOAD
#undef SOLVE_ROW
        const int j = dir ? 63 - lane : lane; const float s1 = GL[256 + dir * 64 + j], s2 = GL[128 + dir * 64 + j];
        LAS bf16* T1 = (LAS bf16*)(lds + P_T1) + dir * 4608; LAS bf16* T2 = (LAS bf16*)(lds + P_T2) + dir * 4608;
#pragma unroll
        for (int ii = 0; ii < 64; ++ii) { const int i = dir ? 63 - ii : ii; T1[i * 72 + j] = (bf16)(pk2(Tr[ii] * s1, 0.f) & 0xffffu); T2[i * 72 + j] = (bf16)(pk2(Tr[ii] * s2, 0.f) & 0xffffu); }
    } else {
        const int hh = lane >> 5, rl = lane & 31;
        for (int b = wave - 2; b < 32; b += 6) {
            v2u lo, hi;
            if (b < 16) { const int it = b >> 3, db = (b >> 1) & 3, s = b & 1; const LAS bf16* p = (const LAS bf16*)(lds + P_QT) + (32 * it + rl) * 136 + 32 * db + 16 * s + 4 * hh; lo = *(const LAS v2u*)p; hi = *(const LAS v2u*)(p + 8); }
            else { const int bb = b - 16, dt = bb >> 2, cb = (bb >> 1) & 1, s = bb & 1; const LAS bf16* p = (const LAS bf16*)(lds + P_KTT) + (32 * dt + rl) * 72 + 32 * cb + 16 * s + 4 * hh; lo = *(const LAS v2u*)p; hi = *(const LAS v2u*)(p + 8); }
            v4u o; o.x = lo.x; o.y = lo.y; o.z = hi.x; o.w = hi.y;
            *(v4u*)(blk + (size_t)b * 1024 + lane * 16) = o;
        }
    }
    __syncthreads();
    }
    for (int rep_ = 0; rep_ < ((PROBE_DUP & 8192) ? 2 : 1); ++rep_) {
#pragma unroll 1
    for (int tix = wave; tix < 32; tix += 8) {
        const int dir = tix >> 4, kind = (tix >> 3) & 1, idx = tix & 7; f32x16 acc = {};
        unsigned char* dst;
        if (kind == 0) { const int ct = idx >> 2, es = idx & 3;
            acc = mma_lds(lds + P_T2 + dir * 9216 + 32 * ct * 144, 144, lds + P_VT + 32 * es * 144, 144, 4, lane, acc);
            dst = blk + DN_DIR0 + dir * DN_DIRSZ + ((ct * 4 + es) * 2) * 1024 + lane * 16;
        } else { const int db = idx >> 1, ct = idx & 1;
            acc = mma_lds(lds + P_KTT + 32 * db * 144, 144, lds + P_T1 + dir * 9216 + 32 * ct * 144, 144, 4, lane, acc);
#pragma unroll
            for (int r = 0; r < 16; ++r) acc[r] = -acc[r];
            dst = blk + DN_DIR0 + dir * DN_DIRSZ + 16384 + ((db * 2 + ct) * 2) * 1024 + lane * 16;
        }
        *(bf16x8*)dst = pack8<0>(acc); *(bf16x8*)(dst + 1024) = pack8<1>(acc);
    }
    __syncthreads();
    }
}

__device__ __forceinline__ void sgu_unit(const LayerP& P, const bf16* zb, bf16* mix, ldsp lds, int rc, int g, bool load_w, int tid, int lane, int wave) {
    asm volatile("" : "+v"(tid), "+v"(lane));
    const size_t grow0 = (size_t)rc * 128; LAS bf16* Wl = (LAS bf16*)lds; LAS bf16* Vt = (LAS bf16*)(lds + 34816);
    {
        const float gn0 = P.sgu_norm_g[g * 128 + 2 * lane], gn1 = P.sgu_norm_g[g * 128 + 2 * lane + 1];
        float v0[16], v1[16];
#pragma unroll
        for (int qq = 0; qq < 16; ++qq) { const unsigned w = *(const unsigned*)(zb + (grow0 + 16 * wave + qq) * DINP + C_SV + g * 128 + 2 * lane);
            const float a = gelu_tanh(bflo(w)), b = gelu_tanh(bfhi(w)); const float r = rsqrtf(wave_sum(a * a + b * b) * (1.f / 128.f) + EPS); v0[qq] = a * r * gn0; v1[qq] = b * r * gn1; }
        v4u o;
        o.x = pk2(v0[0], v0[1]); o.y = pk2(v0[2], v0[3]); o.z = pk2(v0[4], v0[5]); o.w = pk2(v0[6], v0[7]); *(LAS v4u*)(Vt + (2 * lane) * 136 + 16 * wave) = o;
        o.x = pk2(v0[8], v0[9]); o.y = pk2(v0[10], v0[11]); o.z = pk2(v0[12], v0[13]); o.w = pk2(v0[14], v0[15]); *(LAS v4u*)(Vt + (2 * lane) * 136 + 16 * wave + 8) = o;
        o.x = pk2(v1[0], v1[1]); o.y = pk2(v1[2], v1[3]); o.z = pk2(v1[4], v1[5]); o.w = pk2(v1[6], v1[7]); *(LAS v4u*)(Vt + (2 * lane + 1) * 136 + 16 * wave) = o;
        o.x = pk2(v1[8], v1[9]); o.y = pk2(v1[10], v1[11]); o.z = pk2(v1[12], v1[13]); o.w = pk2(v1[14], v1[15]); *(LAS v4u*)(Vt + (2 * lane + 1) * 136 + 16 * wave + 8) = o;
    }
    if (load_w) {
        const int p = tid >> 2, q0 = (tid & 3) * 32; const float* src = P.sgu_w + ((size_t)g * 128 + p) * 128 + q0;
#pragma unroll
        for (int j = 0; j < 4; ++j) { const f32x4 x0 = *(const f32x4*)(src + 8 * j), x1 = *(const f32x4*)(src + 8 * j + 4);
            v4u o; o.x = pk2(x0.x, x0.y); o.y = pk2(x0.z, x0.w); o.z = pk2(x1.x, x1.y); o.w = pk2(x1.z, x1.w); *(LAS v4u*)(Wl + p * 136 + q0 + 8 * j) = o; }
    }
    __syncthreads();
    {
        const int pt = wave >> 1, hh = lane >> 5, cl = lane & 31; LAS float* Ms = (LAS float*)(lds + 69632 + wave * 8704);
#pragma unroll
        for (int cc = 0; cc < 2; ++cc) { const int ct = 2 * (wave & 1) + cc; f32x16 acc = {};
            acc = mma_lds(lds + 32 * pt * 272, 272, lds + 34816 + 32 * ct * 272, 272, 8, lane, acc);
#pragma unroll
            for (int q = 0; q < 4; ++q) { const f32x4 bq = *(const f32x4*)(P.sgu_b + g * 128 + 32 * pt + 8 * q + 4 * hh);
#pragma unroll
                for (int e = 0; e < 4; ++e) Ms[(8 * q + 4 * hh + e) * 68 + 32 * cc + cl] = acc[4 * q + e] + bq[e]; } }
        LDS_WAIT(); asm volatile("" ::: "memory");
        const int row = lane >> 1, c0 = (lane & 1) * 32; const size_t grow = grow0 + 32 * pt + row; const int gcol = g * 128 + 64 * (wave & 1) + c0;
        const bf16* sup = zb + grow * DINP + C_SU + gcol; bf16* op = mix + grow * D + 1536 + gcol;
#pragma unroll
        for (int j = 0; j < 4; ++j) { const v4u su = *(const v4u*)(sup + 8 * j); const f32x4 m0 = *(const LAS f32x4*)(Ms + row * 68 + c0 + 8 * j), m1 = *(const LAS f32x4*)(Ms + row * 68 + c0 + 8 * j + 4);
            v4u o; o.x = pk2(gelu_tanh(bflo(su.x)) * m0.x, gelu_tanh(bfhi(su.x)) * m0.y); o.y = pk2(gelu_tanh(bflo(su.y)) * m0.z, gelu_tanh(bfhi(su.y)) * m0.w);
            o.z = pk2(gelu_tanh(bflo(su.z)) * m1.x, gelu_tanh(bfhi(su.z)) * m1.y); o.w = pk2(gelu_tanh(bflo(su.w)) * m1.z, gelu_tanh(bfhi(su.w)) * m1.w);
            *(v4u*)(op + 8 * j) = o; }
    }
    __syncthreads();
}

__device__ __forceinline__ void rope_item(bf16* zb, const float* ropet, int ri, int lane, int wave) {
    asm volatile("" : "+v"(lane));
    const int hf = (lane >> 4) & 1, ip = (lane & 15) * 2;
#pragma unroll 1
    for (int t4 = 0; t4 < 8; t4 += 4) {
        unsigned wa[4][5], wb[4][5]; f32x2 cs[4], sn[4]; bf16* pp[4];
#pragma unroll
        for (int u = 0; u < 4; ++u) { const int tl = ri * 64 + wave * 8 + t4 + u, t = tl & 2047; pp[u] = zb + (size_t)(NCTX + tl) * DINP + 64 * hf + ip;
            cs[u] = *(const f32x2*)(ropet + t * 64 + 32 * hf + ip); sn[u] = *(const f32x2*)(ropet + 131072 + t * 64 + 32 * hf + ip);
#pragma unroll
            for (int ps = 0; ps < 5; ++ps) { const int hv = ps * 2 + (lane >> 5); const bf16* p = pp[u] + (hv < 8 ? C_AQ + hv * 128 : C_AK + (hv - 8) * 128); wa[u][ps] = *(const unsigned*)p; wb[u][ps] = *(const unsigned*)(p + 32); } }
#pragma unroll
        for (int u = 0; u < 4; ++u)
#pragma unroll
            for (int ps = 0; ps < 5; ++ps) { const int hv = ps * 2 + (lane >> 5); bf16* p = pp[u] + (hv < 8 ? C_AQ + hv * 128 : C_AK + (hv - 8) * 128);
                const float a0 = bflo(wa[u][ps]), a1 = bfhi(wa[u][ps]), b0 = bflo(wb[u][ps]), b1 = bfhi(wb[u][ps]);
                *(unsigned*)p = pk2(a0 * cs[u].x - b0 * sn[u].x, a1 * cs[u].y - b1 * sn[u].y); *(unsigned*)(p + 32) = pk2(b0 * cs[u].x + a0 * sn[u].x, b1 * cs[u].y + a1 * sn[u].y); }
    }
}

constexpr int SC_BUF = 58368;
__device__ __forceinline__ void glds16(const void* g, ldsp l) { __builtin_amdgcn_global_load_lds((const unsigned*)g, (LAS unsigned*)l, 16, 0, 0); }
__device__ __forceinline__ void scan_dma4(const unsigned char* blk, int dir, ldsp buf, int lane, int lw) {
    const unsigned lo = (unsigned)lane * 16u;
#pragma unroll
    for (int i = 0; i < 15; ++i) { const int k = lw + 4 * i;
        if (i < 14 || lw == 0) { const unsigned char* ub = blk + (size_t)k * 1024 + (k >= 32 ? 16384 + dir * (int)DN_DIRSZ : 0); glds16(ub + lo, buf + k * 1024); } }
}
__device__ __forceinline__ void scan_chain(const unsigned char* dn, const float* state0, float* state_out, float* odir, ldsp lds, int isctx, int b, int h, int dir, int lane, int wave) {
    asm volatile("" : "+v"(lane));
    const int hh = lane >> 5, cl = lane & 31; const int nch = isctx ? 4 : 32; const int gch0 = isctx ? b * 4 : 64 + b * 32;
#define BLKOF(n) (dn + (size_t)((gch0 + (dir ? nch - 1 - (n) : (n))) * 4 + h) * DN_BLK)
    if (wave >= 4) {
        scan_dma4(BLKOF(0), dir, lds, lane, wave - 4);
#pragma unroll 1
        for (int n = 0; n < nch; ++n) {
            VM_WAIT(); __builtin_amdgcn_s_barrier(); asm volatile("" ::: "memory");
            if (n + 1 < nch) scan_dma4(BLKOF(n + 1), dir, lds + ((n + 1) & 1) * SC_BUF, lane, wave - 4);
        }
        VM_WAIT(); __builtin_amdgcn_s_barrier(); asm volatile("" ::: "memory");
        return;
    }
    const int es = wave;
    f32x16 S[4];
#pragma unroll
    for (int db = 0; db < 4; ++db) S[db] = f32x16{};
    if (state0) { const float* sp = state0 + (4 * hh) * 128 + 32 * es + cl;
#pragma unroll
        for (int db = 0; db < 4; ++db)
#pragma unroll
            for (int r = 0; r < 16; ++r) S[db][r] = sp[(32 * db + (r & 3) + 8 * (r >> 2)) * 128]; }
#define UPTR(n) (BLKOF(n) + DN_DIR0 + dir * DN_DIRSZ + (es * 2) * 1024 + lane * 16)
    bf16x8 Un[2][2];
    { const unsigned char* up = UPTR(0);
#pragma unroll
      for (int ct = 0; ct < 2; ++ct) { Un[ct][0] = *(const bf16x8*)(up + ct * 8192); Un[ct][1] = *(const bf16x8*)(up + ct * 8192 + 1024); } }
#define SBAR_() __builtin_amdgcn_sched_barrier(0)
#pragma unroll 1
    for (int n = 0; n < nch; ++n) {
        VM_WAIT(); __builtin_amdgcn_s_barrier(); asm volatile("" ::: "memory");
        f32x16 vn[2];
#pragma unroll
        for (int ct = 0; ct < 2; ++ct) { const v4u a = __builtin_bit_cast(v4u, Un[ct][0]), c = __builtin_bit_cast(v4u, Un[ct][1]);
          vn[ct][0] = bflo(a.x); vn[ct][1] = bfhi(a.x); vn[ct][2] = bflo(a.y); vn[ct][3] = bfhi(a.y); vn[ct][4] = bflo(a.z); vn[ct][5] = bfhi(a.z); vn[ct][6] = bflo(a.w); vn[ct][7] = bfhi(a.w);
          vn[ct][8] = bflo(c.x); vn[ct][9] = bfhi(c.x); vn[ct][10] = bflo(c.y); vn[ct][11] = bfhi(c.y); vn[ct][12] = bflo(c.z); vn[ct][13] = bfhi(c.z); vn[ct][14] = bflo(c.w); vn[ct][15] = bfhi(c.w); }
        if (n + 1 < nch) { const unsigned char* up = UPTR(n + 1);
#pragma unroll
            for (int ct = 0; ct < 2; ++ct) { Un[ct][0] = *(const bf16x8*)(up + ct * 8192); Un[ct][1] = *(const bf16x8*)(up + ct * 8192 + 1024); } }
        ldsp buf = lds + (n & 1) * SC_BUF; ldsp fl = buf + lane * 16;
        bf16x8 Sb[4][2];
#pragma unroll
        for (int db = 0; db < 4; ++db) { Sb[db][0] = pack8<0>(S[db]); Sb[db][1] = pack8<1>(S[db]); }
        f32x16 oa[2];
#pragma unroll
        for (int ct = 0; ct < 2; ++ct) {
            bf16x8 Anw[8], Aq[8];
#pragma unroll
            for (int k = 0; k < 8; ++k) { Anw[k] = *(const LAS bf16x8*)(fl + 32768 + (((k >> 1) * 2 + ct) * 2 + (k & 1)) * 1024); Aq[k] = *(const LAS bf16x8*)(fl + ((ct * 4 + (k >> 1)) * 2 + (k & 1)) * 1024); }
            oa[ct] = f32x16{};
            LDS_WAIT(); SBAR_();
#pragma unroll
            for (int k = 0; k < 8; ++k) { vn[ct] = __builtin_amdgcn_mfma_f32_32x32x16_bf16(Anw[k], Sb[k >> 1][k & 1], vn[ct], 0, 0, 0); oa[ct] = __builtin_amdgcn_mfma_f32_32x32x16_bf16(Aq[k], Sb[k >> 1][k & 1], oa[ct], 0, 0, 0); }
            SBAR_();
        }
        bf16x8 V1[2][2], V2[2][2];
        { const float gl = *(const LAS float*)(buf + 57344 + 512);
#pragma unroll
          for (int ct = 0; ct < 2; ++ct) { const LAS float* egl = (const LAS float*)(buf + 57344 + 256) + 32 * ct + 4 * hh; const LAS float* eg = (const LAS float*)(buf + 57344) + 32 * ct + 4 * hh;
            f32x16 vs;
#pragma unroll
            for (int q = 0; q < 4; ++q) { const f32x4 e = *(const LAS f32x4*)(egl + 8 * q), g = *(const LAS f32x4*)(eg + 8 * q);
                vs[4 * q] = vn[ct][4 * q] * e.x; vs[4 * q + 1] = vn[ct][4 * q + 1] * e.y; vs[4 * q + 2] = vn[ct][4 * q + 2] * e.z; vs[4 * q + 3] = vn[ct][4 * q + 3] * e.w;
                oa[ct][4 * q] *= g.x; oa[ct][4 * q + 1] *= g.y; oa[ct][4 * q + 2] *= g.z; oa[ct][4 * q + 3] *= g.w; }
            V1[ct][0] = pack8<0>(vn[ct]); V1[ct][1] = pack8<1>(vn[ct]); V2[ct][0] = pack8<0>(vs); V2[ct][1] = pack8<1>(vs); }
#pragma unroll
          for (int db = 0; db < 4; ++db)
#pragma unroll
              for (int r = 0; r < 16; ++r) S[db][r] *= gl; }
        SBAR_();
        { bf16x8 Aqk[8];
#pragma unroll
          for (int k = 0; k < 8; ++k) Aqk[k] = *(const LAS bf16x8*)(fl + 49152 + k * 1024);
          LDS_WAIT(); SBAR_();
#pragma unroll
          for (int cb = 0; cb < 2; ++cb)
#pragma unroll
              for (int s = 0; s < 2; ++s) { oa[0] = __builtin_amdgcn_mfma_f32_32x32x16_bf16(Aqk[(cb * 2 + 0) * 2 + s], V1[cb][s], oa[0], 0, 0, 0); oa[1] = __builtin_amdgcn_mfma_f32_32x32x16_bf16(Aqk[(cb * 2 + 1) * 2 + s], V1[cb][s], oa[1], 0, 0, 0); }
          SBAR_(); }
#pragma unroll
        for (int half = 0; half < 2; ++half) { bf16x8 Akt[8];
#pragma unroll
            for (int k = 0; k < 8; ++k) Akt[k] = *(const LAS bf16x8*)(fl + 16384 + (half * 8 + k) * 1024);
            LDS_WAIT(); SBAR_();
#pragma unroll
            for (int k = 0; k < 4; ++k) { S[2 * half] = __builtin_amdgcn_mfma_f32_32x32x16_bf16(Akt[k], V2[k >> 1][k & 1], S[2 * half], 0, 0, 0);
                S[2 * half + 1] = __builtin_amdgcn_mfma_f32_32x32x16_bf16(Akt[4 + k], V2[k >> 1][k & 1], S[2 * half + 1], 0, 0, 0); }
            SBAR_(); }
        { const int pc = dir ? nch - 1 - n : n;
#pragma unroll
          for (int ct = 0; ct < 2; ++ct) { unsigned ob = (unsigned)((((gch0 + pc) * 64 + 32 * ct + 4 * hh) * 512 + h * 128 + 32 * es + cl) * 4); asm volatile("" : "+v"(ob));
#pragma unroll
              for (int r = 0; r < 16; ++r) *(float*)((char*)odir + (ob + (unsigned)(((r & 3) + 8 * (r >> 2)) * 2048))) = oa[ct][r]; } }
    }
#undef SBAR_
    if (state_out) {
#pragma unroll
        for (int db = 0; db < 4; ++db)
#pragma unroll
            for (int r = 0; r < 16; ++r) state_out[(size_t)(32 * db + crow(r, hh)) * 128 + 32 * es + cl] = S[db][r];
    }
    VM_WAIT(); LDS_WAIT(); __builtin_amdgcn_s_barrier(); asm volatile("" ::: "memory");
#undef BLKOF
#undef UPTR
}

#define KSWZ(row, colB) ((row) * 256 + ((colB) ^ (((row) & 7) << 4)))
#define SBAR() __builtin_amdgcn_sched_barrier(0)
__device__ __forceinline__ int v_st(int k, int c) { const int kk = (k & ~0xC) | ((k & 4) << 1) | ((k & 8) >> 1); return ((kk >> 3) * 4 + (c >> 5)) * 512 + ((kk & 7) * 32 + (c & 31)) * 2; }
__device__ __forceinline__ int v_rd_base(int lane) { return ((lane & 3) << 3) | (((lane >> 2) & 3) << 6) | (((lane >> 4) & 1) << 5) | (((lane >> 5) & 1) << 8); }
constexpr int v_rd_off(int d0, int ks, int half) { return d0 * 512 + ks * 4096 + half * 2048; }
template <int OFF> __device__ __forceinline__ s16x4 tr_read(int vb) { s16x4 r; asm volatile("ds_read_b64_tr_b16 %0, %1 offset:%2" : "=&v"(r) : "v"(vb), "i"(OFF) : "memory"); return r; }
template <int D0> __device__ __forceinline__ void pv_one(f32x16& od, int vb, bf16x8 pa0, bf16x8 pa1, bf16x8 pa2, bf16x8 pa3) {
    const s16x4 l0 = tr_read<v_rd_off(D0, 0, 0)>(vb), h0 = tr_read<v_rd_off(D0, 0, 1)>(vb), l1 = tr_read<v_rd_off(D0, 1, 0)>(vb), h1 = tr_read<v_rd_off(D0, 1, 1)>(vb);
    const s16x4 l2 = tr_read<v_rd_off(D0, 2, 0)>(vb), h2 = tr_read<v_rd_off(D0, 2, 1)>(vb), l3 = tr_read<v_rd_off(D0, 3, 0)>(vb), h3 = tr_read<v_rd_off(D0, 3, 1)>(vb);
    asm volatile("s_waitcnt lgkmcnt(0)" ::: "memory"); SBAR();
#define PKV(L, H) (bf16x8){L[0], L[1], L[2], L[3], H[0], H[1], H[2], H[3]}
    od = __builtin_amdgcn_mfma_f32_32x32x16_bf16(pa0, PKV(l0, h0), od, 0, 0, 0);
    od = __builtin_amdgcn_mfma_f32_32x32x16_bf16(pa1, PKV(l1, h1), od, 0, 0, 0);
    od = __builtin_amdgcn_mfma_f32_32x32x16_bf16(pa2, PKV(l2, h2), od, 0, 0, 0);
    od = __builtin_amdgcn_mfma_f32_32x32x16_bf16(pa3, PKV(l3, h3), od, 0, 0, 0);
#undef PKV
}
__device__ __forceinline__ void qkt(f32x16& p0, f32x16& p1, ldsp Ks, const bf16x8* qr, int r32, int hi) {
    p0 = f32x16{}; p1 = f32x16{};
#pragma unroll
    for (int d0 = 0; d0 < 8; ++d0) { const int cb = (d0 * 16 + hi * 8) * 2;
        const bf16x8 b0 = *(const LAS bf16x8*)(Ks + KSWZ(r32, cb)); const bf16x8 b1 = *(const LAS bf16x8*)(Ks + KSWZ(32 + r32, cb));
        p0 = __builtin_amdgcn_mfma_f32_32x32x16_bf16(b0, qr[d0], p0, 0, 0, 0); p1 = __builtin_amdgcn_mfma_f32_32x32x16_bf16(b1, qr[d0], p1, 0, 0, 0); }
}
struct AttnP { const bf16* zb; const bf16* ck; const bf16* cv; bf16* mix; const float* sink; int l; };
__device__ __forceinline__ void attn_unit(const AttnP& A, ldsp lds, int u, int tid, int lane, int wave) {
    asm volatile("" : "+v"(tid), "+v"(lane));
    constexpr float C = 0.08838834764831845f * 1.4426950408889634f;
    const int r32 = lane & 31, hi = lane >> 5;
    const bool lat = u < 512; int b, head, q0, T; size_t rowbase;
    if (lat) { q0 = (u & 7) * 256; head = (u >> 3) & 7; b = u >> 6; rowbase = NCTX + (size_t)b * 2048; T = 2048; }
    else { const int uu = u - 512; head = uu & 7; b = uu >> 3; q0 = 0; rowbase = (size_t)b * 256; T = 256; }
    const int kvh = head >> 2, nct = lat ? 8 : 0;
    const int ws = lat ? max(0, q0 - 128) / 64 : 0, we = lat ? min(T, q0 + 384) / 64 : 4, NT = nct + (we - ws);
    const int qw = q0 + 32 * wave;
    ldsp V_lds = lds, K_lds = lds + 32768; LAS float* al = (LAS float*)(lds + 65536) + wave * 64;
    bf16x8 qr[8];
    { const bf16* Qw = A.zb + (rowbase + qw + r32) * DINP + C_AQ + head * 128 + hi * 8;
#pragma unroll
      for (int d0 = 0; d0 < 8; ++d0) qr[d0] = *(const bf16x8*)(Qw + d0 * 16); }
    float m_reg = A.sink[head] * 1.4426950408889634f, l_reg = 1.f; f32x16 o[4] = {};
    const int sr = tid >> 4, sc = (tid & 15) * 8, vst0 = v_st(sr, sc), vst1 = v_st(32 + sr, sc);
    const int vb0 = (int)(unsigned)(size_t)V_lds + v_rd_base(lane);
    bf16x8 ks0, ks1, vs0, vs1;
#define ALOAD(j) do { const bf16 *kp, *vp; size_t st; if ((j) < nct) { kp = A.ck + ((size_t)(b * 4 + A.l) * 512 + (j) * 64) * 256 + kvh * 128; vp = A.cv + ((size_t)(b * 4 + A.l) * 512 + (j) * 64) * 256 + kvh * 128; st = 256; } \
        else { const size_t r0 = rowbase + (size_t)(ws + (j) - nct) * 64; kp = A.zb + r0 * DINP + C_AK + kvh * 128; vp = A.zb + r0 * DINP + C_AV + kvh * 128; st = DINP; } \
        ks0 = *(const bf16x8*)(kp + sr * st + sc); ks1 = *(const bf16x8*)(kp + (32 + sr) * st + sc); vs0 = *(const bf16x8*)(vp + sr * st + sc); vs1 = *(const bf16x8*)(vp + (32 + sr) * st + sc); } while (0)
#define AWRITE(bb) do { *(LAS bf16x8*)(V_lds + (bb) * 16384 + vst0) = vs0; *(LAS bf16x8*)(V_lds + (bb) * 16384 + vst1) = vs1; \
        *(LAS bf16x8*)(K_lds + (bb) * 16384 + KSWZ(sr, sc * 2)) = ks0; *(LAS bf16x8*)(K_lds + (bb) * 16384 + KSWZ(32 + sr, sc * 2)) = ks1; } while (0)
    ALOAD(0); AWRITE(0); __syncthreads();
#pragma unroll 1
    for (int j = 0; j < NT; ++j) {
        if (j + 1 < NT) ALOAD(j + 1);
        bool active = true, needmask = false; int kpos0 = 0;
        if (lat && j >= nct) { kpos0 = (ws + j - nct) * 64; active = (kpos0 + 63 >= qw - 128) && (kpos0 <= qw + 31 + 128); needmask = !((kpos0 >= qw + 31 - 128) && (kpos0 + 63 <= qw + 128)); }
        if (active) {
            f32x16 p0, p1;
            qkt(p0, p1, K_lds + (j & 1) * 16384, qr, r32, hi);
            if (needmask) { const int q = qw + r32;
#pragma unroll
                for (int r = 0; r < 16; ++r) { const int k0 = kpos0 + crow(r, hi) - q, k1 = k0 + 32; if (k0 > 128 || k0 < -128) p0[r] = -1e30f; if (k1 > 128 || k1 < -128) p1[r] = -1e30f; } }
            float pmax = p0[0];
#pragma unroll
            for (int r = 1; r < 16; ++r) pmax = fmaxf(pmax, p0[r]);
#pragma unroll
            for (int r = 0; r < 16; ++r) pmax = fmaxf(pmax, p1[r]);
            { auto rr = __builtin_amdgcn_permlane32_swap(__float_as_uint(pmax), __float_as_uint(pmax), false, false); pmax = fmaxf(__uint_as_float(rr[0]), __uint_as_float(rr[1])); }
            const float mn = fmaxf(m_reg, pmax * C), alpha = __builtin_amdgcn_exp2f(m_reg - mn); m_reg = mn;
            float ps = 0.f;
#pragma unroll
            for (int r = 0; r < 16; ++r) { p0[r] = __builtin_amdgcn_exp2f(fmaf(p0[r], C, -mn)); p1[r] = __builtin_amdgcn_exp2f(fmaf(p1[r], C, -mn)); ps += p0[r] + p1[r]; }
            { auto rr = __builtin_amdgcn_permlane32_swap(__float_as_uint(ps), __float_as_uint(ps), false, false); ps = __uint_as_float(rr[0]) + __uint_as_float(rr[1]); }
            l_reg = l_reg * alpha + ps;
            if (__any(alpha < 1.f)) { if (hi == 0) al[r32] = alpha; LDS_WAIT();
#pragma unroll
                for (int d = 0; d < 4; ++d)
#pragma unroll
                    for (int r = 0; r < 16; ++r) o[d][r] *= al[crow(r, hi)]; }
            bf16x8 pa0, pa1, pa2, pa3;
#define PK4(P, BASE, OUT) do { unsigned a0 = pk2(P[BASE + 0], P[BASE + 1]), a1 = pk2(P[BASE + 2], P[BASE + 3]); unsigned b0 = pk2(P[BASE + 4], P[BASE + 5]), b1 = pk2(P[BASE + 6], P[BASE + 7]); \
    auto r0 = __builtin_amdgcn_permlane32_swap(a0, b0, false, false); auto r1 = __builtin_amdgcn_permlane32_swap(a1, b1, false, false); \
    v4u w = {r0[0], r1[0], r0[1], r1[1]}; OUT = __builtin_bit_cast(bf16x8, w); } while (0)
            PK4(p0, 0, pa0); PK4(p0, 8, pa1); PK4(p1, 0, pa2); PK4(p1, 8, pa3);
#undef PK4
            const int vb = vb0 + (j & 1) * 16384;
            pv_one<0>(o[0], vb, pa0, pa1, pa2, pa3); pv_one<1>(o[1], vb, pa0, pa1, pa2, pa3); pv_one<2>(o[2], vb, pa0, pa1, pa2, pa3); pv_one<3>(o[3], vb, pa0, pa1, pa2, pa3);
        }
        if (j + 1 < NT) AWRITE((j + 1) & 1);
        __syncthreads();
    }
#undef ALOAD
#undef AWRITE
    if (hi == 0) al[r32] = l_reg; LDS_WAIT();
    bf16* Ow = A.mix + (rowbase + qw) * D + head * 128 + r32;
#pragma unroll
    for (int r = 0; r < 16; ++r) { const int orow = crow(r, hi); const float rl = __builtin_amdgcn_rcpf(al[orow]);
#pragma unroll
        for (int d0 = 0; d0 < 4; ++d0) Ow[(size_t)orow * D + d0 * 32] = (bf16)(pk2(o[d0][r] * rl, 0.f) & 0xffffu); }
}

#ifndef PROBE_DUP
#define PROBE_DUP 0
#endif
#ifndef PROBE_T
#define PROBE_T 0
#endif
__device__ __forceinline__ int lane_l() { int t; asm volatile("v_mbcnt_lo_u32_b32 %0, -1, 0\n\tv_mbcnt_hi_u32_b32 %0, -1, %0" : "=v"(t)); return t; }
struct Args { const float* in[24]; float* out; unsigned char* ws; int ph_lo, ph_hi; };
constexpr int NPH = 31;
__global__ void __launch_bounds__(NWAVES * 64, 2) fwd(Args args) {
    extern __shared__ __attribute__((aligned(16))) unsigned char lds_raw[];
    ldsp lds = (ldsp)lds_raw;
    volatile LAS unsigned* MISC = (volatile LAS unsigned*)(lds + LDSCTL_OFF);
    const int wave = __builtin_amdgcn_readfirstlane((int)threadIdx.x >> 6), G = gridDim.x;
#define tid ((wave << 6) | lane_l())
#define lane lane_l()
    unsigned char* ws = args.ws; unsigned* ctl = (unsigned*)(ws + WS_CTL);
    for (int u = tid; u < (LDS_BYTES - LDSCTL_OFF) / 4; u += NWAVES * 64) MISC[u] = 0u;
    __syncthreads();
    const int lo = args.ph_lo, hi = args.ph_hi; const bool multi = (hi - lo) > 1;
    XcdBarrier bar; bar.bar = ctl + CW_BAR; bar.x = 0; bar.st = nullptr; bar.t0 = false;
    if (multi) bar = xcd_barrier_post(ctl + CW_BAR, MISC + 8);
#define IN(k) (lo <= (k) && (k) < hi)
    unsigned long long tacc_ = 0, t0_ = 0;
#define PH_T0(bit) do { if (PROBE_T & (bit)) t0_ = __builtin_amdgcn_s_memrealtime(); } while (0)
#define PH_T1(bit) do { if (PROBE_T & (bit)) tacc_ += __builtin_amdgcn_s_memrealtime() - t0_; } while (0)
#define DUPBAR() do { if (multi) { XcdBarrier b2_ = bar; b2_.t0 = (wave == 0) && (lane_l() == 0); asm volatile("" : "+s"(b2_.bar)); xcd_barrier(b2_); } } while (0)
#if PROBE_DUP & 512
#define SEAM(k) do { if (IN(k) && IN((k) + 1)) { XcdBarrier b2_ = bar; b2_.t0 = (wave == 0) && (lane_l() == 0); asm volatile("" : "+s"(b2_.bar)); xcd_barrier(b2_); xcd_barrier(b2_); } } while (0)
#else
#define SEAM(k) do { if (IN(k) && IN((k) + 1)) { XcdBarrier b2_ = bar; b2_.t0 = (wave == 0) && (lane_l() == 0); asm volatile("" : "+s"(b2_.bar)); xcd_barrier(b2_); } } while (0)
#endif
    const float *x_prompt = args.in[0], *x_sample = args.in[1], *cache_k = args.in[2], *cache_v = args.in[3], *state_delta = args.in[4], *c_in = args.in[5], *c_ctx = args.in[6];
    const float *norm1_g = args.in[7], *w_mod = args.in[8], *b_mod = args.in[9], *w_in = args.in[10], *conv_w = args.in[11], *attn_sink = args.in[12], *dn_a_log = args.in[13], *dn_dt_bias = args.in[14];
    const float *dn_norm_g = args.in[15], *sgu_norm_g = args.in[16], *sgu_w = args.in[17], *sgu_b = args.in[18], *w_out = args.in[19], *norm2_g = args.in[20], *w_ff1 = args.in[21], *w_ff2 = args.in[22], *final_norm_g = args.in[23];
    float* out = args.out;
    float* MOD = (float*)(ws + WS_MOD); float* XB = (float*)(ws + WS_X); bf16* HB = (bf16*)(ws + WS_HB); bf16* ZB = (bf16*)(ws + WS_ZB); bf16* FB = ZB; bf16* XA = (bf16*)(ws + WS_XA);
    float* ODIR = (float*)(ws + WS_ODIR); unsigned char* DN = ws + WS_DN; float* SSQ = (float*)(ctl + CW_SSQ); const float* BW = (const float*)(ws + WS_BW);

    PH_T0(1);
    if (IN(0)) {
        P0Args pa{c_in, c_ctx, norm1_g, norm2_g, w_mod, b_mod, w_in, w_out, w_ff1, w_ff2, cache_k, cache_v, ws};
        p0_prologue(pa, lds, ctl + CW_ATT + 64 * 16, MISC, tid, lane, wave, G);
        __syncthreads();
#if PROBE_DUP & 4
        p0_prologue(pa, lds, ctl + CW_ATT + 64 * 17, MISC, tid, lane, wave, G); __syncthreads();
#endif
    }
    SEAM(0); PH_T1(1); PH_T0(2);
    if (IN(1)) {
        p0b_bias(ws, lds, tid, lane, wave, G);
        norm_phase<false>(x_prompt, x_sample, MOD + 1 * 2048, XA, SSQ, nullptr, lane, wave, G);
    }
    SEAM(1); PH_T1(2);
#pragma unroll 1
    for (int l = 0; l < DEPTH; ++l) {
        const int pb = 2 + 7 * l;
        const float* modl = MOD + (size_t)l * 9 * 12288;
        const float* xa0 = l == 0 ? x_prompt : XB; const float* xa1 = l == 0 ? x_sample : XB + (size_t)NCTX * D;
        if (l == 0) PH_T0(4);
        if (IN(pb + 0)) {
            const bf16* gA = XA; const bf16* gB = (const bf16*)(ws + WS_WIN) + (size_t)l * DINP * 2048; asm volatile("" : "+s"(gA), "+s"(gB));
            pg8::Gemm g{gA, gB, M, DINP, 2048}; pg8::StaticOrder S; S.init(M, DINP, G, (int)blockIdx.x);
            pg8::EpiZ E{ZB, DINP, out + O_K + (size_t)l * 65536, out + O_V + (size_t)l * 65536, SSQ + (size_t)(2 * l) * M, BW + (size_t)l * BW_L};
            pg8::gemm_phase<pg8::EpiZ, pg8::StaticOrder, true, true>(lds, g, S, E, wave);
        }
        SEAM(pb + 0); PH_T1(4); PH_T0(8);
        LayerP LP{conv_w + (size_t)l * 5 * 1536, dn_a_log + l * 8, dn_dt_bias + l * 8, dn_norm_g + l * 128, sgu_norm_g + l * 512, sgu_w + (size_t)l * 4 * 128 * 128, sgu_b + l * 512, attn_sink + l * 8};
        if (IN(pb + 1)) {
            int wg_ = -1;
            for (int it = blockIdx.x; it < 1280 + 640 + 256; it += G) {
                if (it < 1280) dn_prep_unit(LP, ZB, DN, lds, it >> 2, it & 3, tid, lane, wave);
                else if (it < 1920) { const int g_ = (it - 1280) & 3; sgu_unit(LP, ZB, HB, lds, (it - 1280) >> 2, g_, g_ != wg_, tid, lane, wave); wg_ = g_; }
                else rope_item(ZB, (const float*)(ws + WS_ROPE), it - 1920, lane, wave);
            }
        }
#if PROBE_DUP & 16
        if (IN(pb + 1)) { DUPBAR();
            for (int it = blockIdx.x; it < 1280 + 640; it += G) {
                if (it < 1280) dn_prep_unit(LP, ZB, DN, lds, it >> 2, it & 3, tid, lane, wave);
                else sgu_unit(LP, ZB, HB, lds, (it - 1280) >> 2, (it - 1280) & 3, true, tid, lane, wave);
            } }
#endif
#if PROBE_DUP & 32
        if (IN(pb + 1)) { DUPBAR(); for (int it = blockIdx.x; it < 1280; it += G) dn_prep_unit(LP, ZB, DN, lds, it >> 2, it & 3, tid, lane, wave); }
#endif
        SEAM(pb + 1); PH_T1(8); PH_T0(16);
        if (IN(pb + 2)) {
            for (int cu = blockIdx.x; cu < 192; cu += G) {
                const bool isctx = cu >= 64; const int cc = isctx ? cu - 64 : cu; const int b = cc >> 3, h = (cc >> 1) & 3, dir = cc & 1;
                const float* s0 = isctx ? nullptr : state_delta + ((((size_t)b * 4 + l) * 2 + dir) * 4 + h) * 16384;
                float* so = isctx ? out + O_DELTA + ((((size_t)b * 4 + l) * 2 + dir) * 4 + h) * 16384 : nullptr;
                scan_chain(DN, s0, so, ODIR + (size_t)dir * M * 512, lds, isctx ? 1 : 0, b, h, dir, lane, wave);
            }
            AttnP AP{ZB, (const bf16*)(ws + WS_CK), (const bf16*)(ws + WS_CV), HB, LP.sink, l};
            for (;;) {
                if (tid == 0) MISC[0] = atomicAdd(ctl + CW_ATT + 64 * l, 1u);
                __syncthreads(); const int u = (int)MISC[0]; __syncthreads();
                if (u >= 640) break;
                attn_unit(AP, lds, u, tid, lane, wave);
            }
        }
#if PROBE_DUP & 128
        if (IN(pb + 2)) { DUPBAR();
            for (int cu = blockIdx.x; cu < 192; cu += G) {
                const bool isctx = cu >= 64; const int cc = isctx ? cu - 64 : cu; const int b = cc >> 3, h = (cc >> 1) & 3, dir = cc & 1;
                const float* s0 = isctx ? nullptr : state_delta + ((((size_t)b * 4 + l) * 2 + dir) * 4 + h) * 16384;
                float* so = isctx ? out + O_DELTA + ((((size_t)b * 4 + l) * 2 + dir) * 4 + h) * 16384 : nullptr;
                scan_chain(DN, s0, so, ODIR + (size_t)dir * M * 512, lds, isctx ? 1 : 0, b, h, dir, lane, wave);
            } }
#endif
#if PROBE_DUP & 256
        if (IN(pb + 2)) { DUPBAR();
            AttnP AP{ZB, (const bf16*)(ws + WS_CK), (const bf16*)(ws + WS_CV), HB, LP.sink, l};
            for (;;) {
                if (tid == 0) MISC[0] = atomicAdd(ctl + CW_ATT + 64 * (l + 4), 1u);
                __syncthreads(); const int u = (int)MISC[0]; __syncthreads();
                if (u >= 640) break;
                attn_unit(AP, lds, u, tid, lane, wave);
            } }
#endif
#if PROBE_DUP & 2
        if (IN(pb + 2)) { DUPBAR();
            for (int cu = blockIdx.x; cu < 192; cu += G) {
                const bool isctx = cu >= 64; const int cc = isctx ? cu - 64 : cu; const int b = cc >> 3, h = (cc >> 1) & 3, dir = cc & 1;
                const float* s0 = isctx ? nullptr : state_delta + ((((size_t)b * 4 + l) * 2 + dir) * 4 + h) * 16384;
                float* so = isctx ? out + O_DELTA + ((((size_t)b * 4 + l) * 2 + dir) * 4 + h) * 16384 : nullptr;
                scan_chain(DN, s0, so, ODIR + (size_t)dir * M * 512, lds, isctx ? 1 : 0, b, h, dir, lane, wave);
            }
            AttnP AP{ZB, (const bf16*)(ws + WS_CK), (const bf16*)(ws + WS_CV), HB, LP.sink, l};
            for (;;) {
                if (tid == 0) MISC[0] = atomicAdd(ctl + CW_ATT + 64 * (l + 4), 1u);
                __syncthreads(); const int u = (int)MISC[0]; __syncthreads();
                if (u >= 640) break;
                attn_unit(AP, lds, u, tid, lane, wave);
            } }
#endif
        SEAM(pb + 2); PH_T1(16); PH_T0(32);
        if (IN(pb + 3)) {
            const int ln = lane_l();
            const float gn0 = LP.dn_norm_g[2 * ln], gn1 = LP.dn_norm_g[2 * ln + 1];
            for (int it = blockIdx.x * NWAVES + wave; it < M * 4; it += G * NWAVES) { const size_t row = it >> 2; const int hh = it & 3;
                const f32x2 a = *(const f32x2*)(ODIR + row * 512 + hh * 128 + 2 * ln), b2 = *(const f32x2*)(ODIR + (size_t)M * 512 + row * 512 + hh * 128 + 2 * ln);
                const float o0 = a.x + b2.x, o1 = a.y + b2.y; const float r = rsqrtf(wave_sum(o0 * o0 + o1 * o1) * (1.f / 128.f) + EPS);
                const unsigned z = *(const unsigned*)(ZB + row * DINP + C_DZ + hh * 128 + 2 * ln);
                *(unsigned*)(HB + row * D + 1024 + hh * 128 + 2 * ln) = pk2(o0 * r * gn0 * silu_f(bflo(z)), o1 * r * gn1 * silu_f(bfhi(z))); }
        }
        SEAM(pb + 3); PH_T1(32); PH_T0(64);
        if (IN(pb + 4)) {
            const bf16* gA = HB; const bf16* gB = (const bf16*)(ws + WS_WOUT) + (size_t)l * 2048 * 2048; asm volatile("" : "+s"(gA), "+s"(gB));
            pg8::Gemm g{gA, gB, M, 2048, 2048};
            pg8::EpiRes E{xa0, xa1, XB, modl + 2 * 2048, modl + 4 * 2048, XA, SSQ + (size_t)(2 * l + 1) * M};
            pg8::StaticOrder S; S.init(M, 2048, G, (int)blockIdx.x);
            pg8::gemm_phase<pg8::EpiRes, pg8::StaticOrder, true, true>(lds, g, S, E, wave);
        }
        SEAM(pb + 4); PH_T1(64); PH_T0(128);
        if (IN(pb + 5)) {
            const bf16* gA = XA; const bf16* gB = (const bf16*)(ws + WS_WFF1) + (size_t)l * DFF * 2048; asm volatile("" : "+s"(gA), "+s"(gB));
            pg8::Gemm g{gA, gB, M, DFF, 2048}; pg8::StaticOrder S; S.init(M, DFF, G, (int)blockIdx.x);
            pg8::EpiRelu2 E{FB, DFF, SSQ + (size_t)(2 * l + 1) * M, BW + (size_t)l * BW_L + 9 * DINP};
            pg8::gemm_phase<pg8::EpiRelu2, pg8::StaticOrder, true, true>(lds, g, S, E, wave);
        }
        SEAM(pb + 5); PH_T1(128); PH_T0(256);
        if (IN(pb + 6)) {
            const bf16* gA = FB; const bf16* gB = (const bf16*)(ws + WS_WFF2) + (size_t)l * 2048 * DFF; asm volatile("" : "+s"(gA), "+s"(gB));
            pg8::Gemm g{gA, gB, M, 2048, DFF};
            pg8::EpiRes E{XB, XB + (size_t)NCTX * D, XB, modl + 5 * 2048, l + 1 < DEPTH ? modl + 9 * 12288 + 1 * 2048 : nullptr, XA, SSQ + (size_t)(2 * l + 2) * M};
            pg8::StaticOrder S; S.init(M, 2048, G, (int)blockIdx.x);
            pg8::gemm_phase<pg8::EpiRes, pg8::StaticOrder, true, true>(lds, g, S, E, wave);
        }
        SEAM(pb + 6); PH_T1(256); PH_T0(4);
    }
    PH_T0(512);
    if (IN(30)) norm_phase<true>(XB, XB + (size_t)NCTX * D, final_norm_g, nullptr, nullptr, out + O_Y, lane, wave, G);
    PH_T1(512);
    if (PROBE_T && blockIdx.x == 0) { const unsigned long long te_ = __builtin_amdgcn_s_memrealtime() + 4ull * tacc_; while (__builtin_amdgcn_s_memrealtime() < te_) __builtin_amdgcn_s_sleep(64); }
#undef IN
#undef SEAM
#undef DUPBAR
#undef tid
#undef lane
}

#ifndef MK_ONE_LAUNCH
#define MK_ONE_LAUNCH 1
#endif
extern "C" void kernel_launch(void* const* d_in, const int* in_sizes, int n_in, void* d_out, int out_size, void* d_ws, size_t ws_size, hipStream_t stream) {
    static int grid = 0;
    if (grid == 0) {
        if (n_in != 24 || (size_t)out_size != O_END || ws_size < WS_END) { fprintf(stderr, "kernel_launch: unexpected shapes: n_in %d out %d ws %zu (need %zu)\n", n_in, out_size, ws_size, (size_t)WS_END); grid = -1; return; }
        int dev = 0, cus = 0, per_cu = 0;
        if (hipGetDevice(&dev) != hipSuccess || hipDeviceGetAttribute(&cus, hipDeviceAttributeMultiprocessorCount, dev) != hipSuccess) { grid = -1; return; }
        if (hipFuncSetAttribute((const void*)fwd, hipFuncAttributeMaxDynamicSharedMemorySize, LDS_BYTES) != hipSuccess) { fprintf(stderr, "kernel_launch: hipFuncSetAttribute failed\n"); grid = -1; return; }
        if (hipOccupancyMaxActiveBlocksPerMultiprocessor(&per_cu, (const void*)fwd, NWAVES * 64, LDS_BYTES) != hipSuccess || per_cu < 1) fprintf(stderr, "kernel_launch: occupancy query reports %d\n", per_cu);
        (void)hipGetLastError();
        grid = cus;
    }
    if (grid < 0) return;
    (void)hipMemsetAsync((char*)d_ws + WS_CTL, 0, CTL_ZERO_BYTES, stream);
    for (int l = 0; l < DEPTH; ++l) (void)hipMemsetAsync((char*)d_ws + WS_WIN + ((size_t)l * DINP + 4640) * 2048 * 2, 0, (size_t)(DINP - 4640) * 2048 * 2, stream);
    Args a{};
    for (int i = 0; i < 24; ++i) a.in[i] = (const float*)d_in[i];
    a.out = (float*)d_out; a.ws = (unsigned char*)d_ws;
#if MK_ONE_LAUNCH
    a.ph_lo = 0; a.ph_hi = NPH;
    hipLaunchKernelGGL(fwd, dim3(grid), dim3(NWAVES * 64), LDS_BYTES, stream, a);
#else
    for (int p = 0; p < NPH; ++p) { a.ph_lo = p; a.ph_hi = p + 1; hipLaunchKernelGGL(fwd, dim3(grid), dim3(NWAVES * 64), LDS_BYTES, stream, a); }
#endif
    const hipError_t le = hipPeekAtLastError();
    if (le != hipSuccess) fprintf(stderr, "kernel_launch: launch failed: %s\n", hipGetErrorName(le));
}
```

```cpp
#include <hip/hip_runtime.h>
#include <cstdio>
#include <cstdint>
namespace pg8 {
#define PG8_LAS __attribute__((address_space(3)))
typedef unsigned short bf16_t;
typedef short bf16x8 __attribute__((ext_vector_type(8)));
typedef float f32x4 __attribute__((ext_vector_type(4)));
typedef unsigned u32x4 __attribute__((ext_vector_type(4)));
constexpr int BM = 256, BK = 64, HALF = 128, HTB = HALF * BK * 2  , STAGE_BYTES = 8 * HTB, NXCD = 8, WGM = 8;

__host__ __device__ __forceinline__ int lds_byte(int r, int c) { const int st = (r >> 4) * 2 + (c >> 5), rr = r & 15, cc = c & 31, ob = rr * 64 + cc * 2; return st * 1024 + (ob ^ (((ob >> 9) & 1) << 5)); }
__host__ __device__ __forceinline__ void stage_rc(int b, int& R, int& C) { const int st = b / 1024, sb = b % 1024, swz = sb ^ (((sb >> 9) & 1) << 5); R = (st >> 1) * 16 + swz / 64; C = (st & 1) * 32 + (swz % 64) / 2; }
__host__ __device__ __forceinline__ int perm32(int rho) { const int n = rho >> 4, i = rho & 15; return 8 * (i >> 2) + 4 * n + (i & 3); }

struct Unit { int pm, pn; };
struct Gemm { const bf16_t* A; const bf16_t* Bt; int M, N, K; };

struct StaticOrder {
    int nM, nN, nwg, G, c;
    __host__ __device__ void init(int M, int N, int G_, int c_) { nM = M / BM; nN = N / BM; nwg = nM * nN; G = G_; c = c_; }
    __host__ __device__ bool next(int i, Unit& u) const {
        const long L = (long)i * G + c; if (L >= nwg) return false;
        int wgid = (int)L; { const int q = nwg / NXCD, r = nwg % NXCD, xcd = wgid % NXCD, off = wgid / NXCD; wgid = (xcd < r ? xcd * (q + 1) : r * (q + 1) + (xcd - r) * q) + off; }
        const int nig = WGM * nN, gid = wgid / nig, fm = gid * WGM, gsz = (nM - fm) < WGM ? (nM - fm) : WGM;
        u.pm = fm + ((wgid % nig) % gsz); u.pn = (wgid % nig) / gsz; return true;
    }
    __device__ __forceinline__ void a_ready(const Unit&) const {}
    __device__ __forceinline__ void done(const Unit&) const {}
};


typedef float f32x2c __attribute__((ext_vector_type(2))); typedef __bf16 bf16x2c __attribute__((ext_vector_type(2)));
__device__ __forceinline__ unsigned cvt_pk_bf16(float lo, float hi) { const f32x2c v = {lo, hi}; return __builtin_bit_cast(unsigned, __builtin_convertvector(v, bf16x2c)); }
__device__ __forceinline__ int cond_of(int rowt) { return rowt < 4096 ? 8 : ((rowt - 4096) >> 11); }
struct EpiZ {
    static constexpr bool PERM = true, AFTER_DRAIN = false;
    bf16_t* O; int ldc; float* outk; float* outv; const unsigned long long* ssq; const float* bw;
    __device__ __forceinline__ void operator()(const f32x4 (&acc)[2][2][4][2], const Unit& u, int wr, int wc, int fr, int fq) const {
        asm volatile("" : "+v"(fr), "+v"(fq));
        const int rowt = u.pm * BM, row0 = rowt + wr * 64 + fr; const int col0 = u.pn * BM + wc * 32 + 8 * fq;
        const bool kv = (u.pm < 16) && (u.pn == 4 || u.pn == 5);
        float* ob = (u.pn == 4 ? outk : outv) + (size_t)u.pm * (4 * 65536) + wc * 32 + 8 * fq;
        const float* bp = bw + (size_t)cond_of(rowt) * ldc + col0; f32x4 bv[2][2];
#pragma unroll
        for (int bj = 0; bj < 2; ++bj)
#pragma unroll
            for (int n = 0; n < 2; ++n) bv[bj][n] = *(const f32x4*)(bp + bj * HALF + 4 * n);
#pragma unroll
        for (int ai = 0; ai < 2; ++ai)
#pragma unroll
            for (int m = 0; m < 4; ++m) { const int rl = wr * 64 + fr + ai * HALF + m * 16; bf16_t* rowp = O + (size_t)(row0 + ai * HALF + m * 16) * ldc + col0;
                const float rs = __builtin_amdgcn_rsqf((float)ssq[rowt + rl] * (1.f / (2048.f * 16777216.f)) + 1e-6f);
#pragma unroll
                for (int bj = 0; bj < 2; ++bj) { const f32x4 v0 = acc[ai][bj][m][0] * rs + bv[bj][0], v1 = acc[ai][bj][m][1] * rs + bv[bj][1];
                    u32x4 w; w.x = cvt_pk_bf16(v0[0], v0[1]); w.y = cvt_pk_bf16(v0[2], v0[3]); w.z = cvt_pk_bf16(v1[0], v1[1]); w.w = cvt_pk_bf16(v1[2], v1[3]);
                    *(u32x4*)(rowp + bj * HALF) = w;
                    if (kv) { float* p = ob + (size_t)rl * 256 + bj * HALF; *(f32x4*)p = v0; *(f32x4*)(p + 4) = v1; } } }
    }
};
struct EpiRelu2 {
    static constexpr bool PERM = true, AFTER_DRAIN = false;
    bf16_t* O; int ldc; const unsigned long long* ssq; const float* bw;
    __device__ __forceinline__ void operator()(const f32x4 (&acc)[2][2][4][2], const Unit& u, int wr, int wc, int fr, int fq) const {
        asm volatile("" : "+v"(fr), "+v"(fq));
        const int rowt = u.pm * BM, row0 = rowt + wr * 64 + fr; const int col0 = u.pn * BM + wc * 32 + 8 * fq;
        const float* bp = bw + (size_t)cond_of(rowt) * ldc + col0; f32x4 bv[2][2];
#pragma unroll
        for (int bj = 0; bj < 2; ++bj)
#pragma unroll
            for (int n = 0; n < 2; ++n) bv[bj][n] = *(const f32x4*)(bp + bj * HALF + 4 * n);
#pragma unroll
        for (int ai = 0; ai < 2; ++ai)
#pragma unroll
            for (int m = 0; m < 4; ++m) { bf16_t* rowp = O + (size_t)(row0 + ai * HALF + m * 16) * ldc + col0;
                const float rs = __builtin_amdgcn_rsqf((float)ssq[row0 + ai * HALF + m * 16] * (1.f / (2048.f * 16777216.f)) + 1e-6f);
#pragma unroll
                for (int bj = 0; bj < 2; ++bj) { f32x4 v0 = acc[ai][bj][m][0] * rs + bv[bj][0], v1 = acc[ai][bj][m][1] * rs + bv[bj][1];
#pragma unroll
                    for (int j = 0; j < 4; ++j) { const float a = fmaxf(v0[j], 0.f), b = fmaxf(v1[j], 0.f); v0[j] = a * a; v1[j] = b * b; }
                    u32x4 w; w.x = cvt_pk_bf16(v0[0], v0[1]); w.y = cvt_pk_bf16(v0[2], v0[3]); w.z = cvt_pk_bf16(v1[0], v1[1]); w.w = cvt_pk_bf16(v1[2], v1[3]);
                    *(u32x4*)(rowp + bj * HALF) = w; } }
    }
};
struct EpiRes {
    static constexpr bool PERM = true, AFTER_DRAIN = false;
    bf16_t* x; const float* gate; const float* anext; bf16_t* xa; unsigned long long* ssq;
    __device__ __forceinline__ void operator()(const f32x4 (&acc)[2][2][4][2], const Unit& u, int wr, int wc, int fr, int fq) const {
        asm volatile("" : "+v"(fr), "+v"(fq));
        const int rowt = u.pm * BM, col0 = u.pn * BM + wc * 32 + 8 * fq; const int cond = cond_of(rowt);
        bf16_t* xb = x + (size_t)rowt * 2048; bf16_t* ab = xa + (size_t)rowt * 2048;
        const float* g = gate + (size_t)cond * 12288 + col0; f32x4 gv[2][2], av[2][2];
#pragma unroll
        for (int bj = 0; bj < 2; ++bj)
#pragma unroll
            for (int n = 0; n < 2; ++n) { gv[bj][n] = *(const f32x4*)(g + bj * HALF + 4 * n); av[bj][n] = anext ? *(const f32x4*)(anext + (size_t)cond * 12288 + col0 + bj * HALF + 4 * n) : (f32x4){0.f, 0.f, 0.f, 0.f}; }
        const unsigned offb = (unsigned)((wr * 64 + fr) * 2048 + col0) * 2u;
#pragma unroll
        for (int ai = 0; ai < 2; ++ai)
#pragma unroll
            for (int m = 0; m < 4; ++m) { unsigned voff = offb + (unsigned)(ai * HALF + m * 16) * 4096u; asm volatile("" : "+v"(voff));
                char* xp = (char*)xb + voff; char* ap = (char*)ab + voff; float ss = 0.f;
#pragma unroll
                for (int bj = 0; bj < 2; ++bj) { const u32x4 xw = *(const u32x4*)(xp + bj * 256);
                    const f32x4 x0 = {__uint_as_float(xw.x << 16), __uint_as_float(xw.x & 0xffff0000u), __uint_as_float(xw.y << 16), __uint_as_float(xw.y & 0xffff0000u)};
                    const f32x4 x1 = {__uint_as_float(xw.z << 16), __uint_as_float(xw.z & 0xffff0000u), __uint_as_float(xw.w << 16), __uint_as_float(xw.w & 0xffff0000u)};
                    const f32x4 y0 = x0 + gv[bj][0] * acc[ai][bj][m][0], y1 = x1 + gv[bj][1] * acc[ai][bj][m][1];
                    u32x4 yw; yw.x = cvt_pk_bf16(y0[0], y0[1]); yw.y = cvt_pk_bf16(y0[2], y0[3]); yw.z = cvt_pk_bf16(y1[0], y1[1]); yw.w = cvt_pk_bf16(y1[2], y1[3]); *(u32x4*)(xp + bj * 256) = yw;
                    ss += (y0[0] * y0[0] + y0[1] * y0[1]) + (y0[2] * y0[2] + y0[3] * y0[3]) + (y1[0] * y1[0] + y1[1] * y1[1]) + (y1[2] * y1[2] + y1[3] * y1[3]);
                    if (anext) { const f32x4 a0 = y0 * av[bj][0], a1 = y1 * av[bj][1];
                        u32x4 w; w.x = cvt_pk_bf16(a0[0], a0[1]); w.y = cvt_pk_bf16(a0[2], a0[3]); w.z = cvt_pk_bf16(a1[0], a1[1]); w.w = cvt_pk_bf16(a1[2], a1[3]); *(u32x4*)(ap + bj * 256) = w; } }
                ss += __shfl_xor(ss, 16); ss += __shfl_xor(ss, 32);
                if (fq == 0) { const float hi = floorf(ss); const unsigned long long q = ((unsigned long long)(unsigned)hi << 24) + (unsigned long long)(unsigned)((ss - hi) * 16777216.f);
                    __hip_atomic_fetch_add(ssq + rowt + wr * 64 + fr + ai * HALF + m * 16, q, __ATOMIC_RELAXED, __HIP_MEMORY_SCOPE_AGENT); }
                asm volatile("" ::: "memory"); }
    }
};
template <class Epi, class Sched, bool ALIGN_EPI = false, bool SP2 = false>
__device__ __forceinline__ void gemm_phase(PG8_LAS unsigned char* lds, const Gemm g, const Sched& S, const Epi& E, const int wave_in) {
    int tid_; asm volatile("v_mbcnt_lo_u32_b32 %0, -1, 0\n\tv_mbcnt_hi_u32_b32 %0, -1, %0" : "=v"(tid_)); tid_ |= (wave_in << 6);
    const int tid = tid_, wid = __builtin_amdgcn_readfirstlane(tid >> 6), lane = tid & 63, wr = wid >> 2, wc = wid & 3, fr = lane & 15, fq = lane >> 4;
    const int K = g.K, nt = K / BK;
    unsigned voffA[2], voffB[2];
#pragma unroll
    for (int i = 0; i < 2; ++i) { int R, C; stage_rc(tid * 16 + i * 8192, R, C); const int Rb = Epi::PERM ? ((R & ~31) + perm32(R & 31)) : R;
        voffA[i] = (unsigned)(R * K + C) * 2u; voffB[i] = (unsigned)(Rb * K + C) * 2u; }
    const size_t kstep = (size_t)(BK * 2);
    const size_t hstep = (size_t)HALF * K * 2;
    const size_t tstep = 2 * hstep;
    const unsigned ldsw = (unsigned)wid * 1024u;
    const int aoff = lds_byte(wr * 64 + fr, fq * 8), boff = lds_byte(wc * 32 + fr, fq * 8);
#define PG8_SA(b, h) (((b) * 2 + (h)) * HTB)
#define PG8_SB(b, h) ((4 + (b) * 2 + (h)) * HTB)
#define PG8_STAGE(bufoff, gbase, voff) do { _Pragma("unroll") for (int _i = 0; _i < 2; ++_i) \
        __builtin_amdgcn_global_load_lds((const unsigned*)((const char*)(gbase) + (voff)[_i]), (PG8_LAS unsigned*)(lds + (bufoff) + ldsw + _i * 8192), 16, 0, 0); } while (0)
#define PG8_LDA(dst, b, h) do { _Pragma("unroll") for (int m = 0; m < 4; ++m) _Pragma("unroll") for (int k = 0; k < 2; ++k) dst[m][k] = *(const PG8_LAS bf16x8*)(lds + PG8_SA(b, h) + aoff + m * 2048 + k * 1024); } while (0)
#define PG8_LDB(dst, b, h) do { _Pragma("unroll") for (int n = 0; n < 2; ++n) _Pragma("unroll") for (int k = 0; k < 2; ++k) dst[n][k] = *(const PG8_LAS bf16x8*)(lds + PG8_SB(b, h) + boff + n * 2048 + k * 1024); } while (0)
#define PG8_MMA(ai, bj, At, Bt) do { __builtin_amdgcn_s_setprio(1); _Pragma("unroll") for (int m = 0; m < 4; ++m) _Pragma("unroll") for (int n = 0; n < 2; ++n) _Pragma("unroll") for (int k = 0; k < 2; ++k) \
        acc[ai][bj][m][n] = __builtin_amdgcn_mfma_f32_16x16x32_bf16(Bt[n][k], At[m][k], acc[ai][bj][m][n], 0, 0, 0); __builtin_amdgcn_s_setprio(0); } while (0)
#define PG8_WAIT_V(n) asm volatile("s_waitcnt vmcnt(" #n ")" ::: "memory")
#define PG8_WAIT_L(n) asm volatile("s_waitcnt lgkmcnt(" #n ")" ::: "memory")
#define PG8_BAR __builtin_amdgcn_s_barrier()
#define PG8_SCHED __builtin_amdgcn_sched_barrier(0)
    Unit cur, nxt; int ui = 0;
    if (!S.next(0, cur)) return;
    f32x4 acc[2][2][4][2];
#pragma unroll
    for (int a = 0; a < 2; ++a)
#pragma unroll
        for (int b = 0; b < 2; ++b)
#pragma unroll
            for (int m = 0; m < 4; ++m)
#pragma unroll
                for (int n = 0; n < 2; ++n) acc[a][b][m][n] = (f32x4){0.f, 0.f, 0.f, 0.f};
    bf16x8 At[4][2], B0[2][2], B1[2][2];
    const char* cA = (const char*)g.A + (size_t)cur.pm * tstep; const char* cB = (const char*)g.Bt + (size_t)cur.pn * tstep;
    S.a_ready(cur);
    if constexpr (SP2) {
        PG8_STAGE(PG8_SB(0, 0), cB, voffB); PG8_STAGE(PG8_SB(0, 1), cB + hstep, voffB); PG8_STAGE(PG8_SA(0, 0), cA, voffA); PG8_STAGE(PG8_SA(0, 1), cA + hstep, voffA);
        if (wr == 1) PG8_BAR;
        PG8_WAIT_V(2); PG8_BAR;
        PG8_STAGE(PG8_SB(1, 0), cB + kstep, voffB); PG8_STAGE(PG8_SA(1, 0), cA + kstep, voffA); PG8_STAGE(PG8_SB(1, 1), cB + hstep + kstep, voffB);
        PG8_WAIT_V(6); PG8_BAR;
    } else {
        PG8_STAGE(PG8_SB(0, 0), cB, voffB); PG8_STAGE(PG8_SA(0, 0), cA, voffA); PG8_STAGE(PG8_SB(0, 1), cB + hstep, voffB); PG8_STAGE(PG8_SA(0, 1), cA + hstep, voffA);
        if (wr == 1) PG8_BAR;
        PG8_WAIT_V(4); PG8_BAR;
        PG8_STAGE(PG8_SB(1, 0), cB + kstep, voffB); PG8_STAGE(PG8_SA(1, 0), cA + kstep, voffA); PG8_STAGE(PG8_SB(1, 1), cB + hstep + kstep, voffB);
        PG8_WAIT_V(6); PG8_BAR;
    }
    for (;;) {
        const bool has_next = S.next(ui + 1, nxt);
        const char* nA = has_next ? (const char*)g.A + (size_t)nxt.pm * tstep : cA; const char* nB = has_next ? (const char*)g.Bt + (size_t)nxt.pn * tstep : cB;
        for (int t = 0; t < nt; t += 2) {
            const bool last = (t == nt - 2);
            const char* a1 = cA + (size_t)(t + 1) * kstep;
            const char* a2 = last ? nA : cA + (size_t)(t + 2) * kstep; const char* b2 = last ? nB : cB + (size_t)(t + 2) * kstep;
            const char* a3 = a2 + kstep; const char* b3 = b2 + kstep;
            if (last && has_next) S.a_ready(nxt);
            if constexpr (SP2) {
            PG8_LDB(B0, 0, 0); PG8_LDB(B1, 0, 1); PG8_SCHED; PG8_LDA(At, 0, 0); PG8_STAGE(PG8_SA(1, 1), a1 + hstep, voffA);
            PG8_WAIT_V(8); PG8_WAIT_L(0); PG8_BAR; PG8_MMA(0, 0, At, B0); PG8_MMA(0, 1, At, B1); PG8_BAR; PG8_SCHED;
            PG8_LDA(At, 0, 1); PG8_STAGE(PG8_SB(0, 0), b2, voffB); PG8_STAGE(PG8_SB(0, 1), b2 + hstep, voffB); PG8_STAGE(PG8_SA(0, 0), a2, voffA);
            PG8_WAIT_V(8); PG8_WAIT_L(0); PG8_BAR; PG8_MMA(1, 0, At, B0); PG8_MMA(1, 1, At, B1); PG8_BAR; PG8_SCHED;
            PG8_LDB(B0, 1, 0); PG8_LDB(B1, 1, 1); PG8_SCHED; PG8_LDA(At, 1, 0); PG8_STAGE(PG8_SA(0, 1), a2 + hstep, voffA);
            PG8_WAIT_V(8); PG8_WAIT_L(0); PG8_BAR; PG8_MMA(0, 0, At, B0); PG8_MMA(0, 1, At, B1); PG8_BAR; PG8_SCHED;
            PG8_LDA(At, 1, 1); PG8_STAGE(PG8_SB(1, 0), b3, voffB); PG8_STAGE(PG8_SB(1, 1), b3 + hstep, voffB); PG8_STAGE(PG8_SA(1, 0), a3, voffA);
            PG8_WAIT_V(8); PG8_WAIT_L(0); PG8_BAR; PG8_MMA(1, 0, At, B0); PG8_MMA(1, 1, At, B1); PG8_BAR; PG8_SCHED;
            } else {
            PG8_LDB(B0, 0, 0); PG8_SCHED; PG8_LDA(At, 0, 0); PG8_STAGE(PG8_SA(1, 1), a1 + hstep, voffA);
            PG8_WAIT_L(8); PG8_BAR; PG8_WAIT_L(0); PG8_MMA(0, 0, At, B0); PG8_BAR; PG8_SCHED;
            PG8_LDB(B1, 0, 1); PG8_STAGE(PG8_SB(0, 0), b2, voffB);
            PG8_BAR; PG8_WAIT_L(0); PG8_MMA(0, 1, At, B1); PG8_BAR;
            PG8_LDA(At, 0, 1); PG8_STAGE(PG8_SA(0, 0), a2, voffA);
            PG8_BAR; PG8_WAIT_L(0); PG8_MMA(1, 0, At, B0); PG8_BAR; PG8_SCHED;
            PG8_STAGE(PG8_SB(0, 1), b2 + hstep, voffB);
            PG8_WAIT_V(6); PG8_BAR; PG8_MMA(1, 1, At, B1); PG8_BAR;
            PG8_LDB(B0, 1, 0); PG8_SCHED; PG8_LDA(At, 1, 0); PG8_STAGE(PG8_SA(0, 1), a2 + hstep, voffA);
            PG8_WAIT_L(8); PG8_BAR; PG8_WAIT_L(0); PG8_MMA(0, 0, At, B0); PG8_BAR; PG8_SCHED;
            PG8_LDB(B1, 1, 1); PG8_STAGE(PG8_SB(1, 0), b3, voffB);
            PG8_BAR; PG8_WAIT_L(0); PG8_MMA(0, 1, At, B1); PG8_BAR;
            PG8_LDA(At, 1, 1); PG8_STAGE(PG8_SA(1, 0), a3, voffA);
            PG8_BAR; PG8_WAIT_L(0); PG8_MMA(1, 0, At, B0); PG8_BAR; PG8_SCHED;
            PG8_STAGE(PG8_SB(1, 1), b3 + hstep, voffB);
            PG8_WAIT_V(6); PG8_BAR; PG8_MMA(1, 1, At, B1); PG8_BAR;
            }
        }
        if constexpr (ALIGN_EPI) { if (wr == 0) PG8_BAR; }
        if constexpr (!Epi::AFTER_DRAIN) { E(acc, cur, wr, wc, fr, fq); S.done(cur); }
        if (!has_next) break;
#pragma unroll
        for (int a = 0; a < 2; ++a)
#pragma unroll
            for (int b = 0; b < 2; ++b)
#pragma unroll
                for (int m = 0; m < 4; ++m)
#pragma unroll
                    for (int n = 0; n < 2; ++n) acc[a][b][m][n] = (f32x4){0.f, 0.f, 0.f, 0.f};
        cur = nxt; cA = nA; cB = nB; ++ui;
        if constexpr (ALIGN_EPI) { if (wr == 1) PG8_BAR; }
    }
    PG8_WAIT_V(0);
    if constexpr (!ALIGN_EPI) { if (wr == 0) PG8_BAR; }
    PG8_BAR;
    if constexpr (Epi::AFTER_DRAIN) { E.fused(acc, cur, wr, wc, fr, fq, lds, wid, lane); S.done(cur); }
#undef PG8_SA
#undef PG8_SB
#undef PG8_STAGE
#undef PG8_LDA
#undef PG8_LDB
#undef PG8_MMA
#undef PG8_WAIT_V
#undef PG8_WAIT_L
#undef PG8_BAR
#undef PG8_SCHED
}
}


constexpr int D = 2048, NCTX = 4096, NLAT = 16384, M = NCTX + NLAT, DEPTH = 4;
constexpr int DIN = 4624, DINP = 4864, DFF = 8192;
constexpr int C_AQ = 0, C_AK = 1024, C_AV = 1280, C_DQ = 1536, C_DK = 2048, C_DV = 2560, C_DZ = 3072, C_DAB = 3584, C_SU = 3600, C_SV = 4112;
constexpr int NWAVES = 8;
constexpr float EPS = 1e-6f;
constexpr size_t O_Y = 0, O_K = (size_t)M * D, O_V = O_K + 4194304, O_DELTA = O_V + 4194304, O_END = O_DELTA + 8388608;
constexpr size_t MiB = 1u << 20;
constexpr size_t WS_CTL = 0, CTL_ZERO_BYTES = 1 * MiB;
static_assert((16384 + 9 * 20480) * 4 <= 1 * 1048576, "ssq inside the memset region");
constexpr size_t WS_MOD = 1 * MiB, WS_ROPE = 3 * MiB, WS_CK = 4 * MiB, WS_CV = 12 * MiB;
constexpr size_t WS_WIN = 20 * MiB, WS_WOUT = 96 * MiB, WS_WFF1 = 128 * MiB, WS_WFF2 = 256 * MiB;
constexpr size_t WS_X = 384 * MiB, WS_HB = 544 * MiB, WS_ZB = 624 * MiB, WS_ODIR = 816 * MiB, WS_DN = 944 * MiB, WS_BW = 1088 * MiB, WS_XA = 1090 * MiB, WS_SSQ = 1170 * MiB, WS_END = 1172 * MiB;
constexpr int BW_L = 9 * (DINP + DFF);
constexpr int CW_SSQ = 16384;
constexpr size_t DN_BLK = 116736, DN_DIR0 = 32768, DN_DIRSZ = 41984;
static_assert(WS_DN + 1280 * DN_BLK <= WS_END, "dn scratch");
constexpr int CW_BAR = 4096, CW_ATT = 8192, CW_PART = 204800;
constexpr int LDSCTL_OFF = 153600, LDS_BYTES = 154624;

#define GAS __attribute__((address_space(1)))
#define LAS __attribute__((address_space(3)))
typedef unsigned short bf16;
typedef unsigned v4u __attribute__((ext_vector_type(4)));
typedef unsigned v2u __attribute__((ext_vector_type(2)));
typedef float f32x4 __attribute__((ext_vector_type(4)));
typedef float f32x2 __attribute__((ext_vector_type(2)));
typedef float f32x16 __attribute__((ext_vector_type(16)));
typedef short bf16x8 __attribute__((ext_vector_type(8)));
typedef short s16x4 __attribute__((ext_vector_type(4)));
typedef LAS unsigned char* ldsp;
#define LDS_WAIT() asm volatile("s_waitcnt lgkmcnt(0)" ::: "memory")
#define VM_WAIT() asm volatile("s_waitcnt vmcnt(0)" ::: "memory")
__device__ __forceinline__ unsigned pk2(float lo, float hi) { return pg8::cvt_pk_bf16(lo, hi); }
__device__ __forceinline__ float bflo(unsigned w) { return __uint_as_float(w << 16); }
__device__ __forceinline__ float bfhi(unsigned w) { return __uint_as_float(w & 0xffff0000u); }
__device__ __forceinline__ float bf2f(bf16 b) { return __uint_as_float((unsigned)b << 16); }
__device__ __forceinline__ float wave_sum(float v) {
#define WS_DPP(ctrl, rmask) __builtin_bit_cast(float, __builtin_amdgcn_update_dpp(0, __builtin_bit_cast(int, v), ctrl, rmask, 0xF, false))
    v += WS_DPP(0xB1, 0xF);
    v += WS_DPP(0x4E, 0xF);
    v += WS_DPP(0x141, 0xF);
    v += WS_DPP(0x140, 0xF);
    v += WS_DPP(0x142, 0xA);
    v += WS_DPP(0x143, 0xC);
#undef WS_DPP
    return __builtin_bit_cast(float, __builtin_amdgcn_ds_bpermute(63 * 4, __builtin_bit_cast(int, v)));
}
__device__ __forceinline__ int crow(int r, int hi) { return (r & 3) + 8 * (r >> 2) + 4 * hi; }
__device__ __forceinline__ float silu_f(float x) { return x * __builtin_amdgcn_rcpf(1.f + __expf(-x)); }
__device__ __forceinline__ float gelu_tanh(float x) { const float y = 0.7978845608028654f * (x + 0.044715f * x * x * x); const float e = __expf(2.f * y); return x * (1.f - __builtin_amdgcn_rcpf(1.f + e)); }
template <int S> __device__ __forceinline__ bf16x8 pack8(const f32x16& v) {
    v4u w; w.x = pk2(v[8 * S + 0], v[8 * S + 1]); w.y = pk2(v[8 * S + 2], v[8 * S + 3]); w.z = pk2(v[8 * S + 4], v[8 * S + 5]); w.w = pk2(v[8 * S + 6], v[8 * S + 7]);
    return __builtin_bit_cast(bf16x8, w);
}
__device__ __forceinline__ f32x16 mma_lds(ldsp A, int sa, ldsp B, int sb, int nk, int lane, f32x16 acc) {
    ldsp ap = A + (lane & 31) * sa + (lane >> 5) * 16; ldsp bp = B + (lane & 31) * sb + (lane >> 5) * 16;
#pragma unroll 4
    for (int k = 0; k < nk; ++k) { const bf16x8 a = *(const LAS bf16x8*)(ap + k * 32); const bf16x8 b = *(const LAS bf16x8*)(bp + k * 32); acc = __builtin_amdgcn_mfma_f32_32x32x16_bf16(a, b, acc, 0, 0, 0); }
    return acc;
}

#define XB_TMO      128
#define XB_XCNT(j)  (256  + 64 * (j))
#define XB_XSUB(j)  (1280 + 64 * (j))
#define XB_XGEN(j)  (2304 + 64 * (j))
#define XB_TOP      3328
#define XB_TOPGEN   3392
#define XCD_BAR_WORDS 3456
#define XB_SPIN_CAP (1u << 18)
#define LAS __attribute__((address_space(3)))

__device__ __forceinline__ unsigned xb_ld(unsigned* p)              { return __hip_atomic_load(p, __ATOMIC_RELAXED, __HIP_MEMORY_SCOPE_AGENT); }
__device__ __forceinline__ unsigned xb_add(unsigned* p, unsigned v) { return __hip_atomic_fetch_add(p, v, __ATOMIC_RELAXED, __HIP_MEMORY_SCOPE_AGENT); }
__device__ __forceinline__ unsigned xb_xcc_id() { return (unsigned)__builtin_amdgcn_s_getreg((3 << 11) | 20) & 0xFu; }
#define XB_SPIN(cond, bar) do { unsigned _sp = 0; while (cond) { __builtin_amdgcn_s_sleep(1); \
    if ((++_sp & 255u) == 0u) { if (xb_ld(&(bar)[XB_TMO])) break; if (_sp > XB_SPIN_CAP) { atomicAdd(&(bar)[XB_TMO], 1u); break; } } } } while (0)

struct XcdBarrier {
    unsigned* bar; unsigned x; bool t0;
    volatile LAS unsigned* st;
};

__device__ __forceinline__ XcdBarrier xcd_barrier_post(unsigned* bar, volatile LAS unsigned* st) {
    XcdBarrier b; b.bar = bar; b.x = xb_xcc_id(); b.st = st; b.t0 = (threadIdx.x == 0);
    if (threadIdx.x == 0) (void)xb_add(&bar[XB_XCNT(b.x)], 1u);
    return b;
}
__device__ __forceinline__ void xcd_barrier_complete(unsigned* bar, unsigned x, unsigned& nloc, unsigned& nx) {
    const unsigned G = gridDim.x * gridDim.y * gridDim.z;
    unsigned sum, cnt, mine, sp = 0u;
    for (;;) {
        sum = 0u; cnt = 0u; mine = 0u;
#pragma unroll
        for (unsigned j = 0; j < 16; ++j) { const unsigned c = xb_ld(&bar[XB_XCNT(j)]); sum += c; cnt += (c > 0u) ? 1u : 0u; mine = (j == x) ? c : mine; }
        if (sum == G) break;
        __builtin_amdgcn_s_sleep(1);
        if ((++sp & 255u) == 0u) { if (xb_ld(&bar[XB_TMO])) break; if (sp > XB_SPIN_CAP) { atomicAdd(&bar[XB_TMO], 1u); break; } }
    }
    nloc = mine > 0u ? mine : 1u; nx = cnt > 0u ? cnt : 1u;
}

__device__ __forceinline__ void xcd_barrier(const XcdBarrier& b) {
    asm volatile("s_waitcnt vmcnt(0)" ::: "memory");
    __syncthreads();
    if (b.t0) {
        unsigned* bar = b.bar;
        __builtin_amdgcn_s_waitcnt(0);
        unsigned nloc = b.st[0], nx = b.st[1];
        if (nloc == 0u) { xcd_barrier_complete(bar, b.x, nloc, nx); b.st[0] = nloc; b.st[1] = nx; }
        const unsigned old = xb_add(&bar[XB_XSUB(b.x)], 1u);
        const unsigned gen = old / nloc;
        if (old + 1u == (gen + 1u) * nloc) {
            __builtin_amdgcn_fence(__ATOMIC_RELEASE, "agent");
            asm volatile("s_waitcnt vmcnt(0)" ::: "memory");
            const unsigned og = xb_add(&bar[XB_TOP], 1u);
            const unsigned tg = og / nx;
            if (og + 1u == (tg + 1u) * nx) xb_add(&bar[XB_TOPGEN], 1u);
            else XB_SPIN(xb_ld(&bar[XB_TOPGEN]) == tg, bar);
            __builtin_amdgcn_fence(__ATOMIC_ACQUIRE, "agent");
            xb_add(&bar[XB_XGEN(b.x)], 1u);
            asm volatile("s_waitcnt vmcnt(0)" ::: "memory");
        } else {
            XB_SPIN(xb_ld(&bar[XB_XGEN(b.x)]) == gen, bar);
            __builtin_amdgcn_fence(__ATOMIC_ACQUIRE, "agent");
            asm volatile("s_waitcnt vmcnt(0)" ::: "memory");
        }
    }
    __syncthreads();
}


__device__ __forceinline__ void p0_transpose_item(const float* W, int K, int N, bf16* WT, LAS float* scr, int item, int lane) {
    const int nblk = (N + 31) / 32, kb = item / nblk, nb = item % nblk, k0 = 64 * kb, n0 = 32 * nb; const bool okn = (n0 + (lane & 31)) < N;
#pragma unroll 16
    for (int i = 0; i < 32; ++i) { const int kk = 2 * i + (lane >> 5); scr[kk * 33 + (lane & 31)] = okn ? W[(size_t)(k0 + kk) * N + n0 + (lane & 31)] : 0.f; }
    LDS_WAIT(); asm volatile("" ::: "memory");
    const int c = lane & 7;
#pragma unroll
    for (int j = 0; j < 4; ++j) { const int n = (lane >> 3) + 8 * j; const LAS float* s = scr + (8 * c) * 33 + n;
        v4u o; o.x = pk2(s[0 * 33], s[1 * 33]); o.y = pk2(s[2 * 33], s[3 * 33]); o.z = pk2(s[4 * 33], s[5 * 33]); o.w = pk2(s[6 * 33], s[7 * 33]);
        *(GAS v4u*)(WT + (size_t)(n0 + n) * K + k0 + 8 * c) = o; }
    LDS_WAIT(); asm volatile("" ::: "memory");
}
struct P0Args { const float *c, *c_ctx, *norm1_g, *norm2_g, *w_mod, *b_mod, *w_in, *w_out, *w_ff1, *w_ff2, *cache_k, *cache_v; unsigned char* ws; };
constexpr int T_IN = 32 * 145, T_OUT = 32 * 64, T_F1 = 32 * 256, T_F2 = 128 * 64, T_L = T_IN + T_OUT + T_F1 + T_F2;
__device__ __forceinline__ void transpose_layer(const float* w_in, const float* w_out, const float* w_ff1, const float* w_ff2, unsigned char* ws, int l, LAS float* scr, int wi0, int wstride, int lane) {
    asm volatile("" : "+v"(lane));
    for (int wi = wi0; wi < T_L; wi += wstride) {
        int r = wi;
        if (r < T_IN) { p0_transpose_item(w_in + (size_t)l * 2048 * DIN, 2048, DIN, (bf16*)(ws + WS_WIN) + (size_t)l * DINP * 2048, scr, r, lane); continue; } r -= T_IN;
        if (r < T_OUT) { p0_transpose_item(w_out + (size_t)l * 2048 * 2048, 2048, 2048, (bf16*)(ws + WS_WOUT) + (size_t)l * 2048 * 2048, scr, r, lane); continue; } r -= T_OUT;
        if (r < T_F1) { p0_transpose_item(w_ff1 + (size_t)l * 2048 * DFF, 2048, DFF, (bf16*)(ws + WS_WFF1) + (size_t)l * DFF * 2048, scr, r, lane); continue; } r -= T_F1;
        p0_transpose_item(w_ff2 + (size_t)l * DFF * 2048, DFF, 2048, (bf16*)(ws + WS_WFF2) + (size_t)l * 2048 * DFF, scr, r, lane);
    }
}
__device__ __forceinline__ void p0_prologue(const P0Args& a, ldsp lds, unsigned* queue, volatile LAS unsigned* misc, int tid, int lane, int wave, int G) {
    asm volatile("" : "+v"(tid), "+v"(lane));
    LAS float* silu_t = (LAS float*)lds;
    LAS float* scr = (LAS float*)(lds + 73728 + wave * 8448);
    constexpr int N_MOD = 96;
    constexpr int N_CVT = 512, N_ROPE = 256, N_TR = DEPTH * T_L / 8, N_ITEMS = N_MOD + N_CVT + N_ROPE + N_TR;
    static_assert((DEPTH * T_L) % 8 == 0, "transposes");
    bool have_silu = false;
    float* MOD = (float*)(a.ws + WS_MOD);
    for (;;) {
        if (tid == 0) misc[0] = atomicAdd(queue, 1u);
        __syncthreads(); const int it = (int)misc[0]; __syncthreads();
        if (it >= N_ITEMS) break;
        if (it < N_MOD) {
            if (!have_silu) { have_silu = true;
                for (int i = tid; i < 9 * 2048; i += NWAVES * 64) { const float x = i < 8 * 2048 ? a.c[i] : a.c_ctx[i - 8 * 2048]; silu_t[i] = x / (1.f + expf(-x)); }
                __syncthreads(); }
            const int wi = it * 8 + wave, l = wi / 192, cb = wi % 192, j = cb * 64 + lane;
            float acc[9];
#pragma unroll
            for (int c = 0; c < 9; ++c) acc[c] = 0.f;
            const float* wp = a.w_mod + (size_t)l * 2048 * 12288 + j;
            for (int k0 = 0; k0 < 2048; k0 += 32) {
                float w[32];
#pragma unroll
                for (int i = 0; i < 32; ++i) w[i] = wp[(size_t)(k0 + i) * 12288];
#pragma unroll
                for (int c = 0; c < 9; ++c)
#pragma unroll
                    for (int i4 = 0; i4 < 8; ++i4) { const f32x4 s = *(const LAS f32x4*)(silu_t + c * 2048 + k0 + 4 * i4);
                        acc[c] += s.x * w[4 * i4] + s.y * w[4 * i4 + 1] + s.z * w[4 * i4 + 2] + s.w * w[4 * i4 + 3]; }
            }
            const int slot = j >> 11, col = j & 2047; const float bm = a.b_mod[l * 12288 + j];
            const float gn = slot == 1 ? a.norm1_g[l * 2048 + col] : (slot == 4 ? a.norm2_g[l * 2048 + col] : 0.f);
#pragma unroll
            for (int c = 0; c < 9; ++c) { float v = acc[c] + bm; if (slot == 1 || slot == 4) v = gn * (1.f + v); MOD[(size_t)(l * 9 + c) * 12288 + j] = v; }
        } else if (it < N_MOD + N_CVT) {
            const int ci = it - N_MOD;
#pragma unroll
            for (int s = 0; s < 4; ++s) { const size_t e8 = (size_t)ci * 2048 + s * 512 + tid; const bool isv = e8 >= 524288; const size_t j8 = isv ? e8 - 524288 : e8;
                const float* src = (isv ? a.cache_v : a.cache_k) + j8 * 8; const f32x4 x0 = *(const f32x4*)src, x1 = *(const f32x4*)(src + 4);
                v4u o; o.x = pk2(x0.x, x0.y); o.y = pk2(x0.z, x0.w); o.z = pk2(x1.x, x1.y); o.w = pk2(x1.z, x1.w);
                *(v4u*)((bf16*)(a.ws + (isv ? WS_CV : WS_CK)) + j8 * 8) = o; }
        } else if (it < N_MOD + N_CVT + N_ROPE) {
            const int e = (it - N_MOD - N_CVT) * 512 + tid, t = e >> 6, i = e & 63;
            const float inv = powf(10000.f, -(float)(2 * (i & 31)) / 64.f); const float pos = i < 32 ? (float)(t >> 6) : (float)(t & 63); const float ang = pos * inv;
            ((float*)(a.ws + WS_ROPE))[e] = cosf(ang); ((float*)(a.ws + WS_ROPE))[131072 + e] = sinf(ang);
        } else {
            const int wi = (it - N_MOD - N_CVT - N_ROPE) * 8 + wave, l = wi / T_L;
            transpose_layer(a.w_in, a.w_out, a.w_ff1, a.w_ff2, a.ws, l, scr, wi % T_L, T_L, lane);
        }
    }
}
__device__ __forceinline__ void p0b_bias(unsigned char* ws, ldsp lds, int tid, int lane, int wave, int G) {
    asm volatile("" : "+v"(tid), "+v"(lane));
    LAS float* sh = (LAS float*)lds;
    const float* MOD = (const float*)(ws + WS_MOD); float* BW = (float*)(ws + WS_BW);
    constexpr int NB1 = DINP / 64, NB2 = DFF / 64, NBL = NB1 + NB2;
    int cur = -1;
    for (int it = blockIdx.x; it < DEPTH * NBL; it += G) {
        const int l = it / NBL, r = it % NBL, which = r >= NB1 ? 1 : 0, rb = which ? r - NB1 : r, key = l * 2 + which;
        if (key != cur) { __syncthreads(); cur = key;
            for (int i = tid; i < 9 * 2048; i += NWAVES * 64) sh[i] = MOD[(size_t)(l * 9 + (i >> 11)) * 12288 + (which ? 3 : 0) * 2048 + (i & 2047)];
            __syncthreads(); }
        const bf16* WT = which ? (const bf16*)(ws + WS_WFF1) + (size_t)l * DFF * 2048 : (const bf16*)(ws + WS_WIN) + (size_t)l * DINP * 2048;
        const int ldb = which ? DFF : DINP; float* bwp = BW + (size_t)l * BW_L + (which ? 9 * DINP : 0);
#pragma unroll 1
        for (int rr = 0; rr < 8; rr += 2) { const int n = rb * 64 + wave * 8 + rr; const bf16* wr_ = WT + (size_t)n * 2048 + lane * 8;
            v4u q[2][4];
#pragma unroll
            for (int u = 0; u < 2; ++u)
#pragma unroll
                for (int j = 0; j < 4; ++j) q[u][j] = *(const v4u*)(wr_ + (size_t)u * 2048 + 512 * j);
            float res0 = 0.f, res1 = 0.f;
#pragma unroll 1
            for (int c = 0; c < 9; ++c) { float s0 = 0.f, s1 = 0.f;
#pragma unroll
                for (int j = 0; j < 4; ++j) { const f32x4 a0 = *(const LAS f32x4*)(sh + c * 2048 + 512 * j + lane * 8), a1 = *(const LAS f32x4*)(sh + c * 2048 + 512 * j + lane * 8 + 4);
                    s0 += a0.x * bflo(q[0][j].x) + a0.y * bfhi(q[0][j].x) + a0.z * bflo(q[0][j].y) + a0.w * bfhi(q[0][j].y) + a1.x * bflo(q[0][j].z) + a1.y * bfhi(q[0][j].z) + a1.z * bflo(q[0][j].w) + a1.w * bfhi(q[0][j].w);
                    s1 += a0.x * bflo(q[1][j].x) + a0.y * bfhi(q[1][j].x) + a0.z * bflo(q[1][j].y) + a0.w * bfhi(q[1][j].y) + a1.x * bflo(q[1][j].z) + a1.y * bfhi(q[1][j].z) + a1.z * bflo(q[1][j].w) + a1.w * bfhi(q[1][j].w); }
                s0 = wave_sum(s0); s1 = wave_sum(s1); res0 = (lane == c) ? s0 : res0; res1 = (lane == c) ? s1 : res1; }
            if (lane < 9) { bwp[(size_t)lane * ldb + n] = res0; bwp[(size_t)lane * ldb + n + 1] = res1; } }
    }
    __syncthreads();
}

template <bool FINAL>
__device__ __forceinline__ void norm_phase(const float* x0, const float* x1, const float* modA, bf16* xb, bf16* xa, unsigned long long* ssq, float* outf, int lane, int wave, int G) {
    asm volatile("" : "+v"(lane)); asm volatile("" : "+s"(wave), "+s"(G));
    const int rpw = (M + G - 1) / G, r0 = blockIdx.x * rpw, r1 = min(M, r0 + rpw);
    f32x4 A[8]; int cur = -1;
    for (int r = r0 + wave; r < r1; r += NWAVES) {
        const int cond = FINAL ? 0 : (r < NCTX ? 8 : ((r - NCTX) >> 11));
        if (cond != cur) { cur = cond;
#pragma unroll
            for (int j = 0; j < 8; ++j) A[j] = *(const f32x4*)(modA + (size_t)cond * 12288 + 4 * lane + 256 * j); }
        f32x4 v[8]; float ss = 0.f;
        if (FINAL) {
#pragma unroll
            for (int j = 0; j < 8; ++j) { const v2u w = *(const v2u*)(xb + (size_t)r * D + 4 * lane + 256 * j); v[j] = (f32x4){bflo(w.x), bfhi(w.x), bflo(w.y), bfhi(w.y)}; }
        } else { const float* xr = r < NCTX ? x0 + (size_t)r * D : x1 + (size_t)(r - NCTX) * D;
#pragma unroll
            for (int j = 0; j < 8; ++j) v[j] = *(const f32x4*)(xr + 4 * lane + 256 * j); }
#pragma unroll
        for (int j = 0; j < 8; ++j) ss += (v[j].x * v[j].x + v[j].y * v[j].y) + (v[j].z * v[j].z + v[j].w * v[j].w);
        ss = wave_sum(ss);
        if (FINAL) { const float rstd = rsqrtf(ss * (1.f / D) + EPS);
#pragma unroll
            for (int j = 0; j < 8; ++j) *(f32x4*)(outf + (size_t)r * D + 4 * lane + 256 * j) = v[j] * rstd * A[j];
        } else {
#pragma unroll
            for (int j = 0; j < 8; ++j) { const f32x4 y = v[j] * A[j]; v2u o; o.x = pk2(y.x, y.y); o.y = pk2(y.z, y.w); *(v2u*)(xa + (size_t)r * D + 4 * lane + 256 * j) = o;
                v2u xo; xo.x = pk2(v[j].x, v[j].y); xo.y = pk2(v[j].z, v[j].w); *(v2u*)(xb + (size_t)r * D + 4 * lane + 256 * j) = xo; }
            if (lane == 0) { const float hi = floorf(ss); ssq[r] = ((unsigned long long)(unsigned)hi << 24) + (unsigned long long)(unsigned)((ss - hi) * 16777216.f); }
        }
    }
}

#ifndef PROBE_DUP
#define PROBE_DUP 0
#endif
constexpr int P_KT = 0, P_QT = 17408, P_KTT = 34816, P_VT = 53248, P_T1 = 71680, P_T2 = 71680 + 18432, P_AM = 108544, P_GL = 141312;
struct LayerP { const float *conv_w, *a_log, *dt_bias, *dn_norm_g, *sgu_norm_g, *sgu_w, *sgu_b, *sink; };
__device__ __forceinline__ void dn_prep_unit(const LayerP& P, const bf16* zb, unsigned char* dn, ldsp lds, int gchunk, int h, int tid, int lane, int wave) {
    asm volatile("" : "+v"(tid), "+v"(lane));
    const bool isctx = gchunk < 64; const int pc = isctx ? (gchunk & 3) : ((gchunk - 64) & 31); const int T = isctx ? 256 : 2048;
    const long grow0 = (long)gchunk * 64; unsigned char* blk = dn + (size_t)(gchunk * 4 + h) * DN_BLK;
    LAS float* GL = (LAS float*)(lds + P_GL);
    for (int rep_ = 0; rep_ < ((PROBE_DUP & 1024) ? 2 : 1); ++rep_) {
    if (wave == 0) {
        const bf16* zr = zb + (size_t)(grow0 + lane) * DINP + C_DAB;
#pragma unroll
        for (int d = 0; d < 2; ++d) {
            const float alpha = bf2f(zr[d * 8 + h]), braw = bf2f(zr[d * 8 + 4 + h]);
            const float xr = alpha + P.dt_bias[d * 4 + h]; const float sp = fmaxf(xr, 0.f) + log1pf(expf(-fabsf(xr)));
            const float g = -expf(P.a_log[d * 4 + h]) * sp; const float beta = 1.f / (1.f + expf(-braw));
            float gc = g;
#pragma unroll
            for (int o = 1; o < 64; o <<= 1) { const int src = (d == 0) ? lane - o : lane + o;
                const float t = __builtin_bit_cast(float, __builtin_amdgcn_ds_bpermute((src & 63) << 2, __builtin_bit_cast(int, gc))); const bool ok = (d == 0) ? (lane >= o) : (lane + o < 64); gc += ok ? t : 0.f; }
            const float gl = wave_sum(g); const float eg = expf(gc), egl = expf(gl - gc);
            GL[d * 64 + lane] = gc; GL[128 + d * 64 + lane] = beta; GL[256 + d * 64 + lane] = beta * eg;
            float* gv = (float*)(blk + DN_DIR0 + d * DN_DIRSZ + 40960);
            gv[lane] = eg; gv[64 + lane] = egl; if (lane == 0) gv[128] = expf(gl);
        }
    }
    {
        const float* cw = P.conv_w; const int cq = h * 128 + 2 * lane;
        f32x2 wq[5], wk[5], wv[5];
#pragma unroll
        for (int j = 0; j < 5; ++j) { wq[j] = *(const f32x2*)(cw + j * 1536 + cq); wk[j] = *(const f32x2*)(cw + j * 1536 + 512 + cq); wv[j] = *(const f32x2*)(cw + j * 1536 + 1024 + cq); }
        unsigned xq[12], xk[12], xv[12];
#pragma unroll
        for (int rr = 0; rr < 12; ++rr) { const int tl = 8 * wave - 2 + rr, tpos = pc * 64 + tl; const bool ok = tpos >= 0 && tpos < T;
            const bf16* zr = zb + (grow0 + tl) * (long)DINP + h * 128 + 2 * lane;
            xq[rr] = ok ? *(const unsigned*)(zr + C_DQ) : 0u; xk[rr] = ok ? *(const unsigned*)(zr + C_DK) : 0u; xv[rr] = ok ? *(const unsigned*)(zr + C_DV) : 0u; }
        float k0s[8], k1s[8], v0s[8], v1s[8];
        LAS bf16* Kt = (LAS bf16*)(lds + P_KT); LAS bf16* Qt = (LAS bf16*)(lds + P_QT);
#pragma unroll
        for (int tt = 0; tt < 8; ++tt) {
            float q0 = 0.f, q1 = 0.f, k0 = 0.f, k1 = 0.f, v0 = 0.f, v1 = 0.f;
#pragma unroll
            for (int j = 0; j < 5; ++j) { q0 += bflo(xq[tt + j]) * wq[j].x; q1 += bfhi(xq[tt + j]) * wq[j].y; k0 += bflo(xk[tt + j]) * wk[j].x; k1 += bfhi(xk[tt + j]) * wk[j].y;
                v0 += bflo(xv[tt + j]) * wv[j].x; v1 += bfhi(xv[tt + j]) * wv[j].y; }
            q0 = silu_f(q0); q1 = silu_f(q1); k0 = silu_f(k0); k1 = silu_f(k1); v0 = silu_f(v0); v1 = silu_f(v1);
            const float rq = rsqrtf(wave_sum(q0 * q0 + q1 * q1) + EPS) * 0.08838834764831845f, rk = rsqrtf(wave_sum(k0 * k0 + k1 * k1) + EPS);
            q0 *= rq; q1 *= rq; k0 *= rk; k1 *= rk;
            const int t = 8 * wave + tt;
            *(LAS unsigned*)(Qt + t * 136 + 2 * lane) = pk2(q0, q1); *(LAS unsigned*)(Kt + t * 136 + 2 * lane) = pk2(k0, k1);
            k0s[tt] = k0; k1s[tt] = k1; v0s[tt] = v0; v1s[tt] = v1;
        }
        LAS bf16* KT = (LAS bf16*)(lds + P_KTT); LAS bf16* VT = (LAS bf16*)(lds + P_VT);
        v4u o;
        o.x = pk2(k0s[0], k0s[1]); o.y = pk2(k0s[2], k0s[3]); o.z = pk2(k0s[4], k0s[5]); o.w = pk2(k0s[6], k0s[7]); *(LAS v4u*)(KT + (2 * lane) * 72 + 8 * wave) = o;
        o.x = pk2(k1s[0], k1s[1]); o.y = pk2(k1s[2], k1s[3]); o.z = pk2(k1s[4], k1s[5]); o.w = pk2(k1s[6], k1s[7]); *(LAS v4u*)(KT + (2 * lane + 1) * 72 + 8 * wave) = o;
        o.x = pk2(v0s[0], v0s[1]); o.y = pk2(v0s[2], v0s[3]); o.z = pk2(v0s[4], v0s[5]); o.w = pk2(v0s[6], v0s[7]); *(LAS v4u*)(VT + (2 * lane) * 72 + 8 * wave) = o;
        o.x = pk2(v1s[0], v1s[1]); o.y = pk2(v1s[2], v1s[3]); o.z = pk2(v1s[4], v1s[5]); o.w = pk2(v1s[6], v1s[7]); *(LAS v4u*)(VT + (2 * lane + 1) * 72 + 8 * wave) = o;
    }
    __syncthreads();
    }
    for (int rep_ = 0; rep_ < ((PROBE_DUP & 4096) ? 2 : 1); ++rep_) {
    {
        const int hh = lane >> 5, cl = lane & 31; LAS float* AM = (LAS float*)(lds + P_AM);
        f32x16 acc = {};
        if (wave < 4) {
            const int rt = wave >> 1, ct = wave & 1;
            acc = mma_lds(lds + P_KT + 32 * rt * 272, 272, lds + P_KT + 32 * ct * 272, 272, 8, lane, acc);
            const int c = 32 * ct + cl; const float g0c = GL[c], g1c = GL[64 + c];
#pragma unroll
            for (int q = 0; q < 4; ++q) { const int r0 = 32 * rt + 8 * q + 4 * hh;
                const f32x4 g0 = *(const LAS f32x4*)(GL + r0), g1 = *(const LAS f32x4*)(GL + 64 + r0), b0 = *(const LAS f32x4*)(GL + 128 + r0), b1 = *(const LAS f32x4*)(GL + 192 + r0);
#pragma unroll
                for (int e = 0; e < 4; ++e) { const int rr = r0 + e; const float v = acc[4 * q + e];
                    if (rr > c) AM[rr * 64 + c] = b0[e] * v * __expf(g0[e] - g0c);
                    if (rr < c) AM[4096 + (63 - rr) * 64 + (63 - c)] = b1[e] * v * __expf(g1[e] - g1c); } }
        } else {
            const int cb = (wave - 4) >> 1, it = (wave - 4) & 1;
            acc = mma_lds(lds + P_KT + 32 * cb * 272, 272, lds + P_QT + 32 * it * 272, 272, 8, lane, acc);
            const int i = 32 * it + cl; const float g0i = GL[i], g1i = GL[64 + i];
            f32x16 a0, a1;
#pragma unroll
            for (int q = 0; q < 4; ++q) { const int c0 = 32 * cb + 8 * q + 4 * hh; const f32x4 g0 = *(const LAS f32x4*)(GL + c0), g1 = *(const LAS f32x4*)(GL + 64 + c0);
#pragma unroll
                for (int e = 0; e < 4; ++e) { const int c = c0 + e; const float v = acc[4 * q + e];
                    a0[4 * q + e] = (i >= c) ? v * __expf(fminf(g0i - g0[e], 0.f)) : 0.f; a1[4 * q + e] = (i <= c) ? v * __expf(fminf(g1i - g1[e], 0.f)) : 0.f; } }
            unsigned char* q0p = blk + DN_DIR0 + 32768 + ((cb * 2 + it) * 2) * 1024 + lane * 16; unsigned char* q1p = q0p + DN_DIRSZ;
            *(bf16x8*)(q0p) = pack8<0>(a0); *(bf16x8*)(q0p + 1024) = pack8<1>(a0); *(bf16x8*)(q1p) = pack8<0>(a1); *(bf16x8*)(q1p + 1024) = pack8<1>(a1);
        }
    }
    __syncthreads();
    }
    for (int rep_ = 0; rep_ < ((PROBE_DUP & 2048) ? 2 : 1); ++rep_) {
    if (wave < 2) {
        const int dir = wave; const LAS float* Am = (const LAS float*)(lds + P_AM) + dir * 4096;
        float Tr[64]; f32x4 cA[16], cB[16];
#define SOLVE_LOAD(dst, i_) do { _Pragma("unroll") for (int q = 0; q < 16; ++q) if (4 * q < (i_)) dst[q] = *(const LAS f32x4*)(Am + (i_) * 64 + 4 * q); } while (0)
#define SOLVE_ROW(src, i_) do { float a0 = (lane == (i_)) ? 1.f : 0.f, a1 = 0.f, a2 = 0.f, a3 = 0.f; \
            _Pragma("unroll") for (int q = 0; q < 16; ++q) { const int jb = 4 * q; \
                if (jb + 0 < (i_)) a0 -= src[q].x * Tr[jb + 0]; if (jb + 1 < (i_)) a1 -= src[q].y * Tr[jb + 1]; if (jb + 2 < (i_)) a2 -= src[q].z * Tr[jb + 2]; if (jb + 3 < (i_)) a3 -= src[q].w * Tr[jb + 3]; } \
            Tr[i_] = (a0 + a1) + (a2 + a3); } while (0)
        Tr[0] = (lane == 0) ? 1.f : 0.f;
        SOLVE_LOAD(cA, 1);
#pragma unroll
        for (int i = 1; i < 64; i += 2) {
            if (i + 1 < 64) SOLVE_LOAD(cB, i + 1);
            asm volatile("" ::: "memory");
            SOLVE_ROW(cA, i);
            if (i + 2 < 64) SOLVE_LOAD(cA, i + 2);
            asm volatile("" ::: "memory");
            if (i + 1 < 64) SOLVE_ROW(cB, i + 1);
        }
#undef SOLVE_LOAD
#undef SOLVE_ROW
        const int j = dir ? 63 - lane : lane; const float s1 = GL[256 + dir * 64 + j], s2 = GL[128 + dir * 64 + j];
        LAS bf16* T1 = (LAS bf16*)(lds + P_T1) + dir * 4608; LAS bf16* T2 = (LAS bf16*)(lds + P_T2) + dir * 4608;
#pragma unroll
        for (int ii = 0; ii < 64; ++ii) { const int i = dir ? 63 - ii : ii; T1[i * 72 + j] = (bf16)(pk2(Tr[ii] * s1, 0.f) & 0xffffu); T2[i * 72 + j] = (bf16)(pk2(Tr[ii] * s2, 0.f) & 0xffffu); }
    } else {
        const int hh = lane >> 5, rl = lane & 31;
        for (int b = wave - 2; b < 32; b += 6) {
            v2u lo, hi;
            if (b < 16) { const int it = b >> 3, db = (b >> 1) & 3, s = b & 1; const LAS bf16* p = (const LAS bf16*)(lds + P_QT) + (32 * it + rl) * 136 + 32 * db + 16 * s + 4 * hh; lo = *(const LAS v2u*)p; hi = *(const LAS v2u*)(p + 8); }
            else { const int bb = b - 16, dt = bb >> 2, cb = (bb >> 1) & 1, s = bb & 1; const LAS bf16* p = (const LAS bf16*)(lds + P_KTT) + (32 * dt + rl) * 72 + 32 * cb + 16 * s + 4 * hh; lo = *(const LAS v2u*)p; hi = *(const LAS v2u*)(p + 8); }
            v4u o; o.x = lo.x; o.y = lo.y; o.z = hi.x; o.w = hi.y;
            *(v4u*)(blk + (size_t)b * 1024 + lane * 16) = o;
        }
    }
    __syncthreads();
    }
    for (int rep_ = 0; rep_ < ((PROBE_DUP & 8192) ? 2 : 1); ++rep_) {
#pragma unroll 1
    for (int tix = wave; tix < 32; tix += 8) {
        const int dir = tix >> 4, kind = (tix >> 3) & 1, idx = tix & 7; f32x16 acc = {};
        unsigned char* dst;
        if (kind == 0) { const int ct = idx >> 2, es = idx & 3;
            acc = mma_lds(lds + P_T2 + dir * 9216 + 32 * ct * 144, 144, lds + P_VT + 32 * es * 144, 144, 4, lane, acc);
            dst = blk + DN_DIR0 + dir * DN_DIRSZ + ((ct * 4 + es) * 2) * 1024 + lane * 16;
        } else { const int db = idx >> 1, ct = idx & 1;
            acc = mma_lds(lds + P_KTT + 32 * db * 144, 144, lds + P_T1 + dir * 9216 + 32 * ct * 144, 144, 4, lane, acc);
#pragma unroll
            for (int r = 0; r < 16; ++r) acc[r] = -acc[r];
            dst = blk + DN_DIR0 + dir * DN_DIRSZ + 16384 + ((db * 2 + ct) * 2) * 1024 + lane * 16;
        }
        *(bf16x8*)dst = pack8<0>(acc); *(bf16x8*)(dst + 1024) = pack8<1>(acc);
    }
    __syncthreads();
    }
}

__device__ __forceinline__ void sgu_unit(const LayerP& P, const bf16* zb, bf16* mix, ldsp lds, int rc, int g, bool load_w, int tid, int lane, int wave) {
    asm volatile("" : "+v"(tid), "+v"(lane));
    const size_t grow0 = (size_t)rc * 128; LAS bf16* Wl = (LAS bf16*)lds; LAS bf16* Vt = (LAS bf16*)(lds + 34816);
    {
        const float gn0 = P.sgu_norm_g[g * 128 + 2 * lane], gn1 = P.sgu_norm_g[g * 128 + 2 * lane + 1];
        float v0[16], v1[16];
#pragma unroll
        for (int qq = 0; qq < 16; ++qq) { const unsigned w = *(const unsigned*)(zb + (grow0 + 16 * wave + qq) * DINP + C_SV + g * 128 + 2 * lane);
            const float a = gelu_tanh(bflo(w)), b = gelu_tanh(bfhi(w)); const float r = rsqrtf(wave_sum(a * a + b * b) * (1.f / 128.f) + EPS); v0[qq] = a * r * gn0; v1[qq] = b * r * gn1; }
        v4u o;
        o.x = pk2(v0[0], v0[1]); o.y = pk2(v0[2], v0[3]); o.z = pk2(v0[4], v0[5]); o.w = pk2(v0[6], v0[7]); *(LAS v4u*)(Vt + (2 * lane) * 136 + 16 * wave) = o;
        o.x = pk2(v0[8], v0[9]); o.y = pk2(v0[10], v0[11]); o.z = pk2(v0[12], v0[13]); o.w = pk2(v0[14], v0[15]); *(LAS v4u*)(Vt + (2 * lane) * 136 + 16 * wave + 8) = o;
        o.x = pk2(v1[0], v1[1]); o.y = pk2(v1[2], v1[3]); o.z = pk2(v1[4], v1[5]); o.w = pk2(v1[6], v1[7]); *(LAS v4u*)(Vt + (2 * lane + 1) * 136 + 16 * wave) = o;
        o.x = pk2(v1[8], v1[9]); o.y = pk2(v1[10], v1[11]); o.z = pk2(v1[12], v1[13]); o.w = pk2(v1[14], v1[15]); *(LAS v4u*)(Vt + (2 * lane + 1) * 136 + 16 * wave + 8) = o;
    }
    if (load_w) {
        const int p = tid >> 2, q0 = (tid & 3) * 32; const float* src = P.sgu_w + ((size_t)g * 128 + p) * 128 + q0;
#pragma unroll
        for (int j = 0; j < 4; ++j) { const f32x4 x0 = *(const f32x4*)(src + 8 * j), x1 = *(const f32x4*)(src + 8 * j + 4);
            v4u o; o.x = pk2(x0.x, x0.y); o.y = pk2(x0.z, x0.w); o.z = pk2(x1.x, x1.y); o.w = pk2(x1.z, x1.w); *(LAS v4u*)(Wl + p * 136 + q0 + 8 * j) = o; }
    }
    __syncthreads();
    {
        const int pt = wave >> 1, hh = lane >> 5, cl = lane & 31; LAS float* Ms = (LAS float*)(lds + 69632 + wave * 8704);
#pragma unroll
        for (int cc = 0; cc < 2; ++cc) { const int ct = 2 * (wave & 1) + cc; f32x16 acc = {};
            acc = mma_lds(lds + 32 * pt * 272, 272, lds + 34816 + 32 * ct * 272, 272, 8, lane, acc);
#pragma unroll
            for (int q = 0; q < 4; ++q) { const f32x4 bq = *(const f32x4*)(P.sgu_b + g * 128 + 32 * pt + 8 * q + 4 * hh);
#pragma unroll
                for (int e = 0; e < 4; ++e) Ms[(8 * q + 4 * hh + e) * 68 + 32 * cc + cl] = acc[4 * q + e] + bq[e]; } }
        LDS_WAIT(); asm volatile("" ::: "memory");
        const int row = lane >> 1, c0 = (lane & 1) * 32; const size_t grow = grow0 + 32 * pt + row; const int gcol = g * 128 + 64 * (wave & 1) + c0;
        const bf16* sup = zb + grow * DINP + C_SU + gcol; bf16* op = mix + grow * D + 1536 + gcol;
#pragma unroll
        for (int j = 0; j < 4; ++j) { const v4u su = *(const v4u*)(sup + 8 * j); const f32x4 m0 = *(const LAS f32x4*)(Ms + row * 68 + c0 + 8 * j), m1 = *(const LAS f32x4*)(Ms + row * 68 + c0 + 8 * j + 4);
            v4u o; o.x = pk2(gelu_tanh(bflo(su.x)) * m0.x, gelu_tanh(bfhi(su.x)) * m0.y); o.y = pk2(gelu_tanh(bflo(su.y)) * m0.z, gelu_tanh(bfhi(su.y)) * m0.w);
            o.z = pk2(gelu_tanh(bflo(su.z)) * m1.x, gelu_tanh(bfhi(su.z)) * m1.y); o.w = pk2(gelu_tanh(bflo(su.w)) * m1.z, gelu_tanh(bfhi(su.w)) * m1.w);
            *(v4u*)(op + 8 * j) = o; }
    }
    __syncthreads();
}

__device__ __forceinline__ void rope_item(bf16* zb, const float* ropet, int ri, int lane, int wave) {
    asm volatile("" : "+v"(lane));
    const int hf = (lane >> 4) & 1, ip = (lane & 15) * 2;
#pragma unroll 1
    for (int t4 = 0; t4 < 8; t4 += 4) {
        unsigned wa[4][5], wb[4][5]; f32x2 cs[4], sn[4]; bf16* pp[4];
#pragma unroll
        for (int u = 0; u < 4; ++u) { const int tl = ri * 64 + wave * 8 + t4 + u, t = tl & 2047; pp[u] = zb + (size_t)(NCTX + tl) * DINP + 64 * hf + ip;
            cs[u] = *(const f32x2*)(ropet + t * 64 + 32 * hf + ip); sn[u] = *(const f32x2*)(ropet + 131072 + t * 64 + 32 * hf + ip);
#pragma unroll
            for (int ps = 0; ps < 5; ++ps) { const int hv = ps * 2 + (lane >> 5); const bf16* p = pp[u] + (hv < 8 ? C_AQ + hv * 128 : C_AK + (hv - 8) * 128); wa[u][ps] = *(const unsigned*)p; wb[u][ps] = *(const unsigned*)(p + 32); } }
#pragma unroll
        for (int u = 0; u < 4; ++u)
#pragma unroll
            for (int ps = 0; ps < 5; ++ps) { const int hv = ps * 2 + (lane >> 5); bf16* p = pp[u] + (hv < 8 ? C_AQ + hv * 128 : C_AK + (hv - 8) * 128);
                const float a0 = bflo(wa[u][ps]), a1 = bfhi(wa[u][ps]), b0 = bflo(wb[u][ps]), b1 = bfhi(wb[u][ps]);
                *(unsigned*)p = pk2(a0 * cs[u].x - b0 * sn[u].x, a1 * cs[u].y - b1 * sn[u].y); *(unsigned*)(p + 32) = pk2(b0 * cs[u].x + a0 * sn[u].x, b1 * cs[u].y + a1 * sn[u].y); }
    }
}

constexpr int SC_BUF = 58368;
__device__ __forceinline__ void glds16(const void* g, ldsp l) { __builtin_amdgcn_global_load_lds((const unsigned*)g, (LAS unsigned*)l, 16, 0, 0); }
__device__ __forceinline__ void scan_dma4(const unsigned char* blk, int dir, ldsp buf, int lane, int lw) {
    const unsigned lo = (unsigned)lane * 16u;
#pragma unroll
    for (int i = 0; i < 15; ++i) { const int k = lw + 4 * i;
        if (i < 14 || lw == 0) { const unsigned char* ub = blk + (size_t)k * 1024 + (k >= 32 ? 16384 + dir * (int)DN_DIRSZ : 0); glds16(ub + lo, buf + k * 1024); } }
}
__device__ __forceinline__ void scan_chain(const unsigned char* dn, const float* state0, float* state_out, float* odir, ldsp lds, int isctx, int b, int h, int dir, int lane, int wave) {
    asm volatile("" : "+v"(lane));
    const int hh = lane >> 5, cl = lane & 31; const int nch = isctx ? 4 : 32; const int gch0 = isctx ? b * 4 : 64 + b * 32;
#define BLKOF(n) (dn + (size_t)((gch0 + (dir ? nch - 1 - (n) : (n))) * 4 + h) * DN_BLK)
    if (wave >= 4) {
        scan_dma4(BLKOF(0), dir, lds, lane, wave - 4);
#pragma unroll 1
        for (int n = 0; n < nch; ++n) {
            VM_WAIT(); __builtin_amdgcn_s_barrier(); asm volatile("" ::: "memory");
            if (n + 1 < nch) scan_dma4(BLKOF(n + 1), dir, lds + ((n + 1) & 1) * SC_BUF, lane, wave - 4);
        }
        VM_WAIT(); __builtin_amdgcn_s_barrier(); asm volatile("" ::: "memory");
        return;
    }
    const int es = wave;
    f32x16 S[4];
#pragma unroll
    for (int db = 0; db < 4; ++db) S[db] = f32x16{};
    if (state0) { const float* sp = state0 + (4 * hh) * 128 + 32 * es + cl;
#pragma unroll
        for (int db = 0; db < 4; ++db)
#pragma unroll
            for (int r = 0; r < 16; ++r) S[db][r] = sp[(32 * db + (r & 3) + 8 * (r >> 2)) * 128]; }
#define UPTR(n) (BLKOF(n) + DN_DIR0 + dir * DN_DIRSZ + (es * 2) * 1024 + lane * 16)
    bf16x8 Un[2][2];
    { const unsigned char* up = UPTR(0);
#pragma unroll
      for (int ct = 0; ct < 2; ++ct) { Un[ct][0] = *(const bf16x8*)(up + ct * 8192); Un[ct][1] = *(const bf16x8*)(up + ct * 8192 + 1024); } }
#define SBAR_() __builtin_amdgcn_sched_barrier(0)
#pragma unroll 1
    for (int n = 0; n < nch; ++n) {
        VM_WAIT(); __builtin_amdgcn_s_barrier(); asm volatile("" ::: "memory");
        f32x16 vn[2];
#pragma unroll
        for (int ct = 0; ct < 2; ++ct) { const v4u a = __builtin_bit_cast(v4u, Un[ct][0]), c = __builtin_bit_cast(v4u, Un[ct][1]);
          vn[ct][0] = bflo(a.x); vn[ct][1] = bfhi(a.x); vn[ct][2] = bflo(a.y); vn[ct][3] = bfhi(a.y); vn[ct][4] = bflo(a.z); vn[ct][5] = bfhi(a.z); vn[ct][6] = bflo(a.w); vn[ct][7] = bfhi(a.w);
          vn[ct][8] = bflo(c.x); vn[ct][9] = bfhi(c.x); vn[ct][10] = bflo(c.y); vn[ct][11] = bfhi(c.y); vn[ct][12] = bflo(c.z); vn[ct][13] = bfhi(c.z); vn[ct][14] = bflo(c.w); vn[ct][15] = bfhi(c.w); }
        if (n + 1 < nch) { const unsigned char* up = UPTR(n + 1);
#pragma unroll
            for (int ct = 0; ct < 2; ++ct) { Un[ct][0] = *(const bf16x8*)(up + ct * 8192); Un[ct][1] = *(const bf16x8*)(up + ct * 8192 + 1024); } }
        ldsp buf = lds + (n & 1) * SC_BUF; ldsp fl = buf + lane * 16;
        bf16x8 Sb[4][2];
#pragma unroll
        for (int db = 0; db < 4; ++db) { Sb[db][0] = pack8<0>(S[db]); Sb[db][1] = pack8<1>(S[db]); }
        f32x16 oa[2];
#pragma unroll
        for (int ct = 0; ct < 2; ++ct) {
            bf16x8 Anw[8], Aq[8];
#pragma unroll
            for (int k = 0; k < 8; ++k) { Anw[k] = *(const LAS bf16x8*)(fl + 32768 + (((k >> 1) * 2 + ct) * 2 + (k & 1)) * 1024); Aq[k] = *(const LAS bf16x8*)(fl + ((ct * 4 + (k >> 1)) * 2 + (k & 1)) * 1024); }
            oa[ct] = f32x16{};
            LDS_WAIT(); SBAR_();
#pragma unroll
            for (int k = 0; k < 8; ++k) { vn[ct] = __builtin_amdgcn_mfma_f32_32x32x16_bf16(Anw[k], Sb[k >> 1][k & 1], vn[ct], 0, 0, 0); oa[ct] = __builtin_amdgcn_mfma_f32_32x32x16_bf16(Aq[k], Sb[k >> 1][k & 1], oa[ct], 0, 0, 0); }
            SBAR_();
        }
        bf16x8 V1[2][2], V2[2][2];
        { const float gl = *(const LAS float*)(buf + 57344 + 512);
#pragma unroll
          for (int ct = 0; ct < 2; ++ct) { const LAS float* egl = (const LAS float*)(buf + 57344 + 256) + 32 * ct + 4 * hh; const LAS float* eg = (const LAS float*)(buf + 57344) + 32 * ct + 4 * hh;
            f32x16 vs;
#pragma unroll
            for (int q = 0; q < 4; ++q) { const f32x4 e = *(const LAS f32x4*)(egl + 8 * q), g = *(const LAS f32x4*)(eg + 8 * q);
                vs[4 * q] = vn[ct][4 * q] * e.x; vs[4 * q + 1] = vn[ct][4 * q + 1] * e.y; vs[4 * q + 2] = vn[ct][4 * q + 2] * e.z; vs[4 * q + 3] = vn[ct][4 * q + 3] * e.w;
                oa[ct][4 * q] *= g.x; oa[ct][4 * q + 1] *= g.y; oa[ct][4 * q + 2] *= g.z; oa[ct][4 * q + 3] *= g.w; }
            V1[ct][0] = pack8<0>(vn[ct]); V1[ct][1] = pack8<1>(vn[ct]); V2[ct][0] = pack8<0>(vs); V2[ct][1] = pack8<1>(vs); }
#pragma unroll
          for (int db = 0; db < 4; ++db)
#pragma unroll
              for (int r = 0; r < 16; ++r) S[db][r] *= gl; }
        SBAR_();
        { bf16x8 Aqk[8];
#pragma unroll
          for (int k = 0; k < 8; ++k) Aqk[k] = *(const LAS bf16x8*)(fl + 49152 + k * 1024);
          LDS_WAIT(); SBAR_();
#pragma unroll
          for (int cb = 0; cb < 2; ++cb)
#pragma unroll
              for (int s = 0; s < 2; ++s) { oa[0] = __builtin_amdgcn_mfma_f32_32x32x16_bf16(Aqk[(cb * 2 + 0) * 2 + s], V1[cb][s], oa[0], 0, 0, 0); oa[1] = __builtin_amdgcn_mfma_f32_32x32x16_bf16(Aqk[(cb * 2 + 1) * 2 + s], V1[cb][s], oa[1], 0, 0, 0); }
          SBAR_(); }
#pragma unroll
        for (int half = 0; half < 2; ++half) { bf16x8 Akt[8];
#pragma unroll
            for (int k = 0; k < 8; ++k) Akt[k] = *(const LAS bf16x8*)(fl + 16384 + (half * 8 + k) * 1024);
            LDS_WAIT(); SBAR_();
#pragma unroll
            for (int k = 0; k < 4; ++k) { S[2 * half] = __builtin_amdgcn_mfma_f32_32x32x16_bf16(Akt[k], V2[k >> 1][k & 1], S[2 * half], 0, 0, 0);
                S[2 * half + 1] = __builtin_amdgcn_mfma_f32_32x32x16_bf16(Akt[4 + k], V2[k >> 1][k & 1], S[2 * half + 1], 0, 0, 0); }
            SBAR_(); }
        { const int pc = dir ? nch - 1 - n : n;
#pragma unroll
          for (int ct = 0; ct < 2; ++ct) { unsigned ob = (unsigned)((((gch0 + pc) * 64 + 32 * ct + 4 * hh) * 512 + h * 128 + 32 * es + cl) * 4); asm volatile("" : "+v"(ob));
#pragma unroll
              for (int r = 0; r < 16; ++r) *(float*)((char*)odir + (ob + (unsigned)(((r & 3) + 8 * (r >> 2)) * 2048))) = oa[ct][r]; } }
    }
#undef SBAR_
    if (state_out) {
#pragma unroll
        for (int db = 0; db < 4; ++db)
#pragma unroll
            for (int r = 0; r < 16; ++r) state_out[(size_t)(32 * db + crow(r, hh)) * 128 + 32 * es + cl] = S[db][r];
    }
    VM_WAIT(); LDS_WAIT(); __builtin_amdgcn_s_barrier(); asm volatile("" ::: "memory");
#undef BLKOF
#undef UPTR
}

#define KSWZ(row, colB) ((row) * 256 + ((colB) ^ (((row) & 7) << 4)))
#define SBAR() __builtin_amdgcn_sched_barrier(0)
__device__ __forceinline__ int v_st(int k, int c) { const int kk = (k & ~0xC) | ((k & 4) << 1) | ((k & 8) >> 1); return ((kk >> 3) * 4 + (c >> 5)) * 512 + ((kk & 7) * 32 + (c & 31)) * 2; }
__device__ __forceinline__ int v_rd_base(int lane) { return ((lane & 3) << 3) | (((lane >> 2) & 3) << 6) | (((lane >> 4) & 1) << 5) | (((lane >> 5) & 1) << 8); }
constexpr int v_rd_off(int d0, int ks, int half) { return d0 * 512 + ks * 4096 + half * 2048; }
template <int OFF> __device__ __forceinline__ s16x4 tr_read(int vb) { s16x4 r; asm volatile("ds_read_b64_tr_b16 %0, %1 offset:%2" : "=&v"(r) : "v"(vb), "i"(OFF) : "memory"); return r; }
template <int D0> __device__ __forceinline__ void pv_one(f32x16& od, int vb, bf16x8 pa0, bf16x8 pa1, bf16x8 pa2, bf16x8 pa3) {
    const s16x4 l0 = tr_read<v_rd_off(D0, 0, 0)>(vb), h0 = tr_read<v_rd_off(D0, 0, 1)>(vb), l1 = tr_read<v_rd_off(D0, 1, 0)>(vb), h1 = tr_read<v_rd_off(D0, 1, 1)>(vb);
    const s16x4 l2 = tr_read<v_rd_off(D0, 2, 0)>(vb), h2 = tr_read<v_rd_off(D0, 2, 1)>(vb), l3 = tr_read<v_rd_off(D0, 3, 0)>(vb), h3 = tr_read<v_rd_off(D0, 3, 1)>(vb);
    asm volatile("s_waitcnt lgkmcnt(0)" ::: "memory"); SBAR();
#define PKV(L, H) (bf16x8){L[0], L[1], L[2], L[3], H[0], H[1], H[2], H[3]}
    od = __builtin_amdgcn_mfma_f32_32x32x16_bf16(pa0, PKV(l0, h0), od, 0, 0, 0);
    od = __builtin_amdgcn_mfma_f32_32x32x16_bf16(pa1, PKV(l1, h1), od, 0, 0, 0);
    od = __builtin_amdgcn_mfma_f32_32x32x16_bf16(pa2, PKV(l2, h2), od, 0, 0, 0);
    od = __builtin_amdgcn_mfma_f32_32x32x16_bf16(pa3, PKV(l3, h3), od, 0, 0, 0);
#undef PKV
}
__device__ __forceinline__ void qkt(f32x16& p0, f32x16& p1, ldsp Ks, const bf16x8* qr, int r32, int hi) {
    p0 = f32x16{}; p1 = f32x16{};
#pragma unroll
    for (int d0 = 0; d0 < 8; ++d0) { const int cb = (d0 * 16 + hi * 8) * 2;
        const bf16x8 b0 = *(const LAS bf16x8*)(Ks + KSWZ(r32, cb)); const bf16x8 b1 = *(const LAS bf16x8*)(Ks + KSWZ(32 + r32, cb));
        p0 = __builtin_amdgcn_mfma_f32_32x32x16_bf16(b0, qr[d0], p0, 0, 0, 0); p1 = __builtin_amdgcn_mfma_f32_32x32x16_bf16(b1, qr[d0], p1, 0, 0, 0); }
}
struct AttnP { const bf16* zb; const bf16* ck; const bf16* cv; bf16* mix; const float* sink; int l; };
__device__ __forceinline__ void attn_unit(const AttnP& A, ldsp lds, int u, int tid, int lane, int wave) {
    asm volatile("" : "+v"(tid), "+v"(lane));
    constexpr float C = 0.08838834764831845f * 1.4426950408889634f;
    const int r32 = lane & 31, hi = lane >> 5;
    const bool lat = u < 512; int b, head, q0, T; size_t rowbase;
    if (lat) { q0 = (u & 7) * 256; head = (u >> 3) & 7; b = u >> 6; rowbase = NCTX + (size_t)b * 2048; T = 2048; }
    else { const int uu = u - 512; head = uu & 7; b = uu >> 3; q0 = 0; rowbase = (size_t)b * 256; T = 256; }
    const int kvh = head >> 2, nct = lat ? 8 : 0;
    const int ws = lat ? max(0, q0 - 128) / 64 : 0, we = lat ? min(T, q0 + 384) / 64 : 4, NT = nct + (we - ws);
    const int qw = q0 + 32 * wave;
    ldsp V_lds = lds, K_lds = lds + 32768; LAS float* al = (LAS float*)(lds + 65536) + wave * 64;
    bf16x8 qr[8];
    { const bf16* Qw = A.zb + (rowbase + qw + r32) * DINP + C_AQ + head * 128 + hi * 8;
#pragma unroll
      for (int d0 = 0; d0 < 8; ++d0) qr[d0] = *(const bf16x8*)(Qw + d0 * 16); }
    float m_reg = A.sink[head] * 1.4426950408889634f, l_reg = 1.f; f32x16 o[4] = {};
    const int sr = tid >> 4, sc = (tid & 15) * 8, vst0 = v_st(sr, sc), vst1 = v_st(32 + sr, sc);
    const int vb0 = (int)(unsigned)(size_t)V_lds + v_rd_base(lane);
    bf16x8 ks0, ks1, vs0, vs1;
#define ALOAD(j) do { const bf16 *kp, *vp; size_t st; if ((j) < nct) { kp = A.ck + ((size_t)(b * 4 + A.l) * 512 + (j) * 64) * 256 + kvh * 128; vp = A.cv + ((size_t)(b * 4 + A.l) * 512 + (j) * 64) * 256 + kvh * 128; st = 256; } \
        else { const size_t r0 = rowbase + (size_t)(ws + (j) - nct) * 64; kp = A.zb + r0 * DINP + C_AK + kvh * 128; vp = A.zb + r0 * DINP + C_AV + kvh * 128; st = DINP; } \
        ks0 = *(const bf16x8*)(kp + sr * st + sc); ks1 = *(const bf16x8*)(kp + (32 + sr) * st + sc); vs0 = *(const bf16x8*)(vp + sr * st + sc); vs1 = *(const bf16x8*)(vp + (32 + sr) * st + sc); } while (0)
#define AWRITE(bb) do { *(LAS bf16x8*)(V_lds + (bb) * 16384 + vst0) = vs0; *(LAS bf16x8*)(V_lds + (bb) * 16384 + vst1) = vs1; \
        *(LAS bf16x8*)(K_lds + (bb) * 16384 + KSWZ(sr, sc * 2)) = ks0; *(LAS bf16x8*)(K_lds + (bb) * 16384 + KSWZ(32 + sr, sc * 2)) = ks1; } while (0)
    ALOAD(0); AWRITE(0); __syncthreads();
#pragma unroll 1
    for (int j = 0; j < NT; ++j) {
        if (j + 1 < NT) ALOAD(j + 1);
        bool active = true, needmask = false; int kpos0 = 0;
        if (lat && j >= nct) { kpos0 = (ws + j - nct) * 64; active = (kpos0 + 63 >= qw - 128) && (kpos0 <= qw + 31 + 128); needmask = !((kpos0 >= qw + 31 - 128) && (kpos0 + 63 <= qw + 128)); }
        if (active) {
            f32x16 p0, p1;
            qkt(p0, p1, K_lds + (j & 1) * 16384, qr, r32, hi);
            if (needmask) { const int q = qw + r32;
#pragma unroll
                for (int r = 0; r < 16; ++r) { const int k0 = kpos0 + crow(r, hi) - q, k1 = k0 + 32; if (k0 > 128 || k0 < -128) p0[r] = -1e30f; if (k1 > 128 || k1 < -128) p1[r] = -1e30f; } }
            float pmax = p0[0];
#pragma unroll
            for (int r = 1; r < 16; ++r) pmax = fmaxf(pmax, p0[r]);
#pragma unroll
            for (int r = 0; r < 16; ++r) pmax = fmaxf(pmax, p1[r]);
            { auto rr = __builtin_amdgcn_permlane32_swap(__float_as_uint(pmax), __float_as_uint(pmax), false, false); pmax = fmaxf(__uint_as_float(rr[0]), __uint_as_float(rr[1])); }
            const float mn = fmaxf(m_reg, pmax * C), alpha = __builtin_amdgcn_exp2f(m_reg - mn); m_reg = mn;
            float ps = 0.f;
#pragma unroll
            for (int r = 0; r < 16; ++r) { p0[r] = __builtin_amdgcn_exp2f(fmaf(p0[r], C, -mn)); p1[r] = __builtin_amdgcn_exp2f(fmaf(p1[r], C, -mn)); ps += p0[r] + p1[r]; }
            { auto rr = __builtin_amdgcn_permlane32_swap(__float_as_uint(ps), __float_as_uint(ps), false, false); ps = __uint_as_float(rr[0]) + __uint_as_float(rr[1]); }
            l_reg = l_reg * alpha + ps;
            if (__any(alpha < 1.f)) { if (hi == 0) al[r32] = alpha; LDS_WAIT();
#pragma unroll
                for (int d = 0; d < 4; ++d)
#pragma unroll
                    for (int r = 0; r < 16; ++r) o[d][r] *= al[crow(r, hi)]; }
            bf16x8 pa0, pa1, pa2, pa3;
#define PK4(P, BASE, OUT) do { unsigned a0 = pk2(P[BASE + 0], P[BASE + 1]), a1 = pk2(P[BASE + 2], P[BASE + 3]); unsigned b0 = pk2(P[BASE + 4], P[BASE + 5]), b1 = pk2(P[BASE + 6], P[BASE + 7]); \
    auto r0 = __builtin_amdgcn_permlane32_swap(a0, b0, false, false); auto r1 = __builtin_amdgcn_permlane32_swap(a1, b1, false, false); \
    v4u w = {r0[0], r1[0], r0[1], r1[1]}; OUT = __builtin_bit_cast(bf16x8, w); } while (0)
            PK4(p0, 0, pa0); PK4(p0, 8, pa1); PK4(p1, 0, pa2); PK4(p1, 8, pa3);
#undef PK4
            const int vb = vb0 + (j & 1) * 16384;
            pv_one<0>(o[0], vb, pa0, pa1, pa2, pa3); pv_one<1>(o[1], vb, pa0, pa1, pa2, pa3); pv_one<2>(o[2], vb, pa0, pa1, pa2, pa3); pv_one<3>(o[3], vb, pa0, pa1, pa2, pa3);
        }
        if (j + 1 < NT) AWRITE((j + 1) & 1);
        __syncthreads();
    }
#undef ALOAD
#undef AWRITE
    if (hi == 0) al[r32] = l_reg; LDS_WAIT();
    bf16* Ow = A.mix + (rowbase + qw) * D + head * 128 + r32;
#pragma unroll
    for (int r = 0; r < 16; ++r) { const int orow = crow(r, hi); const float rl = __builtin_amdgcn_rcpf(al[orow]);
#pragma unroll
        for (int d0 = 0; d0 < 4; ++d0) Ow[(size_t)orow * D + d0 * 32] = (bf16)(pk2(o[d0][r] * rl, 0.f) & 0xffffu); }
}

#ifndef PROBE_DUP
#define PROBE_DUP 0
#endif
#ifndef PROBE_T
#define PROBE_T 0
#endif
__device__ __forceinline__ int lane_l() { int t; asm volatile("v_mbcnt_lo_u32_b32 %0, -1, 0\n\tv_mbcnt_hi_u32_b32 %0, -1, %0" : "=v"(t)); return t; }
struct Args { const float* in[24]; float* out; unsigned char* ws; int ph_lo, ph_hi; };
constexpr int NPH = 31;
__global__ void __launch_bounds__(NWAVES * 64, 2) fwd(Args args) {
    extern __shared__ __attribute__((aligned(16))) unsigned char lds_raw[];
    ldsp lds = (ldsp)lds_raw;
    volatile LAS unsigned* MISC = (volatile LAS unsigned*)(lds + LDSCTL_OFF);
    const int wave = __builtin_amdgcn_readfirstlane((int)threadIdx.x >> 6), G = gridDim.x;
#define tid ((wave << 6) | lane_l())
#define lane lane_l()
    unsigned char* ws = args.ws; unsigned* ctl = (unsigned*)(ws + WS_CTL);
    for (int u = tid; u < (LDS_BYTES - LDSCTL_OFF) / 4; u += NWAVES * 64) MISC[u] = 0u;
    __syncthreads();
    const int lo = args.ph_lo, hi = args.ph_hi; const bool multi = (hi - lo) > 1;
    XcdBarrier bar; bar.bar = ctl + CW_BAR; bar.x = 0; bar.st = nullptr; bar.t0 = false;
    if (multi) bar = xcd_barrier_post(ctl + CW_BAR, MISC + 8);
#define IN(k) (lo <= (k) && (k) < hi)
    unsigned long long tacc_ = 0, t0_ = 0;
#define PH_T0(bit) do { if (PROBE_T & (bit)) t0_ = __builtin_amdgcn_s_memrealtime(); } while (0)
#define PH_T1(bit) do { if (PROBE_T & (bit)) tacc_ += __builtin_amdgcn_s_memrealtime() - t0_; } while (0)
#define DUPBAR() do { if (multi) { XcdBarrier b2_ = bar; b2_.t0 = (wave == 0) && (lane_l() == 0); asm volatile("" : "+s"(b2_.bar)); xcd_barrier(b2_); } } while (0)
#if PROBE_DUP & 512
#define SEAM(k) do { if (IN(k) && IN((k) + 1)) { XcdBarrier b2_ = bar; b2_.t0 = (wave == 0) && (lane_l() == 0); asm volatile("" : "+s"(b2_.bar)); xcd_barrier(b2_); xcd_barrier(b2_); } } while (0)
#else
#define SEAM(k) do { if (IN(k) && IN((k) + 1)) { XcdBarrier b2_ = bar; b2_.t0 = (wave == 0) && (lane_l() == 0); asm volatile("" : "+s"(b2_.bar)); xcd_barrier(b2_); } } while (0)
#endif
    const float *x_prompt = args.in[0], *x_sample = args.in[1], *cache_k = args.in[2], *cache_v = args.in[3], *state_delta = args.in[4], *c_in = args.in[5], *c_ctx = args.in[6];
    const float *norm1_g = args.in[7], *w_mod = args.in[8], *b_mod = args.in[9], *w_in = args.in[10], *conv_w = args.in[11], *attn_sink = args.in[12], *dn_a_log = args.in[13], *dn_dt_bias = args.in[14];
    const float *dn_norm_g = args.in[15], *sgu_norm_g = args.in[16], *sgu_w = args.in[17], *sgu_b = args.in[18], *w_out = args.in[19], *norm2_g = args.in[20], *w_ff1 = args.in[21], *w_ff2 = args.in[22], *final_norm_g = args.in[23];
    float* out = args.out;
    float* MOD = (float*)(ws + WS_MOD); bf16* XB = (bf16*)(ws + WS_X); bf16* HB = (bf16*)(ws + WS_HB); bf16* ZB = (bf16*)(ws + WS_ZB); bf16* FB = ZB; bf16* XA = (bf16*)(ws + WS_XA);
    float* ODIR = (float*)(ws + WS_ODIR); unsigned char* DN = ws + WS_DN; unsigned long long* SSQ = (unsigned long long*)(ws + WS_SSQ); const float* BW = (const float*)(ws + WS_BW);

    PH_T0(1);
    if (IN(0)) {
        P0Args pa{c_in, c_ctx, norm1_g, norm2_g, w_mod, b_mod, w_in, w_out, w_ff1, w_ff2, cache_k, cache_v, ws};
        p0_prologue(pa, lds, ctl + CW_ATT + 64 * 16, MISC, tid, lane, wave, G);
        __syncthreads();
#if PROBE_DUP & 4
        p0_prologue(pa, lds, ctl + CW_ATT + 64 * 17, MISC, tid, lane, wave, G); __syncthreads();
#endif
    }
    SEAM(0); PH_T1(1); PH_T0(2);
    if (IN(1)) {
        p0b_bias(ws, lds, tid, lane, wave, G);
        norm_phase<false>(x_prompt, x_sample, MOD + 1 * 2048, XB, XA, SSQ, nullptr, lane, wave, G);
    }
    SEAM(1); PH_T1(2);
#pragma unroll 1
    for (int l = 0; l < DEPTH; ++l) {
        const int pb = 2 + 7 * l;
        const float* modl = MOD + (size_t)l * 9 * 12288;
        if (l == 0) PH_T0(4);
        if (IN(pb + 0)) {
            const bf16* gA = XA; const bf16* gB = (const bf16*)(ws + WS_WIN) + (size_t)l * DINP * 2048; asm volatile("" : "+s"(gA), "+s"(gB));
            pg8::Gemm g{gA, gB, M, DINP, 2048}; pg8::StaticOrder S; S.init(M, DINP, G, (int)blockIdx.x);
            pg8::EpiZ E{ZB, DINP, out + O_K + (size_t)l * 65536, out + O_V + (size_t)l * 65536, SSQ + (size_t)(2 * l) * M, BW + (size_t)l * BW_L};
            pg8::gemm_phase<pg8::EpiZ, pg8::StaticOrder, true, true>(lds, g, S, E, wave);
        }
        SEAM(pb + 0); PH_T1(4); PH_T0(8);
        LayerP LP{conv_w + (size_t)l * 5 * 1536, dn_a_log + l * 8, dn_dt_bias + l * 8, dn_norm_g + l * 128, sgu_norm_g + l * 512, sgu_w + (size_t)l * 4 * 128 * 128, sgu_b + l * 512, attn_sink + l * 8};
        if (IN(pb + 1)) {
            int wg_ = -1;
            for (int it = blockIdx.x; it < 1280 + 640 + 256; it += G) {
                if (it < 1280) dn_prep_unit(LP, ZB, DN, lds, it >> 2, it & 3, tid, lane, wave);
                else if (it < 1920) { const int g_ = (it - 1280) & 3; sgu_unit(LP, ZB, HB, lds, (it - 1280) >> 2, g_, g_ != wg_, tid, lane, wave); wg_ = g_; }
                else rope_item(ZB, (const float*)(ws + WS_ROPE), it - 1920, lane, wave);
            }
        }
#if PROBE_DUP & 16
        if (IN(pb + 1)) { DUPBAR();
            for (int it = blockIdx.x; it < 1280 + 640; it += G) {
                if (it < 1280) dn_prep_unit(LP, ZB, DN, lds, it >> 2, it & 3, tid, lane, wave);
                else sgu_unit(LP, ZB, HB, lds, (it - 1280) >> 2, (it - 1280) & 3, true, tid, lane, wave);
            } }
#endif
#if PROBE_DUP & 32
        if (IN(pb + 1)) { DUPBAR(); for (int it = blockIdx.x; it < 1280; it += G) dn_prep_unit(LP, ZB, DN, lds, it >> 2, it & 3, tid, lane, wave); }
#endif
        SEAM(pb + 1); PH_T1(8); PH_T0(16);
        if (IN(pb + 2)) {
            for (int cu = blockIdx.x; cu < 192; cu += G) {
                const bool isctx = cu >= 64; const int cc = isctx ? cu - 64 : cu; const int b = cc >> 3, h = (cc >> 1) & 3, dir = cc & 1;
                const float* s0 = isctx ? nullptr : state_delta + ((((size_t)b * 4 + l) * 2 + dir) * 4 + h) * 16384;
                float* so = isctx ? out + O_DELTA + ((((size_t)b * 4 + l) * 2 + dir) * 4 + h) * 16384 : nullptr;
                scan_chain(DN, s0, so, ODIR + (size_t)dir * M * 512, lds, isctx ? 1 : 0, b, h, dir, lane, wave);
            }
            AttnP AP{ZB, (const bf16*)(ws + WS_CK), (const bf16*)(ws + WS_CV), HB, LP.sink, l};
            for (;;) {
                if (tid == 0) MISC[0] = atomicAdd(ctl + CW_ATT + 64 * l, 1u);
                __syncthreads(); const int u = (int)MISC[0]; __syncthreads();
                if (u >= 640) break;
                attn_unit(AP, lds, u, tid, lane, wave);
            }
        }
#if PROBE_DUP & 128
        if (IN(pb + 2)) { DUPBAR();
            for (int cu = blockIdx.x; cu < 192; cu += G) {
                const bool isctx = cu >= 64; const int cc = isctx ? cu - 64 : cu; const int b = cc >> 3, h = (cc >> 1) & 3, dir = cc & 1;
                const float* s0 = isctx ? nullptr : state_delta + ((((size_t)b * 4 + l) * 2 + dir) * 4 + h) * 16384;
                float* so = isctx ? out + O_DELTA + ((((size_t)b * 4 + l) * 2 + dir) * 4 + h) * 16384 : nullptr;
                scan_chain(DN, s0, so, ODIR + (size_t)dir * M * 512, lds, isctx ? 1 : 0, b, h, dir, lane, wave);
            } }
#endif
#if PROBE_DUP & 256
        if (IN(pb + 2)) { DUPBAR();
            AttnP AP{ZB, (const bf16*)(ws + WS_CK), (const bf16*)(ws + WS_CV), HB, LP.sink, l};
            for (;;) {
                if (tid == 0) MISC[0] = atomicAdd(ctl + CW_ATT + 64 * (l + 4), 1u);
                __syncthreads(); const int u = (int)MISC[0]; __syncthreads();
                if (u >= 640) break;
                attn_unit(AP, lds, u, tid, lane, wave);
            } }
#endif
#if PROBE_DUP & 2
        if (IN(pb + 2)) { DUPBAR();
            for (int cu = blockIdx.x; cu < 192; cu += G) {
                const bool isctx = cu >= 64; const int cc = isctx ? cu - 64 : cu; const int b = cc >> 3, h = (cc >> 1) & 3, dir = cc & 1;
                const float* s0 = isctx ? nullptr : state_delta + ((((size_t)b * 4 + l) * 2 + dir) * 4 + h) * 16384;
                float* so = isctx ? out + O_DELTA + ((((size_t)b * 4 + l) * 2 + dir) * 4 + h) * 16384 : nullptr;
                scan_chain(DN, s0, so, ODIR + (size_t)dir * M * 512, lds, isctx ? 1 : 0, b, h, dir, lane, wave);
            }
            AttnP AP{ZB, (const bf16*)(ws + WS_CK), (const bf16*)(ws + WS_CV), HB, LP.sink, l};
            for (;;) {
                if (tid == 0) MISC[0] = atomicAdd(ctl + CW_ATT + 64 * (l + 4), 1u);
                __syncthreads(); const int u = (int)MISC[0]; __syncthreads();
                if (u >= 640) break;
                attn_unit(AP, lds, u, tid, lane, wave);
            } }
#endif
        SEAM(pb + 2); PH_T1(16); PH_T0(32);
        if (IN(pb + 3)) {
            const int ln = lane_l();
            const float gn0 = LP.dn_norm_g[2 * ln], gn1 = LP.dn_norm_g[2 * ln + 1];
            for (int it = blockIdx.x * NWAVES + wave; it < M * 4; it += G * NWAVES) { const size_t row = it >> 2; const int hh = it & 3;
                const f32x2 a = *(const f32x2*)(ODIR + row * 512 + hh * 128 + 2 * ln), b2 = *(const f32x2*)(ODIR + (size_t)M * 512 + row * 512 + hh * 128 + 2 * ln);
                const float o0 = a.x + b2.x, o1 = a.y + b2.y; const float r = rsqrtf(wave_sum(o0 * o0 + o1 * o1) * (1.f / 128.f) + EPS);
                const unsigned z = *(const unsigned*)(ZB + row * DINP + C_DZ + hh * 128 + 2 * ln);
                *(unsigned*)(HB + row * D + 1024 + hh * 128 + 2 * ln) = pk2(o0 * r * gn0 * silu_f(bflo(z)), o1 * r * gn1 * silu_f(bfhi(z))); }
        }
        SEAM(pb + 3); PH_T1(32); PH_T0(64);
        if (IN(pb + 4)) {
            const bf16* gA = HB; const bf16* gB = (const bf16*)(ws + WS_WOUT) + (size_t)l * 2048 * 2048; asm volatile("" : "+s"(gA), "+s"(gB));
            pg8::Gemm g{gA, gB, M, 2048, 2048};
            pg8::EpiRes E{XB, modl + 2 * 2048, modl + 4 * 2048, XA, SSQ + (size_t)(2 * l + 1) * M};
            pg8::StaticOrder S; S.init(M, 2048, G, (int)blockIdx.x);
            pg8::gemm_phase<pg8::EpiRes, pg8::StaticOrder, true, true>(lds, g, S, E, wave);
        }
        SEAM(pb + 4); PH_T1(64); PH_T0(128);
        if (IN(pb + 5)) {
            const bf16* gA = XA; const bf16* gB = (const bf16*)(ws + WS_WFF1) + (size_t)l * DFF * 2048; asm volatile("" : "+s"(gA), "+s"(gB));
            pg8::Gemm g{gA, gB, M, DFF, 2048}; pg8::StaticOrder S; S.init(M, DFF, G, (int)blockIdx.x);
            pg8::EpiRelu2 E{FB, DFF, SSQ + (size_t)(2 * l + 1) * M, BW + (size_t)l * BW_L + 9 * DINP};
            pg8::gemm_phase<pg8::EpiRelu2, pg8::StaticOrder, true, true>(lds, g, S, E, wave);
        }
        SEAM(pb + 5); PH_T1(128); PH_T0(256);
        if (IN(pb + 6)) {
            const bf16* gA = FB; const bf16* gB = (const bf16*)(ws + WS_WFF2) + (size_t)l * 2048 * DFF; asm volatile("" : "+s"(gA), "+s"(gB));
            pg8::Gemm g{gA, gB, M, 2048, DFF};
            pg8::EpiRes E{XB, modl + 5 * 2048, l + 1 < DEPTH ? modl + 9 * 12288 + 1 * 2048 : nullptr, XA, SSQ + (size_t)(2 * l + 2) * M};
            pg8::StaticOrder S; S.init(M, 2048, G, (int)blockIdx.x);
            pg8::gemm_phase<pg8::EpiRes, pg8::StaticOrder, true, true>(lds, g, S, E, wave);
        }
        SEAM(pb + 6); PH_T1(256); PH_T0(4);
    }
    PH_T0(512);
    if (IN(30)) norm_phase<true>(nullptr, nullptr, final_norm_g, XB, nullptr, nullptr, out + O_Y, lane, wave, G);
    PH_T1(512);
    if (PROBE_T && blockIdx.x == 0) { const unsigned long long te_ = __builtin_amdgcn_s_memrealtime() + 4ull * tacc_; while (__builtin_amdgcn_s_memrealtime() < te_) __builtin_amdgcn_s_sleep(64); }
#undef IN
#undef SEAM
#undef DUPBAR
#undef tid
#undef lane
}

#ifndef MK_ONE_LAUNCH
#define MK_ONE_LAUNCH 1
#endif
extern "C" void kernel_launch(void* const* d_in, const int* in_sizes, int n_in, void* d_out, int out_size, void* d_ws, size_t ws_size, hipStream_t stream) {
    static int grid = 0;
    if (grid == 0) {
        if (n_in != 24 || (size_t)out_size != O_END || ws_size < WS_END) { fprintf(stderr, "kernel_launch: unexpected shapes: n_in %d out %d ws %zu (need %zu)\n", n_in, out_size, ws_size, (size_t)WS_END); grid = -1; return; }
        int dev = 0, cus = 0, per_cu = 0;
        if (hipGetDevice(&dev) != hipSuccess || hipDeviceGetAttribute(&cus, hipDeviceAttributeMultiprocessorCount, dev) != hipSuccess) { grid = -1; return; }
        if (hipFuncSetAttribute((const void*)fwd, hipFuncAttributeMaxDynamicSharedMemorySize, LDS_BYTES) != hipSuccess) { fprintf(stderr, "kernel_launch: hipFuncSetAttribute failed\n"); grid = -1; return; }
        if (hipOccupancyMaxActiveBlocksPerMultiprocessor(&per_cu, (const void*)fwd, NWAVES * 64, LDS_BYTES) != hipSuccess || per_cu < 1) fprintf(stderr, "kernel_launch: occupancy query reports %d\n", per_cu);
        (void)hipGetLastError();
        grid = cus;
    }
    if (grid < 0) return;
    (void)hipMemsetAsync((char*)d_ws + WS_CTL, 0, CTL_ZERO_BYTES, stream);
    (void)hipMemsetAsync((char*)d_ws + WS_SSQ, 0, (size_t)9 * M * 8, stream);
    for (int l = 0; l < DEPTH; ++l) (void)hipMemsetAsync((char*)d_ws + WS_WIN + ((size_t)l * DINP + 4640) * 2048 * 2, 0, (size_t)(DINP - 4640) * 2048 * 2, stream);
    Args a{};
    for (int i = 0; i < 24; ++i) a.in[i] = (const float*)d_in[i];
    a.out = (float*)d_out; a.ws = (unsigned char*)d_ws;
#if MK_ONE_LAUNCH
    a.ph_lo = 0; a.ph_hi = NPH;
    hipLaunchKernelGGL(fwd, dim3(grid), dim3(NWAVES * 64), LDS_BYTES, stream, a);
#else
    for (int p = 0; p < NPH; ++p) { a.ph_lo = p; a.ph_hi = p + 1; hipLaunchKernelGGL(fwd, dim3(grid), dim3(NWAVES * 64), LDS_BYTES, stream, a); }
#endif
    const hipError_t le = hipPeekAtLastError();
    if (le != hipSuccess) fprintf(stderr, "kernel_launch: launch failed: %s\n", hipGetErrorName(le));
}
```

```cpp
#include <hip/hip_runtime.h>
#include <cstdio>
#include <cstdint>
namespace pg8 {
#define PG8_LAS __attribute__((address_space(3)))
typedef unsigned short bf16_t;
typedef short bf16x8 __attribute__((ext_vector_type(8)));
typedef float f32x4 __attribute__((ext_vector_type(4)));
typedef unsigned u32x4 __attribute__((ext_vector_type(4)));
constexpr int BM = 256, BK = 64, HALF = 128, HTB = HALF * BK * 2  , STAGE_BYTES = 8 * HTB, NXCD = 8, WGM = 8;

__host__ __device__ __forceinline__ int lds_byte(int r, int c) { const int st = (r >> 4) * 2 + (c >> 5), rr = r & 15, cc = c & 31, ob = rr * 64 + cc * 2; return st * 1024 + (ob ^ (((ob >> 9) & 1) << 5)); }
__host__ __device__ __forceinline__ void stage_rc(int b, int& R, int& C) { const int st = b / 1024, sb = b % 1024, swz = sb ^ (((sb >> 9) & 1) << 5); R = (st >> 1) * 16 + swz / 64; C = (st & 1) * 32 + (swz % 64) / 2; }
__host__ __device__ __forceinline__ int perm32(int rho) { const int n = rho >> 4, i = rho & 15; return 8 * (i >> 2) + 4 * n + (i & 3); }

struct Unit { int pm, pn; };
struct Gemm { const bf16_t* A; const bf16_t* Bt; int M, N, K; };

struct StaticOrder {
    int nM, nN, nwg, G, c, wgm, rev;
    __host__ __device__ void init(int M, int N, int G_, int c_, int wgm_ = WGM, int rev_ = 0) { nM = M / BM; nN = N / BM; nwg = nM * nN; G = G_; c = c_; wgm = wgm_; rev = rev_; }
    __host__ __device__ bool next(int i, Unit& u) const {
        const long L = (long)i * G + c; if (L >= nwg) return false;
        int wgid = (int)L; { const int q = nwg / NXCD, r = nwg % NXCD, xcd = wgid % NXCD, off = wgid / NXCD; wgid = (xcd < r ? xcd * (q + 1) : r * (q + 1) + (xcd - r) * q) + off; }
        const int nig = wgm * nN, gid = wgid / nig, fm = gid * wgm, gsz = (nM - fm) < wgm ? (nM - fm) : wgm;
        u.pm = fm + ((wgid % nig) % gsz); u.pn = (wgid % nig) / gsz; if (rev) u.pm = nM - 1 - u.pm; return true;
    }
    __device__ __forceinline__ void a_ready(const Unit&) const {}
    __device__ __forceinline__ void done(const Unit&) const {}
};


typedef float f32x2c __attribute__((ext_vector_type(2))); typedef __bf16 bf16x2c __attribute__((ext_vector_type(2)));
__device__ __forceinline__ unsigned cvt_pk_bf16(float lo, float hi) { const f32x2c v = {lo, hi}; return __builtin_bit_cast(unsigned, __builtin_convertvector(v, bf16x2c)); }
__device__ __forceinline__ int cond_of(int rowt) { return rowt < 4096 ? 8 : ((rowt - 4096) >> 11); }
struct EpiZ {
    static constexpr bool PERM = true, AFTER_DRAIN = false;
    bf16_t* O; int ldc; float* outk; float* outv; const unsigned long long* ssq; const float* bw;
    __device__ __forceinline__ void operator()(const f32x4 (&acc)[2][2][4][2], const Unit& u, int wr, int wc, int fr, int fq) const {
        asm volatile("" : "+v"(fr), "+v"(fq));
        const int rowt = u.pm * BM, row0 = rowt + wr * 64 + fr; const int col0 = u.pn * BM + wc * 32 + 8 * fq;
        const bool kv = (u.pm < 16) && (u.pn == 4 || u.pn == 5);
        float* ob = (u.pn == 4 ? outk : outv) + (size_t)u.pm * (4 * 65536) + wc * 32 + 8 * fq;
        const float* bp = bw + (size_t)cond_of(rowt) * ldc + col0; f32x4 bv[2][2];
#pragma unroll
        for (int bj = 0; bj < 2; ++bj)
#pragma unroll
            for (int n = 0; n < 2; ++n) bv[bj][n] = *(const f32x4*)(bp + bj * HALF + 4 * n);
#pragma unroll
        for (int ai = 0; ai < 2; ++ai)
#pragma unroll
            for (int m = 0; m < 4; ++m) { const int rl = wr * 64 + fr + ai * HALF + m * 16; bf16_t* rowp = O + (size_t)(row0 + ai * HALF + m * 16) * ldc + col0;
                const float rs = __builtin_amdgcn_rsqf((float)ssq[rowt + rl] * (1.f / (2048.f * 16777216.f)) + 1e-6f);
#pragma unroll
                for (int bj = 0; bj < 2; ++bj) { const f32x4 v0 = acc[ai][bj][m][0] * rs + bv[bj][0], v1 = acc[ai][bj][m][1] * rs + bv[bj][1];
                    u32x4 w; w.x = cvt_pk_bf16(v0[0], v0[1]); w.y = cvt_pk_bf16(v0[2], v0[3]); w.z = cvt_pk_bf16(v1[0], v1[1]); w.w = cvt_pk_bf16(v1[2], v1[3]);
                    *(u32x4*)(rowp + bj * HALF) = w;
                    if (kv) { float* p = ob + (size_t)rl * 256 + bj * HALF; *(f32x4*)p = v0; *(f32x4*)(p + 4) = v1; } } }
    }
};
struct EpiRelu2 {
    static constexpr bool PERM = true, AFTER_DRAIN = false;
    bf16_t* O; int ldc; const unsigned long long* ssq; const float* bw;
    __device__ __forceinline__ void operator()(const f32x4 (&acc)[2][2][4][2], const Unit& u, int wr, int wc, int fr, int fq) const {
        asm volatile("" : "+v"(fr), "+v"(fq));
        const int rowt = u.pm * BM, row0 = rowt + wr * 64 + fr; const int col0 = u.pn * BM + wc * 32 + 8 * fq;
        const float* bp = bw + (size_t)cond_of(rowt) * ldc + col0; f32x4 bv[2][2];
#pragma unroll
        for (int bj = 0; bj < 2; ++bj)
#pragma unroll
            for (int n = 0; n < 2; ++n) bv[bj][n] = *(const f32x4*)(bp + bj * HALF + 4 * n);
#pragma unroll
        for (int ai = 0; ai < 2; ++ai)
#pragma unroll
            for (int m = 0; m < 4; ++m) { bf16_t* rowp = O + (size_t)(row0 + ai * HALF + m * 16) * ldc + col0;
                const float rs = __builtin_amdgcn_rsqf((float)ssq[row0 + ai * HALF + m * 16] * (1.f / (2048.f * 16777216.f)) + 1e-6f);
#pragma unroll
                for (int bj = 0; bj < 2; ++bj) { f32x4 v0 = acc[ai][bj][m][0] * rs + bv[bj][0], v1 = acc[ai][bj][m][1] * rs + bv[bj][1];
#pragma unroll
                    for (int j = 0; j < 4; ++j) { const float a = fmaxf(v0[j], 0.f), b = fmaxf(v1[j], 0.f); v0[j] = a * a; v1[j] = b * b; }
                    u32x4 w; w.x = cvt_pk_bf16(v0[0], v0[1]); w.y = cvt_pk_bf16(v0[2], v0[3]); w.z = cvt_pk_bf16(v1[0], v1[1]); w.w = cvt_pk_bf16(v1[2], v1[3]);
                    *(u32x4*)(rowp + bj * HALF) = w; } }
    }
};
struct EpiRes {
    static constexpr bool PERM = true, AFTER_DRAIN = false;
    bf16_t* x; const float* gate; const float* anext; bf16_t* xa; unsigned long long* ssq;
    __device__ __forceinline__ void operator()(const f32x4 (&acc)[2][2][4][2], const Unit& u, int wr, int wc, int fr, int fq) const {
        asm volatile("" : "+v"(fr), "+v"(fq));
        const int rowt = u.pm * BM, col0 = u.pn * BM + wc * 32 + 8 * fq; const int cond = cond_of(rowt);
        bf16_t* xb = x + (size_t)rowt * 2048; bf16_t* ab = xa + (size_t)rowt * 2048;
        const float* g = gate + (size_t)cond * 12288 + col0; f32x4 gv[2][2], av[2][2];
#pragma unroll
        for (int bj = 0; bj < 2; ++bj)
#pragma unroll
            for (int n = 0; n < 2; ++n) { gv[bj][n] = *(const f32x4*)(g + bj * HALF + 4 * n); av[bj][n] = anext ? *(const f32x4*)(anext + (size_t)cond * 12288 + col0 + bj * HALF + 4 * n) : (f32x4){0.f, 0.f, 0.f, 0.f}; }
        const unsigned offb = (unsigned)((wr * 64 + fr) * 2048 + col0) * 2u;
#pragma unroll
        for (int ai = 0; ai < 2; ++ai)
#pragma unroll
            for (int m = 0; m < 4; ++m) { unsigned voff = offb + (unsigned)(ai * HALF + m * 16) * 4096u; asm volatile("" : "+v"(voff));
                char* xp = (char*)xb + voff; char* ap = (char*)ab + voff; float ss = 0.f;
#pragma unroll
                for (int bj = 0; bj < 2; ++bj) { const u32x4 xw = *(const u32x4*)(xp + bj * 256);
                    const f32x4 x0 = {__uint_as_float(xw.x << 16), __uint_as_float(xw.x & 0xffff0000u), __uint_as_float(xw.y << 16), __uint_as_float(xw.y & 0xffff0000u)};
                    const f32x4 x1 = {__uint_as_float(xw.z << 16), __uint_as_float(xw.z & 0xffff0000u), __uint_as_float(xw.w << 16), __uint_as_float(xw.w & 0xffff0000u)};
                    const f32x4 y0 = x0 + gv[bj][0] * acc[ai][bj][m][0], y1 = x1 + gv[bj][1] * acc[ai][bj][m][1];
                    u32x4 yw; yw.x = cvt_pk_bf16(y0[0], y0[1]); yw.y = cvt_pk_bf16(y0[2], y0[3]); yw.z = cvt_pk_bf16(y1[0], y1[1]); yw.w = cvt_pk_bf16(y1[2], y1[3]); *(u32x4*)(xp + bj * 256) = yw;
                    ss += (y0[0] * y0[0] + y0[1] * y0[1]) + (y0[2] * y0[2] + y0[3] * y0[3]) + (y1[0] * y1[0] + y1[1] * y1[1]) + (y1[2] * y1[2] + y1[3] * y1[3]);
                    if (anext) { const f32x4 a0 = y0 * av[bj][0], a1 = y1 * av[bj][1];
                        u32x4 w; w.x = cvt_pk_bf16(a0[0], a0[1]); w.y = cvt_pk_bf16(a0[2], a0[3]); w.z = cvt_pk_bf16(a1[0], a1[1]); w.w = cvt_pk_bf16(a1[2], a1[3]); *(u32x4*)(ap + bj * 256) = w; } }
                ss += __shfl_xor(ss, 16); ss += __shfl_xor(ss, 32);
                if (fq == 0) { const float hi = floorf(ss); const unsigned long long q = ((unsigned long long)(unsigned)hi << 24) + (unsigned long long)(unsigned)((ss - hi) * 16777216.f);
                    __hip_atomic_fetch_add(ssq + rowt + wr * 64 + fr + ai * HALF + m * 16, q, __ATOMIC_RELAXED, __HIP_MEMORY_SCOPE_AGENT); }
                asm volatile("" ::: "memory"); }
    }
};
template <class Epi, class Sched, bool ALIGN_EPI = false, bool SP2 = false>
__device__ __forceinline__ void gemm_phase(PG8_LAS unsigned char* lds, const Gemm g, const Sched& S, const Epi& E, const int wave_in) {
    int tid_; asm volatile("v_mbcnt_lo_u32_b32 %0, -1, 0\n\tv_mbcnt_hi_u32_b32 %0, -1, %0" : "=v"(tid_)); tid_ |= (wave_in << 6);
    const int tid = tid_, wid = __builtin_amdgcn_readfirstlane(tid >> 6), lane = tid & 63, wr = wid >> 2, wc = wid & 3, fr = lane & 15, fq = lane >> 4;
    const int K = g.K, nt = K / BK;
    unsigned voffA[2], voffB[2];
#pragma unroll
    for (int i = 0; i < 2; ++i) { int R, C; stage_rc(tid * 16 + i * 8192, R, C); const int Rb = Epi::PERM ? ((R & ~31) + perm32(R & 31)) : R;
        voffA[i] = (unsigned)(R * K + C) * 2u; voffB[i] = (unsigned)(Rb * K + C) * 2u; }
    const size_t kstep = (size_t)(BK * 2);
    const size_t hstep = (size_t)HALF * K * 2;
    const size_t tstep = 2 * hstep;
    const unsigned ldsw = (unsigned)wid * 1024u;
    const int aoff = lds_byte(wr * 64 + fr, fq * 8), boff = lds_byte(wc * 32 + fr, fq * 8);
#define PG8_SA(b, h) (((b) * 2 + (h)) * HTB)
#define PG8_SB(b, h) ((4 + (b) * 2 + (h)) * HTB)
#define PG8_STAGE(bufoff, gbase, voff) do { _Pragma("unroll") for (int _i = 0; _i < 2; ++_i) \
        __builtin_amdgcn_global_load_lds((const unsigned*)((const char*)(gbase) + (voff)[_i]), (PG8_LAS unsigned*)(lds + (bufoff) + ldsw + _i * 8192), 16, 0, 0); } while (0)
#define PG8_LDA(dst, b, h) do { _Pragma("unroll") for (int m = 0; m < 4; ++m) _Pragma("unroll") for (int k = 0; k < 2; ++k) dst[m][k] = *(const PG8_LAS bf16x8*)(lds + PG8_SA(b, h) + aoff + m * 2048 + k * 1024); } while (0)
#define PG8_LDB(dst, b, h) do { _Pragma("unroll") for (int n = 0; n < 2; ++n) _Pragma("unroll") for (int k = 0; k < 2; ++k) dst[n][k] = *(const PG8_LAS bf16x8*)(lds + PG8_SB(b, h) + boff + n * 2048 + k * 1024); } while (0)
#define PG8_MMA(ai, bj, At, Bt) do { __builtin_amdgcn_s_setprio(1); _Pragma("unroll") for (int m = 0; m < 4; ++m) _Pragma("unroll") for (int n = 0; n < 2; ++n) _Pragma("unroll") for (int k = 0; k < 2; ++k) \
        acc[ai][bj][m][n] = __builtin_amdgcn_mfma_f32_16x16x32_bf16(Bt[n][k], At[m][k], acc[ai][bj][m][n], 0, 0, 0); __builtin_amdgcn_s_setprio(0); } while (0)
#define PG8_WAIT_V(n) asm volatile("s_waitcnt vmcnt(" #n ")" ::: "memory")
#define PG8_WAIT_L(n) asm volatile("s_waitcnt lgkmcnt(" #n ")" ::: "memory")
#define PG8_BAR __builtin_amdgcn_s_barrier()
#define PG8_SCHED __builtin_amdgcn_sched_barrier(0)
    Unit cur, nxt; int ui = 0;
    if (!S.next(0, cur)) return;
    f32x4 acc[2][2][4][2];
#pragma unroll
    for (int a = 0; a < 2; ++a)
#pragma unroll
        for (int b = 0; b < 2; ++b)
#pragma unroll
            for (int m = 0; m < 4; ++m)
#pragma unroll
                for (int n = 0; n < 2; ++n) acc[a][b][m][n] = (f32x4){0.f, 0.f, 0.f, 0.f};
    bf16x8 At[4][2], B0[2][2], B1[2][2];
    const char* cA = (const char*)g.A + (size_t)cur.pm * tstep; const char* cB = (const char*)g.Bt + (size_t)cur.pn * tstep;
    S.a_ready(cur);
    if constexpr (SP2) {
        PG8_STAGE(PG8_SB(0, 0), cB, voffB); PG8_STAGE(PG8_SB(0, 1), cB + hstep, voffB); PG8_STAGE(PG8_SA(0, 0), cA, voffA); PG8_STAGE(PG8_SA(0, 1), cA + hstep, voffA);
        if (wr == 1) PG8_BAR;
        PG8_WAIT_V(2); PG8_BAR;
        PG8_STAGE(PG8_SB(1, 0), cB + kstep, voffB); PG8_STAGE(PG8_SA(1, 0), cA + kstep, voffA); PG8_STAGE(PG8_SB(1, 1), cB + hstep + kstep, voffB);
        PG8_WAIT_V(6); PG8_BAR;
    } else {
        PG8_STAGE(PG8_SB(0, 0), cB, voffB); PG8_STAGE(PG8_SA(0, 0), cA, voffA); PG8_STAGE(PG8_SB(0, 1), cB + hstep, voffB); PG8_STAGE(PG8_SA(0, 1), cA + hstep, voffA);
        if (wr == 1) PG8_BAR;
        PG8_WAIT_V(4); PG8_BAR;
        PG8_STAGE(PG8_SB(1, 0), cB + kstep, voffB); PG8_STAGE(PG8_SA(1, 0), cA + kstep, voffA); PG8_STAGE(PG8_SB(1, 1), cB + hstep + kstep, voffB);
        PG8_WAIT_V(6); PG8_BAR;
    }
    for (;;) {
        const bool has_next = S.next(ui + 1, nxt);
        const char* nA = has_next ? (const char*)g.A + (size_t)nxt.pm * tstep : cA; const char* nB = has_next ? (const char*)g.Bt + (size_t)nxt.pn * tstep : cB;
        for (int t = 0; t < nt; t += 2) {
            const bool last = (t == nt - 2);
            const char* a1 = cA + (size_t)(t + 1) * kstep;
            const char* a2 = last ? nA : cA + (size_t)(t + 2) * kstep; const char* b2 = last ? nB : cB + (size_t)(t + 2) * kstep;
            const char* a3 = a2 + kstep; const char* b3 = b2 + kstep;
            if (last && has_next) S.a_ready(nxt);
            if constexpr (SP2) {
            PG8_LDB(B0, 0, 0); PG8_LDB(B1, 0, 1); PG8_SCHED; PG8_LDA(At, 0, 0); PG8_STAGE(PG8_SA(1, 1), a1 + hstep, voffA);
            PG8_WAIT_V(8); PG8_WAIT_L(0); PG8_BAR; PG8_MMA(0, 0, At, B0); PG8_MMA(0, 1, At, B1); PG8_BAR; PG8_SCHED;
            PG8_LDA(At, 0, 1); PG8_STAGE(PG8_SB(0, 0), b2, voffB); PG8_STAGE(PG8_SB(0, 1), b2 + hstep, voffB); PG8_STAGE(PG8_SA(0, 0), a2, voffA);
            PG8_WAIT_V(8); PG8_WAIT_L(0); PG8_BAR; PG8_MMA(1, 0, At, B0); PG8_MMA(1, 1, At, B1); PG8_BAR; PG8_SCHED;
            PG8_LDB(B0, 1, 0); PG8_LDB(B1, 1, 1); PG8_SCHED; PG8_LDA(At, 1, 0); PG8_STAGE(PG8_SA(0, 1), a2 + hstep, voffA);
            PG8_WAIT_V(8); PG8_WAIT_L(0); PG8_BAR; PG8_MMA(0, 0, At, B0); PG8_MMA(0, 1, At, B1); PG8_BAR; PG8_SCHED;
            PG8_LDA(At, 1, 1); PG8_STAGE(PG8_SB(1, 0), b3, voffB); PG8_STAGE(PG8_SB(1, 1), b3 + hstep, voffB); PG8_STAGE(PG8_SA(1, 0), a3, voffA);
            PG8_WAIT_V(8); PG8_WAIT_L(0); PG8_BAR; PG8_MMA(1, 0, At, B0); PG8_MMA(1, 1, At, B1); PG8_BAR; PG8_SCHED;
            } else {
            PG8_LDB(B0, 0, 0); PG8_SCHED; PG8_LDA(At, 0, 0); PG8_STAGE(PG8_SA(1, 1), a1 + hstep, voffA);
            PG8_WAIT_L(8); PG8_BAR; PG8_WAIT_L(0); PG8_MMA(0, 0, At, B0); PG8_BAR; PG8_SCHED;
            PG8_LDB(B1, 0, 1); PG8_STAGE(PG8_SB(0, 0), b2, voffB);
            PG8_BAR; PG8_WAIT_L(0); PG8_MMA(0, 1, At, B1); PG8_BAR;
            PG8_LDA(At, 0, 1); PG8_STAGE(PG8_SA(0, 0), a2, voffA);
            PG8_BAR; PG8_WAIT_L(0); PG8_MMA(1, 0, At, B0); PG8_BAR; PG8_SCHED;
            PG8_STAGE(PG8_SB(0, 1), b2 + hstep, voffB);
            PG8_WAIT_V(6); PG8_BAR; PG8_MMA(1, 1, At, B1); PG8_BAR;
            PG8_LDB(B0, 1, 0); PG8_SCHED; PG8_LDA(At, 1, 0); PG8_STAGE(PG8_SA(0, 1), a2 + hstep, voffA);
            PG8_WAIT_L(8); PG8_BAR; PG8_WAIT_L(0); PG8_MMA(0, 0, At, B0); PG8_BAR; PG8_SCHED;
            PG8_LDB(B1, 1, 1); PG8_STAGE(PG8_SB(1, 0), b3, voffB);
            PG8_BAR; PG8_WAIT_L(0); PG8_MMA(0, 1, At, B1); PG8_BAR;
            PG8_LDA(At, 1, 1); PG8_STAGE(PG8_SA(1, 0), a3, voffA);
            PG8_BAR; PG8_WAIT_L(0); PG8_MMA(1, 0, At, B0); PG8_BAR; PG8_SCHED;
            PG8_STAGE(PG8_SB(1, 1), b3 + hstep, voffB);
            PG8_WAIT_V(6); PG8_BAR; PG8_MMA(1, 1, At, B1); PG8_BAR;
            }
        }
        if constexpr (ALIGN_EPI) { if (wr == 0) PG8_BAR; }
        if constexpr (!Epi::AFTER_DRAIN) { E(acc, cur, wr, wc, fr, fq); S.done(cur); }
        if (!has_next) break;
#pragma unroll
        for (int a = 0; a < 2; ++a)
#pragma unroll
            for (int b = 0; b < 2; ++b)
#pragma unroll
                for (int m = 0; m < 4; ++m)
#pragma unroll
                    for (int n = 0; n < 2; ++n) acc[a][b][m][n] = (f32x4){0.f, 0.f, 0.f, 0.f};
        cur = nxt; cA = nA; cB = nB; ++ui;
        if constexpr (ALIGN_EPI) { if (wr == 1) PG8_BAR; }
    }
    PG8_WAIT_V(0);
    if constexpr (!ALIGN_EPI) { if (wr == 0) PG8_BAR; }
    PG8_BAR;
    if constexpr (Epi::AFTER_DRAIN) { E.fused(acc, cur, wr, wc, fr, fq, lds, wid, lane); S.done(cur); }
#undef PG8_SA
#undef PG8_SB
#undef PG8_STAGE
#undef PG8_LDA
#undef PG8_LDB
#undef PG8_MMA
#undef PG8_WAIT_V
#undef PG8_WAIT_L
#undef PG8_BAR
#undef PG8_SCHED
}
}


constexpr int D = 2048, NCTX = 4096, NLAT = 16384, M = NCTX + NLAT, DEPTH = 4;
constexpr int DIN = 4624, DINP = 4864, DFF = 8192;
constexpr int C_AQ = 0, C_AK = 1024, C_AV = 1280, C_DQ = 1536, C_DK = 2048, C_DV = 2560, C_DZ = 3072, C_DAB = 3584, C_SU = 3600, C_SV = 4112;
constexpr int NWAVES = 8;
constexpr float EPS = 1e-6f;
constexpr size_t O_Y = 0, O_K = (size_t)M * D, O_V = O_K + 4194304, O_DELTA = O_V + 4194304, O_END = O_DELTA + 8388608;
constexpr size_t MiB = 1u << 20;
constexpr size_t WS_CTL = 0, CTL_ZERO_BYTES = 1 * MiB;
static_assert((16384 + 9 * 20480) * 4 <= 1 * 1048576, "ssq inside the memset region");
constexpr size_t WS_MOD = 1 * MiB, WS_ROPE = 3 * MiB, WS_CK = 4 * MiB, WS_CV = 12 * MiB;
constexpr size_t WS_WIN = 20 * MiB, WS_WOUT = 96 * MiB, WS_WFF1 = 128 * MiB, WS_WFF2 = 256 * MiB;
constexpr size_t WS_X = 384 * MiB, WS_HB = 544 * MiB, WS_ZB = 624 * MiB, WS_ODIR = 816 * MiB, WS_DN = 944 * MiB, WS_BW = 1088 * MiB, WS_XA = 1090 * MiB, WS_SSQ = 1170 * MiB, WS_END = 1172 * MiB;
constexpr int BW_L = 9 * (DINP + DFF);
constexpr int CW_SSQ = 16384;
constexpr size_t DN_BLK = 116736, DN_DIR0 = 32768, DN_DIRSZ = 41984;
static_assert(WS_DN + 1280 * DN_BLK <= WS_END, "dn scratch");
constexpr int CW_BAR = 4096, CW_ATT = 8192, CW_PART = 204800;
constexpr int LDSCTL_OFF = 153600, LDS_BYTES = 154624;

#define GAS __attribute__((address_space(1)))
#define LAS __attribute__((address_space(3)))
typedef unsigned short bf16;
typedef unsigned v4u __attribute__((ext_vector_type(4)));
typedef unsigned v2u __attribute__((ext_vector_type(2)));
typedef float f32x4 __attribute__((ext_vector_type(4)));
typedef float f32x2 __attribute__((ext_vector_type(2)));
typedef float f32x16 __attribute__((ext_vector_type(16)));
typedef short bf16x8 __attribute__((ext_vector_type(8)));
typedef short s16x4 __attribute__((ext_vector_type(4)));
typedef LAS unsigned char* ldsp;
#define LDS_WAIT() asm volatile("s_waitcnt lgkmcnt(0)" ::: "memory")
#define VM_WAIT() asm volatile("s_waitcnt vmcnt(0)" ::: "memory")
__device__ __forceinline__ unsigned pk2(float lo, float hi) { return pg8::cvt_pk_bf16(lo, hi); }
__device__ __forceinline__ float bflo(unsigned w) { return __uint_as_float(w << 16); }
__device__ __forceinline__ float bfhi(unsigned w) { return __uint_as_float(w & 0xffff0000u); }
__device__ __forceinline__ float bf2f(bf16 b) { return __uint_as_float((unsigned)b << 16); }
__device__ __forceinline__ float wave_sum(float v) {
#define WS_DPP(ctrl, rmask) __builtin_bit_cast(float, __builtin_amdgcn_update_dpp(0, __builtin_bit_cast(int, v), ctrl, rmask, 0xF, false))
    v += WS_DPP(0xB1, 0xF);
    v += WS_DPP(0x4E, 0xF);
    v += WS_DPP(0x141, 0xF);
    v += WS_DPP(0x140, 0xF);
    v += WS_DPP(0x142, 0xA);
    v += WS_DPP(0x143, 0xC);
#undef WS_DPP
    return __builtin_bit_cast(float, __builtin_amdgcn_ds_bpermute(63 * 4, __builtin_bit_cast(int, v)));
}
__device__ __forceinline__ int crow(int r, int hi) { return (r & 3) + 8 * (r >> 2) + 4 * hi; }
__device__ __forceinline__ float silu_f(float x) { return x * __builtin_amdgcn_rcpf(1.f + __expf(-x)); }
__device__ __forceinline__ float gelu_tanh(float x) { const float y = 0.7978845608028654f * (x + 0.044715f * x * x * x); const float e = __expf(2.f * y); return x * (1.f - __builtin_amdgcn_rcpf(1.f + e)); }
template <int S> __device__ __forceinline__ bf16x8 pack8(const f32x16& v) {
    v4u w; w.x = pk2(v[8 * S + 0], v[8 * S + 1]); w.y = pk2(v[8 * S + 2], v[8 * S + 3]); w.z = pk2(v[8 * S + 4], v[8 * S + 5]); w.w = pk2(v[8 * S + 6], v[8 * S + 7]);
    return __builtin_bit_cast(bf16x8, w);
}
__device__ __forceinline__ f32x16 mma_lds(ldsp A, int sa, ldsp B, int sb, int nk, int lane, f32x16 acc) {
    ldsp ap = A + (lane & 31) * sa + (lane >> 5) * 16; ldsp bp = B + (lane & 31) * sb + (lane >> 5) * 16;
#pragma unroll 4
    for (int k = 0; k < nk; ++k) { const bf16x8 a = *(const LAS bf16x8*)(ap + k * 32); const bf16x8 b = *(const LAS bf16x8*)(bp + k * 32); acc = __builtin_amdgcn_mfma_f32_32x32x16_bf16(a, b, acc, 0, 0, 0); }
    return acc;
}

#define XB_TMO      128
#define XB_XCNT(j)  (256  + 64 * (j))
#define XB_XSUB(j)  (1280 + 64 * (j))
#define XB_XGEN(j)  (2304 + 64 * (j))
#define XB_TOP      3328
#define XB_TOPGEN   3392
#define XCD_BAR_WORDS 3456
#define XB_SPIN_CAP (1u << 18)
#define LAS __attribute__((address_space(3)))

__device__ __forceinline__ unsigned xb_ld(unsigned* p)              { return __hip_atomic_load(p, __ATOMIC_RELAXED, __HIP_MEMORY_SCOPE_AGENT); }
__device__ __forceinline__ unsigned xb_add(unsigned* p, unsigned v) { return __hip_atomic_fetch_add(p, v, __ATOMIC_RELAXED, __HIP_MEMORY_SCOPE_AGENT); }
__device__ __forceinline__ unsigned xb_xcc_id() { return (unsigned)__builtin_amdgcn_s_getreg((3 << 11) | 20) & 0xFu; }
#define XB_SPIN(cond, bar) do { unsigned _sp = 0; while (cond) { __builtin_amdgcn_s_sleep(1); \
    if ((++_sp & 255u) == 0u) { if (xb_ld(&(bar)[XB_TMO])) break; if (_sp > XB_SPIN_CAP) { atomicAdd(&(bar)[XB_TMO], 1u); break; } } } } while (0)

struct XcdBarrier {
    unsigned* bar; unsigned x; bool t0;
    volatile LAS unsigned* st;
};

__device__ __forceinline__ XcdBarrier xcd_barrier_post(unsigned* bar, volatile LAS unsigned* st) {
    XcdBarrier b; b.bar = bar; b.x = xb_xcc_id(); b.st = st; b.t0 = (threadIdx.x == 0);
    if (threadIdx.x == 0) (void)xb_add(&bar[XB_XCNT(b.x)], 1u);
    return b;
}
__device__ __forceinline__ void xcd_barrier_complete(unsigned* bar, unsigned x, unsigned& nloc, unsigned& nx) {
    const unsigned G = gridDim.x * gridDim.y * gridDim.z;
    unsigned sum, cnt, mine, sp = 0u;
    for (;;) {
        sum = 0u; cnt = 0u; mine = 0u;
#pragma unroll
        for (unsigned j = 0; j < 16; ++j) { const unsigned c = xb_ld(&bar[XB_XCNT(j)]); sum += c; cnt += (c > 0u) ? 1u : 0u; mine = (j == x) ? c : mine; }
        if (sum == G) break;
        __builtin_amdgcn_s_sleep(1);
        if ((++sp & 255u) == 0u) { if (xb_ld(&bar[XB_TMO])) break; if (sp > XB_SPIN_CAP) { atomicAdd(&bar[XB_TMO], 1u); break; } }
    }
    nloc = mine > 0u ? mine : 1u; nx = cnt > 0u ? cnt : 1u;
}

__device__ __forceinline__ void xcd_barrier(const XcdBarrier& b) {
    asm volatile("s_waitcnt vmcnt(0)" ::: "memory");
    __syncthreads();
    if (b.t0) {
        unsigned* bar = b.bar;
        __builtin_amdgcn_s_waitcnt(0);
        unsigned nloc = b.st[0], nx = b.st[1];
        if (nloc == 0u) { xcd_barrier_complete(bar, b.x, nloc, nx); b.st[0] = nloc; b.st[1] = nx; }
        const unsigned old = xb_add(&bar[XB_XSUB(b.x)], 1u);
        const unsigned gen = old / nloc;
        if (old + 1u == (gen + 1u) * nloc) {
            __builtin_amdgcn_fence(__ATOMIC_RELEASE, "agent");
            asm volatile("s_waitcnt vmcnt(0)" ::: "memory");
            const unsigned og = xb_add(&bar[XB_TOP], 1u);
            const unsigned tg = og / nx;
            if (og + 1u == (tg + 1u) * nx) xb_add(&bar[XB_TOPGEN], 1u);
            else XB_SPIN(xb_ld(&bar[XB_TOPGEN]) == tg, bar);
            __builtin_amdgcn_fence(__ATOMIC_ACQUIRE, "agent");
            xb_add(&bar[XB_XGEN(b.x)], 1u);
            asm volatile("s_waitcnt vmcnt(0)" ::: "memory");
        } else {
            XB_SPIN(xb_ld(&bar[XB_XGEN(b.x)]) == gen, bar);
            __builtin_amdgcn_fence(__ATOMIC_ACQUIRE, "agent");
            asm volatile("s_waitcnt vmcnt(0)" ::: "memory");
        }
    }
    __syncthreads();
}


__device__ __forceinline__ void p0_transpose_item(const float* W, int K, int N, bf16* WT, LAS float* scr, int item, int lane) {
    const int nblk = (N + 31) / 32, kb = item / nblk, nb = item % nblk, k0 = 64 * kb, n0 = 32 * nb; const bool okn = (n0 + (lane & 31)) < N;
#pragma unroll 16
    for (int i = 0; i < 32; ++i) { const int kk = 2 * i + (lane >> 5); scr[kk * 33 + (lane & 31)] = okn ? W[(size_t)(k0 + kk) * N + n0 + (lane & 31)] : 0.f; }
    LDS_WAIT(); asm volatile("" ::: "memory");
    const int c = lane & 7;
#pragma unroll
    for (int j = 0; j < 4; ++j) { const int n = (lane >> 3) + 8 * j; const LAS float* s = scr + (8 * c) * 33 + n;
        v4u o; o.x = pk2(s[0 * 33], s[1 * 33]); o.y = pk2(s[2 * 33], s[3 * 33]); o.z = pk2(s[4 * 33], s[5 * 33]); o.w = pk2(s[6 * 33], s[7 * 33]);
        *(GAS v4u*)(WT + (size_t)(n0 + n) * K + k0 + 8 * c) = o; }
    LDS_WAIT(); asm volatile("" ::: "memory");
}
struct P0Args { const float *c, *c_ctx, *norm1_g, *norm2_g, *w_mod, *b_mod, *w_in, *w_out, *w_ff1, *w_ff2, *cache_k, *cache_v; unsigned char* ws; };
constexpr int T_IN = 32 * 145, T_OUT = 32 * 64, T_F1 = 32 * 256, T_F2 = 128 * 64, T_L = T_IN + T_OUT + T_F1 + T_F2;
__device__ __forceinline__ void transpose_layer(const float* w_in, const float* w_out, const float* w_ff1, const float* w_ff2, unsigned char* ws, int l, LAS float* scr, int wi0, int wstride, int lane) {
    asm volatile("" : "+v"(lane));
    for (int wi = wi0; wi < T_L; wi += wstride) {
        int r = wi;
        if (r < T_IN) { p0_transpose_item(w_in + (size_t)l * 2048 * DIN, 2048, DIN, (bf16*)(ws + WS_WIN) + (size_t)l * DINP * 2048, scr, r, lane); continue; } r -= T_IN;
        if (r < T_OUT) { p0_transpose_item(w_out + (size_t)l * 2048 * 2048, 2048, 2048, (bf16*)(ws + WS_WOUT) + (size_t)l * 2048 * 2048, scr, r, lane); continue; } r -= T_OUT;
        if (r < T_F1) { p0_transpose_item(w_ff1 + (size_t)l * 2048 * DFF, 2048, DFF, (bf16*)(ws + WS_WFF1) + (size_t)l * DFF * 2048, scr, r, lane); continue; } r -= T_F1;
        p0_transpose_item(w_ff2 + (size_t)l * DFF * 2048, DFF, 2048, (bf16*)(ws + WS_WFF2) + (size_t)l * 2048 * DFF, scr, r, lane);
    }
}
__device__ __forceinline__ void p0_prologue(const P0Args& a, ldsp lds, unsigned* queue, volatile LAS unsigned* misc, int tid, int lane, int wave, int G) {
    asm volatile("" : "+v"(tid), "+v"(lane));
    LAS float* silu_t = (LAS float*)lds;
    LAS float* scr = (LAS float*)(lds + 73728 + wave * 8448);
    constexpr int N_MOD = 96;
    constexpr int N_CVT = 512, N_ROPE = 256, N_TR = DEPTH * T_L / 8, N_ITEMS = N_MOD + N_CVT + N_ROPE + N_TR;
    static_assert((DEPTH * T_L) % 8 == 0, "transposes");
    bool have_silu = false;
    float* MOD = (float*)(a.ws + WS_MOD);
    for (;;) {
        if (tid == 0) misc[0] = atomicAdd(queue, 1u);
        __syncthreads(); const int it = (int)misc[0]; __syncthreads();
        if (it >= N_ITEMS) break;
        if (it < N_MOD) {
            if (!have_silu) { have_silu = true;
                for (int i = tid; i < 9 * 2048; i += NWAVES * 64) { const float x = i < 8 * 2048 ? a.c[i] : a.c_ctx[i - 8 * 2048]; silu_t[i] = x / (1.f + expf(-x)); }
                __syncthreads(); }
            const int wi = it * 8 + wave, l = wi / 192, cb = wi % 192, j = cb * 64 + lane;
            float acc[9];
#pragma unroll
            for (int c = 0; c < 9; ++c) acc[c] = 0.f;
            const float* wp = a.w_mod + (size_t)l * 2048 * 12288 + j;
            for (int k0 = 0; k0 < 2048; k0 += 32) {
                float w[32];
#pragma unroll
                for (int i = 0; i < 32; ++i) w[i] = wp[(size_t)(k0 + i) * 12288];
#pragma unroll
                for (int c = 0; c < 9; ++c)
#pragma unroll
                    for (int i4 = 0; i4 < 8; ++i4) { const f32x4 s = *(const LAS f32x4*)(silu_t + c * 2048 + k0 + 4 * i4);
                        acc[c] += s.x * w[4 * i4] + s.y * w[4 * i4 + 1] + s.z * w[4 * i4 + 2] + s.w * w[4 * i4 + 3]; }
            }
            const int slot = j >> 11, col = j & 2047; const float bm = a.b_mod[l * 12288 + j];
            const float gn = slot == 1 ? a.norm1_g[l * 2048 + col] : (slot == 4 ? a.norm2_g[l * 2048 + col] : 0.f);
#pragma unroll
            for (int c = 0; c < 9; ++c) { float v = acc[c] + bm; if (slot == 1 || slot == 4) v = gn * (1.f + v); MOD[(size_t)(l * 9 + c) * 12288 + j] = v; }
        } else if (it < N_MOD + N_CVT) {
            const int ci = it - N_MOD;
#pragma unroll
            for (int s = 0; s < 4; ++s) { const size_t e8 = (size_t)ci * 2048 + s * 512 + tid; const bool isv = e8 >= 524288; const size_t j8 = isv ? e8 - 524288 : e8;
                const float* src = (isv ? a.cache_v : a.cache_k) + j8 * 8; const f32x4 x0 = *(const f32x4*)src, x1 = *(const f32x4*)(src + 4);
                v4u o; o.x = pk2(x0.x, x0.y); o.y = pk2(x0.z, x0.w); o.z = pk2(x1.x, x1.y); o.w = pk2(x1.z, x1.w);
                *(v4u*)((bf16*)(a.ws + (isv ? WS_CV : WS_CK)) + j8 * 8) = o; }
        } else if (it < N_MOD + N_CVT + N_ROPE) {
            const int e = (it - N_MOD - N_CVT) * 512 + tid, t = e >> 6, i = e & 63;
            const float inv = powf(10000.f, -(float)(2 * (i & 31)) / 64.f); const float pos = i < 32 ? (float)(t >> 6) : (float)(t & 63); const float ang = pos * inv;
            ((float*)(a.ws + WS_ROPE))[e] = cosf(ang); ((float*)(a.ws + WS_ROPE))[131072 + e] = sinf(ang);
        } else {
            const int wi = (it - N_MOD - N_CVT - N_ROPE) * 8 + wave, l = wi / T_L;
            transpose_layer(a.w_in, a.w_out, a.w_ff1, a.w_ff2, a.ws, l, scr, wi % T_L, T_L, lane);
        }
    }
}
__device__ __forceinline__ void p0b_bias(unsigned char* ws, ldsp lds, int tid, int lane, int wave, int G) {
    asm volatile("" : "+v"(tid), "+v"(lane));
    LAS float* sh = (LAS float*)lds;
    const float* MOD = (const float*)(ws + WS_MOD); float* BW = (float*)(ws + WS_BW);
    constexpr int NB1 = DINP / 64, NB2 = DFF / 64, NBL = NB1 + NB2;
    int cur = -1;
    for (int it = blockIdx.x; it < DEPTH * NBL; it += G) {
        const int l = it / NBL, r = it % NBL, which = r >= NB1 ? 1 : 0, rb = which ? r - NB1 : r, key = l * 2 + which;
        if (key != cur) { __syncthreads(); cur = key;
            for (int i = tid; i < 9 * 2048; i += NWAVES * 64) sh[i] = MOD[(size_t)(l * 9 + (i >> 11)) * 12288 + (which ? 3 : 0) * 2048 + (i & 2047)];
            __syncthreads(); }
        const bf16* WT = which ? (const bf16*)(ws + WS_WFF1) + (size_t)l * DFF * 2048 : (const bf16*)(ws + WS_WIN) + (size_t)l * DINP * 2048;
        const int ldb = which ? DFF : DINP; float* bwp = BW + (size_t)l * BW_L + (which ? 9 * DINP : 0);
#pragma unroll 1
        for (int rr = 0; rr < 8; rr += 2) { const int n = rb * 64 + wave * 8 + rr; const bf16* wr_ = WT + (size_t)n * 2048 + lane * 8;
            v4u q[2][4];
#pragma unroll
            for (int u = 0; u < 2; ++u)
#pragma unroll
                for (int j = 0; j < 4; ++j) q[u][j] = *(const v4u*)(wr_ + (size_t)u * 2048 + 512 * j);
            float res0 = 0.f, res1 = 0.f;
#pragma unroll 1
            for (int c = 0; c < 9; ++c) { float s0 = 0.f, s1 = 0.f;
#pragma unroll
                for (int j = 0; j < 4; ++j) { const f32x4 a0 = *(const LAS f32x4*)(sh + c * 2048 + 512 * j + lane * 8), a1 = *(const LAS f32x4*)(sh + c * 2048 + 512 * j + lane * 8 + 4);
                    s0 += a0.x * bflo(q[0][j].x) + a0.y * bfhi(q[0][j].x) + a0.z * bflo(q[0][j].y) + a0.w * bfhi(q[0][j].y) + a1.x * bflo(q[0][j].z) + a1.y * bfhi(q[0][j].z) + a1.z * bflo(q[0][j].w) + a1.w * bfhi(q[0][j].w);
                    s1 += a0.x * bflo(q[1][j].x) + a0.y * bfhi(q[1][j].x) + a0.z * bflo(q[1][j].y) + a0.w * bfhi(q[1][j].y) + a1.x * bflo(q[1][j].z) + a1.y * bfhi(q[1][j].z) + a1.z * bflo(q[1][j].w) + a1.w * bfhi(q[1][j].w); }
                s0 = wave_sum(s0); s1 = wave_sum(s1); res0 = (lane == c) ? s0 : res0; res1 = (lane == c) ? s1 : res1; }
            if (lane < 9) { bwp[(size_t)lane * ldb + n] = res0; bwp[(size_t)lane * ldb + n + 1] = res1; } }
    }
    __syncthreads();
}

template <bool FINAL>
__device__ __forceinline__ void norm_phase(const float* x0, const float* x1, const float* modA, bf16* xb, bf16* xa, unsigned long long* ssq, float* outf, int lane, int wave, int G) {
    asm volatile("" : "+v"(lane)); asm volatile("" : "+s"(wave), "+s"(G));
    const int rpw = (M + G - 1) / G, r0 = blockIdx.x * rpw, r1 = min(M, r0 + rpw);
    f32x4 A[8]; int cur = -1;
    for (int r = r0 + wave; r < r1; r += NWAVES) {
        const int cond = FINAL ? 0 : (r < NCTX ? 8 : ((r - NCTX) >> 11));
        if (cond != cur) { cur = cond;
#pragma unroll
            for (int j = 0; j < 8; ++j) A[j] = *(const f32x4*)(modA + (size_t)cond * 12288 + 4 * lane + 256 * j); }
        f32x4 v[8]; float ss = 0.f;
        if (FINAL) {
#pragma unroll
            for (int j = 0; j < 8; ++j) { const v2u w = *(const v2u*)(xb + (size_t)r * D + 4 * lane + 256 * j); v[j] = (f32x4){bflo(w.x), bfhi(w.x), bflo(w.y), bfhi(w.y)}; }
        } else { const float* xr = r < NCTX ? x0 + (size_t)r * D : x1 + (size_t)(r - NCTX) * D;
#pragma unroll
            for (int j = 0; j < 8; ++j) v[j] = *(const f32x4*)(xr + 4 * lane + 256 * j); }
#pragma unroll
        for (int j = 0; j < 8; ++j) ss += (v[j].x * v[j].x + v[j].y * v[j].y) + (v[j].z * v[j].z + v[j].w * v[j].w);
        ss = wave_sum(ss);
        if (FINAL) { const float rstd = rsqrtf(ss * (1.f / D) + EPS);
#pragma unroll
            for (int j = 0; j < 8; ++j) *(f32x4*)(outf + (size_t)r * D + 4 * lane + 256 * j) = v[j] * rstd * A[j];
        } else {
#pragma unroll
            for (int j = 0; j < 8; ++j) { const f32x4 y = v[j] * A[j]; v2u o; o.x = pk2(y.x, y.y); o.y = pk2(y.z, y.w); *(v2u*)(xa + (size_t)r * D + 4 * lane + 256 * j) = o;
                v2u xo; xo.x = pk2(v[j].x, v[j].y); xo.y = pk2(v[j].z, v[j].w); *(v2u*)(xb + (size_t)r * D + 4 * lane + 256 * j) = xo; }
            if (lane == 0) { const float hi = floorf(ss); ssq[r] = ((unsigned long long)(unsigned)hi << 24) + (unsigned long long)(unsigned)((ss - hi) * 16777216.f); }
        }
    }
}

#ifndef PROBE_DUP
#define PROBE_DUP 0
#endif
constexpr int P_KT = 0, P_QT = 17408, P_KTT = 34816, P_VT = 53248, P_T1 = 71680, P_T2 = 71680 + 18432, P_AM = 108544, P_GL = 141312;
struct LayerP { const float *conv_w, *a_log, *dt_bias, *dn_norm_g, *sgu_norm_g, *sgu_w, *sgu_b, *sink; };
__device__ __forceinline__ void dn_prep_unit(const LayerP& P, const bf16* zb, unsigned char* dn, ldsp lds, int gchunk, int h, int tid, int lane, int wave) {
    asm volatile("" : "+v"(tid), "+v"(lane));
    const bool isctx = gchunk < 64; const int pc = isctx ? (gchunk & 3) : ((gchunk - 64) & 31); const int T = isctx ? 256 : 2048;
    const long grow0 = (long)gchunk * 64; unsigned char* blk = dn + (size_t)(gchunk * 4 + h) * DN_BLK;
    LAS float* GL = (LAS float*)(lds + P_GL);
    for (int rep_ = 0; rep_ < ((PROBE_DUP & 1024) ? 2 : 1); ++rep_) {
    if (wave == 0) {
        const bf16* zr = zb + (size_t)(grow0 + lane) * DINP + C_DAB;
#pragma unroll
        for (int d = 0; d < 2; ++d) {
            const float alpha = bf2f(zr[d * 8 + h]), braw = bf2f(zr[d * 8 + 4 + h]);
            const float xr = alpha + P.dt_bias[d * 4 + h]; const float sp = fmaxf(xr, 0.f) + log1pf(expf(-fabsf(xr)));
            const float g = -expf(P.a_log[d * 4 + h]) * sp; const float beta = 1.f / (1.f + expf(-braw));
            float gc = g;
#pragma unroll
            for (int o = 1; o < 64; o <<= 1) { const int src = (d == 0) ? lane - o : lane + o;
                const float t = __builtin_bit_cast(float, __builtin_amdgcn_ds_bpermute((src & 63) << 2, __builtin_bit_cast(int, gc))); const bool ok = (d == 0) ? (lane >= o) : (lane + o < 64); gc += ok ? t : 0.f; }
            const float gl = wave_sum(g); const float eg = expf(gc), egl = expf(gl - gc);
            GL[d * 64 + lane] = gc; GL[128 + d * 64 + lane] = beta; GL[256 + d * 64 + lane] = beta * eg;
            float* gv = (float*)(blk + DN_DIR0 + d * DN_DIRSZ + 40960);
            gv[lane] = eg; gv[64 + lane] = egl; if (lane == 0) gv[128] = expf(gl);
        }
    }
    {
        const float* cw = P.conv_w; const int cq = h * 128 + 2 * lane;
        f32x2 wq[5], wk[5], wv[5];
#pragma unroll
        for (int j = 0; j < 5; ++j) { wq[j] = *(const f32x2*)(cw + j * 1536 + cq); wk[j] = *(const f32x2*)(cw + j * 1536 + 512 + cq); wv[j] = *(const f32x2*)(cw + j * 1536 + 1024 + cq); }
        unsigned xq[12], xk[12], xv[12];
#pragma unroll
        for (int rr = 0; rr < 12; ++rr) { const int tl = 8 * wave - 2 + rr, tpos = pc * 64 + tl; const bool ok = tpos >= 0 && tpos < T;
            const bf16* zr = zb + (grow0 + tl) * (long)DINP + h * 128 + 2 * lane;
            xq[rr] = ok ? *(const unsigned*)(zr + C_DQ) : 0u; xk[rr] = ok ? *(const unsigned*)(zr + C_DK) : 0u; xv[rr] = ok ? *(const unsigned*)(zr + C_DV) : 0u; }
        float k0s[8], k1s[8], v0s[8], v1s[8];
        LAS bf16* Kt = (LAS bf16*)(lds + P_KT); LAS bf16* Qt = (LAS bf16*)(lds + P_QT);
#pragma unroll
        for (int tt = 0; tt < 8; ++tt) {
            float q0 = 0.f, q1 = 0.f, k0 = 0.f, k1 = 0.f, v0 = 0.f, v1 = 0.f;
#pragma unroll
            for (int j = 0; j < 5; ++j) { q0 += bflo(xq[tt + j]) * wq[j].x; q1 += bfhi(xq[tt + j]) * wq[j].y; k0 += bflo(xk[tt + j]) * wk[j].x; k1 += bfhi(xk[tt + j]) * wk[j].y;
                v0 += bflo(xv[tt + j]) * wv[j].x; v1 += bfhi(xv[tt + j]) * wv[j].y; }
            q0 = silu_f(q0); q1 = silu_f(q1); k0 = silu_f(k0); k1 = silu_f(k1); v0 = silu_f(v0); v1 = silu_f(v1);
            const float rq = rsqrtf(wave_sum(q0 * q0 + q1 * q1) + EPS) * 0.08838834764831845f, rk = rsqrtf(wave_sum(k0 * k0 + k1 * k1) + EPS);
            q0 *= rq; q1 *= rq; k0 *= rk; k1 *= rk;
            const int t = 8 * wave + tt;
            *(LAS unsigned*)(Qt + t * 136 + 2 * lane) = pk2(q0, q1); *(LAS unsigned*)(Kt + t * 136 + 2 * lane) = pk2(k0, k1);
            k0s[tt] = k0; k1s[tt] = k1; v0s[tt] = v0; v1s[tt] = v1;
        }
        LAS bf16* KT = (LAS bf16*)(lds + P_KTT); LAS bf16* VT = (LAS bf16*)(lds + P_VT);
        v4u o;
        o.x = pk2(k0s[0], k0s[1]); o.y = pk2(k0s[2], k0s[3]); o.z = pk2(k0s[4], k0s[5]); o.w = pk2(k0s[6], k0s[7]); *(LAS v4u*)(KT + (2 * lane) * 72 + 8 * wave) = o;
        o.x = pk2(k1s[0], k1s[1]); o.y = pk2(k1s[2], k1s[3]); o.z = pk2(k1s[4], k1s[5]); o.w = pk2(k1s[6], k1s[7]); *(LAS v4u*)(KT + (2 * lane + 1) * 72 + 8 * wave) = o;
        o.x = pk2(v0s[0], v0s[1]); o.y = pk2(v0s[2], v0s[3]); o.z = pk2(v0s[4], v0s[5]); o.w = pk2(v0s[6], v0s[7]); *(LAS v4u*)(VT + (2 * lane) * 72 + 8 * wave) = o;
        o.x = pk2(v1s[0], v1s[1]); o.y = pk2(v1s[2], v1s[3]); o.z = pk2(v1s[4], v1s[5]); o.w = pk2(v1s[6], v1s[7]); *(LAS v4u*)(VT + (2 * lane + 1) * 72 + 8 * wave) = o;
    }
    __syncthreads();
    }
    for (int rep_ = 0; rep_ < ((PROBE_DUP & 4096) ? 2 : 1); ++rep_) {
    {
        const int hh = lane >> 5, cl = lane & 31; LAS float* AM = (LAS float*)(lds + P_AM);
        f32x16 acc = {};
        if (wave < 4) {
            const int rt = wave >> 1, ct = wave & 1;
            acc = mma_lds(lds + P_KT + 32 * rt * 272, 272, lds + P_KT + 32 * ct * 272, 272, 8, lane, acc);
            const int c = 32 * ct + cl; const float g0c = GL[c], g1c = GL[64 + c];
#pragma unroll
            for (int q = 0; q < 4; ++q) { const int r0 = 32 * rt + 8 * q + 4 * hh;
                const f32x4 g0 = *(const LAS f32x4*)(GL + r0), g1 = *(const LAS f32x4*)(GL + 64 + r0), b0 = *(const LAS f32x4*)(GL + 128 + r0), b1 = *(const LAS f32x4*)(GL + 192 + r0);
#pragma unroll
                for (int e = 0; e < 4; ++e) { const int rr = r0 + e; const float v = acc[4 * q + e];
                    if (rr > c) AM[rr * 64 + c] = b0[e] * v * __expf(g0[e] - g0c);
                    if (rr < c) AM[4096 + (63 - rr) * 64 + (63 - c)] = b1[e] * v * __expf(g1[e] - g1c); } }
        } else {
            const int cb = (wave - 4) >> 1, it = (wave - 4) & 1;
            acc = mma_lds(lds + P_KT + 32 * cb * 272, 272, lds + P_QT + 32 * it * 272, 272, 8, lane, acc);
            const int i = 32 * it + cl; const float g0i = GL[i], g1i = GL[64 + i];
            f32x16 a0, a1;
#pragma unroll
            for (int q = 0; q < 4; ++q) { const int c0 = 32 * cb + 8 * q + 4 * hh; const f32x4 g0 = *(const LAS f32x4*)(GL + c0), g1 = *(const LAS f32x4*)(GL + 64 + c0);
#pragma unroll
                for (int e = 0; e < 4; ++e) { const int c = c0 + e; const float v = acc[4 * q + e];
                    a0[4 * q + e] = (i >= c) ? v * __expf(fminf(g0i - g0[e], 0.f)) : 0.f; a1[4 * q + e] = (i <= c) ? v * __expf(fminf(g1i - g1[e], 0.f)) : 0.f; } }
            unsigned char* q0p = blk + DN_DIR0 + 32768 + ((cb * 2 + it) * 2) * 1024 + lane * 16; unsigned char* q1p = q0p + DN_DIRSZ;
            *(bf16x8*)(q0p) = pack8<0>(a0); *(bf16x8*)(q0p + 1024) = pack8<1>(a0); *(bf16x8*)(q1p) = pack8<0>(a1); *(bf16x8*)(q1p + 1024) = pack8<1>(a1);
        }
    }
    __syncthreads();
    }
    for (int rep_ = 0; rep_ < ((PROBE_DUP & 2048) ? 2 : 1); ++rep_) {
    if (wave < 2) {
        const int dir = wave; const LAS float* Am = (const LAS float*)(lds + P_AM) + dir * 4096;
        float Tr[64]; f32x4 cA[16], cB[16];
#define SOLVE_LOAD(dst, i_) do { _Pragma("unroll") for (int q = 0; q < 16; ++q) if (4 * q < (i_)) dst[q] = *(const LAS f32x4*)(Am + (i_) * 64 + 4 * q); } while (0)
#define SOLVE_ROW(src, i_) do { float a0 = (lane == (i_)) ? 1.f : 0.f, a1 = 0.f, a2 = 0.f, a3 = 0.f; \
            _Pragma("unroll") for (int q = 0; q < 16; ++q) { const int jb = 4 * q; \
                if (jb + 0 < (i_)) a0 -= src[q].x * Tr[jb + 0]; if (jb + 1 < (i_)) a1 -= src[q].y * Tr[jb + 1]; if (jb + 2 < (i_)) a2 -= src[q].z * Tr[jb + 2]; if (jb + 3 < (i_)) a3 -= src[q].w * Tr[jb + 3]; } \
            Tr[i_] = (a0 + a1) + (a2 + a3); } while (0)
        Tr[0] = (lane == 0) ? 1.f : 0.f;
        SOLVE_LOAD(cA, 1);
#pragma unroll
        for (int i = 1; i < 64; i += 2) {
            if (i + 1 < 64) SOLVE_LOAD(cB, i + 1);
            asm volatile("" ::: "memory");
            SOLVE_ROW(cA, i);
            if (i + 2 < 64) SOLVE_LOAD(cA, i + 2);
            asm volatile("" ::: "memory");
            if (i + 1 < 64) SOLVE_ROW(cB, i + 1);
        }
#undef SOLVE_LOAD
#undef SOLVE_ROW
        const int j = dir ? 63 - lane : lane; const float s1 = GL[256 + dir * 64 + j], s2 = GL[128 + dir * 64 + j];
        LAS bf16* T1 = (LAS bf16*)(lds + P_T1) + dir * 4608; LAS bf16* T2 = (LAS bf16*)(lds + P_T2) + dir * 4608;
#pragma unroll
        for (int ii = 0; ii < 64; ++ii) { const int i = dir ? 63 - ii : ii; T1[i * 72 + j] = (bf16)(pk2(Tr[ii] * s1, 0.f) & 0xffffu); T2[i * 72 + j] = (bf16)(pk2(Tr[ii] * s2, 0.f) & 0xffffu); }
    } else {
        const int hh = lane >> 5, rl = lane & 31;
        for (int b = wave - 2; b < 32; b += 6) {
            v2u lo, hi;
            if (b < 16) { const int it = b >> 3, db = (b >> 1) & 3, s = b & 1; const LAS bf16* p = (const LAS bf16*)(lds + P_QT) + (32 * it + rl) * 136 + 32 * db + 16 * s + 4 * hh; lo = *(const LAS v2u*)p; hi = *(const LAS v2u*)(p + 8); }
            else { const int bb = b - 16, dt = bb >> 2, cb = (bb >> 1) & 1, s = bb & 1; const LAS bf16* p = (const LAS bf16*)(lds + P_KTT) + (32 * dt + rl) * 72 + 32 * cb + 16 * s + 4 * hh; lo = *(const LAS v2u*)p; hi = *(const LAS v2u*)(p + 8); }
            v4u o; o.x = lo.x; o.y = lo.y; o.z = hi.x; o.w = hi.y;
            *(v4u*)(blk + (size_t)b * 1024 + lane * 16) = o;
        }
    }
    __syncthreads();
    }
    for (int rep_ = 0; rep_ < ((PROBE_DUP & 8192) ? 2 : 1); ++rep_) {
#pragma unroll 1
    for (int tix = wave; tix < 32; tix += 8) {
        const int dir = tix >> 4, kind = (tix >> 3) & 1, idx = tix & 7; f32x16 acc = {};
        unsigned char* dst;
        if (kind == 0) { const int ct = idx >> 2, es = idx & 3;
            acc = mma_lds(lds + P_T2 + dir * 9216 + 32 * ct * 144, 144, lds + P_VT + 32 * es * 144, 144, 4, lane, acc);
            dst = blk + DN_DIR0 + dir * DN_DIRSZ + ((ct * 4 + es) * 2) * 1024 + lane * 16;
        } else { const int db = idx >> 1, ct = idx & 1;
            acc = mma_lds(lds + P_KTT + 32 * db * 144, 144, lds + P_T1 + dir * 9216 + 32 * ct * 144, 144, 4, lane, acc);
#pragma unroll
            for (int r = 0; r < 16; ++r) acc[r] = -acc[r];
            dst = blk + DN_DIR0 + dir * DN_DIRSZ + 16384 + ((db * 2 + ct) * 2) * 1024 + lane * 16;
        }
        *(bf16x8*)dst = pack8<0>(acc); *(bf16x8*)(dst + 1024) = pack8<1>(acc);
    }
    __syncthreads();
    }
}

__device__ __forceinline__ void sgu_unit(const LayerP& P, const bf16* zb, bf16* mix, ldsp lds, int rc, int g, bool load_w, int tid, int lane, int wave) {
    asm volatile("" : "+v"(tid), "+v"(lane));
    const size_t grow0 = (size_t)rc * 128; LAS bf16* Wl = (LAS bf16*)lds; LAS bf16* Vt = (LAS bf16*)(lds + 34816);
    {
        const float gn0 = P.sgu_norm_g[g * 128 + 2 * lane], gn1 = P.sgu_norm_g[g * 128 + 2 * lane + 1];
        float v0[16], v1[16];
#pragma unroll
        for (int qq = 0; qq < 16; ++qq) { const unsigned w = *(const unsigned*)(zb + (grow0 + 16 * wave + qq) * DINP + C_SV + g * 128 + 2 * lane);
            const float a = gelu_tanh(bflo(w)), b = gelu_tanh(bfhi(w)); const float r = rsqrtf(wave_sum(a * a + b * b) * (1.f / 128.f) + EPS); v0[qq] = a * r * gn0; v1[qq] = b * r * gn1; }
        v4u o;
        o.x = pk2(v0[0], v0[1]); o.y = pk2(v0[2], v0[3]); o.z = pk2(v0[4], v0[5]); o.w = pk2(v0[6], v0[7]); *(LAS v4u*)(Vt + (2 * lane) * 136 + 16 * wave) = o;
        o.x = pk2(v0[8], v0[9]); o.y = pk2(v0[10], v0[11]); o.z = pk2(v0[12], v0[13]); o.w = pk2(v0[14], v0[15]); *(LAS v4u*)(Vt + (2 * lane) * 136 + 16 * wave + 8) = o;
        o.x = pk2(v1[0], v1[1]); o.y = pk2(v1[2], v1[3]); o.z = pk2(v1[4], v1[5]); o.w = pk2(v1[6], v1[7]); *(LAS v4u*)(Vt + (2 * lane + 1) * 136 + 16 * wave) = o;
        o.x = pk2(v1[8], v1[9]); o.y = pk2(v1[10], v1[11]); o.z = pk2(v1[12], v1[13]); o.w = pk2(v1[14], v1[15]); *(LAS v4u*)(Vt + (2 * lane + 1) * 136 + 16 * wave + 8) = o;
    }
    if (load_w) {
        const int p = tid >> 2, q0 = (tid & 3) * 32; const float* src = P.sgu_w + ((size_t)g * 128 + p) * 128 + q0;
#pragma unroll
        for (int j = 0; j < 4; ++j) { const f32x4 x0 = *(const f32x4*)(src + 8 * j), x1 = *(const f32x4*)(src + 8 * j + 4);
            v4u o; o.x = pk2(x0.x, x0.y); o.y = pk2(x0.z, x0.w); o.z = pk2(x1.x, x1.y); o.w = pk2(x1.z, x1.w); *(LAS v4u*)(Wl + p * 136 + q0 + 8 * j) = o; }
    }
    __syncthreads();
    {
        const int pt = wave >> 1, hh = lane >> 5, cl = lane & 31; LAS float* Ms = (LAS float*)(lds + 69632 + wave * 8704);
#pragma unroll
        for (int cc = 0; cc < 2; ++cc) { const int ct = 2 * (wave & 1) + cc; f32x16 acc = {};
            acc = mma_lds(lds + 32 * pt * 272, 272, lds + 34816 + 32 * ct * 272, 272, 8, lane, acc);
#pragma unroll
            for (int q = 0; q < 4; ++q) { const f32x4 bq = *(const f32x4*)(P.sgu_b + g * 128 + 32 * pt + 8 * q + 4 * hh);
#pragma unroll
                for (int e = 0; e < 4; ++e) Ms[(8 * q + 4 * hh + e) * 68 + 32 * cc + cl] = acc[4 * q + e] + bq[e]; } }
        LDS_WAIT(); asm volatile("" ::: "memory");
        const int row = lane >> 1, c0 = (lane & 1) * 32; const size_t grow = grow0 + 32 * pt + row; const int gcol = g * 128 + 64 * (wave & 1) + c0;
        const bf16* sup = zb + grow * DINP + C_SU + gcol; bf16* op = mix + grow * D + 1536 + gcol;
#pragma unroll
        for (int j = 0; j < 4; ++j) { const v4u su = *(const v4u*)(sup + 8 * j); const f32x4 m0 = *(const LAS f32x4*)(Ms + row * 68 + c0 + 8 * j), m1 = *(const LAS f32x4*)(Ms + row * 68 + c0 + 8 * j + 4);
            v4u o; o.x = pk2(gelu_tanh(bflo(su.x)) * m0.x, gelu_tanh(bfhi(su.x)) * m0.y); o.y = pk2(gelu_tanh(bflo(su.y)) * m0.z, gelu_tanh(bfhi(su.y)) * m0.w);
            o.z = pk2(gelu_tanh(bflo(su.z)) * m1.x, gelu_tanh(bfhi(su.z)) * m1.y); o.w = pk2(gelu_tanh(bflo(su.w)) * m1.z, gelu_tanh(bfhi(su.w)) * m1.w);
            *(v4u*)(op + 8 * j) = o; }
    }
    __syncthreads();
}

__device__ __forceinline__ void rope_item(bf16* zb, const float* ropet, int ri, int lane, int wave) {
    asm volatile("" : "+v"(lane));
    const int hf = (lane >> 4) & 1, ip = (lane & 15) * 2;
#pragma unroll 1
    for (int t4 = 0; t4 < 8; t4 += 4) {
        unsigned wa[4][5], wb[4][5]; f32x2 cs[4], sn[4]; bf16* pp[4];
#pragma unroll
        for (int u = 0; u < 4; ++u) { const int tl = ri * 64 + wave * 8 + t4 + u, t = tl & 2047; pp[u] = zb + (size_t)(NCTX + tl) * DINP + 64 * hf + ip;
            cs[u] = *(const f32x2*)(ropet + t * 64 + 32 * hf + ip); sn[u] = *(const f32x2*)(ropet + 131072 + t * 64 + 32 * hf + ip);
#pragma unroll
            for (int ps = 0; ps < 5; ++ps) { const int hv = ps * 2 + (lane >> 5); const bf16* p = pp[u] + (hv < 8 ? C_AQ + hv * 128 : C_AK + (hv - 8) * 128); wa[u][ps] = *(const unsigned*)p; wb[u][ps] = *(const unsigned*)(p + 32); } }
#pragma unroll
        for (int u = 0; u < 4; ++u)
#pragma unroll
            for (int ps = 0; ps < 5; ++ps) { const int hv = ps * 2 + (lane >> 5); bf16* p = pp[u] + (hv < 8 ? C_AQ + hv * 128 : C_AK + (hv - 8) * 128);
                const float a0 = bflo(wa[u][ps]), a1 = bfhi(wa[u][ps]), b0 = bflo(wb[u][ps]), b1 = bfhi(wb[u][ps]);
                *(unsigned*)p = pk2(a0 * cs[u].x - b0 * sn[u].x, a1 * cs[u].y - b1 * sn[u].y); *(unsigned*)(p + 32) = pk2(b0 * cs[u].x + a0 * sn[u].x, b1 * cs[u].y + a1 * sn[u].y); }
    }
}

constexpr int SC_BUF = 58368;
__device__ __forceinline__ void glds16(const void* g, ldsp l) { __builtin_amdgcn_global_load_lds((const unsigned*)g, (LAS unsigned*)l, 16, 0, 0); }
__device__ __forceinline__ void scan_dma4(const unsigned char* blk, int dir, ldsp buf, int lane, int lw) {
    const unsigned lo = (unsigned)lane * 16u;
#pragma unroll
    for (int i = 0; i < 15; ++i) { const int k = lw + 4 * i;
        if (i < 14 || lw == 0) { const unsigned char* ub = blk + (size_t)k * 1024 + (k >= 32 ? 16384 + dir * (int)DN_DIRSZ : 0); glds16(ub + lo, buf + k * 1024); } }
}
__device__ __forceinline__ void scan_chain(const unsigned char* dn, const float* state0, float* state_out, float* odir, ldsp lds, int isctx, int b, int h, int dir, int lane, int wave) {
    asm volatile("" : "+v"(lane));
    const int hh = lane >> 5, cl = lane & 31; const int nch = isctx ? 4 : 32; const int gch0 = isctx ? b * 4 : 64 + b * 32;
#define BLKOF(n) (dn + (size_t)((gch0 + (dir ? nch - 1 - (n) : (n))) * 4 + h) * DN_BLK)
    if (wave >= 4) {
        scan_dma4(BLKOF(0), dir, lds, lane, wave - 4);
#pragma unroll 1
        for (int n = 0; n < nch; ++n) {
            VM_WAIT(); __builtin_amdgcn_s_barrier(); asm volatile("" ::: "memory");
            if (n + 1 < nch) scan_dma4(BLKOF(n + 1), dir, lds + ((n + 1) & 1) * SC_BUF, lane, wave - 4);
        }
        VM_WAIT(); __builtin_amdgcn_s_barrier(); asm volatile("" ::: "memory");
        return;
    }
    const int es = wave;
    f32x16 S[4];
#pragma unroll
    for (int db = 0; db < 4; ++db) S[db] = f32x16{};
    if (state0) { const float* sp = state0 + (4 * hh) * 128 + 32 * es + cl;
#pragma unroll
        for (int db = 0; db < 4; ++db)
#pragma unroll
            for (int r = 0; r < 16; ++r) S[db][r] = sp[(32 * db + (r & 3) + 8 * (r >> 2)) * 128]; }
#define UPTR(n) (BLKOF(n) + DN_DIR0 + dir * DN_DIRSZ + (es * 2) * 1024 + lane * 16)
    bf16x8 Un[2][2];
    { const unsigned char* up = UPTR(0);
#pragma unroll
      for (int ct = 0; ct < 2; ++ct) { Un[ct][0] = *(const bf16x8*)(up + ct * 8192); Un[ct][1] = *(const bf16x8*)(up + ct * 8192 + 1024); } }
#define SBAR_() __builtin_amdgcn_sched_barrier(0)
#pragma unroll 1
    for (int n = 0; n < nch; ++n) {
        VM_WAIT(); __builtin_amdgcn_s_barrier(); asm volatile("" ::: "memory");
        f32x16 vn[2];
#pragma unroll
        for (int ct = 0; ct < 2; ++ct) { const v4u a = __builtin_bit_cast(v4u, Un[ct][0]), c = __builtin_bit_cast(v4u, Un[ct][1]);
          vn[ct][0] = bflo(a.x); vn[ct][1] = bfhi(a.x); vn[ct][2] = bflo(a.y); vn[ct][3] = bfhi(a.y); vn[ct][4] = bflo(a.z); vn[ct][5] = bfhi(a.z); vn[ct][6] = bflo(a.w); vn[ct][7] = bfhi(a.w);
          vn[ct][8] = bflo(c.x); vn[ct][9] = bfhi(c.x); vn[ct][10] = bflo(c.y); vn[ct][11] = bfhi(c.y); vn[ct][12] = bflo(c.z); vn[ct][13] = bfhi(c.z); vn[ct][14] = bflo(c.w); vn[ct][15] = bfhi(c.w); }
        if (n + 1 < nch) { const unsigned char* up = UPTR(n + 1);
#pragma unroll
            for (int ct = 0; ct < 2; ++ct) { Un[ct][0] = *(const bf16x8*)(up + ct * 8192); Un[ct][1] = *(const bf16x8*)(up + ct * 8192 + 1024); } }
        ldsp buf = lds + (n & 1) * SC_BUF; ldsp fl = buf + lane * 16;
        bf16x8 Sb[4][2];
#pragma unroll
        for (int db = 0; db < 4; ++db) { Sb[db][0] = pack8<0>(S[db]); Sb[db][1] = pack8<1>(S[db]); }
        f32x16 oa[2];
#pragma unroll
        for (int ct = 0; ct < 2; ++ct) {
            bf16x8 Anw[8], Aq[8];
#pragma unroll
            for (int k = 0; k < 8; ++k) { Anw[k] = *(const LAS bf16x8*)(fl + 32768 + (((k >> 1) * 2 + ct) * 2 + (k & 1)) * 1024); Aq[k] = *(const LAS bf16x8*)(fl + ((ct * 4 + (k >> 1)) * 2 + (k & 1)) * 1024); }
            oa[ct] = f32x16{};
            LDS_WAIT(); SBAR_();
#pragma unroll
            for (int k = 0; k < 8; ++k) { vn[ct] = __builtin_amdgcn_mfma_f32_32x32x16_bf16(Anw[k], Sb[k >> 1][k & 1], vn[ct], 0, 0, 0); oa[ct] = __builtin_amdgcn_mfma_f32_32x32x16_bf16(Aq[k], Sb[k >> 1][k & 1], oa[ct], 0, 0, 0); }
            SBAR_();
        }
        bf16x8 V1[2][2], V2[2][2];
        { const float gl = *(const LAS float*)(buf + 57344 + 512);
#pragma unroll
          for (int ct = 0; ct < 2; ++ct) { const LAS float* egl = (const LAS float*)(buf + 57344 + 256) + 32 * ct + 4 * hh; const LAS float* eg = (const LAS float*)(buf + 57344) + 32 * ct + 4 * hh;
            f32x16 vs;
#pragma unroll
            for (int q = 0; q < 4; ++q) { const f32x4 e = *(const LAS f32x4*)(egl + 8 * q), g = *(const LAS f32x4*)(eg + 8 * q);
                vs[4 * q] = vn[ct][4 * q] * e.x; vs[4 * q + 1] = vn[ct][4 * q + 1] * e.y; vs[4 * q + 2] = vn[ct][4 * q + 2] * e.z; vs[4 * q + 3] = vn[ct][4 * q + 3] * e.w;
                oa[ct][4 * q] *= g.x; oa[ct][4 * q + 1] *= g.y; oa[ct][4 * q + 2] *= g.z; oa[ct][4 * q + 3] *= g.w; }
            V1[ct][0] = pack8<0>(vn[ct]); V1[ct][1] = pack8<1>(vn[ct]); V2[ct][0] = pack8<0>(vs); V2[ct][1] = pack8<1>(vs); }
#pragma unroll
          for (int db = 0; db < 4; ++db)
#pragma unroll
              for (int r = 0; r < 16; ++r) S[db][r] *= gl; }
        SBAR_();
        { bf16x8 Aqk[8];
#pragma unroll
          for (int k = 0; k < 8; ++k) Aqk[k] = *(const LAS bf16x8*)(fl + 49152 + k * 1024);
          LDS_WAIT(); SBAR_();
#pragma unroll
          for (int cb = 0; cb < 2; ++cb)
#pragma unroll
              for (int s = 0; s < 2; ++s) { oa[0] = __builtin_amdgcn_mfma_f32_32x32x16_bf16(Aqk[(cb * 2 + 0) * 2 + s], V1[cb][s], oa[0], 0, 0, 0); oa[1] = __builtin_amdgcn_mfma_f32_32x32x16_bf16(Aqk[(cb * 2 + 1) * 2 + s], V1[cb][s], oa[1], 0, 0, 0); }
          SBAR_(); }
#pragma unroll
        for (int half = 0; half < 2; ++half) { bf16x8 Akt[8];
#pragma unroll
            for (int k = 0; k < 8; ++k) Akt[k] = *(const LAS bf16x8*)(fl + 16384 + (half * 8 + k) * 1024);
            LDS_WAIT(); SBAR_();
#pragma unroll
            for (int k = 0; k < 4; ++k) { S[2 * half] = __builtin_amdgcn_mfma_f32_32x32x16_bf16(Akt[k], V2[k >> 1][k & 1], S[2 * half], 0, 0, 0);
                S[2 * half + 1] = __builtin_amdgcn_mfma_f32_32x32x16_bf16(Akt[4 + k], V2[k >> 1][k & 1], S[2 * half + 1], 0, 0, 0); }
            SBAR_(); }
        { const int pc = dir ? nch - 1 - n : n;
#pragma unroll
          for (int ct = 0; ct < 2; ++ct) { unsigned ob = (unsigned)((((gch0 + pc) * 64 + 32 * ct + 4 * hh) * 512 + h * 128 + 32 * es + cl) * 4); asm volatile("" : "+v"(ob));
#pragma unroll
              for (int r = 0; r < 16; ++r) *(float*)((char*)odir + (ob + (unsigned)(((r & 3) + 8 * (r >> 2)) * 2048))) = oa[ct][r]; } }
    }
#undef SBAR_
    if (state_out) {
#pragma unroll
        for (int db = 0; db < 4; ++db)
#pragma unroll
            for (int r = 0; r < 16; ++r) state_out[(size_t)(32 * db + crow(r, hh)) * 128 + 32 * es + cl] = S[db][r];
    }
    VM_WAIT(); LDS_WAIT(); __builtin_amdgcn_s_barrier(); asm volatile("" ::: "memory");
#undef BLKOF
#undef UPTR
}

#define KSWZ(row, colB) ((row) * 256 + ((colB) ^ (((row) & 7) << 4)))
#define SBAR() __builtin_amdgcn_sched_barrier(0)
__device__ __forceinline__ int v_st(int k, int c) { const int kk = (k & ~0xC) | ((k & 4) << 1) | ((k & 8) >> 1); return ((kk >> 3) * 4 + (c >> 5)) * 512 + ((kk & 7) * 32 + (c & 31)) * 2; }
__device__ __forceinline__ int v_rd_base(int lane) { return ((lane & 3) << 3) | (((lane >> 2) & 3) << 6) | (((lane >> 4) & 1) << 5) | (((lane >> 5) & 1) << 8); }
constexpr int v_rd_off(int d0, int ks, int half) { return d0 * 512 + ks * 4096 + half * 2048; }
template <int OFF> __device__ __forceinline__ s16x4 tr_read(int vb) { s16x4 r; asm volatile("ds_read_b64_tr_b16 %0, %1 offset:%2" : "=&v"(r) : "v"(vb), "i"(OFF) : "memory"); return r; }
template <int D0> __device__ __forceinline__ void pv_one(f32x16& od, int vb, bf16x8 pa0, bf16x8 pa1, bf16x8 pa2, bf16x8 pa3) {
    const s16x4 l0 = tr_read<v_rd_off(D0, 0, 0)>(vb), h0 = tr_read<v_rd_off(D0, 0, 1)>(vb), l1 = tr_read<v_rd_off(D0, 1, 0)>(vb), h1 = tr_read<v_rd_off(D0, 1, 1)>(vb);
    const s16x4 l2 = tr_read<v_rd_off(D0, 2, 0)>(vb), h2 = tr_read<v_rd_off(D0, 2, 1)>(vb), l3 = tr_read<v_rd_off(D0, 3, 0)>(vb), h3 = tr_read<v_rd_off(D0, 3, 1)>(vb);
    asm volatile("s_waitcnt lgkmcnt(0)" ::: "memory"); SBAR();
#define PKV(L, H) (bf16x8){L[0], L[1], L[2], L[3], H[0], H[1], H[2], H[3]}
    od = __builtin_amdgcn_mfma_f32_32x32x16_bf16(pa0, PKV(l0, h0), od, 0, 0, 0);
    od = __builtin_amdgcn_mfma_f32_32x32x16_bf16(pa1, PKV(l1, h1), od, 0, 0, 0);
    od = __builtin_amdgcn_mfma_f32_32x32x16_bf16(pa2, PKV(l2, h2), od, 0, 0, 0);
    od = __builtin_amdgcn_mfma_f32_32x32x16_bf16(pa3, PKV(l3, h3), od, 0, 0, 0);
#undef PKV
}
__device__ __forceinline__ void qkt(f32x16& p0, f32x16& p1, ldsp Ks, const bf16x8* qr, int r32, int hi) {
    p0 = f32x16{}; p1 = f32x16{};
#pragma unroll
    for (int d0 = 0; d0 < 8; ++d0) { const int cb = (d0 * 16 + hi * 8) * 2;
        const bf16x8 b0 = *(const LAS bf16x8*)(Ks + KSWZ(r32, cb)); const bf16x8 b1 = *(const LAS bf16x8*)(Ks + KSWZ(32 + r32, cb));
        p0 = __builtin_amdgcn_mfma_f32_32x32x16_bf16(b0, qr[d0], p0, 0, 0, 0); p1 = __builtin_amdgcn_mfma_f32_32x32x16_bf16(b1, qr[d0], p1, 0, 0, 0); }
}
struct AttnP { const bf16* zb; const bf16* ck; const bf16* cv; bf16* mix; const float* sink; int l; };
__device__ __forceinline__ void attn_unit(const AttnP& A, ldsp lds, int u, int tid, int lane, int wave) {
    asm volatile("" : "+v"(tid), "+v"(lane));
    constexpr float C = 0.08838834764831845f * 1.4426950408889634f;
    const int r32 = lane & 31, hi = lane >> 5;
    const bool lat = u < 512; int b, head, q0, T; size_t rowbase;
    if (lat) { q0 = (u & 7) * 256; head = (u >> 3) & 7; b = u >> 6; rowbase = NCTX + (size_t)b * 2048; T = 2048; }
    else { const int uu = u - 512; head = uu & 7; b = uu >> 3; q0 = 0; rowbase = (size_t)b * 256; T = 256; }
    const int kvh = head >> 2, nct = lat ? 8 : 0;
    const int ws = lat ? max(0, q0 - 128) / 64 : 0, we = lat ? min(T, q0 + 384) / 64 : 4, NT = nct + (we - ws);
    const int qw = q0 + 32 * wave;
    ldsp V_lds = lds, K_lds = lds + 32768; LAS float* al = (LAS float*)(lds + 65536) + wave * 64;
    bf16x8 qr[8];
    { const bf16* Qw = A.zb + (rowbase + qw + r32) * DINP + C_AQ + head * 128 + hi * 8;
#pragma unroll
      for (int d0 = 0; d0 < 8; ++d0) qr[d0] = *(const bf16x8*)(Qw + d0 * 16); }
    float m_reg = A.sink[head] * 1.4426950408889634f, l_reg = 1.f; f32x16 o[4] = {};
    const int sr = tid >> 4, sc = (tid & 15) * 8, vst0 = v_st(sr, sc), vst1 = v_st(32 + sr, sc);
    const int vb0 = (int)(unsigned)(size_t)V_lds + v_rd_base(lane);
    bf16x8 ks0, ks1, vs0, vs1;
#define ALOAD(j) do { const bf16 *kp, *vp; size_t st; if ((j) < nct) { kp = A.ck + ((size_t)(b * 4 + A.l) * 512 + (j) * 64) * 256 + kvh * 128; vp = A.cv + ((size_t)(b * 4 + A.l) * 512 + (j) * 64) * 256 + kvh * 128; st = 256; } \
        else { const size_t r0 = rowbase + (size_t)(ws + (j) - nct) * 64; kp = A.zb + r0 * DINP + C_AK + kvh * 128; vp = A.zb + r0 * DINP + C_AV + kvh * 128; st = DINP; } \
        ks0 = *(const bf16x8*)(kp + sr * st + sc); ks1 = *(const bf16x8*)(kp + (32 + sr) * st + sc); vs0 = *(const bf16x8*)(vp + sr * st + sc); vs1 = *(const bf16x8*)(vp + (32 + sr) * st + sc); } while (0)
#define AWRITE(bb) do { *(LAS bf16x8*)(V_lds + (bb) * 16384 + vst0) = vs0; *(LAS bf16x8*)(V_lds + (bb) * 16384 + vst1) = vs1; \
        *(LAS bf16x8*)(K_lds + (bb) * 16384 + KSWZ(sr, sc * 2)) = ks0; *(LAS bf16x8*)(K_lds + (bb) * 16384 + KSWZ(32 + sr, sc * 2)) = ks1; } while (0)
    ALOAD(0); AWRITE(0); __syncthreads();
#pragma unroll 1
    for (int j = 0; j < NT; ++j) {
        if (j + 1 < NT) ALOAD(j + 1);
        bool active = true, needmask = false; int kpos0 = 0;
        if (lat && j >= nct) { kpos0 = (ws + j - nct) * 64; active = (kpos0 + 63 >= qw - 128) && (kpos0 <= qw + 31 + 128); needmask = !((kpos0 >= qw + 31 - 128) && (kpos0 + 63 <= qw + 128)); }
        if (active) {
            f32x16 p0, p1;
            qkt(p0, p1, K_lds + (j & 1) * 16384, qr, r32, hi);
            if (needmask) { const int q = qw + r32;
#pragma unroll
                for (int r = 0; r < 16; ++r) { const int k0 = kpos0 + crow(r, hi) - q, k1 = k0 + 32; if (k0 > 128 || k0 < -128) p0[r] = -1e30f; if (k1 > 128 || k1 < -128) p1[r] = -1e30f; } }
            float pmax = p0[0];
#pragma unroll
            for (int r = 1; r < 16; ++r) pmax = fmaxf(pmax, p0[r]);
#pragma unroll
            for (int r = 0; r < 16; ++r) pmax = fmaxf(pmax, p1[r]);
            { auto rr = __builtin_amdgcn_permlane32_swap(__float_as_uint(pmax), __float_as_uint(pmax), false, false); pmax = fmaxf(__uint_as_float(rr[0]), __uint_as_float(rr[1])); }
            float mn = m_reg, alpha = 1.f;
            if (!__all(pmax * C - m_reg <= 11.5f)) { mn = fmaxf(m_reg, pmax * C); alpha = __builtin_amdgcn_exp2f(m_reg - mn); m_reg = mn; }
            float ps = 0.f;
#pragma unroll
            for (int r = 0; r < 16; ++r) { p0[r] = __builtin_amdgcn_exp2f(fmaf(p0[r], C, -mn)); p1[r] = __builtin_amdgcn_exp2f(fmaf(p1[r], C, -mn)); ps += p0[r] + p1[r]; }
            { auto rr = __builtin_amdgcn_permlane32_swap(__float_as_uint(ps), __float_as_uint(ps), false, false); ps = __uint_as_float(rr[0]) + __uint_as_float(rr[1]); }
            l_reg = l_reg * alpha + ps;
            if (__any(alpha < 1.f)) { if (hi == 0) al[r32] = alpha; LDS_WAIT();
#pragma unroll
                for (int d = 0; d < 4; ++d)
#pragma unroll
                    for (int r = 0; r < 16; ++r) o[d][r] *= al[crow(r, hi)]; }
            bf16x8 pa0, pa1, pa2, pa3;
#define PK4(P, BASE, OUT) do { unsigned a0 = pk2(P[BASE + 0], P[BASE + 1]), a1 = pk2(P[BASE + 2], P[BASE + 3]); unsigned b0 = pk2(P[BASE + 4], P[BASE + 5]), b1 = pk2(P[BASE + 6], P[BASE + 7]); \
    auto r0 = __builtin_amdgcn_permlane32_swap(a0, b0, false, false); auto r1 = __builtin_amdgcn_permlane32_swap(a1, b1, false, false); \
    v4u w = {r0[0], r1[0], r0[1], r1[1]}; OUT = __builtin_bit_cast(bf16x8, w); } while (0)
            PK4(p0, 0, pa0); PK4(p0, 8, pa1); PK4(p1, 0, pa2); PK4(p1, 8, pa3);
#undef PK4
            const int vb = vb0 + (j & 1) * 16384;
            pv_one<0>(o[0], vb, pa0, pa1, pa2, pa3); pv_one<1>(o[1], vb, pa0, pa1, pa2, pa3); pv_one<2>(o[2], vb, pa0, pa1, pa2, pa3); pv_one<3>(o[3], vb, pa0, pa1, pa2, pa3);
        }
        if (j + 1 < NT) AWRITE((j + 1) & 1);
        __syncthreads();
    }
#undef ALOAD
#undef AWRITE
    if (hi == 0) al[r32] = l_reg; LDS_WAIT();
    bf16* Ow = A.mix + (rowbase + qw) * D + head * 128 + r32;
#pragma unroll
    for (int r = 0; r < 16; ++r) { const int orow = crow(r, hi); const float rl = __builtin_amdgcn_rcpf(al[orow]);
#pragma unroll
        for (int d0 = 0; d0 < 4; ++d0) Ow[(size_t)orow * D + d0 * 32] = (bf16)(pk2(o[d0][r] * rl, 0.f) & 0xffffu); }
}

#ifndef PROBE_DUP
#define PROBE_DUP 0
#endif
#ifndef PROBE_T
#define PROBE_T 0
#endif
__device__ __forceinline__ int lane_l() { int t; asm volatile("v_mbcnt_lo_u32_b32 %0, -1, 0\n\tv_mbcnt_hi_u32_b32 %0, -1, %0" : "=v"(t)); return t; }
struct Args { const float* in[24]; float* out; unsigned char* ws; int ph_lo, ph_hi; };
constexpr int NPH = 31;
__global__ void __launch_bounds__(NWAVES * 64, 2) fwd(Args args) {
    extern __shared__ __attribute__((aligned(16))) unsigned char lds_raw[];
    ldsp lds = (ldsp)lds_raw;
    volatile LAS unsigned* MISC = (volatile LAS unsigned*)(lds + LDSCTL_OFF);
    const int wave = __builtin_amdgcn_readfirstlane((int)threadIdx.x >> 6), G = gridDim.x;
#define tid ((wave << 6) | lane_l())
#define lane lane_l()
    unsigned char* ws = args.ws; unsigned* ctl = (unsigned*)(ws + WS_CTL);
    for (int u = tid; u < (LDS_BYTES - LDSCTL_OFF) / 4; u += NWAVES * 64) MISC[u] = 0u;
    __syncthreads();
    const int lo = args.ph_lo, hi = args.ph_hi; const bool multi = (hi - lo) > 1;
    XcdBarrier bar; bar.bar = ctl + CW_BAR; bar.x = 0; bar.st = nullptr; bar.t0 = false;
    if (multi) bar = xcd_barrier_post(ctl + CW_BAR, MISC + 8);
#define IN(k) (lo <= (k) && (k) < hi)
    unsigned long long tacc_ = 0, t0_ = 0;
#define PH_T0(bit) do { if (PROBE_T & (bit)) t0_ = __builtin_amdgcn_s_memrealtime(); } while (0)
#define PH_T1(bit) do { if (PROBE_T & (bit)) tacc_ += __builtin_amdgcn_s_memrealtime() - t0_; } while (0)
#define DUPBAR() do { if (multi) { XcdBarrier b2_ = bar; b2_.t0 = (wave == 0) && (lane_l() == 0); asm volatile("" : "+s"(b2_.bar)); xcd_barrier(b2_); } } while (0)
#if PROBE_DUP & 512
#define SEAM(k) do { if (IN(k) && IN((k) + 1)) { XcdBarrier b2_ = bar; b2_.t0 = (wave == 0) && (lane_l() == 0); asm volatile("" : "+s"(b2_.bar)); xcd_barrier(b2_); xcd_barrier(b2_); } } while (0)
#else
#define SEAM(k) do { if (IN(k) && IN((k) + 1)) { XcdBarrier b2_ = bar; b2_.t0 = (wave == 0) && (lane_l() == 0); asm volatile("" : "+s"(b2_.bar)); xcd_barrier(b2_); } } while (0)
#endif
    const float *x_prompt = args.in[0], *x_sample = args.in[1], *cache_k = args.in[2], *cache_v = args.in[3], *state_delta = args.in[4], *c_in = args.in[5], *c_ctx = args.in[6];
    const float *norm1_g = args.in[7], *w_mod = args.in[8], *b_mod = args.in[9], *w_in = args.in[10], *conv_w = args.in[11], *attn_sink = args.in[12], *dn_a_log = args.in[13], *dn_dt_bias = args.in[14];
    const float *dn_norm_g = args.in[15], *sgu_norm_g = args.in[16], *sgu_w = args.in[17], *sgu_b = args.in[18], *w_out = args.in[19], *norm2_g = args.in[20], *w_ff1 = args.in[21], *w_ff2 = args.in[22], *final_norm_g = args.in[23];
    float* out = args.out;
    float* MOD = (float*)(ws + WS_MOD); bf16* XB = (bf16*)(ws + WS_X); bf16* HB = (bf16*)(ws + WS_HB); bf16* ZB = (bf16*)(ws + WS_ZB); bf16* FB = ZB; bf16* XA = (bf16*)(ws + WS_XA);
    float* ODIR = (float*)(ws + WS_ODIR); unsigned char* DN = ws + WS_DN; unsigned long long* SSQ = (unsigned long long*)(ws + WS_SSQ); const float* BW = (const float*)(ws + WS_BW);

    PH_T0(1);
    if (IN(0)) {
        P0Args pa{c_in, c_ctx, norm1_g, norm2_g, w_mod, b_mod, w_in, w_out, w_ff1, w_ff2, cache_k, cache_v, ws};
        p0_prologue(pa, lds, ctl + CW_ATT + 64 * 16, MISC, tid, lane, wave, G);
        __syncthreads();
#if PROBE_DUP & 4
        p0_prologue(pa, lds, ctl + CW_ATT + 64 * 17, MISC, tid, lane, wave, G); __syncthreads();
#endif
    }
    SEAM(0); PH_T1(1); PH_T0(2);
    if (IN(1)) {
        p0b_bias(ws, lds, tid, lane, wave, G);
        norm_phase<false>(x_prompt, x_sample, MOD + 1 * 2048, XB, XA, SSQ, nullptr, lane, wave, G);
    }
    SEAM(1); PH_T1(2);
#pragma unroll 1
    for (int l = 0; l < DEPTH; ++l) {
        const int pb = 2 + 7 * l;
        const float* modl = MOD + (size_t)l * 9 * 12288;
        if (l == 0) PH_T0(4);
        if (IN(pb + 0)) {
            const bf16* gA = XA; const bf16* gB = (const bf16*)(ws + WS_WIN) + (size_t)l * DINP * 2048; asm volatile("" : "+s"(gA), "+s"(gB));
            pg8::Gemm g{gA, gB, M, DINP, 2048}; pg8::StaticOrder S; S.init(M, DINP, G, (int)blockIdx.x);
            pg8::EpiZ E{ZB, DINP, out + O_K + (size_t)l * 65536, out + O_V + (size_t)l * 65536, SSQ + (size_t)(2 * l) * M, BW + (size_t)l * BW_L};
            pg8::gemm_phase<pg8::EpiZ, pg8::StaticOrder, true, true>(lds, g, S, E, wave);
        }
        SEAM(pb + 0); PH_T1(4); PH_T0(8);
        LayerP LP{conv_w + (size_t)l * 5 * 1536, dn_a_log + l * 8, dn_dt_bias + l * 8, dn_norm_g + l * 128, sgu_norm_g + l * 512, sgu_w + (size_t)l * 4 * 128 * 128, sgu_b + l * 512, attn_sink + l * 8};
        if (IN(pb + 1)) {
            int wg_ = -1;
            for (int it = blockIdx.x; it < 1280 + 640 + 256; it += G) {
                if (it < 1280) dn_prep_unit(LP, ZB, DN, lds, it >> 2, it & 3, tid, lane, wave);
                else if (it < 1920) { const int g_ = (it - 1280) & 3; sgu_unit(LP, ZB, HB, lds, (it - 1280) >> 2, g_, g_ != wg_, tid, lane, wave); wg_ = g_; }
                else if (G == 256 && it >= 2048) {   }
                else rope_item(ZB, (const float*)(ws + WS_ROPE), it - 1920, lane, wave);
            }
            if (G == 256 && (int)blockIdx.x >= 128) rope_item(ZB, (const float*)(ws + WS_ROPE), 128 + ((int)blockIdx.x - 128), lane, wave);
        }
#if PROBE_DUP & 16
        if (IN(pb + 1)) { DUPBAR();
            for (int it = blockIdx.x; it < 1280 + 640; it += G) {
                if (it < 1280) dn_prep_unit(LP, ZB, DN, lds, it >> 2, it & 3, tid, lane, wave);
                else sgu_unit(LP, ZB, HB, lds, (it - 1280) >> 2, (it - 1280) & 3, true, tid, lane, wave);
            } }
#endif
#if PROBE_DUP & 32
        if (IN(pb + 1)) { DUPBAR(); for (int it = blockIdx.x; it < 1280; it += G) dn_prep_unit(LP, ZB, DN, lds, it >> 2, it & 3, tid, lane, wave); }
#endif
        SEAM(pb + 1); PH_T1(8); PH_T0(16);
        if (IN(pb + 2)) {
            for (int cu = blockIdx.x; cu < 192; cu += G) {
                const bool isctx = cu >= 64; const int cc = isctx ? cu - 64 : cu; const int b = cc >> 3, h = (cc >> 1) & 3, dir = cc & 1;
                const float* s0 = isctx ? nullptr : state_delta + ((((size_t)b * 4 + l) * 2 + dir) * 4 + h) * 16384;
                float* so = isctx ? out + O_DELTA + ((((size_t)b * 4 + l) * 2 + dir) * 4 + h) * 16384 : nullptr;
                scan_chain(DN, s0, so, ODIR + (size_t)dir * M * 512, lds, isctx ? 1 : 0, b, h, dir, lane, wave);
            }
            AttnP AP{ZB, (const bf16*)(ws + WS_CK), (const bf16*)(ws + WS_CV), HB, LP.sink, l};
            for (;;) {
                if (tid == 0) MISC[0] = atomicAdd(ctl + CW_ATT + 64 * l, 1u);
                __syncthreads(); const int u = (int)MISC[0]; __syncthreads();
                if (u >= 640) break;
                attn_unit(AP, lds, u, tid, lane, wave);
            }
        }
#if PROBE_DUP & 128
        if (IN(pb + 2)) { DUPBAR();
            for (int cu = blockIdx.x; cu < 192; cu += G) {
                const bool isctx = cu >= 64; const int cc = isctx ? cu - 64 : cu; const int b = cc >> 3, h = (cc >> 1) & 3, dir = cc & 1;
                const float* s0 = isctx ? nullptr : state_delta + ((((size_t)b * 4 + l) * 2 + dir) * 4 + h) * 16384;
                float* so = isctx ? out + O_DELTA + ((((size_t)b * 4 + l) * 2 + dir) * 4 + h) * 16384 : nullptr;
                scan_chain(DN, s0, so, ODIR + (size_t)dir * M * 512, lds, isctx ? 1 : 0, b, h, dir, lane, wave);
            } }
#endif
#if PROBE_DUP & 256
        if (IN(pb + 2)) { DUPBAR();
            AttnP AP{ZB, (const bf16*)(ws + WS_CK), (const bf16*)(ws + WS_CV), HB, LP.sink, l};
            for (;;) {
                if (tid == 0) MISC[0] = atomicAdd(ctl + CW_ATT + 64 * (l + 4), 1u);
                __syncthreads(); const int u = (int)MISC[0]; __syncthreads();
                if (u >= 640) break;
                attn_unit(AP, lds, u, tid, lane, wave);
            } }
#endif
#if PROBE_DUP & 2
        if (IN(pb + 2)) { DUPBAR();
            for (int cu = blockIdx.x; cu < 192; cu += G) {
                const bool isctx = cu >= 64; const int cc = isctx ? cu - 64 : cu; const int b = cc >> 3, h = (cc >> 1) & 3, dir = cc & 1;
                const float* s0 = isctx ? nullptr : state_delta + ((((size_t)b * 4 + l) * 2 + dir) * 4 + h) * 16384;
                float* so = isctx ? out + O_DELTA + ((((size_t)b * 4 + l) * 2 + dir) * 4 + h) * 16384 : nullptr;
                scan_chain(DN, s0, so, ODIR + (size_t)dir * M * 512, lds, isctx ? 1 : 0, b, h, dir, lane, wave);
            }
            AttnP AP{ZB, (const bf16*)(ws + WS_CK), (const bf16*)(ws + WS_CV), HB, LP.sink, l};
            for (;;) {
                if (tid == 0) MISC[0] = atomicAdd(ctl + CW_ATT + 64 * (l + 4), 1u);
                __syncthreads(); const int u = (int)MISC[0]; __syncthreads();
                if (u >= 640) break;
                attn_unit(AP, lds, u, tid, lane, wave);
            } }
#endif
        SEAM(pb + 2); PH_T1(16); PH_T0(32);
        if (IN(pb + 3)) {
            const int ln = lane_l();
            const float gn0 = LP.dn_norm_g[2 * ln], gn1 = LP.dn_norm_g[2 * ln + 1];
            for (int it = blockIdx.x * NWAVES + wave; it < M * 4; it += G * NWAVES) { const size_t row = it >> 2; const int hh = it & 3;
                const f32x2 a = *(const f32x2*)(ODIR + row * 512 + hh * 128 + 2 * ln), b2 = *(const f32x2*)(ODIR + (size_t)M * 512 + row * 512 + hh * 128 + 2 * ln);
                const float o0 = a.x + b2.x, o1 = a.y + b2.y; const float r = rsqrtf(wave_sum(o0 * o0 + o1 * o1) * (1.f / 128.f) + EPS);
                const unsigned z = *(const unsigned*)(ZB + row * DINP + C_DZ + hh * 128 + 2 * ln);
                *(unsigned*)(HB + row * D + 1024 + hh * 128 + 2 * ln) = pk2(o0 * r * gn0 * silu_f(bflo(z)), o1 * r * gn1 * silu_f(bfhi(z))); }
        }
        SEAM(pb + 3); PH_T1(32); PH_T0(64);
        if (IN(pb + 4)) {
            const bf16* gA = HB; const bf16* gB = (const bf16*)(ws + WS_WOUT) + (size_t)l * 2048 * 2048; asm volatile("" : "+s"(gA), "+s"(gB));
            pg8::Gemm g{gA, gB, M, 2048, 2048};
            pg8::EpiRes E{XB, modl + 2 * 2048, modl + 4 * 2048, XA, SSQ + (size_t)(2 * l + 1) * M};
            pg8::StaticOrder S; S.init(M, 2048, G, (int)blockIdx.x, 4);
            pg8::gemm_phase<pg8::EpiRes, pg8::StaticOrder, true, true>(lds, g, S, E, wave);
        }
        SEAM(pb + 4); PH_T1(64); PH_T0(128);
        if (IN(pb + 5)) {
            const bf16* gA = XA; const bf16* gB = (const bf16*)(ws + WS_WFF1) + (size_t)l * DFF * 2048; asm volatile("" : "+s"(gA), "+s"(gB));
            pg8::Gemm g{gA, gB, M, DFF, 2048}; pg8::StaticOrder S; S.init(M, DFF, G, (int)blockIdx.x);
            pg8::EpiRelu2 E{FB, DFF, SSQ + (size_t)(2 * l + 1) * M, BW + (size_t)l * BW_L + 9 * DINP};
            pg8::gemm_phase<pg8::EpiRelu2, pg8::StaticOrder, true, true>(lds, g, S, E, wave);
        }
        SEAM(pb + 5); PH_T1(128); PH_T0(256);
        if (IN(pb + 6)) {
            const bf16* gA = FB; const bf16* gB = (const bf16*)(ws + WS_WFF2) + (size_t)l * 2048 * DFF; asm volatile("" : "+s"(gA), "+s"(gB));
            pg8::Gemm g{gA, gB, M, 2048, DFF};
            pg8::EpiRes E{XB, modl + 5 * 2048, l + 1 < DEPTH ? modl + 9 * 12288 + 1 * 2048 : nullptr, XA, SSQ + (size_t)(2 * l + 2) * M};
            pg8::StaticOrder S; S.init(M, 2048, G, (int)blockIdx.x, 4);
            pg8::gemm_phase<pg8::EpiRes, pg8::StaticOrder, true, true>(lds, g, S, E, wave);
        }
        SEAM(pb + 6); PH_T1(256); PH_T0(4);
    }
    PH_T0(512);
    if (IN(30)) norm_phase<true>(nullptr, nullptr, final_norm_g, XB, nullptr, nullptr, out + O_Y, lane, wave, G);
    PH_T1(512);
    if (PROBE_T && blockIdx.x == 0) { const unsigned long long te_ = __builtin_amdgcn_s_memrealtime() + 4ull * tacc_; while (__builtin_amdgcn_s_memrealtime() < te_) __builtin_amdgcn_s_sleep(64); }
#undef IN
#undef SEAM
#undef DUPBAR
#undef tid
#undef lane
}

#ifndef MK_ONE_LAUNCH
#define MK_ONE_LAUNCH 1
#endif
extern "C" void kernel_launch(void* const* d_in, const int* in_sizes, int n_in, void* d_out, int out_size, void* d_ws, size_t ws_size, hipStream_t stream) {
    static int grid = 0;
    if (grid == 0) {
        if (n_in != 24 || (size_t)out_size != O_END || ws_size < WS_END) { fprintf(stderr, "kernel_launch: unexpected shapes: n_in %d out %d ws %zu (need %zu)\n", n_in, out_size, ws_size, (size_t)WS_END); grid = -1; return; }
        int dev = 0, cus = 0, per_cu = 0;
        if (hipGetDevice(&dev) != hipSuccess || hipDeviceGetAttribute(&cus, hipDeviceAttributeMultiprocessorCount, dev) != hipSuccess) { grid = -1; return; }
        if (hipFuncSetAttribute((const void*)fwd, hipFuncAttributeMaxDynamicSharedMemorySize, LDS_BYTES) != hipSuccess) { fprintf(stderr, "kernel_launch: hipFuncSetAttribute failed\n"); grid = -1; return; }
        if (hipOccupancyMaxActiveBlocksPerMultiprocessor(&per_cu, (const void*)fwd, NWAVES * 64, LDS_BYTES) != hipSuccess || per_cu < 1) fprintf(stderr, "kernel_launch: occupancy query reports %d\n", per_cu);
        (void)hipGetLastError();
        grid = cus;
    }
    if (grid < 0) return;
    (void)hipMemsetAsync((char*)d_ws + WS_CTL, 0, CTL_ZERO_BYTES, stream);
    (void)hipMemsetAsync((char*)d_ws + WS_SSQ, 0, (size_t)9 * M * 8, stream);
    for (int l = 0; l < DEPTH; ++l) (void)hipMemsetAsync((char*)d_ws + WS_WIN + ((size_t)l * DINP + 4640) * 2048 * 2, 0, (size_t)(DINP - 4640) * 2048 * 2, stream);
    Args a{};
    for (int i = 0; i < 24; ++i) a.in[i] = (const float*)d_in[i];
    a.out = (float*)d_out; a.ws = (unsigned char*)d_ws;
#if MK_ONE_LAUNCH
    a.ph_lo = 0; a.ph_hi = NPH;
    hipLaunchKernelGGL(fwd, dim3(grid), dim3(NWAVES * 64), LDS_BYTES, stream, a);
#else
    for (int p = 0; p < NPH; ++p) { a.ph_lo = p; a.ph_hi = p + 1; hipLaunchKernelGGL(fwd, dim3(grid), dim3(NWAVES * 64), LDS_BYTES, stream, a); }
#endif
    const hipError_t le = hipPeekAtLastError();
    if (le != hipSuccess) fprintf(stderr, "kernel_launch: launch failed: %s\n", hipGetErrorName(le));
}
```

```cpp
#include <hip/hip_runtime.h>
#include <cstdio>
#include <cstdint>
namespace pg8 {
#define PG8_LAS __attribute__((address_space(3)))
typedef unsigned short bf16_t;
typedef short bf16x8 __attribute__((ext_vector_type(8)));
typedef float f32x4 __attribute__((ext_vector_type(4)));
typedef unsigned u32x4 __attribute__((ext_vector_type(4)));
constexpr int BM = 256, BK = 64, HALF = 128, HTB = HALF * BK * 2  , STAGE_BYTES = 8 * HTB, NXCD = 8, WGM = 8;

__host__ __device__ __forceinline__ int lds_byte(int r, int c) { const int st = (r >> 4) * 2 + (c >> 5), rr = r & 15, cc = c & 31, ob = rr * 64 + cc * 2; return st * 1024 + (ob ^ (((ob >> 9) & 1) << 5)); }
__host__ __device__ __forceinline__ void stage_rc(int b, int& R, int& C) { const int st = b / 1024, sb = b % 1024, swz = sb ^ (((sb >> 9) & 1) << 5); R = (st >> 1) * 16 + swz / 64; C = (st & 1) * 32 + (swz % 64) / 2; }
__host__ __device__ __forceinline__ int perm32(int rho) { const int n = rho >> 4, i = rho & 15; return 8 * (i >> 2) + 4 * n + (i & 3); }

struct Unit { int pm, pn; };
struct Gemm { const bf16_t* A; const bf16_t* Bt; int M, N, K; };

struct StaticOrder {
    int nM, nN, nwg, G, c, wgm, rev;
    __host__ __device__ void init(int M, int N, int G_, int c_, int wgm_ = WGM, int rev_ = 0) { nM = M / BM; nN = N / BM; nwg = nM * nN; G = G_; c = c_; wgm = wgm_; rev = rev_; }
    __host__ __device__ bool next(int i, Unit& u) const {
        const long L = (long)i * G + c; if (L >= nwg) return false;
        int wgid = (int)L; { const int q = nwg / NXCD, r = nwg % NXCD, xcd = wgid % NXCD, off = wgid / NXCD; wgid = (xcd < r ? xcd * (q + 1) : r * (q + 1) + (xcd - r) * q) + off; }
        const int nig = wgm * nN, gid = wgid / nig, fm = gid * wgm, gsz = (nM - fm) < wgm ? (nM - fm) : wgm;
        u.pm = fm + ((wgid % nig) % gsz); u.pn = (wgid % nig) / gsz; if (rev) u.pm = nM - 1 - u.pm; return true;
    }
    __device__ __forceinline__ void a_ready(const Unit&) const {}
    __device__ __forceinline__ void done(const Unit&) const {}
};


typedef float f32x2c __attribute__((ext_vector_type(2))); typedef __bf16 bf16x2c __attribute__((ext_vector_type(2)));
__device__ __forceinline__ unsigned cvt_pk_bf16(float lo, float hi) { const f32x2c v = {lo, hi}; return __builtin_bit_cast(unsigned, __builtin_convertvector(v, bf16x2c)); }
__device__ __forceinline__ int cond_of(int rowt) { return rowt < 4096 ? 8 : ((rowt - 4096) >> 11); }
struct EpiZ {
    static constexpr bool PERM = true, AFTER_DRAIN = false;
    bf16_t* O; int ldc; float* outk; float* outv; const unsigned long long* ssq; const float* bw;
    __device__ __forceinline__ void operator()(const f32x4 (&acc)[2][2][4][2], const Unit& u, int wr, int wc, int fr, int fq) const {
        asm volatile("" : "+v"(fr), "+v"(fq));
        const int rowt = u.pm * BM, row0 = rowt + wr * 64 + fr; const int col0 = u.pn * BM + wc * 32 + 8 * fq;
        const bool kv = (u.pm < 16) && (u.pn == 4 || u.pn == 5);
        float* ob = (u.pn == 4 ? outk : outv) + (size_t)u.pm * (4 * 65536) + wc * 32 + 8 * fq;
        const float* bp = bw + (size_t)cond_of(rowt) * ldc + col0; f32x4 bv[2][2];
#pragma unroll
        for (int bj = 0; bj < 2; ++bj)
#pragma unroll
            for (int n = 0; n < 2; ++n) bv[bj][n] = *(const f32x4*)(bp + bj * HALF + 4 * n);
#pragma unroll
        for (int ai = 0; ai < 2; ++ai)
#pragma unroll
            for (int m = 0; m < 4; ++m) { const int rl = wr * 64 + fr + ai * HALF + m * 16; bf16_t* rowp = O + (size_t)(row0 + ai * HALF + m * 16) * ldc + col0;
                const float rs = __builtin_amdgcn_rsqf((float)ssq[rowt + rl] * (1.f / (2048.f * 16777216.f)) + 1e-6f);
#pragma unroll
                for (int bj = 0; bj < 2; ++bj) { const f32x4 v0 = acc[ai][bj][m][0] * rs + bv[bj][0], v1 = acc[ai][bj][m][1] * rs + bv[bj][1];
                    u32x4 w; w.x = cvt_pk_bf16(v0[0], v0[1]); w.y = cvt_pk_bf16(v0[2], v0[3]); w.z = cvt_pk_bf16(v1[0], v1[1]); w.w = cvt_pk_bf16(v1[2], v1[3]);
                    *(u32x4*)(rowp + bj * HALF) = w;
                    if (kv) { float* p = ob + (size_t)rl * 256 + bj * HALF; *(f32x4*)p = v0; *(f32x4*)(p + 4) = v1; } } }
    }
};
struct EpiRelu2 {
    static constexpr bool PERM = true, AFTER_DRAIN = false;
    bf16_t* O; int ldc; const unsigned long long* ssq; const float* bw;
    __device__ __forceinline__ void operator()(const f32x4 (&acc)[2][2][4][2], const Unit& u, int wr, int wc, int fr, int fq) const {
        asm volatile("" : "+v"(fr), "+v"(fq));
        const int rowt = u.pm * BM, row0 = rowt + wr * 64 + fr; const int col0 = u.pn * BM + wc * 32 + 8 * fq;
        const float* bp = bw + (size_t)cond_of(rowt) * ldc + col0; f32x4 bv[2][2];
#pragma unroll
        for (int bj = 0; bj < 2; ++bj)
#pragma unroll
            for (int n = 0; n < 2; ++n) bv[bj][n] = *(const f32x4*)(bp + bj * HALF + 4 * n);
#pragma unroll
        for (int ai = 0; ai < 2; ++ai)
#pragma unroll
            for (int m = 0; m < 4; ++m) { bf16_t* rowp = O + (size_t)(row0 + ai * HALF + m * 16) * ldc + col0;
                const float rs = __builtin_amdgcn_rsqf((float)ssq[row0 + ai * HALF + m * 16] * (1.f / (2048.f * 16777216.f)) + 1e-6f);
#pragma unroll
                for (int bj = 0; bj < 2; ++bj) { f32x4 v0 = acc[ai][bj][m][0] * rs + bv[bj][0], v1 = acc[ai][bj][m][1] * rs + bv[bj][1];
#pragma unroll
                    for (int j = 0; j < 4; ++j) { const float a = fmaxf(v0[j], 0.f), b = fmaxf(v1[j], 0.f); v0[j] = a * a; v1[j] = b * b; }
                    u32x4 w; w.x = cvt_pk_bf16(v0[0], v0[1]); w.y = cvt_pk_bf16(v0[2], v0[3]); w.z = cvt_pk_bf16(v1[0], v1[1]); w.w = cvt_pk_bf16(v1[2], v1[3]);
                    *(u32x4*)(rowp + bj * HALF) = w; } }
    }
};
struct EpiRes {
    static constexpr bool PERM = true, AFTER_DRAIN = false;
    bf16_t* x; const float* gate; const float* anext; bf16_t* xa; unsigned long long* ssq;
    __device__ __forceinline__ void operator()(const f32x4 (&acc)[2][2][4][2], const Unit& u, int wr, int wc, int fr, int fq) const {
        asm volatile("" : "+v"(fr), "+v"(fq));
        const int rowt = u.pm * BM, col0 = u.pn * BM + wc * 32 + 8 * fq; const int cond = cond_of(rowt);
        bf16_t* xb = x + (size_t)rowt * 2048; bf16_t* ab = xa + (size_t)rowt * 2048;
        const float* g = gate + (size_t)cond * 12288 + col0; f32x4 gv[2][2], av[2][2];
#pragma unroll
        for (int bj = 0; bj < 2; ++bj)
#pragma unroll
            for (int n = 0; n < 2; ++n) { gv[bj][n] = *(const f32x4*)(g + bj * HALF + 4 * n); av[bj][n] = anext ? *(const f32x4*)(anext + (size_t)cond * 12288 + col0 + bj * HALF + 4 * n) : (f32x4){0.f, 0.f, 0.f, 0.f}; }
        const unsigned offb = (unsigned)((wr * 64 + fr) * 2048 + col0) * 2u;
#pragma unroll
        for (int ai = 0; ai < 2; ++ai) {
            u32x4 xw[4][2];
#pragma unroll
            for (int m = 0; m < 4; ++m) { unsigned voff = offb + (unsigned)(ai * HALF + m * 16) * 4096u; asm volatile("" : "+v"(voff));
#pragma unroll
                for (int bj = 0; bj < 2; ++bj) xw[m][bj] = *(const u32x4*)((const char*)xb + voff + bj * 256); }
            asm volatile("" ::: "memory");
#pragma unroll
            for (int m = 0; m < 4; ++m) { unsigned voff = offb + (unsigned)(ai * HALF + m * 16) * 4096u; asm volatile("" : "+v"(voff));
                char* xp = (char*)xb + voff; char* ap = (char*)ab + voff; float ss = 0.f;
#pragma unroll
                for (int bj = 0; bj < 2; ++bj) { const u32x4 xv = xw[m][bj];
                    const f32x4 x0 = {__uint_as_float(xv.x << 16), __uint_as_float(xv.x & 0xffff0000u), __uint_as_float(xv.y << 16), __uint_as_float(xv.y & 0xffff0000u)};
                    const f32x4 x1 = {__uint_as_float(xv.z << 16), __uint_as_float(xv.z & 0xffff0000u), __uint_as_float(xv.w << 16), __uint_as_float(xv.w & 0xffff0000u)};
                    const f32x4 y0 = x0 + gv[bj][0] * acc[ai][bj][m][0], y1 = x1 + gv[bj][1] * acc[ai][bj][m][1];
                    u32x4 yw; yw.x = cvt_pk_bf16(y0[0], y0[1]); yw.y = cvt_pk_bf16(y0[2], y0[3]); yw.z = cvt_pk_bf16(y1[0], y1[1]); yw.w = cvt_pk_bf16(y1[2], y1[3]); *(u32x4*)(xp + bj * 256) = yw;
                    ss += (y0[0] * y0[0] + y0[1] * y0[1]) + (y0[2] * y0[2] + y0[3] * y0[3]) + (y1[0] * y1[0] + y1[1] * y1[1]) + (y1[2] * y1[2] + y1[3] * y1[3]);
                    if (anext) { const f32x4 a0 = y0 * av[bj][0], a1 = y1 * av[bj][1];
                        u32x4 w; w.x = cvt_pk_bf16(a0[0], a0[1]); w.y = cvt_pk_bf16(a0[2], a0[3]); w.z = cvt_pk_bf16(a1[0], a1[1]); w.w = cvt_pk_bf16(a1[2], a1[3]); *(u32x4*)(ap + bj * 256) = w; } }
                ss += __shfl_xor(ss, 16); ss += __shfl_xor(ss, 32);
                if (fq == 0) { const float hi = floorf(ss); const unsigned long long q = ((unsigned long long)(unsigned)hi << 24) + (unsigned long long)(unsigned)((ss - hi) * 16777216.f);
                    __hip_atomic_fetch_add(ssq + rowt + wr * 64 + fr + ai * HALF + m * 16, q, __ATOMIC_RELAXED, __HIP_MEMORY_SCOPE_AGENT); }
            }
            asm volatile("" ::: "memory");
        }
    }
};
template <class Epi, class Sched, bool ALIGN_EPI = false, bool SP2 = false>
__device__ __forceinline__ void gemm_phase(PG8_LAS unsigned char* lds, const Gemm g, const Sched& S, const Epi& E, const int wave_in) {
    int tid_; asm volatile("v_mbcnt_lo_u32_b32 %0, -1, 0\n\tv_mbcnt_hi_u32_b32 %0, -1, %0" : "=v"(tid_)); tid_ |= (wave_in << 6);
    const int tid = tid_, wid = __builtin_amdgcn_readfirstlane(tid >> 6), lane = tid & 63, wr = wid >> 2, wc = wid & 3, fr = lane & 15, fq = lane >> 4;
    const int K = g.K, nt = K / BK;
    unsigned voffA[2], voffB[2];
#pragma unroll
    for (int i = 0; i < 2; ++i) { int R, C; stage_rc(tid * 16 + i * 8192, R, C); const int Rb = Epi::PERM ? ((R & ~31) + perm32(R & 31)) : R;
        voffA[i] = (unsigned)(R * K + C) * 2u; voffB[i] = (unsigned)(Rb * K + C) * 2u; }
    const size_t kstep = (size_t)(BK * 2);
    const size_t hstep = (size_t)HALF * K * 2;
    const size_t tstep = 2 * hstep;
    const unsigned ldsw = (unsigned)wid * 1024u;
    const int aoff = lds_byte(wr * 64 + fr, fq * 8), boff = lds_byte(wc * 32 + fr, fq * 8);
#define PG8_SA(b, h) (((b) * 2 + (h)) * HTB)
#define PG8_SB(b, h) ((4 + (b) * 2 + (h)) * HTB)
#define PG8_STAGE(bufoff, gbase, voff) do { _Pragma("unroll") for (int _i = 0; _i < 2; ++_i) \
        __builtin_amdgcn_global_load_lds((const unsigned*)((const char*)(gbase) + (voff)[_i]), (PG8_LAS unsigned*)(lds + (bufoff) + ldsw + _i * 8192), 16, 0, 0); } while (0)
#define PG8_LDA(dst, b, h) do { _Pragma("unroll") for (int m = 0; m < 4; ++m) _Pragma("unroll") for (int k = 0; k < 2; ++k) dst[m][k] = *(const PG8_LAS bf16x8*)(lds + PG8_SA(b, h) + aoff + m * 2048 + k * 1024); } while (0)
#define PG8_LDB(dst, b, h) do { _Pragma("unroll") for (int n = 0; n < 2; ++n) _Pragma("unroll") for (int k = 0; k < 2; ++k) dst[n][k] = *(const PG8_LAS bf16x8*)(lds + PG8_SB(b, h) + boff + n * 2048 + k * 1024); } while (0)
#define PG8_MMA(ai, bj, At, Bt) do { __builtin_amdgcn_s_setprio(1); _Pragma("unroll") for (int m = 0; m < 4; ++m) _Pragma("unroll") for (int n = 0; n < 2; ++n) _Pragma("unroll") for (int k = 0; k < 2; ++k) \
        acc[ai][bj][m][n] = __builtin_amdgcn_mfma_f32_16x16x32_bf16(Bt[n][k], At[m][k], acc[ai][bj][m][n], 0, 0, 0); __builtin_amdgcn_s_setprio(0); } while (0)
#define PG8_WAIT_V(n) asm volatile("s_waitcnt vmcnt(" #n ")" ::: "memory")
#define PG8_WAIT_L(n) asm volatile("s_waitcnt lgkmcnt(" #n ")" ::: "memory")
#define PG8_BAR __builtin_amdgcn_s_barrier()
#define PG8_SCHED __builtin_amdgcn_sched_barrier(0)
    Unit cur, nxt; int ui = 0;
    if (!S.next(0, cur)) return;
    f32x4 acc[2][2][4][2];
#pragma unroll
    for (int a = 0; a < 2; ++a)
#pragma unroll
        for (int b = 0; b < 2; ++b)
#pragma unroll
            for (int m = 0; m < 4; ++m)
#pragma unroll
                for (int n = 0; n < 2; ++n) acc[a][b][m][n] = (f32x4){0.f, 0.f, 0.f, 0.f};
    bf16x8 At[4][2], B0[2][2], B1[2][2];
    const char* cA = (const char*)g.A + (size_t)cur.pm * tstep; const char* cB = (const char*)g.Bt + (size_t)cur.pn * tstep;
    S.a_ready(cur);
    if constexpr (SP2) {
        PG8_STAGE(PG8_SB(0, 0), cB, voffB); PG8_STAGE(PG8_SB(0, 1), cB + hstep, voffB); PG8_STAGE(PG8_SA(0, 0), cA, voffA); PG8_STAGE(PG8_SA(0, 1), cA + hstep, voffA);
        if (wr == 1) PG8_BAR;
        PG8_WAIT_V(2); PG8_BAR;
        PG8_STAGE(PG8_SB(1, 0), cB + kstep, voffB); PG8_STAGE(PG8_SA(1, 0), cA + kstep, voffA); PG8_STAGE(PG8_SB(1, 1), cB + hstep + kstep, voffB);
        PG8_WAIT_V(6); PG8_BAR;
    } else {
        PG8_STAGE(PG8_SB(0, 0), cB, voffB); PG8_STAGE(PG8_SA(0, 0), cA, voffA); PG8_STAGE(PG8_SB(0, 1), cB + hstep, voffB); PG8_STAGE(PG8_SA(0, 1), cA + hstep, voffA);
        if (wr == 1) PG8_BAR;
        PG8_WAIT_V(4); PG8_BAR;
        PG8_STAGE(PG8_SB(1, 0), cB + kstep, voffB); PG8_STAGE(PG8_SA(1, 0), cA + kstep, voffA); PG8_STAGE(PG8_SB(1, 1), cB + hstep + kstep, voffB);
        PG8_WAIT_V(6); PG8_BAR;
    }
    for (;;) {
        const bool has_next = S.next(ui + 1, nxt);
        const char* nA = has_next ? (const char*)g.A + (size_t)nxt.pm * tstep : cA; const char* nB = has_next ? (const char*)g.Bt + (size_t)nxt.pn * tstep : cB;
        for (int t = 0; t < nt; t += 2) {
            const bool last = (t == nt - 2);
            const char* a1 = cA + (size_t)(t + 1) * kstep;
            const char* a2 = last ? nA : cA + (size_t)(t + 2) * kstep; const char* b2 = last ? nB : cB + (size_t)(t + 2) * kstep;
            const char* a3 = a2 + kstep; const char* b3 = b2 + kstep;
            if (last && has_next) S.a_ready(nxt);
            if constexpr (SP2) {
            PG8_LDB(B0, 0, 0); PG8_LDB(B1, 0, 1); PG8_SCHED; PG8_LDA(At, 0, 0); PG8_STAGE(PG8_SA(1, 1), a1 + hstep, voffA);
            PG8_WAIT_V(8); PG8_WAIT_L(0); PG8_BAR; PG8_MMA(0, 0, At, B0); PG8_MMA(0, 1, At, B1); PG8_BAR; PG8_SCHED;
            PG8_LDA(At, 0, 1); PG8_STAGE(PG8_SB(0, 0), b2, voffB); PG8_STAGE(PG8_SB(0, 1), b2 + hstep, voffB); PG8_STAGE(PG8_SA(0, 0), a2, voffA);
            PG8_WAIT_V(8); PG8_WAIT_L(0); PG8_BAR; PG8_MMA(1, 0, At, B0); PG8_MMA(1, 1, At, B1); PG8_BAR; PG8_SCHED;
            PG8_LDB(B0, 1, 0); PG8_LDB(B1, 1, 1); PG8_SCHED; PG8_LDA(At, 1, 0); PG8_STAGE(PG8_SA(0, 1), a2 + hstep, voffA);
            PG8_WAIT_V(8); PG8_WAIT_L(0); PG8_BAR; PG8_MMA(0, 0, At, B0); PG8_MMA(0, 1, At, B1); PG8_BAR; PG8_SCHED;
            PG8_LDA(At, 1, 1); PG8_STAGE(PG8_SB(1, 0), b3, voffB); PG8_STAGE(PG8_SB(1, 1), b3 + hstep, voffB); PG8_STAGE(PG8_SA(1, 0), a3, voffA);
            PG8_WAIT_V(8); PG8_WAIT_L(0); PG8_BAR; PG8_MMA(1, 0, At, B0); PG8_MMA(1, 1, At, B1); PG8_BAR; PG8_SCHED;
            } else {
            PG8_LDB(B0, 0, 0); PG8_SCHED; PG8_LDA(At, 0, 0); PG8_STAGE(PG8_SA(1, 1), a1 + hstep, voffA);
            PG8_WAIT_L(8); PG8_BAR; PG8_WAIT_L(0); PG8_MMA(0, 0, At, B0); PG8_BAR; PG8_SCHED;
            PG8_LDB(B1, 0, 1); PG8_STAGE(PG8_SB(0, 0), b2, voffB);
            PG8_BAR; PG8_WAIT_L(0); PG8_MMA(0, 1, At, B1); PG8_BAR;
            PG8_LDA(At, 0, 1); PG8_STAGE(PG8_SA(0, 0), a2, voffA);
            PG8_BAR; PG8_WAIT_L(0); PG8_MMA(1, 0, At, B0); PG8_BAR; PG8_SCHED;
            PG8_STAGE(PG8_SB(0, 1), b2 + hstep, voffB);
            PG8_WAIT_V(6); PG8_BAR; PG8_MMA(1, 1, At, B1); PG8_BAR;
            PG8_LDB(B0, 1, 0); PG8_SCHED; PG8_LDA(At, 1, 0); PG8_STAGE(PG8_SA(0, 1), a2 + hstep, voffA);
            PG8_WAIT_L(8); PG8_BAR; PG8_WAIT_L(0); PG8_MMA(0, 0, At, B0); PG8_BAR; PG8_SCHED;
            PG8_LDB(B1, 1, 1); PG8_STAGE(PG8_SB(1, 0), b3, voffB);
            PG8_BAR; PG8_WAIT_L(0); PG8_MMA(0, 1, At, B1); PG8_BAR;
            PG8_LDA(At, 1, 1); PG8_STAGE(PG8_SA(1, 0), a3, voffA);
            PG8_BAR; PG8_WAIT_L(0); PG8_MMA(1, 0, At, B0); PG8_BAR; PG8_SCHED;
            PG8_STAGE(PG8_SB(1, 1), b3 + hstep, voffB);
            PG8_WAIT_V(6); PG8_BAR; PG8_MMA(1, 1, At, B1); PG8_BAR;
            }
        }
        if constexpr (ALIGN_EPI) { if (wr == 0) PG8_BAR; }
        if constexpr (!Epi::AFTER_DRAIN) { E(acc, cur, wr, wc, fr, fq); S.done(cur); }
        if (!has_next) break;
#pragma unroll
        for (int a = 0; a < 2; ++a)
#pragma unroll
            for (int b = 0; b < 2; ++b)
#pragma unroll
                for (int m = 0; m < 4; ++m)
#pragma unroll
                    for (int n = 0; n < 2; ++n) acc[a][b][m][n] = (f32x4){0.f, 0.f, 0.f, 0.f};
        cur = nxt; cA = nA; cB = nB; ++ui;
        if constexpr (ALIGN_EPI) { if (wr == 1) PG8_BAR; }
    }
    PG8_WAIT_V(0);
    if constexpr (!ALIGN_EPI) { if (wr == 0) PG8_BAR; }
    PG8_BAR;
    if constexpr (Epi::AFTER_DRAIN) { E.fused(acc, cur, wr, wc, fr, fq, lds, wid, lane); S.done(cur); }
#undef PG8_SA
#undef PG8_SB
#undef PG8_STAGE
#undef PG8_LDA
#undef PG8_LDB
#undef PG8_MMA
#undef PG8_WAIT_V
#undef PG8_WAIT_L
#undef PG8_BAR
#undef PG8_SCHED
}
}


constexpr int D = 2048, NCTX = 4096, NLAT = 16384, M = NCTX + NLAT, DEPTH = 4;
constexpr int DIN = 4624, DINP = 4864, DFF = 8192;
constexpr int C_AQ = 0, C_AK = 1024, C_AV = 1280, C_DQ = 1536, C_DK = 2048, C_DV = 2560, C_DZ = 3072, C_DAB = 3584, C_SU = 3600, C_SV = 4112;
constexpr int NWAVES = 8;
constexpr float EPS = 1e-6f;
constexpr size_t O_Y = 0, O_K = (size_t)M * D, O_V = O_K + 4194304, O_DELTA = O_V + 4194304, O_END = O_DELTA + 8388608;
constexpr size_t MiB = 1u << 20;
constexpr size_t WS_CTL = 0, CTL_ZERO_BYTES = 1 * MiB;
static_assert((16384 + 9 * 20480) * 4 <= 1 * 1048576, "ssq inside the memset region");
constexpr size_t WS_MOD = 1 * MiB, WS_ROPE = 3 * MiB, WS_CK = 4 * MiB, WS_CV = 12 * MiB;
constexpr size_t WS_WIN = 20 * MiB, WS_WOUT = 96 * MiB, WS_WFF1 = 128 * MiB, WS_WFF2 = 256 * MiB;
constexpr size_t WS_X = 384 * MiB, WS_HB = 544 * MiB, WS_ZB = 624 * MiB, WS_ODIR = 816 * MiB, WS_DN = 944 * MiB, WS_BW = 1088 * MiB, WS_XA = 1090 * MiB, WS_SSQ = 1170 * MiB, WS_END = 1172 * MiB;
constexpr int BW_L = 9 * (DINP + DFF);
constexpr int CW_SSQ = 16384;
constexpr size_t DN_BLK = 116736, DN_DIR0 = 32768, DN_DIRSZ = 41984;
static_assert(WS_DN + 1280 * DN_BLK <= WS_END, "dn scratch");
constexpr int CW_BAR = 4096, CW_ATT = 8192, CW_PART = 204800;
constexpr int LDSCTL_OFF = 153600, LDS_BYTES = 154624;

#define GAS __attribute__((address_space(1)))
#define LAS __attribute__((address_space(3)))
typedef unsigned short bf16;
typedef unsigned v4u __attribute__((ext_vector_type(4)));
typedef unsigned v2u __attribute__((ext_vector_type(2)));
typedef float f32x4 __attribute__((ext_vector_type(4)));
typedef float f32x2 __attribute__((ext_vector_type(2)));
typedef float f32x16 __attribute__((ext_vector_type(16)));
typedef short bf16x8 __attribute__((ext_vector_type(8)));
typedef short s16x4 __attribute__((ext_vector_type(4)));
typedef LAS unsigned char* ldsp;
#define LDS_WAIT() asm volatile("s_waitcnt lgkmcnt(0)" ::: "memory")
#define VM_WAIT() asm volatile("s_waitcnt vmcnt(0)" ::: "memory")
__device__ __forceinline__ unsigned pk2(float lo, float hi) { return pg8::cvt_pk_bf16(lo, hi); }
__device__ __forceinline__ float bflo(unsigned w) { return __uint_as_float(w << 16); }
__device__ __forceinline__ float bfhi(unsigned w) { return __uint_as_float(w & 0xffff0000u); }
__device__ __forceinline__ float bf2f(bf16 b) { return __uint_as_float((unsigned)b << 16); }
__device__ __forceinline__ float wave_sum(float v) {
#define WS_DPP(ctrl, rmask) __builtin_bit_cast(float, __builtin_amdgcn_update_dpp(0, __builtin_bit_cast(int, v), ctrl, rmask, 0xF, false))
    v += WS_DPP(0xB1, 0xF);
    v += WS_DPP(0x4E, 0xF);
    v += WS_DPP(0x141, 0xF);
    v += WS_DPP(0x140, 0xF);
    v += WS_DPP(0x142, 0xA);
    v += WS_DPP(0x143, 0xC);
#undef WS_DPP
    return __builtin_bit_cast(float, __builtin_amdgcn_ds_bpermute(63 * 4, __builtin_bit_cast(int, v)));
}
__device__ __forceinline__ int crow(int r, int hi) { return (r & 3) + 8 * (r >> 2) + 4 * hi; }
__device__ __forceinline__ float silu_f(float x) { return x * __builtin_amdgcn_rcpf(1.f + __expf(-x)); }
__device__ __forceinline__ float gelu_tanh(float x) { const float y = 0.7978845608028654f * (x + 0.044715f * x * x * x); const float e = __expf(2.f * y); return x * (1.f - __builtin_amdgcn_rcpf(1.f + e)); }
template <int S> __device__ __forceinline__ bf16x8 pack8(const f32x16& v) {
    v4u w; w.x = pk2(v[8 * S + 0], v[8 * S + 1]); w.y = pk2(v[8 * S + 2], v[8 * S + 3]); w.z = pk2(v[8 * S + 4], v[8 * S + 5]); w.w = pk2(v[8 * S + 6], v[8 * S + 7]);
    return __builtin_bit_cast(bf16x8, w);
}
__device__ __forceinline__ f32x16 mma_lds(ldsp A, int sa, ldsp B, int sb, int nk, int lane, f32x16 acc) {
    ldsp ap = A + (lane & 31) * sa + (lane >> 5) * 16; ldsp bp = B + (lane & 31) * sb + (lane >> 5) * 16;
#pragma unroll 4
    for (int k = 0; k < nk; ++k) { const bf16x8 a = *(const LAS bf16x8*)(ap + k * 32); const bf16x8 b = *(const LAS bf16x8*)(bp + k * 32); acc = __builtin_amdgcn_mfma_f32_32x32x16_bf16(a, b, acc, 0, 0, 0); }
    return acc;
}

#define XB_TMO      128
#define XB_XCNT(j)  (256  + 64 * (j))
#define XB_XSUB(j)  (1280 + 64 * (j))
#define XB_XGEN(j)  (2304 + 64 * (j))
#define XB_TOP      3328
#define XB_TOPGEN   3392
#define XCD_BAR_WORDS 3456
#define XB_SPIN_CAP (1u << 18)
#define LAS __attribute__((address_space(3)))

__device__ __forceinline__ unsigned xb_ld(unsigned* p)              { return __hip_atomic_load(p, __ATOMIC_RELAXED, __HIP_MEMORY_SCOPE_AGENT); }
__device__ __forceinline__ unsigned xb_add(unsigned* p, unsigned v) { return __hip_atomic_fetch_add(p, v, __ATOMIC_RELAXED, __HIP_MEMORY_SCOPE_AGENT); }
__device__ __forceinline__ unsigned xb_xcc_id() { return (unsigned)__builtin_amdgcn_s_getreg((3 << 11) | 20) & 0xFu; }
#define XB_SPIN(cond, bar) do { unsigned _sp = 0; while (cond) { __builtin_amdgcn_s_sleep(1); \
    if ((++_sp & 255u) == 0u) { if (xb_ld(&(bar)[XB_TMO])) break; if (_sp > XB_SPIN_CAP) { atomicAdd(&(bar)[XB_TMO], 1u); break; } } } } while (0)

struct XcdBarrier {
    unsigned* bar; unsigned x; bool t0;
    volatile LAS unsigned* st;
};

__device__ __forceinline__ XcdBarrier xcd_barrier_post(unsigned* bar, volatile LAS unsigned* st) {
    XcdBarrier b; b.bar = bar; b.x = xb_xcc_id(); b.st = st; b.t0 = (threadIdx.x == 0);
    if (threadIdx.x == 0) (void)xb_add(&bar[XB_XCNT(b.x)], 1u);
    return b;
}
__device__ __forceinline__ void xcd_barrier_complete(unsigned* bar, unsigned x, unsigned& nloc, unsigned& nx) {
    const unsigned G = gridDim.x * gridDim.y * gridDim.z;
    unsigned sum, cnt, mine, sp = 0u;
    for (;;) {
        sum = 0u; cnt = 0u; mine = 0u;
#pragma unroll
        for (unsigned j = 0; j < 16; ++j) { const unsigned c = xb_ld(&bar[XB_XCNT(j)]); sum += c; cnt += (c > 0u) ? 1u : 0u; mine = (j == x) ? c : mine; }
        if (sum == G) break;
        __builtin_amdgcn_s_sleep(1);
        if ((++sp & 255u) == 0u) { if (xb_ld(&bar[XB_TMO])) break; if (sp > XB_SPIN_CAP) { atomicAdd(&bar[XB_TMO], 1u); break; } }
    }
    nloc = mine > 0u ? mine : 1u; nx = cnt > 0u ? cnt : 1u;
}

__device__ __forceinline__ void xcd_barrier(const XcdBarrier& b) {
    asm volatile("s_waitcnt vmcnt(0)" ::: "memory");
    __syncthreads();
    if (b.t0) {
        unsigned* bar = b.bar;
        __builtin_amdgcn_s_waitcnt(0);
        unsigned nloc = b.st[0], nx = b.st[1];
        if (nloc == 0u) { xcd_barrier_complete(bar, b.x, nloc, nx); b.st[0] = nloc; b.st[1] = nx; }
        const unsigned old = xb_add(&bar[XB_XSUB(b.x)], 1u);
        const unsigned gen = old / nloc;
        if (old + 1u == (gen + 1u) * nloc) {
            __builtin_amdgcn_fence(__ATOMIC_RELEASE, "agent");
            asm volatile("s_waitcnt vmcnt(0)" ::: "memory");
            const unsigned og = xb_add(&bar[XB_TOP], 1u);
            const unsigned tg = og / nx;
            if (og + 1u == (tg + 1u) * nx) xb_add(&bar[XB_TOPGEN], 1u);
            else XB_SPIN(xb_ld(&bar[XB_TOPGEN]) == tg, bar);
            __builtin_amdgcn_fence(__ATOMIC_ACQUIRE, "agent");
            xb_add(&bar[XB_XGEN(b.x)], 1u);
            asm volatile("s_waitcnt vmcnt(0)" ::: "memory");
        } else {
            XB_SPIN(xb_ld(&bar[XB_XGEN(b.x)]) == gen, bar);
            __builtin_amdgcn_fence(__ATOMIC_ACQUIRE, "agent");
            asm volatile("s_waitcnt vmcnt(0)" ::: "memory");
        }
    }
    __syncthreads();
}


__device__ __forceinline__ void p0_transpose_item(const float* W, int K, int N, bf16* WT, LAS float* scr, int item, int lane) {
    const int nblk = (N + 31) / 32, kb = item / nblk, nb = item % nblk, k0 = 64 * kb, n0 = 32 * nb; const bool okn = (n0 + (lane & 31)) < N;
#pragma unroll 16
    for (int i = 0; i < 32; ++i) { const int kk = 2 * i + (lane >> 5); scr[kk * 33 + (lane & 31)] = okn ? W[(size_t)(k0 + kk) * N + n0 + (lane & 31)] : 0.f; }
    LDS_WAIT(); asm volatile("" ::: "memory");
    const int c = lane & 7;
#pragma unroll
    for (int j = 0; j < 4; ++j) { const int n = (lane >> 3) + 8 * j; const LAS float* s = scr + (8 * c) * 33 + n;
        v4u o; o.x = pk2(s[0 * 33], s[1 * 33]); o.y = pk2(s[2 * 33], s[3 * 33]); o.z = pk2(s[4 * 33], s[5 * 33]); o.w = pk2(s[6 * 33], s[7 * 33]);
        *(GAS v4u*)(WT + (size_t)(n0 + n) * K + k0 + 8 * c) = o; }
    LDS_WAIT(); asm volatile("" ::: "memory");
}
struct P0Args { const float *c, *c_ctx, *norm1_g, *norm2_g, *w_mod, *b_mod, *w_in, *w_out, *w_ff1, *w_ff2, *cache_k, *cache_v; unsigned char* ws; };
constexpr int T_IN = 32 * 145, T_OUT = 32 * 64, T_F1 = 32 * 256, T_F2 = 128 * 64, T_L = T_IN + T_OUT + T_F1 + T_F2;
__device__ __forceinline__ void transpose_layer(const float* w_in, const float* w_out, const float* w_ff1, const float* w_ff2, unsigned char* ws, int l, LAS float* scr, int wi0, int wstride, int lane) {
    asm volatile("" : "+v"(lane));
    for (int wi = wi0; wi < T_L; wi += wstride) {
        int r = wi;
        if (r < T_IN) { p0_transpose_item(w_in + (size_t)l * 2048 * DIN, 2048, DIN, (bf16*)(ws + WS_WIN) + (size_t)l * DINP * 2048, scr, r, lane); continue; } r -= T_IN;
        if (r < T_OUT) { p0_transpose_item(w_out + (size_t)l * 2048 * 2048, 2048, 2048, (bf16*)(ws + WS_WOUT) + (size_t)l * 2048 * 2048, scr, r, lane); continue; } r -= T_OUT;
        if (r < T_F1) { p0_transpose_item(w_ff1 + (size_t)l * 2048 * DFF, 2048, DFF, (bf16*)(ws + WS_WFF1) + (size_t)l * DFF * 2048, scr, r, lane); continue; } r -= T_F1;
        p0_transpose_item(w_ff2 + (size_t)l * DFF * 2048, DFF, 2048, (bf16*)(ws + WS_WFF2) + (size_t)l * 2048 * DFF, scr, r, lane);
    }
}
__device__ __forceinline__ void p0_prologue(const P0Args& a, ldsp lds, unsigned* queue, volatile LAS unsigned* misc, int tid, int lane, int wave, int G) {
    asm volatile("" : "+v"(tid), "+v"(lane));
    LAS float* silu_t = (LAS float*)lds;
    LAS float* scr = (LAS float*)(lds + 73728 + wave * 8448);
    constexpr int N_MOD = 96;
    constexpr int N_CVT = 512, N_ROPE = 256, N_TR = DEPTH * T_L / 8, N_ITEMS = N_MOD + N_CVT + N_ROPE + N_TR;
    static_assert((DEPTH * T_L) % 8 == 0, "transposes");
    bool have_silu = false;
    float* MOD = (float*)(a.ws + WS_MOD);
    for (;;) {
        if (tid == 0) misc[0] = atomicAdd(queue, 1u);
        __syncthreads(); const int it = (int)misc[0]; __syncthreads();
        if (it >= N_ITEMS) break;
        if (it < N_MOD) {
            if (!have_silu) { have_silu = true;
                for (int i = tid; i < 9 * 2048; i += NWAVES * 64) { const float x = i < 8 * 2048 ? a.c[i] : a.c_ctx[i - 8 * 2048]; silu_t[i] = x / (1.f + expf(-x)); }
                __syncthreads(); }
            const int wi = it * 8 + wave, l = wi / 192, cb = wi % 192, j = cb * 64 + lane;
            float acc[9];
#pragma unroll
            for (int c = 0; c < 9; ++c) acc[c] = 0.f;
            const float* wp = a.w_mod + (size_t)l * 2048 * 12288 + j;
            for (int k0 = 0; k0 < 2048; k0 += 32) {
                float w[32];
#pragma unroll
                for (int i = 0; i < 32; ++i) w[i] = wp[(size_t)(k0 + i) * 12288];
#pragma unroll
                for (int c = 0; c < 9; ++c)
#pragma unroll
                    for (int i4 = 0; i4 < 8; ++i4) { const f32x4 s = *(const LAS f32x4*)(silu_t + c * 2048 + k0 + 4 * i4);
                        acc[c] += s.x * w[4 * i4] + s.y * w[4 * i4 + 1] + s.z * w[4 * i4 + 2] + s.w * w[4 * i4 + 3]; }
            }
            const int slot = j >> 11, col = j & 2047; const float bm = a.b_mod[l * 12288 + j];
            const float gn = slot == 1 ? a.norm1_g[l * 2048 + col] : (slot == 4 ? a.norm2_g[l * 2048 + col] : 0.f);
#pragma unroll
            for (int c = 0; c < 9; ++c) { float v = acc[c] + bm; if (slot == 1 || slot == 4) v = gn * (1.f + v); MOD[(size_t)(l * 9 + c) * 12288 + j] = v; }
        } else if (it < N_MOD + N_CVT) {
            const int ci = it - N_MOD;
#pragma unroll
            for (int s = 0; s < 4; ++s) { const size_t e8 = (size_t)ci * 2048 + s * 512 + tid; const bool isv = e8 >= 524288; const size_t j8 = isv ? e8 - 524288 : e8;
                const float* src = (isv ? a.cache_v : a.cache_k) + j8 * 8; const f32x4 x0 = *(const f32x4*)src, x1 = *(const f32x4*)(src + 4);
                v4u o; o.x = pk2(x0.x, x0.y); o.y = pk2(x0.z, x0.w); o.z = pk2(x1.x, x1.y); o.w = pk2(x1.z, x1.w);
                *(v4u*)((bf16*)(a.ws + (isv ? WS_CV : WS_CK)) + j8 * 8) = o; }
        } else if (it < N_MOD + N_CVT + N_ROPE) {
            const int e = (it - N_MOD - N_CVT) * 512 + tid, t = e >> 6, i = e & 63;
            const float inv = powf(10000.f, -(float)(2 * (i & 31)) / 64.f); const float pos = i < 32 ? (float)(t >> 6) : (float)(t & 63); const float ang = pos * inv;
            ((float*)(a.ws + WS_ROPE))[e] = cosf(ang); ((float*)(a.ws + WS_ROPE))[131072 + e] = sinf(ang);
        } else {
            const int wi = (it - N_MOD - N_CVT - N_ROPE) * 8 + wave, l = wi / T_L;
            transpose_layer(a.w_in, a.w_out, a.w_ff1, a.w_ff2, a.ws, l, scr, wi % T_L, T_L, lane);
        }
    }
}
__device__ __forceinline__ void p0b_bias(unsigned char* ws, ldsp lds, int tid, int lane, int wave, int G) {
    asm volatile("" : "+v"(tid), "+v"(lane));
    LAS float* sh = (LAS float*)lds;
    const float* MOD = (const float*)(ws + WS_MOD); float* BW = (float*)(ws + WS_BW);
    constexpr int NB1 = DINP / 64, NB2 = DFF / 64, NBL = NB1 + NB2;
    int cur = -1;
    for (int it = blockIdx.x; it < DEPTH * NBL; it += G) {
        const int l = it / NBL, r = it % NBL, which = r >= NB1 ? 1 : 0, rb = which ? r - NB1 : r, key = l * 2 + which;
        if (key != cur) { __syncthreads(); cur = key;
            for (int i = tid; i < 9 * 2048; i += NWAVES * 64) sh[i] = MOD[(size_t)(l * 9 + (i >> 11)) * 12288 + (which ? 3 : 0) * 2048 + (i & 2047)];
            __syncthreads(); }
        const bf16* WT = which ? (const bf16*)(ws + WS_WFF1) + (size_t)l * DFF * 2048 : (const bf16*)(ws + WS_WIN) + (size_t)l * DINP * 2048;
        const int ldb = which ? DFF : DINP; float* bwp = BW + (size_t)l * BW_L + (which ? 9 * DINP : 0);
#pragma unroll 1
        for (int rr = 0; rr < 8; rr += 2) { const int n = rb * 64 + wave * 8 + rr; const bf16* wr_ = WT + (size_t)n * 2048 + lane * 8;
            v4u q[2][4];
#pragma unroll
            for (int u = 0; u < 2; ++u)
#pragma unroll
                for (int j = 0; j < 4; ++j) q[u][j] = *(const v4u*)(wr_ + (size_t)u * 2048 + 512 * j);
            float res0 = 0.f, res1 = 0.f;
#pragma unroll 1
            for (int c = 0; c < 9; ++c) { float s0 = 0.f, s1 = 0.f;
#pragma unroll
                for (int j = 0; j < 4; ++j) { const f32x4 a0 = *(const LAS f32x4*)(sh + c * 2048 + 512 * j + lane * 8), a1 = *(const LAS f32x4*)(sh + c * 2048 + 512 * j + lane * 8 + 4);
                    s0 += a0.x * bflo(q[0][j].x) + a0.y * bfhi(q[0][j].x) + a0.z * bflo(q[0][j].y) + a0.w * bfhi(q[0][j].y) + a1.x * bflo(q[0][j].z) + a1.y * bfhi(q[0][j].z) + a1.z * bflo(q[0][j].w) + a1.w * bfhi(q[0][j].w);
                    s1 += a0.x * bflo(q[1][j].x) + a0.y * bfhi(q[1][j].x) + a0.z * bflo(q[1][j].y) + a0.w * bfhi(q[1][j].y) + a1.x * bflo(q[1][j].z) + a1.y * bfhi(q[1][j].z) + a1.z * bflo(q[1][j].w) + a1.w * bfhi(q[1][j].w); }
                s0 = wave_sum(s0); s1 = wave_sum(s1); res0 = (lane == c) ? s0 : res0; res1 = (lane == c) ? s1 : res1; }
            if (lane < 9) { bwp[(size_t)lane * ldb + n] = res0; bwp[(size_t)lane * ldb + n + 1] = res1; } }
    }
    __syncthreads();
}

template <bool FINAL>
__device__ __forceinline__ void norm_phase(const float* x0, const float* x1, const float* modA, bf16* xb, bf16* xa, unsigned long long* ssq, float* outf, int lane, int wave, int G) {
    asm volatile("" : "+v"(lane)); asm volatile("" : "+s"(wave), "+s"(G));
    const int rpw = (M + G - 1) / G, r0 = blockIdx.x * rpw, r1 = min(M, r0 + rpw);
    f32x4 A[8]; int cur = -1;
    for (int r = r0 + wave; r < r1; r += NWAVES) {
        const int cond = FINAL ? 0 : (r < NCTX ? 8 : ((r - NCTX) >> 11));
        if (cond != cur) { cur = cond;
#pragma unroll
            for (int j = 0; j < 8; ++j) A[j] = *(const f32x4*)(modA + (size_t)cond * 12288 + 4 * lane + 256 * j); }
        f32x4 v[8]; float ss = 0.f;
        if (FINAL) {
#pragma unroll
            for (int j = 0; j < 8; ++j) { const v2u w = *(const v2u*)(xb + (size_t)r * D + 4 * lane + 256 * j); v[j] = (f32x4){bflo(w.x), bfhi(w.x), bflo(w.y), bfhi(w.y)}; }
        } else { const float* xr = r < NCTX ? x0 + (size_t)r * D : x1 + (size_t)(r - NCTX) * D;
#pragma unroll
            for (int j = 0; j < 8; ++j) v[j] = *(const f32x4*)(xr + 4 * lane + 256 * j); }
#pragma unroll
        for (int j = 0; j < 8; ++j) ss += (v[j].x * v[j].x + v[j].y * v[j].y) + (v[j].z * v[j].z + v[j].w * v[j].w);
        ss = wave_sum(ss);
        if (FINAL) { const float rstd = rsqrtf(ss * (1.f / D) + EPS);
#pragma unroll
            for (int j = 0; j < 8; ++j) *(f32x4*)(outf + (size_t)r * D + 4 * lane + 256 * j) = v[j] * rstd * A[j];
        } else {
#pragma unroll
            for (int j = 0; j < 8; ++j) { const f32x4 y = v[j] * A[j]; v2u o; o.x = pk2(y.x, y.y); o.y = pk2(y.z, y.w); *(v2u*)(xa + (size_t)r * D + 4 * lane + 256 * j) = o;
                v2u xo; xo.x = pk2(v[j].x, v[j].y); xo.y = pk2(v[j].z, v[j].w); *(v2u*)(xb + (size_t)r * D + 4 * lane + 256 * j) = xo; }
            if (lane == 0) { const float hi = floorf(ss); ssq[r] = ((unsigned long long)(unsigned)hi << 24) + (unsigned long long)(unsigned)((ss - hi) * 16777216.f); }
        }
    }
}

#ifndef PROBE_DUP
#define PROBE_DUP 0
#endif
constexpr int P_KT = 0, P_QT = 17408, P_KTT = 34816, P_VT = 53248, P_T1 = 71680, P_T2 = 71680 + 18432, P_AM = 108544, P_GL = 141312;
struct LayerP { const float *conv_w, *a_log, *dt_bias, *dn_norm_g, *sgu_norm_g, *sgu_w, *sgu_b, *sink; };
__device__ __forceinline__ void dn_prep_unit(const LayerP& P, const bf16* zb, unsigned char* dn, ldsp lds, int gchunk, int h, int tid, int lane, int wave) {
    asm volatile("" : "+v"(tid), "+v"(lane));
    const bool isctx = gchunk < 64; const int pc = isctx ? (gchunk & 3) : ((gchunk - 64) & 31); const int T = isctx ? 256 : 2048;
    const long grow0 = (long)gchunk * 64; unsigned char* blk = dn + (size_t)(gchunk * 4 + h) * DN_BLK;
    LAS float* GL = (LAS float*)(lds + P_GL);
    for (int rep_ = 0; rep_ < ((PROBE_DUP & 1024) ? 2 : 1); ++rep_) {
    if (wave == 0) {
        const bf16* zr = zb + (size_t)(grow0 + lane) * DINP + C_DAB;
#pragma unroll
        for (int d = 0; d < 2; ++d) {
            const float alpha = bf2f(zr[d * 8 + h]), braw = bf2f(zr[d * 8 + 4 + h]);
            const float xr = alpha + P.dt_bias[d * 4 + h]; const float sp = fmaxf(xr, 0.f) + log1pf(expf(-fabsf(xr)));
            const float g = -expf(P.a_log[d * 4 + h]) * sp; const float beta = 1.f / (1.f + expf(-braw));
            float gc = g;
#pragma unroll
            for (int o = 1; o < 64; o <<= 1) { const int src = (d == 0) ? lane - o : lane + o;
                const float t = __builtin_bit_cast(float, __builtin_amdgcn_ds_bpermute((src & 63) << 2, __builtin_bit_cast(int, gc))); const bool ok = (d == 0) ? (lane >= o) : (lane + o < 64); gc += ok ? t : 0.f; }
            const float gl = wave_sum(g); const float eg = expf(gc), egl = expf(gl - gc);
            GL[d * 64 + lane] = gc; GL[128 + d * 64 + lane] = beta; GL[256 + d * 64 + lane] = beta * eg;
            float* gv = (float*)(blk + DN_DIR0 + d * DN_DIRSZ + 40960);
            gv[lane] = eg; gv[64 + lane] = egl; if (lane == 0) gv[128] = expf(gl);
        }
    }
    {
        const float* cw = P.conv_w; const int cq = h * 128 + 2 * lane;
        f32x2 wq[5], wk[5], wv[5];
#pragma unroll
        for (int j = 0; j < 5; ++j) { wq[j] = *(const f32x2*)(cw + j * 1536 + cq); wk[j] = *(const f32x2*)(cw + j * 1536 + 512 + cq); wv[j] = *(const f32x2*)(cw + j * 1536 + 1024 + cq); }
        unsigned xq[12], xk[12], xv[12];
#pragma unroll
        for (int rr = 0; rr < 12; ++rr) { const int tl = 8 * wave - 2 + rr, tpos = pc * 64 + tl; const bool ok = tpos >= 0 && tpos < T;
            const bf16* zr = zb + (grow0 + tl) * (long)DINP + h * 128 + 2 * lane;
            xq[rr] = ok ? *(const unsigned*)(zr + C_DQ) : 0u; xk[rr] = ok ? *(const unsigned*)(zr + C_DK) : 0u; xv[rr] = ok ? *(const unsigned*)(zr + C_DV) : 0u; }
        float k0s[8], k1s[8], v0s[8], v1s[8];
        LAS bf16* Kt = (LAS bf16*)(lds + P_KT); LAS bf16* Qt = (LAS bf16*)(lds + P_QT);
#pragma unroll
        for (int tt = 0; tt < 8; ++tt) {
            float q0 = 0.f, q1 = 0.f, k0 = 0.f, k1 = 0.f, v0 = 0.f, v1 = 0.f;
#pragma unroll
            for (int j = 0; j < 5; ++j) { q0 += bflo(xq[tt + j]) * wq[j].x; q1 += bfhi(xq[tt + j]) * wq[j].y; k0 += bflo(xk[tt + j]) * wk[j].x; k1 += bfhi(xk[tt + j]) * wk[j].y;
                v0 += bflo(xv[tt + j]) * wv[j].x; v1 += bfhi(xv[tt + j]) * wv[j].y; }
            q0 = silu_f(q0); q1 = silu_f(q1); k0 = silu_f(k0); k1 = silu_f(k1); v0 = silu_f(v0); v1 = silu_f(v1);
            const float rq = rsqrtf(wave_sum(q0 * q0 + q1 * q1) + EPS) * 0.08838834764831845f, rk = rsqrtf(wave_sum(k0 * k0 + k1 * k1) + EPS);
            q0 *= rq; q1 *= rq; k0 *= rk; k1 *= rk;
            const int t = 8 * wave + tt;
            *(LAS unsigned*)(Qt + t * 136 + 2 * lane) = pk2(q0, q1); *(LAS unsigned*)(Kt + t * 136 + 2 * lane) = pk2(k0, k1);
            k0s[tt] = k0; k1s[tt] = k1; v0s[tt] = v0; v1s[tt] = v1;
        }
        LAS bf16* KT = (LAS bf16*)(lds + P_KTT); LAS bf16* VT = (LAS bf16*)(lds + P_VT);
        v4u o;
        o.x = pk2(k0s[0], k0s[1]); o.y = pk2(k0s[2], k0s[3]); o.z = pk2(k0s[4], k0s[5]); o.w = pk2(k0s[6], k0s[7]); *(LAS v4u*)(KT + (2 * lane) * 72 + 8 * wave) = o;
        o.x = pk2(k1s[0], k1s[1]); o.y = pk2(k1s[2], k1s[3]); o.z = pk2(k1s[4], k1s[5]); o.w = pk2(k1s[6], k1s[7]); *(LAS v4u*)(KT + (2 * lane + 1) * 72 + 8 * wave) = o;
        o.x = pk2(v0s[0], v0s[1]); o.y = pk2(v0s[2], v0s[3]); o.z = pk2(v0s[4], v0s[5]); o.w = pk2(v0s[6], v0s[7]); *(LAS v4u*)(VT + (2 * lane) * 72 + 8 * wave) = o;
        o.x = pk2(v1s[0], v1s[1]); o.y = pk2(v1s[2], v1s[3]); o.z = pk2(v1s[4], v1s[5]); o.w = pk2(v1s[6], v1s[7]); *(LAS v4u*)(VT + (2 * lane + 1) * 72 + 8 * wave) = o;
    }
    __syncthreads();
    }
    for (int rep_ = 0; rep_ < ((PROBE_DUP & 4096) ? 2 : 1); ++rep_) {
    {
        const int hh = lane >> 5, cl = lane & 31; LAS float* AM = (LAS float*)(lds + P_AM);
        f32x16 acc = {};
        if (wave < 4) {
            const int rt = wave >> 1, ct = wave & 1;
            acc = mma_lds(lds + P_KT + 32 * rt * 272, 272, lds + P_KT + 32 * ct * 272, 272, 8, lane, acc);
            const int c = 32 * ct + cl; const float g0c = GL[c], g1c = GL[64 + c];
#pragma unroll
            for (int q = 0; q < 4; ++q) { const int r0 = 32 * rt + 8 * q + 4 * hh;
                const f32x4 g0 = *(const LAS f32x4*)(GL + r0), g1 = *(const LAS f32x4*)(GL + 64 + r0), b0 = *(const LAS f32x4*)(GL + 128 + r0), b1 = *(const LAS f32x4*)(GL + 192 + r0);
#pragma unroll
                for (int e = 0; e < 4; ++e) { const int rr = r0 + e; const float v = acc[4 * q + e];
                    if (rr > c) AM[rr * 64 + c] = b0[e] * v * __expf(g0[e] - g0c);
                    if (rr < c) AM[4096 + (63 - rr) * 64 + (63 - c)] = b1[e] * v * __expf(g1[e] - g1c); } }
        } else {
            const int cb = (wave - 4) >> 1, it = (wave - 4) & 1;
            acc = mma_lds(lds + P_KT + 32 * cb * 272, 272, lds + P_QT + 32 * it * 272, 272, 8, lane, acc);
            const int i = 32 * it + cl; const float g0i = GL[i], g1i = GL[64 + i];
            f32x16 a0, a1;
#pragma unroll
            for (int q = 0; q < 4; ++q) { const int c0 = 32 * cb + 8 * q + 4 * hh; const f32x4 g0 = *(const LAS f32x4*)(GL + c0), g1 = *(const LAS f32x4*)(GL + 64 + c0);
#pragma unroll
                for (int e = 0; e < 4; ++e) { const int c = c0 + e; const float v = acc[4 * q + e];
                    a0[4 * q + e] = (i >= c) ? v * __expf(fminf(g0i - g0[e], 0.f)) : 0.f; a1[4 * q + e] = (i <= c) ? v * __expf(fminf(g1i - g1[e], 0.f)) : 0.f; } }
            unsigned char* q0p = blk + DN_DIR0 + 32768 + ((cb * 2 + it) * 2) * 1024 + lane * 16; unsigned char* q1p = q0p + DN_DIRSZ;
            *(bf16x8*)(q0p) = pack8<0>(a0); *(bf16x8*)(q0p + 1024) = pack8<1>(a0); *(bf16x8*)(q1p) = pack8<0>(a1); *(bf16x8*)(q1p + 1024) = pack8<1>(a1);
        }
    }
    __syncthreads();
    }
    for (int rep_ = 0; rep_ < ((PROBE_DUP & 2048) ? 2 : 1); ++rep_) {
    if (wave < 2) {
        const int dir = wave; const LAS float* Am = (const LAS float*)(lds + P_AM) + dir * 4096;
        float Tr[64]; f32x4 cA[16], cB[16];
#define SOLVE_LOAD(dst, i_) do { _Pragma("unroll") for (int q = 0; q < 16; ++q) if (4 * q < (i_)) dst[q] = *(const LAS f32x4*)(Am + (i_) * 64 + 4 * q); } while (0)
#define SOLVE_ROW(src, i_) do { float a0 = (lane == (i_)) ? 1.f : 0.f, a1 = 0.f, a2 = 0.f, a3 = 0.f; \
            _Pragma("unroll") for (int q = 0; q < 16; ++q) { const int jb = 4 * q; \
                if (jb + 0 < (i_)) a0 -= src[q].x * Tr[jb + 0]; if (jb + 1 < (i_)) a1 -= src[q].y * Tr[jb + 1]; if (jb + 2 < (i_)) a2 -= src[q].z * Tr[jb + 2]; if (jb + 3 < (i_)) a3 -= src[q].w * Tr[jb + 3]; } \
            Tr[i_] = (a0 + a1) + (a2 + a3); } while (0)
        Tr[0] = (lane == 0) ? 1.f : 0.f;
        SOLVE_LOAD(cA, 1);
#pragma unroll
        for (int i = 1; i < 64; i += 2) {
            if (i + 1 < 64) SOLVE_LOAD(cB, i + 1);
            asm volatile("" ::: "memory");
            SOLVE_ROW(cA, i);
            if (i + 2 < 64) SOLVE_LOAD(cA, i + 2);
            asm volatile("" ::: "memory");
            if (i + 1 < 64) SOLVE_ROW(cB, i + 1);
        }
#undef SOLVE_LOAD
#undef SOLVE_ROW
        const int j = dir ? 63 - lane : lane; const float s1 = GL[256 + dir * 64 + j], s2 = GL[128 + dir * 64 + j];
        LAS bf16* T1 = (LAS bf16*)(lds + P_T1) + dir * 4608; LAS bf16* T2 = (LAS bf16*)(lds + P_T2) + dir * 4608;
#pragma unroll
        for (int ii = 0; ii < 64; ++ii) { const int i = dir ? 63 - ii : ii; T1[i * 72 + j] = (bf16)(pk2(Tr[ii] * s1, 0.f) & 0xffffu); T2[i * 72 + j] = (bf16)(pk2(Tr[ii] * s2, 0.f) & 0xffffu); }
    } else {
        const int hh = lane >> 5, rl = lane & 31;
        for (int b = wave - 2; b < 32; b += 6) {
            v2u lo, hi;
            if (b < 16) { const int it = b >> 3, db = (b >> 1) & 3, s = b & 1; const LAS bf16* p = (const LAS bf16*)(lds + P_QT) + (32 * it + rl) * 136 + 32 * db + 16 * s + 4 * hh; lo = *(const LAS v2u*)p; hi = *(const LAS v2u*)(p + 8); }
            else { const int bb = b - 16, dt = bb >> 2, cb = (bb >> 1) & 1, s = bb & 1; const LAS bf16* p = (const LAS bf16*)(lds + P_KTT) + (32 * dt + rl) * 72 + 32 * cb + 16 * s + 4 * hh; lo = *(const LAS v2u*)p; hi = *(const LAS v2u*)(p + 8); }
            v4u o; o.x = lo.x; o.y = lo.y; o.z = hi.x; o.w = hi.y;
            *(v4u*)(blk + (size_t)b * 1024 + lane * 16) = o;
        }
    }
    __syncthreads();
    }
    for (int rep_ = 0; rep_ < ((PROBE_DUP & 8192) ? 2 : 1); ++rep_) {
#pragma unroll 1
    for (int tix = wave; tix < 32; tix += 8) {
        const int dir = tix >> 4, kind = (tix >> 3) & 1, idx = tix & 7; f32x16 acc = {};
        unsigned char* dst;
        if (kind == 0) { const int ct = idx >> 2, es = idx & 3;
            acc = mma_lds(lds + P_T2 + dir * 9216 + 32 * ct * 144, 144, lds + P_VT + 32 * es * 144, 144, 4, lane, acc);
            dst = blk + DN_DIR0 + dir * DN_DIRSZ + ((ct * 4 + es) * 2) * 1024 + lane * 16;
        } else { const int db = idx >> 1, ct = idx & 1;
            acc = mma_lds(lds + P_KTT + 32 * db * 144, 144, lds + P_T1 + dir * 9216 + 32 * ct * 144, 144, 4, lane, acc);
#pragma unroll
            for (int r = 0; r < 16; ++r) acc[r] = -acc[r];
            dst = blk + DN_DIR0 + dir * DN_DIRSZ + 16384 + ((db * 2 + ct) * 2) * 1024 + lane * 16;
        }
        *(bf16x8*)dst = pack8<0>(acc); *(bf16x8*)(dst + 1024) = pack8<1>(acc);
    }
    __syncthreads();
    }
}

__device__ __forceinline__ void sgu_unit(const LayerP& P, const bf16* zb, bf16* mix, ldsp lds, int rc, int g, bool load_w, int tid, int lane, int wave) {
    asm volatile("" : "+v"(tid), "+v"(lane));
    const size_t grow0 = (size_t)rc * 128; LAS bf16* Wl = (LAS bf16*)lds; LAS bf16* Vt = (LAS bf16*)(lds + 34816);
    {
        const float gn0 = P.sgu_norm_g[g * 128 + 2 * lane], gn1 = P.sgu_norm_g[g * 128 + 2 * lane + 1];
        float v0[16], v1[16];
#pragma unroll
        for (int qq = 0; qq < 16; ++qq) { const unsigned w = *(const unsigned*)(zb + (grow0 + 16 * wave + qq) * DINP + C_SV + g * 128 + 2 * lane);
            const float a = gelu_tanh(bflo(w)), b = gelu_tanh(bfhi(w)); const float r = rsqrtf(wave_sum(a * a + b * b) * (1.f / 128.f) + EPS); v0[qq] = a * r * gn0; v1[qq] = b * r * gn1; }
        v4u o;
        o.x = pk2(v0[0], v0[1]); o.y = pk2(v0[2], v0[3]); o.z = pk2(v0[4], v0[5]); o.w = pk2(v0[6], v0[7]); *(LAS v4u*)(Vt + (2 * lane) * 136 + 16 * wave) = o;
        o.x = pk2(v0[8], v0[9]); o.y = pk2(v0[10], v0[11]); o.z = pk2(v0[12], v0[13]); o.w = pk2(v0[14], v0[15]); *(LAS v4u*)(Vt + (2 * lane) * 136 + 16 * wave + 8) = o;
        o.x = pk2(v1[0], v1[1]); o.y = pk2(v1[2], v1[3]); o.z = pk2(v1[4], v1[5]); o.w = pk2(v1[6], v1[7]); *(LAS v4u*)(Vt + (2 * lane + 1) * 136 + 16 * wave) = o;
        o.x = pk2(v1[8], v1[9]); o.y = pk2(v1[10], v1[11]); o.z = pk2(v1[12], v1[13]); o.w = pk2(v1[14], v1[15]); *(LAS v4u*)(Vt + (2 * lane + 1) * 136 + 16 * wave + 8) = o;
    }
    if (load_w) {
        const int p = tid >> 2, q0 = (tid & 3) * 32; const float* src = P.sgu_w + ((size_t)g * 128 + p) * 128 + q0;
#pragma unroll
        for (int j = 0; j < 4; ++j) { const f32x4 x0 = *(const f32x4*)(src + 8 * j), x1 = *(const f32x4*)(src + 8 * j + 4);
            v4u o; o.x = pk2(x0.x, x0.y); o.y = pk2(x0.z, x0.w); o.z = pk2(x1.x, x1.y); o.w = pk2(x1.z, x1.w); *(LAS v4u*)(Wl + p * 136 + q0 + 8 * j) = o; }
    }
    __syncthreads();
    {
        const int pt = wave >> 1, hh = lane >> 5, cl = lane & 31; LAS float* Ms = (LAS float*)(lds + 69632 + wave * 8704);
#pragma unroll
        for (int cc = 0; cc < 2; ++cc) { const int ct = 2 * (wave & 1) + cc; f32x16 acc = {};
            acc = mma_lds(lds + 32 * pt * 272, 272, lds + 34816 + 32 * ct * 272, 272, 8, lane, acc);
#pragma unroll
            for (int q = 0; q < 4; ++q) { const f32x4 bq = *(const f32x4*)(P.sgu_b + g * 128 + 32 * pt + 8 * q + 4 * hh);
#pragma unroll
                for (int e = 0; e < 4; ++e) Ms[(8 * q + 4 * hh + e) * 68 + 32 * cc + cl] = acc[4 * q + e] + bq[e]; } }
        LDS_WAIT(); asm volatile("" ::: "memory");
        const int row = lane >> 1, c0 = (lane & 1) * 32; const size_t grow = grow0 + 32 * pt + row; const int gcol = g * 128 + 64 * (wave & 1) + c0;
        const bf16* sup = zb + grow * DINP + C_SU + gcol; bf16* op = mix + grow * D + 1536 + gcol;
#pragma unroll
        for (int j = 0; j < 4; ++j) { const v4u su = *(const v4u*)(sup + 8 * j); const f32x4 m0 = *(const LAS f32x4*)(Ms + row * 68 + c0 + 8 * j), m1 = *(const LAS f32x4*)(Ms + row * 68 + c0 + 8 * j + 4);
            v4u o; o.x = pk2(gelu_tanh(bflo(su.x)) * m0.x, gelu_tanh(bfhi(su.x)) * m0.y); o.y = pk2(gelu_tanh(bflo(su.y)) * m0.z, gelu_tanh(bfhi(su.y)) * m0.w);
            o.z = pk2(gelu_tanh(bflo(su.z)) * m1.x, gelu_tanh(bfhi(su.z)) * m1.y); o.w = pk2(gelu_tanh(bflo(su.w)) * m1.z, gelu_tanh(bfhi(su.w)) * m1.w);
            *(v4u*)(op + 8 * j) = o; }
    }
    __syncthreads();
}

__device__ __forceinline__ void rope_item(bf16* zb, const float* ropet, int ri, int lane, int wave) {
    asm volatile("" : "+v"(lane));
    const int hf = (lane >> 4) & 1, ip = (lane & 15) * 2;
#pragma unroll 1
    for (int t4 = 0; t4 < 8; t4 += 4) {
        unsigned wa[4][5], wb[4][5]; f32x2 cs[4], sn[4]; bf16* pp[4];
#pragma unroll
        for (int u = 0; u < 4; ++u) { const int tl = ri * 64 + wave * 8 + t4 + u, t = tl & 2047; pp[u] = zb + (size_t)(NCTX + tl) * DINP + 64 * hf + ip;
            cs[u] = *(const f32x2*)(ropet + t * 64 + 32 * hf + ip); sn[u] = *(const f32x2*)(ropet + 131072 + t * 64 + 32 * hf + ip);
#pragma unroll
            for (int ps = 0; ps < 5; ++ps) { const int hv = ps * 2 + (lane >> 5); const bf16* p = pp[u] + (hv < 8 ? C_AQ + hv * 128 : C_AK + (hv - 8) * 128); wa[u][ps] = *(const unsigned*)p; wb[u][ps] = *(const unsigned*)(p + 32); } }
#pragma unroll
        for (int u = 0; u < 4; ++u)
#pragma unroll
            for (int ps = 0; ps < 5; ++ps) { const int hv = ps * 2 + (lane >> 5); bf16* p = pp[u] + (hv < 8 ? C_AQ + hv * 128 : C_AK + (hv - 8) * 128);
                const float a0 = bflo(wa[u][ps]), a1 = bfhi(wa[u][ps]), b0 = bflo(wb[u][ps]), b1 = bfhi(wb[u][ps]);
                *(unsigned*)p = pk2(a0 * cs[u].x - b0 * sn[u].x, a1 * cs[u].y - b1 * sn[u].y); *(unsigned*)(p + 32) = pk2(b0 * cs[u].x + a0 * sn[u].x, b1 * cs[u].y + a1 * sn[u].y); }
    }
}

constexpr int SC_BUF = 58368;
__device__ __forceinline__ void glds16(const void* g, ldsp l) { __builtin_amdgcn_global_load_lds((const unsigned*)g, (LAS unsigned*)l, 16, 0, 0); }
__device__ __forceinline__ void scan_dma4(const unsigned char* blk, int dir, ldsp buf, int lane, int lw) {
    const unsigned lo = (unsigned)lane * 16u;
#pragma unroll
    for (int i = 0; i < 15; ++i) { const int k = lw + 4 * i;
        if (i < 14 || lw == 0) { const unsigned char* ub = blk + (size_t)k * 1024 + (k >= 32 ? 16384 + dir * (int)DN_DIRSZ : 0); glds16(ub + lo, buf + k * 1024); } }
}
__device__ __forceinline__ void scan_chain(const unsigned char* dn, const float* state0, float* state_out, float* odir, ldsp lds, int isctx, int b, int h, int dir, int lane, int wave) {
    asm volatile("" : "+v"(lane));
    const int hh = lane >> 5, cl = lane & 31; const int nch = isctx ? 4 : 32; const int gch0 = isctx ? b * 4 : 64 + b * 32;
#define BLKOF(n) (dn + (size_t)((gch0 + (dir ? nch - 1 - (n) : (n))) * 4 + h) * DN_BLK)
    if (wave >= 4) {
        scan_dma4(BLKOF(0), dir, lds, lane, wave - 4);
#pragma unroll 1
        for (int n = 0; n < nch; ++n) {
            VM_WAIT(); __builtin_amdgcn_s_barrier(); asm volatile("" ::: "memory");
            if (n + 1 < nch) scan_dma4(BLKOF(n + 1), dir, lds + ((n + 1) & 1) * SC_BUF, lane, wave - 4);
        }
        VM_WAIT(); __builtin_amdgcn_s_barrier(); asm volatile("" ::: "memory");
        return;
    }
    const int es = wave;
    f32x16 S[4];
#pragma unroll
    for (int db = 0; db < 4; ++db) S[db] = f32x16{};
    if (state0) { const float* sp = state0 + (4 * hh) * 128 + 32 * es + cl;
#pragma unroll
        for (int db = 0; db < 4; ++db)
#pragma unroll
            for (int r = 0; r < 16; ++r) S[db][r] = sp[(32 * db + (r & 3) + 8 * (r >> 2)) * 128]; }
#define UPTR(n) (BLKOF(n) + DN_DIR0 + dir * DN_DIRSZ + (es * 2) * 1024 + lane * 16)
    bf16x8 Un[2][2];
    { const unsigned char* up = UPTR(0);
#pragma unroll
      for (int ct = 0; ct < 2; ++ct) { Un[ct][0] = *(const bf16x8*)(up + ct * 8192); Un[ct][1] = *(const bf16x8*)(up + ct * 8192 + 1024); } }
#define SBAR_() __builtin_amdgcn_sched_barrier(0)
#pragma unroll 1
    for (int n = 0; n < nch; ++n) {
        VM_WAIT(); __builtin_amdgcn_s_barrier(); asm volatile("" ::: "memory");
        f32x16 vn[2];
#pragma unroll
        for (int ct = 0; ct < 2; ++ct) { const v4u a = __builtin_bit_cast(v4u, Un[ct][0]), c = __builtin_bit_cast(v4u, Un[ct][1]);
          vn[ct][0] = bflo(a.x); vn[ct][1] = bfhi(a.x); vn[ct][2] = bflo(a.y); vn[ct][3] = bfhi(a.y); vn[ct][4] = bflo(a.z); vn[ct][5] = bfhi(a.z); vn[ct][6] = bflo(a.w); vn[ct][7] = bfhi(a.w);
          vn[ct][8] = bflo(c.x); vn[ct][9] = bfhi(c.x); vn[ct][10] = bflo(c.y); vn[ct][11] = bfhi(c.y); vn[ct][12] = bflo(c.z); vn[ct][13] = bfhi(c.z); vn[ct][14] = bflo(c.w); vn[ct][15] = bfhi(c.w); }
        if (n + 1 < nch) { const unsigned char* up = UPTR(n + 1);
#pragma unroll
            for (int ct = 0; ct < 2; ++ct) { Un[ct][0] = *(const bf16x8*)(up + ct * 8192); Un[ct][1] = *(const bf16x8*)(up + ct * 8192 + 1024); } }
        ldsp buf = lds + (n & 1) * SC_BUF; ldsp fl = buf + lane * 16;
        bf16x8 Sb[4][2];
#pragma unroll
        for (int db = 0; db < 4; ++db) { Sb[db][0] = pack8<0>(S[db]); Sb[db][1] = pack8<1>(S[db]); }
        f32x16 oa[2];
#pragma unroll
        for (int ct = 0; ct < 2; ++ct) {
            bf16x8 Anw[8], Aq[8];
#pragma unroll
            for (int k = 0; k < 8; ++k) { Anw[k] = *(const LAS bf16x8*)(fl + 32768 + (((k >> 1) * 2 + ct) * 2 + (k & 1)) * 1024); Aq[k] = *(const LAS bf16x8*)(fl + ((ct * 4 + (k >> 1)) * 2 + (k & 1)) * 1024); }
            oa[ct] = f32x16{};
            LDS_WAIT(); SBAR_();
#pragma unroll
            for (int k = 0; k < 8; ++k) { vn[ct] = __builtin_amdgcn_mfma_f32_32x32x16_bf16(Anw[k], Sb[k >> 1][k & 1], vn[ct], 0, 0, 0); oa[ct] = __builtin_amdgcn_mfma_f32_32x32x16_bf16(Aq[k], Sb[k >> 1][k & 1], oa[ct], 0, 0, 0); }
            SBAR_();
        }
        bf16x8 V1[2][2], V2[2][2];
        { const float gl = *(const LAS float*)(buf + 57344 + 512);
#pragma unroll
          for (int ct = 0; ct < 2; ++ct) { const LAS float* egl = (const LAS float*)(buf + 57344 + 256) + 32 * ct + 4 * hh; const LAS float* eg = (const LAS float*)(buf + 57344) + 32 * ct + 4 * hh;
            f32x16 vs;
#pragma unroll
            for (int q = 0; q < 4; ++q) { const f32x4 e = *(const LAS f32x4*)(egl + 8 * q), g = *(const LAS f32x4*)(eg + 8 * q);
                vs[4 * q] = vn[ct][4 * q] * e.x; vs[4 * q + 1] = vn[ct][4 * q + 1] * e.y; vs[4 * q + 2] = vn[ct][4 * q + 2] * e.z; vs[4 * q + 3] = vn[ct][4 * q + 3] * e.w;
                oa[ct][4 * q] *= g.x; oa[ct][4 * q + 1] *= g.y; oa[ct][4 * q + 2] *= g.z; oa[ct][4 * q + 3] *= g.w; }
            V1[ct][0] = pack8<0>(vn[ct]); V1[ct][1] = pack8<1>(vn[ct]); V2[ct][0] = pack8<0>(vs); V2[ct][1] = pack8<1>(vs); }
#pragma unroll
          for (int db = 0; db < 4; ++db)
#pragma unroll
              for (int r = 0; r < 16; ++r) S[db][r] *= gl; }
        SBAR_();
        { bf16x8 Aqk[8];
#pragma unroll
          for (int k = 0; k < 8; ++k) Aqk[k] = *(const LAS bf16x8*)(fl + 49152 + k * 1024);
          LDS_WAIT(); SBAR_();
#pragma unroll
          for (int cb = 0; cb < 2; ++cb)
#pragma unroll
              for (int s = 0; s < 2; ++s) { oa[0] = __builtin_amdgcn_mfma_f32_32x32x16_bf16(Aqk[(cb * 2 + 0) * 2 + s], V1[cb][s], oa[0], 0, 0, 0); oa[1] = __builtin_amdgcn_mfma_f32_32x32x16_bf16(Aqk[(cb * 2 + 1) * 2 + s], V1[cb][s], oa[1], 0, 0, 0); }
          SBAR_(); }
#pragma unroll
        for (int half = 0; half < 2; ++half) { bf16x8 Akt[8];
#pragma unroll
            for (int k = 0; k < 8; ++k) Akt[k] = *(const LAS bf16x8*)(fl + 16384 + (half * 8 + k) * 1024);
            LDS_WAIT(); SBAR_();
#pragma unroll
            for (int k = 0; k < 4; ++k) { S[2 * half] = __builtin_amdgcn_mfma_f32_32x32x16_bf16(Akt[k], V2[k >> 1][k & 1], S[2 * half], 0, 0, 0);
                S[2 * half + 1] = __builtin_amdgcn_mfma_f32_32x32x16_bf16(Akt[4 + k], V2[k >> 1][k & 1], S[2 * half + 1], 0, 0, 0); }
            SBAR_(); }
        { const int pc = dir ? nch - 1 - n : n;
#pragma unroll
          for (int ct = 0; ct < 2; ++ct) { unsigned ob = (unsigned)((((gch0 + pc) * 64 + 32 * ct + 4 * hh) * 512 + h * 128 + 32 * es + cl) * 4); asm volatile("" : "+v"(ob));
#pragma unroll
              for (int r = 0; r < 16; ++r) *(float*)((char*)odir + (ob + (unsigned)(((r & 3) + 8 * (r >> 2)) * 2048))) = oa[ct][r]; } }
    }
#undef SBAR_
    if (state_out) {
#pragma unroll
        for (int db = 0; db < 4; ++db)
#pragma unroll
            for (int r = 0; r < 16; ++r) state_out[(size_t)(32 * db + crow(r, hh)) * 128 + 32 * es + cl] = S[db][r];
    }
    VM_WAIT(); LDS_WAIT(); __builtin_amdgcn_s_barrier(); asm volatile("" ::: "memory");
#undef BLKOF
#undef UPTR
}


#define KSWZ(row, colB) ((row) * 256 + ((colB) ^ (((row) & 7) << 4)))
#define SBAR() __builtin_amdgcn_sched_barrier(0)
__device__ __forceinline__ int v_st(int k, int c) { const int kk = (k & ~0xC) | ((k & 4) << 1) | ((k & 8) >> 1); return ((kk >> 3) * 4 + (c >> 5)) * 512 + ((kk & 7) * 32 + (c & 31)) * 2; }
__device__ __forceinline__ int v_rd_base(int lane) { return ((lane & 3) << 3) | (((lane >> 2) & 3) << 6) | (((lane >> 4) & 1) << 5) | (((lane >> 5) & 1) << 8); }
constexpr int v_rd_off(int d0, int ks, int half) { return d0 * 512 + ks * 4096 + half * 2048; }
template <int OFF> __device__ __forceinline__ s16x4 tr_read(int vb) { s16x4 r; asm volatile("ds_read_b64_tr_b16 %0, %1 offset:%2" : "=&v"(r) : "v"(vb), "i"(OFF) : "memory"); return r; }
template <int D0> __device__ __forceinline__ void pv_one(f32x16& od, int vb, bf16x8 pa0, bf16x8 pa1, bf16x8 pa2, bf16x8 pa3) {
    const s16x4 l0 = tr_read<v_rd_off(D0, 0, 0)>(vb), h0 = tr_read<v_rd_off(D0, 0, 1)>(vb), l1 = tr_read<v_rd_off(D0, 1, 0)>(vb), h1 = tr_read<v_rd_off(D0, 1, 1)>(vb);
    const s16x4 l2 = tr_read<v_rd_off(D0, 2, 0)>(vb), h2 = tr_read<v_rd_off(D0, 2, 1)>(vb), l3 = tr_read<v_rd_off(D0, 3, 0)>(vb), h3 = tr_read<v_rd_off(D0, 3, 1)>(vb);
    asm volatile("s_waitcnt lgkmcnt(0)" ::: "memory"); SBAR();
#define PKV(L, H) (bf16x8){L[0], L[1], L[2], L[3], H[0], H[1], H[2], H[3]}
    od = __builtin_amdgcn_mfma_f32_32x32x16_bf16(pa0, PKV(l0, h0), od, 0, 0, 0);
    od = __builtin_amdgcn_mfma_f32_32x32x16_bf16(pa1, PKV(l1, h1), od, 0, 0, 0);
    od = __builtin_amdgcn_mfma_f32_32x32x16_bf16(pa2, PKV(l2, h2), od, 0, 0, 0);
    od = __builtin_amdgcn_mfma_f32_32x32x16_bf16(pa3, PKV(l3, h3), od, 0, 0, 0);
#undef PKV
}
__device__ __forceinline__ void qkt(f32x16& p0, f32x16& p1, ldsp Ks, const bf16x8* qr, int r32, int hi) {
    p0 = f32x16{}; p1 = f32x16{};
#pragma unroll
    for (int d0 = 0; d0 < 8; ++d0) { const int cb = (d0 * 16 + hi * 8) * 2;
        const bf16x8 b0 = *(const LAS bf16x8*)(Ks + KSWZ(r32, cb)); const bf16x8 b1 = *(const LAS bf16x8*)(Ks + KSWZ(32 + r32, cb));
        p0 = __builtin_amdgcn_mfma_f32_32x32x16_bf16(b0, qr[d0], p0, 0, 0, 0); p1 = __builtin_amdgcn_mfma_f32_32x32x16_bf16(b1, qr[d0], p1, 0, 0, 0); }
}
struct AttnP { const bf16* zb; const bf16* ck; const bf16* cv; bf16* mix; const float* sink; int l; };
__device__ __forceinline__ void attn_unit(const AttnP& A, ldsp lds, int u, int tid, int lane, int wave) {
    asm volatile("" : "+v"(tid), "+v"(lane));
    constexpr float C = 0.08838834764831845f * 1.4426950408889634f;
    const int r32 = lane & 31, hi = lane >> 5;
    const bool lat = u < 512; int b, head, q0, T; size_t rowbase;
    if (lat) { q0 = (u & 7) * 256; head = (u >> 3) & 7; b = u >> 6; rowbase = NCTX + (size_t)b * 2048; T = 2048; }
    else { const int uu = u - 512; head = uu & 7; b = uu >> 3; q0 = 0; rowbase = (size_t)b * 256; T = 256; }
    const int kvh = head >> 2, nct = lat ? 8 : 0;
    const int ws = lat ? max(0, q0 - 128) / 64 : 0, we = lat ? min(T, q0 + 384) / 64 : 4, NT = nct + (we - ws);
    const int qw = q0 + 32 * wave;
    ldsp V_lds = lds, K_lds = lds + 32768; LAS float* al = (LAS float*)(lds + 65536) + wave * 64;
    bf16x8 qr[8];
    { const bf16* Qw = A.zb + (rowbase + qw + r32) * DINP + C_AQ + head * 128 + hi * 8;
#pragma unroll
      for (int d0 = 0; d0 < 8; ++d0) qr[d0] = *(const bf16x8*)(Qw + d0 * 16); }
    float m_reg = A.sink[head] * 1.4426950408889634f, l_reg = 1.f; f32x16 o[4] = {};
    const int sr = tid >> 4, sc = (tid & 15) * 8, vst0 = v_st(sr, sc), vst1 = v_st(32 + sr, sc);
    const int vb0 = (int)(unsigned)(size_t)V_lds + v_rd_base(lane);
    bf16x8 ks0, ks1, vs0, vs1;
#define ALOAD(j) do { const bf16 *kp, *vp; size_t st; if ((j) < nct) { kp = A.ck + ((size_t)(b * 4 + A.l) * 512 + (j) * 64) * 256 + kvh * 128; vp = A.cv + ((size_t)(b * 4 + A.l) * 512 + (j) * 64) * 256 + kvh * 128; st = 256; } \
        else { const size_t r0 = rowbase + (size_t)(ws + (j) - nct) * 64; kp = A.zb + r0 * DINP + C_AK + kvh * 128; vp = A.zb + r0 * DINP + C_AV + kvh * 128; st = DINP; } \
        ks0 = *(const bf16x8*)(kp + sr * st + sc); ks1 = *(const bf16x8*)(kp + (32 + sr) * st + sc); vs0 = *(const bf16x8*)(vp + sr * st + sc); vs1 = *(const bf16x8*)(vp + (32 + sr) * st + sc); } while (0)
#define AWRITE(bb) do { *(LAS bf16x8*)(V_lds + (bb) * 16384 + vst0) = vs0; *(LAS bf16x8*)(V_lds + (bb) * 16384 + vst1) = vs1; \
        *(LAS bf16x8*)(K_lds + (bb) * 16384 + KSWZ(sr, sc * 2)) = ks0; *(LAS bf16x8*)(K_lds + (bb) * 16384 + KSWZ(32 + sr, sc * 2)) = ks1; } while (0)
    ALOAD(0); AWRITE(0); __syncthreads();
#pragma unroll 1
    for (int j = 0; j < NT; ++j) {
        if (j + 1 < NT) ALOAD(j + 1);
        bool active = true, needmask = false; int kpos0 = 0;
        if (lat && j >= nct) { kpos0 = (ws + j - nct) * 64; active = (kpos0 + 63 >= qw - 128) && (kpos0 <= qw + 31 + 128); needmask = !((kpos0 >= qw + 31 - 128) && (kpos0 + 63 <= qw + 128)); }
        if (active) {
            f32x16 p0, p1;
            qkt(p0, p1, K_lds + (j & 1) * 16384, qr, r32, hi);
            if (needmask) { const int q = qw + r32;
#pragma unroll
                for (int r = 0; r < 16; ++r) { const int k0 = kpos0 + crow(r, hi) - q, k1 = k0 + 32; if (k0 > 128 || k0 < -128) p0[r] = -1e30f; if (k1 > 128 || k1 < -128) p1[r] = -1e30f; } }
            float pmax = p0[0];
#pragma unroll
            for (int r = 1; r < 16; ++r) pmax = fmaxf(pmax, p0[r]);
#pragma unroll
            for (int r = 0; r < 16; ++r) pmax = fmaxf(pmax, p1[r]);
            { auto rr = __builtin_amdgcn_permlane32_swap(__float_as_uint(pmax), __float_as_uint(pmax), false, false); pmax = fmaxf(__uint_as_float(rr[0]), __uint_as_float(rr[1])); }
            float mn = m_reg, alpha = 1.f;
            if (!__all(pmax * C - m_reg <= 11.5f)) { mn = fmaxf(m_reg, pmax * C); alpha = __builtin_amdgcn_exp2f(m_reg - mn); m_reg = mn; }
            float ps = 0.f;
#pragma unroll
            for (int r = 0; r < 16; ++r) { p0[r] = __builtin_amdgcn_exp2f(fmaf(p0[r], C, -mn)); p1[r] = __builtin_amdgcn_exp2f(fmaf(p1[r], C, -mn)); ps += p0[r] + p1[r]; }
            { auto rr = __builtin_amdgcn_permlane32_swap(__float_as_uint(ps), __float_as_uint(ps), false, false); ps = __uint_as_float(rr[0]) + __uint_as_float(rr[1]); }
            l_reg = l_reg * alpha + ps;
            if (__any(alpha < 1.f)) { if (hi == 0) al[r32] = alpha; LDS_WAIT();
#pragma unroll
                for (int d = 0; d < 4; ++d)
#pragma unroll
                    for (int r = 0; r < 16; ++r) o[d][r] *= al[crow(r, hi)]; }
            bf16x8 pa0, pa1, pa2, pa3;
#define PK4(P, BASE, OUT) do { unsigned a0 = pk2(P[BASE + 0], P[BASE + 1]), a1 = pk2(P[BASE + 2], P[BASE + 3]); unsigned b0 = pk2(P[BASE + 4], P[BASE + 5]), b1 = pk2(P[BASE + 6], P[BASE + 7]); \
    auto r0 = __builtin_amdgcn_permlane32_swap(a0, b0, false, false); auto r1 = __builtin_amdgcn_permlane32_swap(a1, b1, false, false); \
    v4u w = {r0[0], r1[0], r0[1], r1[1]}; OUT = __builtin_bit_cast(bf16x8, w); } while (0)
            PK4(p0, 0, pa0); PK4(p0, 8, pa1); PK4(p1, 0, pa2); PK4(p1, 8, pa3);
#undef PK4
            const int vb = vb0 + (j & 1) * 16384;
            pv_one<0>(o[0], vb, pa0, pa1, pa2, pa3); pv_one<1>(o[1], vb, pa0, pa1, pa2, pa3); pv_one<2>(o[2], vb, pa0, pa1, pa2, pa3); pv_one<3>(o[3], vb, pa0, pa1, pa2, pa3);
        }
        if (j + 1 < NT) AWRITE((j + 1) & 1);
        __syncthreads();
    }
#undef ALOAD
#undef AWRITE
    if (hi == 0) al[r32] = l_reg; LDS_WAIT();
    bf16* Ow = A.mix + (rowbase + qw) * D + head * 128 + r32;
#pragma unroll
    for (int r = 0; r < 16; ++r) { const int orow = crow(r, hi); const float rl = __builtin_amdgcn_rcpf(al[orow]);
#pragma unroll
        for (int d0 = 0; d0 < 4; ++d0) Ow[(size_t)orow * D + d0 * 32] = (bf16)(pk2(o[d0][r] * rl, 0.f) & 0xffffu); }
}

#ifndef PROBE_DUP
#define PROBE_DUP 0
#endif
#ifndef PROBE_T
#define PROBE_T 0
#endif
__device__ __forceinline__ int lane_l() { int t; asm volatile("v_mbcnt_lo_u32_b32 %0, -1, 0\n\tv_mbcnt_hi_u32_b32 %0, -1, %0" : "=v"(t)); return t; }
struct Args { const float* in[24]; float* out; unsigned char* ws; int ph_lo, ph_hi; };
constexpr int NPH = 31;
__global__ void __launch_bounds__(NWAVES * 64, 2) fwd(Args args) {
    extern __shared__ __attribute__((aligned(16))) unsigned char lds_raw[];
    ldsp lds = (ldsp)lds_raw;
    volatile LAS unsigned* MISC = (volatile LAS unsigned*)(lds + LDSCTL_OFF);
    const int wave = __builtin_amdgcn_readfirstlane((int)threadIdx.x >> 6), G = gridDim.x;
#define tid ((wave << 6) | lane_l())
#define lane lane_l()
    unsigned char* ws = args.ws; unsigned* ctl = (unsigned*)(ws + WS_CTL);
    for (int u = tid; u < (LDS_BYTES - LDSCTL_OFF) / 4; u += NWAVES * 64) MISC[u] = 0u;
    __syncthreads();
    const int lo = args.ph_lo, hi = args.ph_hi; const bool multi = (hi - lo) > 1;
    XcdBarrier bar; bar.bar = ctl + CW_BAR; bar.x = 0; bar.st = nullptr; bar.t0 = false;
    if (multi) bar = xcd_barrier_post(ctl + CW_BAR, MISC + 8);
#define IN(k) (lo <= (k) && (k) < hi)
    unsigned long long tacc_ = 0, t0_ = 0;
#define PH_T0(bit) do { if (PROBE_T & (bit)) t0_ = __builtin_amdgcn_s_memrealtime(); } while (0)
#define PH_T1(bit) do { if (PROBE_T & (bit)) tacc_ += __builtin_amdgcn_s_memrealtime() - t0_; } while (0)
#define DUPBAR() do { if (multi) { XcdBarrier b2_ = bar; b2_.t0 = (wave == 0) && (lane_l() == 0); asm volatile("" : "+s"(b2_.bar)); xcd_barrier(b2_); } } while (0)
#if PROBE_DUP & 512
#define SEAM(k) do { if (IN(k) && IN((k) + 1)) { XcdBarrier b2_ = bar; b2_.t0 = (wave == 0) && (lane_l() == 0); asm volatile("" : "+s"(b2_.bar)); xcd_barrier(b2_); xcd_barrier(b2_); } } while (0)
#else
#define SEAM(k) do { if (IN(k) && IN((k) + 1)) { XcdBarrier b2_ = bar; b2_.t0 = (wave == 0) && (lane_l() == 0); asm volatile("" : "+s"(b2_.bar)); xcd_barrier(b2_); } } while (0)
#endif
    const float *x_prompt = args.in[0], *x_sample = args.in[1], *cache_k = args.in[2], *cache_v = args.in[3], *state_delta = args.in[4], *c_in = args.in[5], *c_ctx = args.in[6];
    const float *norm1_g = args.in[7], *w_mod = args.in[8], *b_mod = args.in[9], *w_in = args.in[10], *conv_w = args.in[11], *attn_sink = args.in[12], *dn_a_log = args.in[13], *dn_dt_bias = args.in[14];
    const float *dn_norm_g = args.in[15], *sgu_norm_g = args.in[16], *sgu_w = args.in[17], *sgu_b = args.in[18], *w_out = args.in[19], *norm2_g = args.in[20], *w_ff1 = args.in[21], *w_ff2 = args.in[22], *final_norm_g = args.in[23];
    float* out = args.out;
    float* MOD = (float*)(ws + WS_MOD); bf16* XB = (bf16*)(ws + WS_X); bf16* HB = (bf16*)(ws + WS_HB); bf16* ZB = (bf16*)(ws + WS_ZB); bf16* FB = ZB; bf16* XA = (bf16*)(ws + WS_XA);
    float* ODIR = (float*)(ws + WS_ODIR); unsigned char* DN = ws + WS_DN; unsigned long long* SSQ = (unsigned long long*)(ws + WS_SSQ); const float* BW = (const float*)(ws + WS_BW);

    PH_T0(1);
    if (IN(0)) {
        P0Args pa{c_in, c_ctx, norm1_g, norm2_g, w_mod, b_mod, w_in, w_out, w_ff1, w_ff2, cache_k, cache_v, ws};
        p0_prologue(pa, lds, ctl + CW_ATT + 64 * 16, MISC, tid, lane, wave, G);
        __syncthreads();
#if PROBE_DUP & 4
        p0_prologue(pa, lds, ctl + CW_ATT + 64 * 17, MISC, tid, lane, wave, G); __syncthreads();
#endif
    }
    SEAM(0); PH_T1(1); PH_T0(2);
    if (IN(1)) {
        p0b_bias(ws, lds, tid, lane, wave, G);
        norm_phase<false>(x_prompt, x_sample, MOD + 1 * 2048, XB, XA, SSQ, nullptr, lane, wave, G);
    }
    SEAM(1); PH_T1(2);
#pragma unroll 1
    for (int l = 0; l < DEPTH; ++l) {
        const int pb = 2 + 7 * l;
        const float* modl = MOD + (size_t)l * 9 * 12288;
        if (l == 0) PH_T0(4);
        if (IN(pb + 0)) {
            const bf16* gA = XA; const bf16* gB = (const bf16*)(ws + WS_WIN) + (size_t)l * DINP * 2048; asm volatile("" : "+s"(gA), "+s"(gB));
            pg8::Gemm g{gA, gB, M, DINP, 2048}; pg8::StaticOrder S; S.init(M, DINP, G, (int)blockIdx.x);
            pg8::EpiZ E{ZB, DINP, out + O_K + (size_t)l * 65536, out + O_V + (size_t)l * 65536, SSQ + (size_t)(2 * l) * M, BW + (size_t)l * BW_L};
            pg8::gemm_phase<pg8::EpiZ, pg8::StaticOrder, true, true>(lds, g, S, E, wave);
        }
        SEAM(pb + 0); PH_T1(4); PH_T0(8);
        LayerP LP{conv_w + (size_t)l * 5 * 1536, dn_a_log + l * 8, dn_dt_bias + l * 8, dn_norm_g + l * 128, sgu_norm_g + l * 512, sgu_w + (size_t)l * 4 * 128 * 128, sgu_b + l * 512, attn_sink + l * 8};
        if (IN(pb + 1)) {
            int wg_ = -1;
            for (int it = blockIdx.x; it < 1280 + 640 + 256; it += G) {
                if (it < 1280) dn_prep_unit(LP, ZB, DN, lds, it >> 2, it & 3, tid, lane, wave);
                else if (it < 1920) { const int g_ = (it - 1280) & 3; sgu_unit(LP, ZB, HB, lds, (it - 1280) >> 2, g_, g_ != wg_, tid, lane, wave); wg_ = g_; }
                else if (G == 256 && it >= 2048) {   }
                else rope_item(ZB, (const float*)(ws + WS_ROPE), it - 1920, lane, wave);
            }
            if (G == 256 && (int)blockIdx.x >= 128) rope_item(ZB, (const float*)(ws + WS_ROPE), 128 + ((int)blockIdx.x - 128), lane, wave);
        }
#if PROBE_DUP & 16
        if (IN(pb + 1)) { DUPBAR();
            for (int it = blockIdx.x; it < 1280 + 640; it += G) {
                if (it < 1280) dn_prep_unit(LP, ZB, DN, lds, it >> 2, it & 3, tid, lane, wave);
                else sgu_unit(LP, ZB, HB, lds, (it - 1280) >> 2, (it - 1280) & 3, true, tid, lane, wave);
            } }
#endif
#if PROBE_DUP & 32
        if (IN(pb + 1)) { DUPBAR(); for (int it = blockIdx.x; it < 1280; it += G) dn_prep_unit(LP, ZB, DN, lds, it >> 2, it & 3, tid, lane, wave); }
#endif
        SEAM(pb + 1); PH_T1(8); PH_T0(16);
        if (IN(pb + 2)) {
            for (int cu = blockIdx.x; cu < 192; cu += G) {
                const bool isctx = cu >= 64; const int cc = isctx ? cu - 64 : cu; const int b = cc >> 3, h = (cc >> 1) & 3, dir = cc & 1;
                const float* s0 = isctx ? nullptr : state_delta + ((((size_t)b * 4 + l) * 2 + dir) * 4 + h) * 16384;
                float* so = isctx ? out + O_DELTA + ((((size_t)b * 4 + l) * 2 + dir) * 4 + h) * 16384 : nullptr;
                scan_chain(DN, s0, so, ODIR + (size_t)dir * M * 512, lds, isctx ? 1 : 0, b, h, dir, lane, wave);
            }
            AttnP AP{ZB, (const bf16*)(ws + WS_CK), (const bf16*)(ws + WS_CV), HB, LP.sink, l};
            for (;;) {
                if (tid == 0) MISC[0] = atomicAdd(ctl + CW_ATT + 64 * l, 1u);
                __syncthreads(); const int u = (int)MISC[0]; __syncthreads();
                if (u >= 640) break;
                attn_unit(AP, lds, u, tid, lane, wave);
            }
        }
#if PROBE_DUP & 128
        if (IN(pb + 2)) { DUPBAR();
            for (int cu = blockIdx.x; cu < 192; cu += G) {
                const bool isctx = cu >= 64; const int cc = isctx ? cu - 64 : cu; const int b = cc >> 3, h = (cc >> 1) & 3, dir = cc & 1;
                const float* s0 = isctx ? nullptr : state_delta + ((((size_t)b * 4 + l) * 2 + dir) * 4 + h) * 16384;
                float* so = isctx ? out + O_DELTA + ((((size_t)b * 4 + l) * 2 + dir) * 4 + h) * 16384 : nullptr;
                scan_chain(DN, s0, so, ODIR + (size_t)dir * M * 512, lds, isctx ? 1 : 0, b, h, dir, lane, wave);
            } }
#endif
#if PROBE_DUP & 256
        if (IN(pb + 2)) { DUPBAR();
            AttnP AP{ZB, (const bf16*)(ws + WS_CK), (const bf16*)(ws + WS_CV), HB, LP.sink, l};
            for (;;) {
                if (tid == 0) MISC[0] = atomicAdd(ctl + CW_ATT + 64 * (l + 4), 1u);
                __syncthreads(); const int u = (int)MISC[0]; __syncthreads();
                if (u >= 640) break;
                attn_unit(AP, lds, u, tid, lane, wave);
            } }
#endif
#if PROBE_DUP & 2
        if (IN(pb + 2)) { DUPBAR();
            for (int cu = blockIdx.x; cu < 192; cu += G) {
                const bool isctx = cu >= 64; const int cc = isctx ? cu - 64 : cu; const int b = cc >> 3, h = (cc >> 1) & 3, dir = cc & 1;
                const float* s0 = isctx ? nullptr : state_delta + ((((size_t)b * 4 + l) * 2 + dir) * 4 + h) * 16384;
                float* so = isctx ? out + O_DELTA + ((((size_t)b * 4 + l) * 2 + dir) * 4 + h) * 16384 : nullptr;
                scan_chain(DN, s0, so, ODIR + (size_t)dir * M * 512, lds, isctx ? 1 : 0, b, h, dir, lane, wave);
            }
            AttnP AP{ZB, (const bf16*)(ws + WS_CK), (const bf16*)(ws + WS_CV), HB, LP.sink, l};
            for (;;) {
                if (tid == 0) MISC[0] = atomicAdd(ctl + CW_ATT + 64 * (l + 4), 1u);
                __syncthreads(); const int u = (int)MISC[0]; __syncthreads();
                if (u >= 640) break;
                attn_unit(AP, lds, u, tid, lane, wave);
            } }
#endif
        SEAM(pb + 2); PH_T1(16); PH_T0(32);
        if (IN(pb + 3)) {
            const int ln = lane_l();
            const float gn0 = LP.dn_norm_g[2 * ln], gn1 = LP.dn_norm_g[2 * ln + 1];
            for (int it = blockIdx.x * NWAVES + wave; it < M * 4; it += G * NWAVES) { const size_t row = it >> 2; const int hh = it & 3;
                const f32x2 a = *(const f32x2*)(ODIR + row * 512 + hh * 128 + 2 * ln), b2 = *(const f32x2*)(ODIR + (size_t)M * 512 + row * 512 + hh * 128 + 2 * ln);
                const float o0 = a.x + b2.x, o1 = a.y + b2.y; const float r = rsqrtf(wave_sum(o0 * o0 + o1 * o1) * (1.f / 128.f) + EPS);
                const unsigned z = *(const unsigned*)(ZB + row * DINP + C_DZ + hh * 128 + 2 * ln);
                *(unsigned*)(HB + row * D + 1024 + hh * 128 + 2 * ln) = pk2(o0 * r * gn0 * silu_f(bflo(z)), o1 * r * gn1 * silu_f(bfhi(z))); }
        }
        SEAM(pb + 3); PH_T1(32); PH_T0(64);
        if (IN(pb + 4)) {
            const bf16* gA = HB; const bf16* gB = (const bf16*)(ws + WS_WOUT) + (size_t)l * 2048 * 2048; asm volatile("" : "+s"(gA), "+s"(gB));
            pg8::Gemm g{gA, gB, M, 2048, 2048};
            pg8::EpiRes E{XB, modl + 2 * 2048, modl + 4 * 2048, XA, SSQ + (size_t)(2 * l + 1) * M};
            pg8::StaticOrder S; S.init(M, 2048, G, (int)blockIdx.x, 4);
            pg8::gemm_phase<pg8::EpiRes, pg8::StaticOrder, true, true>(lds, g, S, E, wave);
        }
        SEAM(pb + 4); PH_T1(64); PH_T0(128);
        if (IN(pb + 5)) {
            const bf16* gA = XA; const bf16* gB = (const bf16*)(ws + WS_WFF1) + (size_t)l * DFF * 2048; asm volatile("" : "+s"(gA), "+s"(gB));
            pg8::Gemm g{gA, gB, M, DFF, 2048}; pg8::StaticOrder S; S.init(M, DFF, G, (int)blockIdx.x);
            pg8::EpiRelu2 E{FB, DFF, SSQ + (size_t)(2 * l + 1) * M, BW + (size_t)l * BW_L + 9 * DINP};
            pg8::gemm_phase<pg8::EpiRelu2, pg8::StaticOrder, true, true>(lds, g, S, E, wave);
        }
        SEAM(pb + 5); PH_T1(128); PH_T0(256);
        if (IN(pb + 6)) {
            const bf16* gA = FB; const bf16* gB = (const bf16*)(ws + WS_WFF2) + (size_t)l * 2048 * DFF; asm volatile("" : "+s"(gA), "+s"(gB));
            pg8::Gemm g{gA, gB, M, 2048, DFF};
            pg8::EpiRes E{XB, modl + 5 * 2048, l + 1 < DEPTH ? modl + 9 * 12288 + 1 * 2048 : nullptr, XA, SSQ + (size_t)(2 * l + 2) * M};
            pg8::StaticOrder S; S.init(M, 2048, G, (int)blockIdx.x, 4);
            pg8::gemm_phase<pg8::EpiRes, pg8::StaticOrder, true, true>(lds, g, S, E, wave);
        }
        SEAM(pb + 6); PH_T1(256); PH_T0(4);
    }
    PH_T0(512);
    if (IN(30)) norm_phase<true>(nullptr, nullptr, final_norm_g, XB, nullptr, nullptr, out + O_Y, lane, wave, G);
    PH_T1(512);
    if (PROBE_T && blockIdx.x == 0) { const unsigned long long te_ = __builtin_amdgcn_s_memrealtime() + 4ull * tacc_; while (__builtin_amdgcn_s_memrealtime() < te_) __builtin_amdgcn_s_sleep(64); }
#undef IN
#undef SEAM
#undef DUPBAR
#undef tid
#undef lane
}

#ifndef MK_ONE_LAUNCH
#define MK_ONE_LAUNCH 1
#endif
extern "C" void kernel_launch(void* const* d_in, const int* in_sizes, int n_in, void* d_out, int out_size, void* d_ws, size_t ws_size, hipStream_t stream) {
    static int grid = 0;
    if (grid == 0) {
        if (n_in != 24 || (size_t)out_size != O_END || ws_size < WS_END) { fprintf(stderr, "kernel_launch: unexpected shapes: n_in %d out %d ws %zu (need %zu)\n", n_in, out_size, ws_size, (size_t)WS_END); grid = -1; return; }
        int dev = 0, cus = 0, per_cu = 0;
        if (hipGetDevice(&dev) != hipSuccess || hipDeviceGetAttribute(&cus, hipDeviceAttributeMultiprocessorCount, dev) != hipSuccess) { grid = -1; return; }
        if (hipFuncSetAttribute((const void*)fwd, hipFuncAttributeMaxDynamicSharedMemorySize, LDS_BYTES) != hipSuccess) { fprintf(stderr, "kernel_launch: hipFuncSetAttribute failed\n"); grid = -1; return; }
        if (hipOccupancyMaxActiveBlocksPerMultiprocessor(&per_cu, (const void*)fwd, NWAVES * 64, LDS_BYTES) != hipSuccess || per_cu < 1) fprintf(stderr, "kernel_launch: occupancy query reports %d\n", per_cu);
        (void)hipGetLastError();
        grid = cus;
    }
    if (grid < 0) return;
    (void)hipMemsetAsync((char*)d_ws + WS_CTL, 0, CTL_ZERO_BYTES, stream);
    (void)hipMemsetAsync((char*)d_ws + WS_SSQ, 0, (size_t)9 * M * 8, stream);
    for (int l = 0; l < DEPTH; ++l) (void)hipMemsetAsync((char*)d_ws + WS_WIN + ((size_t)l * DINP + 4640) * 2048 * 2, 0, (size_t)(DINP - 4640) * 2048 * 2, stream);
    Args a{};
    for (int i = 0; i < 24; ++i) a.in[i] = (const float*)d_in[i];
    a.out = (float*)d_out; a.ws = (unsigned char*)d_ws;
#if MK_ONE_LAUNCH
    a.ph_lo = 0; a.ph_hi = NPH;
    hipLaunchKernelGGL(fwd, dim3(grid), dim3(NWAVES * 64), LDS_BYTES, stream, a);
#else
    for (int p = 0; p < NPH; ++p) { a.ph_lo = p; a.ph_hi = p + 1; hipLaunchKernelGGL(fwd, dim3(grid), dim3(NWAVES * 64), LDS_BYTES, stream, a); }
#endif
    const hipError_t le = hipPeekAtLastError();
    if (le != hipSuccess) fprintf(stderr, "kernel_launch: launch failed: %s\n", hipGetErrorName(le));
}
```

```cpp
#include <hip/hip_runtime.h>
#include <cstdio>
#include <cstdint>
namespace pg8 {
#define PG8_LAS __attribute__((address_space(3)))
typedef unsigned short bf16_t;
typedef short bf16x8 __attribute__((ext_vector_type(8)));
typedef float f32x4 __attribute__((ext_vector_type(4)));
typedef unsigned u32x4 __attribute__((ext_vector_type(4)));
constexpr int BM = 256, BK = 64, HALF = 128, HTB = HALF * BK * 2  , STAGE_BYTES = 8 * HTB, NXCD = 8, WGM = 8;

__host__ __device__ __forceinline__ int lds_byte(int r, int c) { const int st = (r >> 4) * 2 + (c >> 5), rr = r & 15, cc = c & 31, ob = rr * 64 + cc * 2; return st * 1024 + (ob ^ (((ob >> 9) & 1) << 5)); }
__host__ __device__ __forceinline__ void stage_rc(int b, int& R, int& C) { const int st = b / 1024, sb = b % 1024, swz = sb ^ (((sb >> 9) & 1) << 5); R = (st >> 1) * 16 + swz / 64; C = (st & 1) * 32 + (swz % 64) / 2; }
__host__ __device__ __forceinline__ int perm32(int rho) { const int n = rho >> 4, i = rho & 15; return 8 * (i >> 2) + 4 * n + (i & 3); }

struct Unit { int pm, pn; };
struct Gemm { const bf16_t* A; const bf16_t* Bt; int M, N, K; };

struct StaticOrder {
    int nM, nN, nwg, G, c, wgm, rev;
    __host__ __device__ void init(int M, int N, int G_, int c_, int wgm_ = WGM, int rev_ = 0) { nM = M / BM; nN = N / BM; nwg = nM * nN; G = G_; c = c_; wgm = wgm_; rev = rev_; }
    __host__ __device__ bool next(int i, Unit& u) const {
        const long L = (long)i * G + c; if (L >= nwg) return false;
        int wgid = (int)L; { const int q = nwg / NXCD, r = nwg % NXCD, xcd = wgid % NXCD, off = wgid / NXCD; wgid = (xcd < r ? xcd * (q + 1) : r * (q + 1) + (xcd - r) * q) + off; }
        const int nig = wgm * nN, gid = wgid / nig, fm = gid * wgm, gsz = (nM - fm) < wgm ? (nM - fm) : wgm;
        u.pm = fm + ((wgid % nig) % gsz); u.pn = (wgid % nig) / gsz; if (rev) u.pm = nM - 1 - u.pm; return true;
    }
    __device__ __forceinline__ void a_ready(const Unit&) const {}
    __device__ __forceinline__ void done(const Unit&) const {}
};


typedef float f32x2c __attribute__((ext_vector_type(2))); typedef __bf16 bf16x2c __attribute__((ext_vector_type(2)));
__device__ __forceinline__ unsigned cvt_pk_bf16(float lo, float hi) { const f32x2c v = {lo, hi}; return __builtin_bit_cast(unsigned, __builtin_convertvector(v, bf16x2c)); }
__device__ __forceinline__ int cond_of(int rowt) { return rowt < 4096 ? 8 : ((rowt - 4096) >> 11); }
struct EpiZ {
    static constexpr bool PERM = true, AFTER_DRAIN = false;
    bf16_t* O; int ldc; float* outk; float* outv; const unsigned long long* ssq; const float* bw;
    __device__ __forceinline__ void operator()(const f32x4 (&acc)[2][2][4][2], const Unit& u, int wr, int wc, int fr, int fq) const {
        asm volatile("" : "+v"(fr), "+v"(fq));
        const int rowt = u.pm * BM, row0 = rowt + wr * 64 + fr; const int col0 = u.pn * BM + wc * 32 + 8 * fq;
        const bool kv = (u.pm < 16) && (u.pn == 4 || u.pn == 5);
        float* ob = (u.pn == 4 ? outk : outv) + (size_t)u.pm * (4 * 65536) + wc * 32 + 8 * fq;
        const float* bp = bw + (size_t)cond_of(rowt) * ldc + col0; f32x4 bv[2][2];
#pragma unroll
        for (int bj = 0; bj < 2; ++bj)
#pragma unroll
            for (int n = 0; n < 2; ++n) bv[bj][n] = *(const f32x4*)(bp + bj * HALF + 4 * n);
#pragma unroll
        for (int ai = 0; ai < 2; ++ai)
#pragma unroll
            for (int m = 0; m < 4; ++m) { const int rl = wr * 64 + fr + ai * HALF + m * 16; bf16_t* rowp = O + (size_t)(row0 + ai * HALF + m * 16) * ldc + col0;
                const float rs = __builtin_amdgcn_rsqf((float)ssq[rowt + rl] * (1.f / (2048.f * 16777216.f)) + 1e-6f);
#pragma unroll
                for (int bj = 0; bj < 2; ++bj) { const f32x4 v0 = acc[ai][bj][m][0] * rs + bv[bj][0], v1 = acc[ai][bj][m][1] * rs + bv[bj][1];
                    u32x4 w; w.x = cvt_pk_bf16(v0[0], v0[1]); w.y = cvt_pk_bf16(v0[2], v0[3]); w.z = cvt_pk_bf16(v1[0], v1[1]); w.w = cvt_pk_bf16(v1[2], v1[3]);
                    *(u32x4*)(rowp + bj * HALF) = w;
                    if (kv) { float* p = ob + (size_t)rl * 256 + bj * HALF; *(f32x4*)p = v0; *(f32x4*)(p + 4) = v1; } } }
    }
};
struct EpiRelu2 {
    static constexpr bool PERM = true, AFTER_DRAIN = false;
    bf16_t* O; int ldc; const unsigned long long* ssq; const float* bw;
    __device__ __forceinline__ void operator()(const f32x4 (&acc)[2][2][4][2], const Unit& u, int wr, int wc, int fr, int fq) const {
        asm volatile("" : "+v"(fr), "+v"(fq));
        const int rowt = u.pm * BM, row0 = rowt + wr * 64 + fr; const int col0 = u.pn * BM + wc * 32 + 8 * fq;
        const float* bp = bw + (size_t)cond_of(rowt) * ldc + col0; f32x4 bv[2][2];
#pragma unroll
        for (int bj = 0; bj < 2; ++bj)
#pragma unroll
            for (int n = 0; n < 2; ++n) bv[bj][n] = *(const f32x4*)(bp + bj * HALF + 4 * n);
#pragma unroll
        for (int ai = 0; ai < 2; ++ai)
#pragma unroll
            for (int m = 0; m < 4; ++m) { bf16_t* rowp = O + (size_t)(row0 + ai * HALF + m * 16) * ldc + col0;
                const float rs = __builtin_amdgcn_rsqf((float)ssq[row0 + ai * HALF + m * 16] * (1.f / (2048.f * 16777216.f)) + 1e-6f);
#pragma unroll
                for (int bj = 0; bj < 2; ++bj) { f32x4 v0 = acc[ai][bj][m][0] * rs + bv[bj][0], v1 = acc[ai][bj][m][1] * rs + bv[bj][1];
#pragma unroll
                    for (int j = 0; j < 4; ++j) { const float a = fmaxf(v0[j], 0.f), b = fmaxf(v1[j], 0.f); v0[j] = a * a; v1[j] = b * b; }
                    u32x4 w; w.x = cvt_pk_bf16(v0[0], v0[1]); w.y = cvt_pk_bf16(v0[2], v0[3]); w.z = cvt_pk_bf16(v1[0], v1[1]); w.w = cvt_pk_bf16(v1[2], v1[3]);
                    *(u32x4*)(rowp + bj * HALF) = w; } }
    }
};
struct EpiRes {
    static constexpr bool PERM = true, AFTER_DRAIN = false;
    bf16_t* x; const float* gate; const float* anext; bf16_t* xa; unsigned long long* ssq;
    __device__ __forceinline__ void operator()(const f32x4 (&acc)[2][2][4][2], const Unit& u, int wr, int wc, int fr, int fq) const {
        asm volatile("" : "+v"(fr), "+v"(fq));
        const int rowt = u.pm * BM, col0 = u.pn * BM + wc * 32 + 8 * fq; const int cond = cond_of(rowt);
        bf16_t* xb = x + (size_t)rowt * 2048; bf16_t* ab = xa + (size_t)rowt * 2048;
        const float* g = gate + (size_t)cond * 12288 + col0; f32x4 gv[2][2], av[2][2];
#pragma unroll
        for (int bj = 0; bj < 2; ++bj)
#pragma unroll
            for (int n = 0; n < 2; ++n) { gv[bj][n] = *(const f32x4*)(g + bj * HALF + 4 * n); av[bj][n] = anext ? *(const f32x4*)(anext + (size_t)cond * 12288 + col0 + bj * HALF + 4 * n) : (f32x4){0.f, 0.f, 0.f, 0.f}; }
        const unsigned offb = (unsigned)((wr * 64 + fr) * 2048 + col0) * 2u;
#pragma unroll
        for (int ai = 0; ai < 2; ++ai) {
            u32x4 xw[4][2];
#pragma unroll
            for (int m = 0; m < 4; ++m) { unsigned voff = offb + (unsigned)(ai * HALF + m * 16) * 4096u; asm volatile("" : "+v"(voff));
#pragma unroll
                for (int bj = 0; bj < 2; ++bj) xw[m][bj] = *(const u32x4*)((const char*)xb + voff + bj * 256); }
            asm volatile("" ::: "memory");
#pragma unroll
            for (int m = 0; m < 4; ++m) { unsigned voff = offb + (unsigned)(ai * HALF + m * 16) * 4096u; asm volatile("" : "+v"(voff));
                char* xp = (char*)xb + voff; char* ap = (char*)ab + voff; float ss = 0.f;
#pragma unroll
                for (int bj = 0; bj < 2; ++bj) { const u32x4 xv = xw[m][bj];
                    const f32x4 x0 = {__uint_as_float(xv.x << 16), __uint_as_float(xv.x & 0xffff0000u), __uint_as_float(xv.y << 16), __uint_as_float(xv.y & 0xffff0000u)};
                    const f32x4 x1 = {__uint_as_float(xv.z << 16), __uint_as_float(xv.z & 0xffff0000u), __uint_as_float(xv.w << 16), __uint_as_float(xv.w & 0xffff0000u)};
                    const f32x4 y0 = x0 + gv[bj][0] * acc[ai][bj][m][0], y1 = x1 + gv[bj][1] * acc[ai][bj][m][1];
                    u32x4 yw; yw.x = cvt_pk_bf16(y0[0], y0[1]); yw.y = cvt_pk_bf16(y0[2], y0[3]); yw.z = cvt_pk_bf16(y1[0], y1[1]); yw.w = cvt_pk_bf16(y1[2], y1[3]); *(u32x4*)(xp + bj * 256) = yw;
                    ss += (y0[0] * y0[0] + y0[1] * y0[1]) + (y0[2] * y0[2] + y0[3] * y0[3]) + (y1[0] * y1[0] + y1[1] * y1[1]) + (y1[2] * y1[2] + y1[3] * y1[3]);
                    if (anext) { const f32x4 a0 = y0 * av[bj][0], a1 = y1 * av[bj][1];
                        u32x4 w; w.x = cvt_pk_bf16(a0[0], a0[1]); w.y = cvt_pk_bf16(a0[2], a0[3]); w.z = cvt_pk_bf16(a1[0], a1[1]); w.w = cvt_pk_bf16(a1[2], a1[3]); *(u32x4*)(ap + bj * 256) = w; } }
                ss += __shfl_xor(ss, 16); ss += __shfl_xor(ss, 32);
                if (fq == 0) { const float hi = floorf(ss); const unsigned long long q = ((unsigned long long)(unsigned)hi << 24) + (unsigned long long)(unsigned)((ss - hi) * 16777216.f);
                    __hip_atomic_fetch_add(ssq + rowt + wr * 64 + fr + ai * HALF + m * 16, q, __ATOMIC_RELAXED, __HIP_MEMORY_SCOPE_AGENT); }
            }
            asm volatile("" ::: "memory");
        }
    }
};
template <class Epi, class Sched, bool ALIGN_EPI = false, bool SP2 = false>
__device__ __forceinline__ void gemm_phase(PG8_LAS unsigned char* lds, const Gemm g, const Sched& S, const Epi& E, const int wave_in) {
    int tid_; asm volatile("v_mbcnt_lo_u32_b32 %0, -1, 0\n\tv_mbcnt_hi_u32_b32 %0, -1, %0" : "=v"(tid_)); tid_ |= (wave_in << 6);
    const int tid = tid_, wid = __builtin_amdgcn_readfirstlane(tid >> 6), lane = tid & 63, wr = wid >> 2, wc = wid & 3, fr = lane & 15, fq = lane >> 4;
    const int K = g.K, nt = K / BK;
    unsigned voffA[2], voffB[2];
#pragma unroll
    for (int i = 0; i < 2; ++i) { int R, C; stage_rc(tid * 16 + i * 8192, R, C); const int Rb = Epi::PERM ? ((R & ~31) + perm32(R & 31)) : R;
        voffA[i] = (unsigned)(R * K + C) * 2u; voffB[i] = (unsigned)(Rb * K + C) * 2u; }
    const size_t kstep = (size_t)(BK * 2);
    const size_t hstep = (size_t)HALF * K * 2;
    const size_t tstep = 2 * hstep;
    const unsigned ldsw = (unsigned)wid * 1024u;
    const int aoff = lds_byte(wr * 64 + fr, fq * 8), boff = lds_byte(wc * 32 + fr, fq * 8);
#define PG8_SA(b, h) (((b) * 2 + (h)) * HTB)
#define PG8_SB(b, h) ((4 + (b) * 2 + (h)) * HTB)
#define PG8_STAGE(bufoff, gbase, voff) do { _Pragma("unroll") for (int _i = 0; _i < 2; ++_i) \
        __builtin_amdgcn_global_load_lds((const unsigned*)((const char*)(gbase) + (voff)[_i]), (PG8_LAS unsigned*)(lds + (bufoff) + ldsw + _i * 8192), 16, 0, 0); } while (0)
#define PG8_LDA(dst, b, h) do { _Pragma("unroll") for (int m = 0; m < 4; ++m) _Pragma("unroll") for (int k = 0; k < 2; ++k) dst[m][k] = *(const PG8_LAS bf16x8*)(lds + PG8_SA(b, h) + aoff + m * 2048 + k * 1024); } while (0)
#define PG8_LDB(dst, b, h) do { _Pragma("unroll") for (int n = 0; n < 2; ++n) _Pragma("unroll") for (int k = 0; k < 2; ++k) dst[n][k] = *(const PG8_LAS bf16x8*)(lds + PG8_SB(b, h) + boff + n * 2048 + k * 1024); } while (0)
#define PG8_MMA(ai, bj, At, Bt) do { __builtin_amdgcn_s_setprio(1); _Pragma("unroll") for (int m = 0; m < 4; ++m) _Pragma("unroll") for (int n = 0; n < 2; ++n) _Pragma("unroll") for (int k = 0; k < 2; ++k) \
        acc[ai][bj][m][n] = __builtin_amdgcn_mfma_f32_16x16x32_bf16(Bt[n][k], At[m][k], acc[ai][bj][m][n], 0, 0, 0); __builtin_amdgcn_s_setprio(0); } while (0)
#define PG8_WAIT_V(n) asm volatile("s_waitcnt vmcnt(" #n ")" ::: "memory")
#define PG8_WAIT_L(n) asm volatile("s_waitcnt lgkmcnt(" #n ")" ::: "memory")
#define PG8_BAR __builtin_amdgcn_s_barrier()
#define PG8_SCHED __builtin_amdgcn_sched_barrier(0)
    Unit cur, nxt; int ui = 0;
    if (!S.next(0, cur)) return;
    f32x4 acc[2][2][4][2];
#pragma unroll
    for (int a = 0; a < 2; ++a)
#pragma unroll
        for (int b = 0; b < 2; ++b)
#pragma unroll
            for (int m = 0; m < 4; ++m)
#pragma unroll
                for (int n = 0; n < 2; ++n) acc[a][b][m][n] = (f32x4){0.f, 0.f, 0.f, 0.f};
    bf16x8 At[4][2], B0[2][2], B1[2][2];
    const char* cA = (const char*)g.A + (size_t)cur.pm * tstep; const char* cB = (const char*)g.Bt + (size_t)cur.pn * tstep;
    S.a_ready(cur);
    if constexpr (SP2) {
        PG8_STAGE(PG8_SB(0, 0), cB, voffB); PG8_STAGE(PG8_SB(0, 1), cB + hstep, voffB); PG8_STAGE(PG8_SA(0, 0), cA, voffA); PG8_STAGE(PG8_SA(0, 1), cA + hstep, voffA);
        if (wr == 1) PG8_BAR;
        PG8_WAIT_V(2); PG8_BAR;
        PG8_STAGE(PG8_SB(1, 0), cB + kstep, voffB); PG8_STAGE(PG8_SA(1, 0), cA + kstep, voffA); PG8_STAGE(PG8_SB(1, 1), cB + hstep + kstep, voffB);
        PG8_WAIT_V(6); PG8_BAR;
    } else {
        PG8_STAGE(PG8_SB(0, 0), cB, voffB); PG8_STAGE(PG8_SA(0, 0), cA, voffA); PG8_STAGE(PG8_SB(0, 1), cB + hstep, voffB); PG8_STAGE(PG8_SA(0, 1), cA + hstep, voffA);
        if (wr == 1) PG8_BAR;
        PG8_WAIT_V(4); PG8_BAR;
        PG8_STAGE(PG8_SB(1, 0), cB + kstep, voffB); PG8_STAGE(PG8_SA(1, 0), cA + kstep, voffA); PG8_STAGE(PG8_SB(1, 1), cB + hstep + kstep, voffB);
        PG8_WAIT_V(6); PG8_BAR;
    }
    for (;;) {
        const bool has_next = S.next(ui + 1, nxt);
        const char* nA = has_next ? (const char*)g.A + (size_t)nxt.pm * tstep : cA; const char* nB = has_next ? (const char*)g.Bt + (size_t)nxt.pn * tstep : cB;
        for (int t = 0; t < nt; t += 2) {
            const bool last = (t == nt - 2);
            const char* a1 = cA + (size_t)(t + 1) * kstep;
            const char* a2 = last ? nA : cA + (size_t)(t + 2) * kstep; const char* b2 = last ? nB : cB + (size_t)(t + 2) * kstep;
            const char* a3 = a2 + kstep; const char* b3 = b2 + kstep;
            if (last && has_next) S.a_ready(nxt);
            if constexpr (SP2) {
            PG8_LDB(B0, 0, 0); PG8_LDB(B1, 0, 1); PG8_SCHED; PG8_LDA(At, 0, 0); PG8_STAGE(PG8_SA(1, 1), a1 + hstep, voffA);
            PG8_WAIT_V(8); PG8_WAIT_L(0); PG8_BAR; PG8_MMA(0, 0, At, B0); PG8_MMA(0, 1, At, B1); PG8_BAR; PG8_SCHED;
            PG8_LDA(At, 0, 1); PG8_STAGE(PG8_SB(0, 0), b2, voffB); PG8_STAGE(PG8_SB(0, 1), b2 + hstep, voffB); PG8_STAGE(PG8_SA(0, 0), a2, voffA);
            PG8_WAIT_V(8); PG8_WAIT_L(0); PG8_BAR; PG8_MMA(1, 0, At, B0); PG8_MMA(1, 1, At, B1); PG8_BAR; PG8_SCHED;
            PG8_LDB(B0, 1, 0); PG8_LDB(B1, 1, 1); PG8_SCHED; PG8_LDA(At, 1, 0); PG8_STAGE(PG8_SA(0, 1), a2 + hstep, voffA);
            PG8_WAIT_V(8); PG8_WAIT_L(0); PG8_BAR; PG8_MMA(0, 0, At, B0); PG8_MMA(0, 1, At, B1); PG8_BAR; PG8_SCHED;
            PG8_LDA(At, 1, 1); PG8_STAGE(PG8_SB(1, 0), b3, voffB); PG8_STAGE(PG8_SB(1, 1), b3 + hstep, voffB); PG8_STAGE(PG8_SA(1, 0), a3, voffA);
            PG8_WAIT_V(8); PG8_WAIT_L(0); PG8_BAR; PG8_MMA(1, 0, At, B0); PG8_MMA(1, 1, At, B1); PG8_BAR; PG8_SCHED;
            } else {
            PG8_LDB(B0, 0, 0); PG8_SCHED; PG8_LDA(At, 0, 0); PG8_STAGE(PG8_SA(1, 1), a1 + hstep, voffA);
            PG8_WAIT_L(8); PG8_BAR; PG8_WAIT_L(0); PG8_MMA(0, 0, At, B0); PG8_BAR; PG8_SCHED;
            PG8_LDB(B1, 0, 1); PG8_STAGE(PG8_SB(0, 0), b2, voffB);
            PG8_BAR; PG8_WAIT_L(0); PG8_MMA(0, 1, At, B1); PG8_BAR;
            PG8_LDA(At, 0, 1); PG8_STAGE(PG8_SA(0, 0), a2, voffA);
            PG8_BAR; PG8_WAIT_L(0); PG8_MMA(1, 0, At, B0); PG8_BAR; PG8_SCHED;
            PG8_STAGE(PG8_SB(0, 1), b2 + hstep, voffB);
            PG8_WAIT_V(6); PG8_BAR; PG8_MMA(1, 1, At, B1); PG8_BAR;
            PG8_LDB(B0, 1, 0); PG8_SCHED; PG8_LDA(At, 1, 0); PG8_STAGE(PG8_SA(0, 1), a2 + hstep, voffA);
            PG8_WAIT_L(8); PG8_BAR; PG8_WAIT_L(0); PG8_MMA(0, 0, At, B0); PG8_BAR; PG8_SCHED;
            PG8_LDB(B1, 1, 1); PG8_STAGE(PG8_SB(1, 0), b3, voffB);
            PG8_BAR; PG8_WAIT_L(0); PG8_MMA(0, 1, At, B1); PG8_BAR;
            PG8_LDA(At, 1, 1); PG8_STAGE(PG8_SA(1, 0), a3, voffA);
            PG8_BAR; PG8_WAIT_L(0); PG8_MMA(1, 0, At, B0); PG8_BAR; PG8_SCHED;
            PG8_STAGE(PG8_SB(1, 1), b3 + hstep, voffB);
            PG8_WAIT_V(6); PG8_BAR; PG8_MMA(1, 1, At, B1); PG8_BAR;
            }
        }
        if constexpr (ALIGN_EPI) { if (wr == 0) PG8_BAR; }
        if constexpr (!Epi::AFTER_DRAIN) { E(acc, cur, wr, wc, fr, fq); S.done(cur); }
        if (!has_next) break;
#pragma unroll
        for (int a = 0; a < 2; ++a)
#pragma unroll
            for (int b = 0; b < 2; ++b)
#pragma unroll
                for (int m = 0; m < 4; ++m)
#pragma unroll
                    for (int n = 0; n < 2; ++n) acc[a][b][m][n] = (f32x4){0.f, 0.f, 0.f, 0.f};
        cur = nxt; cA = nA; cB = nB; ++ui;
        if constexpr (ALIGN_EPI) { if (wr == 1) PG8_BAR; }
    }
    PG8_WAIT_V(0);
    if constexpr (!ALIGN_EPI) { if (wr == 0) PG8_BAR; }
    PG8_BAR;
    if constexpr (Epi::AFTER_DRAIN) { E.fused(acc, cur, wr, wc, fr, fq, lds, wid, lane); S.done(cur); }
#undef PG8_SA
#undef PG8_SB
#undef PG8_STAGE
#undef PG8_LDA
#undef PG8_LDB
#undef PG8_MMA
#undef PG8_WAIT_V
#undef PG8_WAIT_L
#undef PG8_BAR
#undef PG8_SCHED
}
}


constexpr int D = 2048, NCTX = 4096, NLAT = 16384, M = NCTX + NLAT, DEPTH = 4;
constexpr int DIN = 4624, DINP = 4864, DFF = 8192;
constexpr int C_AQ = 0, C_AK = 1024, C_AV = 1280, C_DQ = 1536, C_DK = 2048, C_DV = 2560, C_DZ = 3072, C_DAB = 3584, C_SU = 3600, C_SV = 4112;
constexpr int NWAVES = 8;
constexpr float EPS = 1e-6f;
constexpr size_t O_Y = 0, O_K = (size_t)M * D, O_V = O_K + 4194304, O_DELTA = O_V + 4194304, O_END = O_DELTA + 8388608;
constexpr size_t MiB = 1u << 20;
constexpr size_t WS_CTL = 0, CTL_ZERO_BYTES = 1 * MiB;
static_assert((16384 + 9 * 20480) * 4 <= 1 * 1048576, "ssq inside the memset region");
constexpr size_t WS_MOD = 1 * MiB, WS_ROPE = 3 * MiB, WS_CK = 4 * MiB, WS_CV = 12 * MiB;
constexpr size_t WS_WIN = 20 * MiB, WS_WOUT = 96 * MiB, WS_WFF1 = 128 * MiB, WS_WFF2 = 256 * MiB;
constexpr size_t WS_X = 384 * MiB, WS_HB = 544 * MiB, WS_ZB = 624 * MiB, WS_ODIR = 816 * MiB, WS_DN = 944 * MiB, WS_BW = 1088 * MiB, WS_XA = 1090 * MiB, WS_SSQ = 1170 * MiB, WS_END = 1172 * MiB;
constexpr int BW_L = 9 * (DINP + DFF);
constexpr int CW_SSQ = 16384;
constexpr size_t DN_BLK = 116736, DN_DIR0 = 32768, DN_DIRSZ = 41984;
static_assert(WS_DN + 1280 * DN_BLK <= WS_END, "dn scratch");
constexpr int CW_BAR = 4096, CW_ATT = 8192, CW_PART = 204800;
constexpr int LDSCTL_OFF = 153600, LDS_BYTES = 154624;

#define GAS __attribute__((address_space(1)))
#define LAS __attribute__((address_space(3)))
typedef unsigned short bf16;
typedef unsigned v4u __attribute__((ext_vector_type(4)));
typedef unsigned v2u __attribute__((ext_vector_type(2)));
typedef float f32x4 __attribute__((ext_vector_type(4)));
typedef float f32x2 __attribute__((ext_vector_type(2)));
typedef float f32x16 __attribute__((ext_vector_type(16)));
typedef short bf16x8 __attribute__((ext_vector_type(8)));
typedef short s16x4 __attribute__((ext_vector_type(4)));
typedef LAS unsigned char* ldsp;
#define LDS_WAIT() asm volatile("s_waitcnt lgkmcnt(0)" ::: "memory")
#define VM_WAIT() asm volatile("s_waitcnt vmcnt(0)" ::: "memory")
__device__ __forceinline__ unsigned pk2(float lo, float hi) { return pg8::cvt_pk_bf16(lo, hi); }
__device__ __forceinline__ float bflo(unsigned w) { return __uint_as_float(w << 16); }
__device__ __forceinline__ float bfhi(unsigned w) { return __uint_as_float(w & 0xffff0000u); }
__device__ __forceinline__ float bf2f(bf16 b) { return __uint_as_float((unsigned)b << 16); }
__device__ __forceinline__ float wave_sum(float v) {
#define WS_DPP(ctrl, rmask) __builtin_bit_cast(float, __builtin_amdgcn_update_dpp(0, __builtin_bit_cast(int, v), ctrl, rmask, 0xF, false))
    v += WS_DPP(0xB1, 0xF);
    v += WS_DPP(0x4E, 0xF);
    v += WS_DPP(0x141, 0xF);
    v += WS_DPP(0x140, 0xF);
    v += WS_DPP(0x142, 0xA);
    v += WS_DPP(0x143, 0xC);
#undef WS_DPP
    return __builtin_bit_cast(float, __builtin_amdgcn_ds_bpermute(63 * 4, __builtin_bit_cast(int, v)));
}
__device__ __forceinline__ int crow(int r, int hi) { return (r & 3) + 8 * (r >> 2) + 4 * hi; }
__device__ __forceinline__ float silu_f(float x) { return x * __builtin_amdgcn_rcpf(1.f + __expf(-x)); }
__device__ __forceinline__ float gelu_tanh(float x) { const float y = 0.7978845608028654f * (x + 0.044715f * x * x * x); const float e = __expf(2.f * y); return x * (1.f - __builtin_amdgcn_rcpf(1.f + e)); }
template <int S> __device__ __forceinline__ bf16x8 pack8(const f32x16& v) {
    v4u w; w.x = pk2(v[8 * S + 0], v[8 * S + 1]); w.y = pk2(v[8 * S + 2], v[8 * S + 3]); w.z = pk2(v[8 * S + 4], v[8 * S + 5]); w.w = pk2(v[8 * S + 6], v[8 * S + 7]);
    return __builtin_bit_cast(bf16x8, w);
}
__device__ __forceinline__ f32x16 mma_lds(ldsp A, int sa, ldsp B, int sb, int nk, int lane, f32x16 acc) {
    ldsp ap = A + (lane & 31) * sa + (lane >> 5) * 16; ldsp bp = B + (lane & 31) * sb + (lane >> 5) * 16;
#pragma unroll 4
    for (int k = 0; k < nk; ++k) { const bf16x8 a = *(const LAS bf16x8*)(ap + k * 32); const bf16x8 b = *(const LAS bf16x8*)(bp + k * 32); acc = __builtin_amdgcn_mfma_f32_32x32x16_bf16(a, b, acc, 0, 0, 0); }
    return acc;
}

#define XB_TMO      128
#define XB_XCNT(j)  (256  + 64 * (j))
#define XB_XSUB(j)  (1280 + 64 * (j))
#define XB_XGEN(j)  (2304 + 64 * (j))
#define XB_TOP      3328
#define XB_TOPGEN   3392
#define XCD_BAR_WORDS 3456
#define XB_SPIN_CAP (1u << 18)
#define LAS __attribute__((address_space(3)))

__device__ __forceinline__ unsigned xb_ld(unsigned* p)              { return __hip_atomic_load(p, __ATOMIC_RELAXED, __HIP_MEMORY_SCOPE_AGENT); }
__device__ __forceinline__ unsigned xb_add(unsigned* p, unsigned v) { return __hip_atomic_fetch_add(p, v, __ATOMIC_RELAXED, __HIP_MEMORY_SCOPE_AGENT); }
__device__ __forceinline__ unsigned xb_xcc_id() { return (unsigned)__builtin_amdgcn_s_getreg((3 << 11) | 20) & 0xFu; }
#define XB_SPIN(cond, bar) do { unsigned _sp = 0; while (cond) { __builtin_amdgcn_s_sleep(1); \
    if ((++_sp & 255u) == 0u) { if (xb_ld(&(bar)[XB_TMO])) break; if (_sp > XB_SPIN_CAP) { atomicAdd(&(bar)[XB_TMO], 1u); break; } } } } while (0)

struct XcdBarrier {
    unsigned* bar; unsigned x; bool t0;
    volatile LAS unsigned* st;
};

__device__ __forceinline__ XcdBarrier xcd_barrier_post(unsigned* bar, volatile LAS unsigned* st) {
    XcdBarrier b; b.bar = bar; b.x = xb_xcc_id(); b.st = st; b.t0 = (threadIdx.x == 0);
    if (threadIdx.x == 0) (void)xb_add(&bar[XB_XCNT(b.x)], 1u);
    return b;
}
__device__ __forceinline__ void xcd_barrier_complete(unsigned* bar, unsigned x, unsigned& nloc, unsigned& nx) {
    const unsigned G = gridDim.x * gridDim.y * gridDim.z;
    unsigned sum, cnt, mine, sp = 0u;
    for (;;) {
        sum = 0u; cnt = 0u; mine = 0u;
#pragma unroll
        for (unsigned j = 0; j < 16; ++j) { const unsigned c = xb_ld(&bar[XB_XCNT(j)]); sum += c; cnt += (c > 0u) ? 1u : 0u; mine = (j == x) ? c : mine; }
        if (sum == G) break;
        __builtin_amdgcn_s_sleep(1);
        if ((++sp & 255u) == 0u) { if (xb_ld(&bar[XB_TMO])) break; if (sp > XB_SPIN_CAP) { atomicAdd(&bar[XB_TMO], 1u); break; } }
    }
    nloc = mine > 0u ? mine : 1u; nx = cnt > 0u ? cnt : 1u;
}

__device__ __forceinline__ void xcd_barrier(const XcdBarrier& b) {
    asm volatile("s_waitcnt vmcnt(0)" ::: "memory");
    __syncthreads();
    if (b.t0) {
        unsigned* bar = b.bar;
        __builtin_amdgcn_s_waitcnt(0);
        unsigned nloc = b.st[0], nx = b.st[1];
        if (nloc == 0u) { xcd_barrier_complete(bar, b.x, nloc, nx); b.st[0] = nloc; b.st[1] = nx; }
        const unsigned old = xb_add(&bar[XB_XSUB(b.x)], 1u);
        const unsigned gen = old / nloc;
        if (old + 1u == (gen + 1u) * nloc) {
            __builtin_amdgcn_fence(__ATOMIC_RELEASE, "agent");
            asm volatile("s_waitcnt vmcnt(0)" ::: "memory");
            const unsigned og = xb_add(&bar[XB_TOP], 1u);
            const unsigned tg = og / nx;
            if (og + 1u == (tg + 1u) * nx) xb_add(&bar[XB_TOPGEN], 1u);
            else XB_SPIN(xb_ld(&bar[XB_TOPGEN]) == tg, bar);
            __builtin_amdgcn_fence(__ATOMIC_ACQUIRE, "agent");
            xb_add(&bar[XB_XGEN(b.x)], 1u);
            asm volatile("s_waitcnt vmcnt(0)" ::: "memory");
        } else {
            XB_SPIN(xb_ld(&bar[XB_XGEN(b.x)]) == gen, bar);
            __builtin_amdgcn_fence(__ATOMIC_ACQUIRE, "agent");
            asm volatile("s_waitcnt vmcnt(0)" ::: "memory");
        }
    }
    __syncthreads();
}


__device__ __forceinline__ void p0_transpose_item(const float* W, int K, int N, bf16* WT, LAS float* scr, int item, int lane) {
    const int nblk = (N + 31) / 32, kb = item / nblk, nb = item % nblk, k0 = 64 * kb, n0 = 32 * nb; const bool okn = (n0 + (lane & 31)) < N;
#pragma unroll 16
    for (int i = 0; i < 32; ++i) { const int kk = 2 * i + (lane >> 5); scr[kk * 33 + (lane & 31)] = okn ? W[(size_t)(k0 + kk) * N + n0 + (lane & 31)] : 0.f; }
    LDS_WAIT(); asm volatile("" ::: "memory");
    const int c = lane & 7;
#pragma unroll
    for (int j = 0; j < 4; ++j) { const int n = (lane >> 3) + 8 * j; const LAS float* s = scr + (8 * c) * 33 + n;
        v4u o; o.x = pk2(s[0 * 33], s[1 * 33]); o.y = pk2(s[2 * 33], s[3 * 33]); o.z = pk2(s[4 * 33], s[5 * 33]); o.w = pk2(s[6 * 33], s[7 * 33]);
        *(GAS v4u*)(WT + (size_t)(n0 + n) * K + k0 + 8 * c) = o; }
    LDS_WAIT(); asm volatile("" ::: "memory");
}
struct P0Args { const float *c, *c_ctx, *norm1_g, *norm2_g, *w_mod, *b_mod, *w_in, *w_out, *w_ff1, *w_ff2, *cache_k, *cache_v; unsigned char* ws; };
constexpr int T_IN = 32 * 145, T_OUT = 32 * 64, T_F1 = 32 * 256, T_F2 = 128 * 64, T_L = T_IN + T_OUT + T_F1 + T_F2;
__device__ __forceinline__ void transpose_layer(const float* w_in, const float* w_out, const float* w_ff1, const float* w_ff2, unsigned char* ws, int l, LAS float* scr, int wi0, int wstride, int lane) {
    asm volatile("" : "+v"(lane));
    for (int wi = wi0; wi < T_L; wi += wstride) {
        int r = wi;
        if (r < T_IN) { p0_transpose_item(w_in + (size_t)l * 2048 * DIN, 2048, DIN, (bf16*)(ws + WS_WIN) + (size_t)l * DINP * 2048, scr, r, lane); continue; } r -= T_IN;
        if (r < T_OUT) { p0_transpose_item(w_out + (size_t)l * 2048 * 2048, 2048, 2048, (bf16*)(ws + WS_WOUT) + (size_t)l * 2048 * 2048, scr, r, lane); continue; } r -= T_OUT;
        if (r < T_F1) { p0_transpose_item(w_ff1 + (size_t)l * 2048 * DFF, 2048, DFF, (bf16*)(ws + WS_WFF1) + (size_t)l * DFF * 2048, scr, r, lane); continue; } r -= T_F1;
        p0_transpose_item(w_ff2 + (size_t)l * DFF * 2048, DFF, 2048, (bf16*)(ws + WS_WFF2) + (size_t)l * 2048 * DFF, scr, r, lane);
    }
}
__device__ __forceinline__ void p0_prologue(const P0Args& a, ldsp lds, unsigned* queue, volatile LAS unsigned* misc, int tid, int lane, int wave, int G) {
    asm volatile("" : "+v"(tid), "+v"(lane));
    LAS float* silu_t = (LAS float*)lds;
    LAS float* scr = (LAS float*)(lds + 73728 + wave * 8448);
    constexpr int N_MOD = 96;
    constexpr int N_CVT = 512, N_ROPE = 256, N_TR = DEPTH * T_L / 8, N_ITEMS = N_MOD + N_CVT + N_ROPE + N_TR;
    static_assert((DEPTH * T_L) % 8 == 0, "transposes");
    bool have_silu = false;
    float* MOD = (float*)(a.ws + WS_MOD);
    for (;;) {
        if (tid == 0) misc[0] = atomicAdd(queue, 1u);
        __syncthreads(); const int it = (int)misc[0]; __syncthreads();
        if (it >= N_ITEMS) break;
        if (it < N_MOD) {
            if (!have_silu) { have_silu = true;
                for (int i = tid; i < 9 * 2048; i += NWAVES * 64) { const float x = i < 8 * 2048 ? a.c[i] : a.c_ctx[i - 8 * 2048]; silu_t[i] = x / (1.f + expf(-x)); }
                __syncthreads(); }
            const int wi = it * 8 + wave, l = wi / 192, cb = wi % 192, j = cb * 64 + lane;
            float acc[9];
#pragma unroll
            for (int c = 0; c < 9; ++c) acc[c] = 0.f;
            const float* wp = a.w_mod + (size_t)l * 2048 * 12288 + j;
            for (int k0 = 0; k0 < 2048; k0 += 32) {
                float w[32];
#pragma unroll
                for (int i = 0; i < 32; ++i) w[i] = wp[(size_t)(k0 + i) * 12288];
#pragma unroll
                for (int c = 0; c < 9; ++c)
#pragma unroll
                    for (int i4 = 0; i4 < 8; ++i4) { const f32x4 s = *(const LAS f32x4*)(silu_t + c * 2048 + k0 + 4 * i4);
                        acc[c] += s.x * w[4 * i4] + s.y * w[4 * i4 + 1] + s.z * w[4 * i4 + 2] + s.w * w[4 * i4 + 3]; }
            }
            const int slot = j >> 11, col = j & 2047; const float bm = a.b_mod[l * 12288 + j];
            const float gn = slot == 1 ? a.norm1_g[l * 2048 + col] : (slot == 4 ? a.norm2_g[l * 2048 + col] : 0.f);
#pragma unroll
            for (int c = 0; c < 9; ++c) { float v = acc[c] + bm; if (slot == 1 || slot == 4) v = gn * (1.f + v); MOD[(size_t)(l * 9 + c) * 12288 + j] = v; }
        } else if (it < N_MOD + N_CVT) {
            const int ci = it - N_MOD;
#pragma unroll
            for (int s = 0; s < 4; ++s) { const size_t e8 = (size_t)ci * 2048 + s * 512 + tid; const bool isv = e8 >= 524288; const size_t j8 = isv ? e8 - 524288 : e8;
                const float* src = (isv ? a.cache_v : a.cache_k) + j8 * 8; const f32x4 x0 = *(const f32x4*)src, x1 = *(const f32x4*)(src + 4);
                v4u o; o.x = pk2(x0.x, x0.y); o.y = pk2(x0.z, x0.w); o.z = pk2(x1.x, x1.y); o.w = pk2(x1.z, x1.w);
                *(v4u*)((bf16*)(a.ws + (isv ? WS_CV : WS_CK)) + j8 * 8) = o; }
        } else if (it < N_MOD + N_CVT + N_ROPE) {
            const int e = (it - N_MOD - N_CVT) * 512 + tid, t = e >> 6, i = e & 63;
            const float inv = powf(10000.f, -(float)(2 * (i & 31)) / 64.f); const float pos = i < 32 ? (float)(t >> 6) : (float)(t & 63); const float ang = pos * inv;
            ((float*)(a.ws + WS_ROPE))[e] = cosf(ang); ((float*)(a.ws + WS_ROPE))[131072 + e] = sinf(ang);
        } else {
            const int wi = (it - N_MOD - N_CVT - N_ROPE) * 8 + wave, l = wi / T_L;
            transpose_layer(a.w_in, a.w_out, a.w_ff1, a.w_ff2, a.ws, l, scr, wi % T_L, T_L, lane);
        }
    }
}
__device__ __forceinline__ void p0b_bias(unsigned char* ws, ldsp lds, int tid, int lane, int wave, int G) {
    asm volatile("" : "+v"(tid), "+v"(lane));
    LAS float* sh = (LAS float*)lds;
    const float* MOD = (const float*)(ws + WS_MOD); float* BW = (float*)(ws + WS_BW);
    constexpr int NB1 = DINP / 64, NB2 = DFF / 64, NBL = NB1 + NB2;
    int cur = -1;
    for (int it = blockIdx.x; it < DEPTH * NBL; it += G) {
        const int l = it / NBL, r = it % NBL, which = r >= NB1 ? 1 : 0, rb = which ? r - NB1 : r, key = l * 2 + which;
        if (key != cur) { __syncthreads(); cur = key;
            for (int i = tid; i < 9 * 2048; i += NWAVES * 64) sh[i] = MOD[(size_t)(l * 9 + (i >> 11)) * 12288 + (which ? 3 : 0) * 2048 + (i & 2047)];
            __syncthreads(); }
        const bf16* WT = which ? (const bf16*)(ws + WS_WFF1) + (size_t)l * DFF * 2048 : (const bf16*)(ws + WS_WIN) + (size_t)l * DINP * 2048;
        const int ldb = which ? DFF : DINP; float* bwp = BW + (size_t)l * BW_L + (which ? 9 * DINP : 0);
#pragma unroll 1
        for (int rr = 0; rr < 8; rr += 2) { const int n = rb * 64 + wave * 8 + rr; const bf16* wr_ = WT + (size_t)n * 2048 + lane * 8;
            v4u q[2][4];
#pragma unroll
            for (int u = 0; u < 2; ++u)
#pragma unroll
                for (int j = 0; j < 4; ++j) q[u][j] = *(const v4u*)(wr_ + (size_t)u * 2048 + 512 * j);
            float res0 = 0.f, res1 = 0.f;
#pragma unroll 1
            for (int c = 0; c < 9; ++c) { float s0 = 0.f, s1 = 0.f;
#pragma unroll
                for (int j = 0; j < 4; ++j) { const f32x4 a0 = *(const LAS f32x4*)(sh + c * 2048 + 512 * j + lane * 8), a1 = *(const LAS f32x4*)(sh + c * 2048 + 512 * j + lane * 8 + 4);
                    s0 += a0.x * bflo(q[0][j].x) + a0.y * bfhi(q[0][j].x) + a0.z * bflo(q[0][j].y) + a0.w * bfhi(q[0][j].y) + a1.x * bflo(q[0][j].z) + a1.y * bfhi(q[0][j].z) + a1.z * bflo(q[0][j].w) + a1.w * bfhi(q[0][j].w);
                    s1 += a0.x * bflo(q[1][j].x) + a0.y * bfhi(q[1][j].x) + a0.z * bflo(q[1][j].y) + a0.w * bfhi(q[1][j].y) + a1.x * bflo(q[1][j].z) + a1.y * bfhi(q[1][j].z) + a1.z * bflo(q[1][j].w) + a1.w * bfhi(q[1][j].w); }
                s0 = wave_sum(s0); s1 = wave_sum(s1); res0 = (lane == c) ? s0 : res0; res1 = (lane == c) ? s1 : res1; }
            if (lane < 9) { bwp[(size_t)lane * ldb + n] = res0; bwp[(size_t)lane * ldb + n + 1] = res1; } }
    }
    __syncthreads();
}

template <bool FINAL>
__device__ __forceinline__ void norm_phase(const float* x0, const float* x1, const float* modA, bf16* xb, bf16* xa, unsigned long long* ssq, float* outf, int lane, int wave, int G) {
    asm volatile("" : "+v"(lane)); asm volatile("" : "+s"(wave), "+s"(G));
    const int rpw = (M + G - 1) / G, r0 = blockIdx.x * rpw, r1 = min(M, r0 + rpw);
    f32x4 A[8]; int cur = -1;
    for (int rb = r0 + wave; rb < r1; rb += 2 * NWAVES) {
        f32x4 v[2][8];
#pragma unroll
        for (int u = 0; u < 2; ++u) { const int r = rb + u * NWAVES; if (r < r1) {
            if (FINAL) {
#pragma unroll
                for (int j = 0; j < 8; ++j) { const v2u w = *(const v2u*)(xb + (size_t)r * D + 4 * lane + 256 * j); v[u][j] = (f32x4){bflo(w.x), bfhi(w.x), bflo(w.y), bfhi(w.y)}; }
            } else { const float* xr = r < NCTX ? x0 + (size_t)r * D : x1 + (size_t)(r - NCTX) * D;
#pragma unroll
                for (int j = 0; j < 8; ++j) v[u][j] = *(const f32x4*)(xr + 4 * lane + 256 * j); } } }
#pragma unroll
        for (int u = 0; u < 2; ++u) { const int r = rb + u * NWAVES; if (r < r1) {
            const int cond = FINAL ? 0 : (r < NCTX ? 8 : ((r - NCTX) >> 11));
            if (cond != cur) { cur = cond;
#pragma unroll
                for (int j = 0; j < 8; ++j) A[j] = *(const f32x4*)(modA + (size_t)cond * 12288 + 4 * lane + 256 * j); }
            float ss = 0.f;
#pragma unroll
            for (int j = 0; j < 8; ++j) ss += (v[u][j].x * v[u][j].x + v[u][j].y * v[u][j].y) + (v[u][j].z * v[u][j].z + v[u][j].w * v[u][j].w);
            ss = wave_sum(ss);
            if (FINAL) { const float rstd = rsqrtf(ss * (1.f / D) + EPS);
#pragma unroll
                for (int j = 0; j < 8; ++j) *(f32x4*)(outf + (size_t)r * D + 4 * lane + 256 * j) = v[u][j] * rstd * A[j];
            } else {
#pragma unroll
                for (int j = 0; j < 8; ++j) { const f32x4 y = v[u][j] * A[j]; v2u o; o.x = pk2(y.x, y.y); o.y = pk2(y.z, y.w); *(v2u*)(xa + (size_t)r * D + 4 * lane + 256 * j) = o;
                    v2u xo; xo.x = pk2(v[u][j].x, v[u][j].y); xo.y = pk2(v[u][j].z, v[u][j].w); *(v2u*)(xb + (size_t)r * D + 4 * lane + 256 * j) = xo; }
                if (lane == 0) { const float hi = floorf(ss); ssq[r] = ((unsigned long long)(unsigned)hi << 24) + (unsigned long long)(unsigned)((ss - hi) * 16777216.f); }
            } } }
    }
}

#ifndef PROBE_DUP
#define PROBE_DUP 0
#endif
constexpr int P_KT = 0, P_QT = 17408, P_KTT = 34816, P_VT = 53248, P_T1 = 71680, P_T2 = 71680 + 18432, P_AM = 108544, P_GL = 141312;
struct LayerP { const float *conv_w, *a_log, *dt_bias, *dn_norm_g, *sgu_norm_g, *sgu_w, *sgu_b, *sink; };
__device__ __forceinline__ void dn_prep_unit(const LayerP& P, const bf16* zb, unsigned char* dn, ldsp lds, int gchunk, int h, int tid, int lane, int wave) {
    asm volatile("" : "+v"(tid), "+v"(lane));
    const bool isctx = gchunk < 64; const int pc = isctx ? (gchunk & 3) : ((gchunk - 64) & 31); const int T = isctx ? 256 : 2048;
    const long grow0 = (long)gchunk * 64; unsigned char* blk = dn + (size_t)(gchunk * 4 + h) * DN_BLK;
    LAS float* GL = (LAS float*)(lds + P_GL);
    for (int rep_ = 0; rep_ < ((PROBE_DUP & 1024) ? 2 : 1); ++rep_) {
    float s0_alpha[2] = {0.f, 0.f}, s0_braw[2] = {0.f, 0.f}, s0_dt[2] = {0.f, 0.f}, s0_al[2] = {0.f, 0.f};
    if (wave == 0) { const bf16* zr = zb + (size_t)(grow0 + lane) * DINP + C_DAB;
#pragma unroll
        for (int d = 0; d < 2; ++d) { s0_alpha[d] = bf2f(zr[d * 8 + h]); s0_braw[d] = bf2f(zr[d * 8 + 4 + h]); s0_dt[d] = P.dt_bias[d * 4 + h]; s0_al[d] = P.a_log[d * 4 + h]; } }
    {
        const float* cw = P.conv_w; const int cq = h * 128 + 2 * lane;
        f32x2 wq[5], wk[5], wv[5];
#pragma unroll
        for (int j = 0; j < 5; ++j) { wq[j] = *(const f32x2*)(cw + j * 1536 + cq); wk[j] = *(const f32x2*)(cw + j * 1536 + 512 + cq); wv[j] = *(const f32x2*)(cw + j * 1536 + 1024 + cq); }
        unsigned xq[12], xk[12], xv[12];
#pragma unroll
        for (int rr = 0; rr < 12; ++rr) { const int tl = 8 * wave - 2 + rr, tpos = pc * 64 + tl; const bool ok = tpos >= 0 && tpos < T;
            const bf16* zr = zb + (grow0 + tl) * (long)DINP + h * 128 + 2 * lane;
            xq[rr] = ok ? *(const unsigned*)(zr + C_DQ) : 0u; xk[rr] = ok ? *(const unsigned*)(zr + C_DK) : 0u; xv[rr] = ok ? *(const unsigned*)(zr + C_DV) : 0u; }
        float k0s[8], k1s[8], v0s[8], v1s[8];
        LAS bf16* Kt = (LAS bf16*)(lds + P_KT); LAS bf16* Qt = (LAS bf16*)(lds + P_QT);
#pragma unroll
        for (int tt = 0; tt < 8; ++tt) {
            float q0 = 0.f, q1 = 0.f, k0 = 0.f, k1 = 0.f, v0 = 0.f, v1 = 0.f;
#pragma unroll
            for (int j = 0; j < 5; ++j) { q0 += bflo(xq[tt + j]) * wq[j].x; q1 += bfhi(xq[tt + j]) * wq[j].y; k0 += bflo(xk[tt + j]) * wk[j].x; k1 += bfhi(xk[tt + j]) * wk[j].y;
                v0 += bflo(xv[tt + j]) * wv[j].x; v1 += bfhi(xv[tt + j]) * wv[j].y; }
            q0 = silu_f(q0); q1 = silu_f(q1); k0 = silu_f(k0); k1 = silu_f(k1); v0 = silu_f(v0); v1 = silu_f(v1);
            const float rq = rsqrtf(wave_sum(q0 * q0 + q1 * q1) + EPS) * 0.08838834764831845f, rk = rsqrtf(wave_sum(k0 * k0 + k1 * k1) + EPS);
            q0 *= rq; q1 *= rq; k0 *= rk; k1 *= rk;
            const int t = 8 * wave + tt;
            *(LAS unsigned*)(Qt + t * 136 + 2 * lane) = pk2(q0, q1); *(LAS unsigned*)(Kt + t * 136 + 2 * lane) = pk2(k0, k1);
            k0s[tt] = k0; k1s[tt] = k1; v0s[tt] = v0; v1s[tt] = v1;
        }
        LAS bf16* KT = (LAS bf16*)(lds + P_KTT); LAS bf16* VT = (LAS bf16*)(lds + P_VT);
        v4u o;
        o.x = pk2(k0s[0], k0s[1]); o.y = pk2(k0s[2], k0s[3]); o.z = pk2(k0s[4], k0s[5]); o.w = pk2(k0s[6], k0s[7]); *(LAS v4u*)(KT + (2 * lane) * 72 + 8 * wave) = o;
        o.x = pk2(k1s[0], k1s[1]); o.y = pk2(k1s[2], k1s[3]); o.z = pk2(k1s[4], k1s[5]); o.w = pk2(k1s[6], k1s[7]); *(LAS v4u*)(KT + (2 * lane + 1) * 72 + 8 * wave) = o;
        o.x = pk2(v0s[0], v0s[1]); o.y = pk2(v0s[2], v0s[3]); o.z = pk2(v0s[4], v0s[5]); o.w = pk2(v0s[6], v0s[7]); *(LAS v4u*)(VT + (2 * lane) * 72 + 8 * wave) = o;
        o.x = pk2(v1s[0], v1s[1]); o.y = pk2(v1s[2], v1s[3]); o.z = pk2(v1s[4], v1s[5]); o.w = pk2(v1s[6], v1s[7]); *(LAS v4u*)(VT + (2 * lane + 1) * 72 + 8 * wave) = o;
    }
    if (wave == 0) {
#pragma unroll
        for (int d = 0; d < 2; ++d) {
            const float alpha = s0_alpha[d], braw = s0_braw[d];
            const float xr = alpha + s0_dt[d]; const float sp = fmaxf(xr, 0.f) + log1pf(expf(-fabsf(xr)));
            const float g = -expf(s0_al[d]) * sp; const float beta = 1.f / (1.f + expf(-braw));
            float gc = g;
#pragma unroll
            for (int o = 1; o < 64; o <<= 1) { const int src = (d == 0) ? lane - o : lane + o;
                const float t = __builtin_bit_cast(float, __builtin_amdgcn_ds_bpermute((src & 63) << 2, __builtin_bit_cast(int, gc))); const bool ok = (d == 0) ? (lane >= o) : (lane + o < 64); gc += ok ? t : 0.f; }
            const float gl = wave_sum(g); const float eg = expf(gc), egl = expf(gl - gc);
            GL[d * 64 + lane] = gc; GL[128 + d * 64 + lane] = beta; GL[256 + d * 64 + lane] = beta * eg;
            float* gv = (float*)(blk + DN_DIR0 + d * DN_DIRSZ + 40960);
            gv[lane] = eg; gv[64 + lane] = egl; if (lane == 0) gv[128] = expf(gl);
        }
    }
    __syncthreads();
    }
    for (int rep_ = 0; rep_ < ((PROBE_DUP & 4096) ? 2 : 1); ++rep_) {
    {
        const int hh = lane >> 5, cl = lane & 31; LAS float* AM = (LAS float*)(lds + P_AM);
        f32x16 acc = {};
        if (wave < 4) {
            const int rt = wave >> 1, ct = wave & 1;
            acc = mma_lds(lds + P_KT + 32 * rt * 272, 272, lds + P_KT + 32 * ct * 272, 272, 8, lane, acc);
            const int c = 32 * ct + cl; const float g0c = GL[c], g1c = GL[64 + c];
#pragma unroll
            for (int q = 0; q < 4; ++q) { const int r0 = 32 * rt + 8 * q + 4 * hh;
                const f32x4 g0 = *(const LAS f32x4*)(GL + r0), g1 = *(const LAS f32x4*)(GL + 64 + r0), b0 = *(const LAS f32x4*)(GL + 128 + r0), b1 = *(const LAS f32x4*)(GL + 192 + r0);
#pragma unroll
                for (int e = 0; e < 4; ++e) { const int rr = r0 + e; const float v = acc[4 * q + e];
                    if (rr > c) AM[rr * 64 + c] = b0[e] * v * __expf(g0[e] - g0c);
                    if (rr < c) AM[4096 + (63 - rr) * 64 + (63 - c)] = b1[e] * v * __expf(g1[e] - g1c); } }
        } else {
            const int cb = (wave - 4) >> 1, it = (wave - 4) & 1;
            acc = mma_lds(lds + P_KT + 32 * cb * 272, 272, lds + P_QT + 32 * it * 272, 272, 8, lane, acc);
            const int i = 32 * it + cl; const float g0i = GL[i], g1i = GL[64 + i];
            f32x16 a0, a1;
#pragma unroll
            for (int q = 0; q < 4; ++q) { const int c0 = 32 * cb + 8 * q + 4 * hh; const f32x4 g0 = *(const LAS f32x4*)(GL + c0), g1 = *(const LAS f32x4*)(GL + 64 + c0);
#pragma unroll
                for (int e = 0; e < 4; ++e) { const int c = c0 + e; const float v = acc[4 * q + e];
                    a0[4 * q + e] = (i >= c) ? v * __expf(fminf(g0i - g0[e], 0.f)) : 0.f; a1[4 * q + e] = (i <= c) ? v * __expf(fminf(g1i - g1[e], 0.f)) : 0.f; } }
            unsigned char* q0p = blk + DN_DIR0 + 32768 + ((cb * 2 + it) * 2) * 1024 + lane * 16; unsigned char* q1p = q0p + DN_DIRSZ;
            *(bf16x8*)(q0p) = pack8<0>(a0); *(bf16x8*)(q0p + 1024) = pack8<1>(a0); *(bf16x8*)(q1p) = pack8<0>(a1); *(bf16x8*)(q1p + 1024) = pack8<1>(a1);
        }
    }
    __syncthreads();
    }
    for (int rep_ = 0; rep_ < ((PROBE_DUP & 2048) ? 2 : 1); ++rep_) {
    if (wave < 2) {
        const int dir = wave; const LAS float* Am = (const LAS float*)(lds + P_AM) + dir * 4096;
        float Tr[64]; f32x4 cA[16], cB[16];
#define SOLVE_LOAD(dst, i_) do { _Pragma("unroll") for (int q = 0; q < 16; ++q) if (4 * q < (i_)) dst[q] = *(const LAS f32x4*)(Am + (i_) * 64 + 4 * q); } while (0)
#define SOLVE_ROW(src, i_) do { float a0 = (lane == (i_)) ? 1.f : 0.f, a1 = 0.f, a2 = 0.f, a3 = 0.f; \
            _Pragma("unroll") for (int q = 0; q < 16; ++q) { const int jb = 4 * q; \
                if (jb + 0 < (i_)) a0 -= src[q].x * Tr[jb + 0]; if (jb + 1 < (i_)) a1 -= src[q].y * Tr[jb + 1]; if (jb + 2 < (i_)) a2 -= src[q].z * Tr[jb + 2]; if (jb + 3 < (i_)) a3 -= src[q].w * Tr[jb + 3]; } \
            Tr[i_] = (a0 + a1) + (a2 + a3); } while (0)
        Tr[0] = (lane == 0) ? 1.f : 0.f;
        SOLVE_LOAD(cA, 1);
#pragma unroll
        for (int i = 1; i < 64; i += 2) {
            if (i + 1 < 64) SOLVE_LOAD(cB, i + 1);
            asm volatile("" ::: "memory");
            SOLVE_ROW(cA, i);
            if (i + 2 < 64) SOLVE_LOAD(cA, i + 2);
            asm volatile("" ::: "memory");
            if (i + 1 < 64) SOLVE_ROW(cB, i + 1);
        }
#undef SOLVE_LOAD
#undef SOLVE_ROW
        const int j = dir ? 63 - lane : lane; const float s1 = GL[256 + dir * 64 + j], s2 = GL[128 + dir * 64 + j];
        LAS bf16* T1 = (LAS bf16*)(lds + P_T1) + dir * 4608; LAS bf16* T2 = (LAS bf16*)(lds + P_T2) + dir * 4608;
#pragma unroll
        for (int ii = 0; ii < 64; ++ii) { const int i = dir ? 63 - ii : ii; T1[i * 72 + j] = (bf16)(pk2(Tr[ii] * s1, 0.f) & 0xffffu); T2[i * 72 + j] = (bf16)(pk2(Tr[ii] * s2, 0.f) & 0xffffu); }
    } else {
        const int hh = lane >> 5, rl = lane & 31;
        for (int b = wave - 2; b < 32; b += 6) {
            v2u lo, hi;
            if (b < 16) { const int it = b >> 3, db = (b >> 1) & 3, s = b & 1; const LAS bf16* p = (const LAS bf16*)(lds + P_QT) + (32 * it + rl) * 136 + 32 * db + 16 * s + 4 * hh; lo = *(const LAS v2u*)p; hi = *(const LAS v2u*)(p + 8); }
            else { const int bb = b - 16, dt = bb >> 2, cb = (bb >> 1) & 1, s = bb & 1; const LAS bf16* p = (const LAS bf16*)(lds + P_KTT) + (32 * dt + rl) * 72 + 32 * cb + 16 * s + 4 * hh; lo = *(const LAS v2u*)p; hi = *(const LAS v2u*)(p + 8); }
            v4u o; o.x = lo.x; o.y = lo.y; o.z = hi.x; o.w = hi.y;
            *(v4u*)(blk + (size_t)b * 1024 + lane * 16) = o;
        }
    }
    __syncthreads();
    }
    for (int rep_ = 0; rep_ < ((PROBE_DUP & 8192) ? 2 : 1); ++rep_) {
#pragma unroll 1
    for (int tix = wave; tix < 32; tix += 8) {
        const int dir = tix >> 4, kind = (tix >> 3) & 1, idx = tix & 7; f32x16 acc = {};
        unsigned char* dst;
        if (kind == 0) { const int ct = idx >> 2, es = idx & 3;
            acc = mma_lds(lds + P_T2 + dir * 9216 + 32 * ct * 144, 144, lds + P_VT + 32 * es * 144, 144, 4, lane, acc);
            dst = blk + DN_DIR0 + dir * DN_DIRSZ + ((ct * 4 + es) * 2) * 1024 + lane * 16;
        } else { const int db = idx >> 1, ct = idx & 1;
            acc = mma_lds(lds + P_KTT + 32 * db * 144, 144, lds + P_T1 + dir * 9216 + 32 * ct * 144, 144, 4, lane, acc);
#pragma unroll
            for (int r = 0; r < 16; ++r) acc[r] = -acc[r];
            dst = blk + DN_DIR0 + dir * DN_DIRSZ + 16384 + ((db * 2 + ct) * 2) * 1024 + lane * 16;
        }
        *(bf16x8*)dst = pack8<0>(acc); *(bf16x8*)(dst + 1024) = pack8<1>(acc);
    }
    __syncthreads();
    }
}

__device__ __forceinline__ void sgu_unit(const LayerP& P, const bf16* zb, bf16* mix, ldsp lds, int rc, int g, bool load_w, int tid, int lane, int wave) {
    asm volatile("" : "+v"(tid), "+v"(lane));
    const size_t grow0 = (size_t)rc * 128; LAS bf16* Wl = (LAS bf16*)lds; LAS bf16* Vt = (LAS bf16*)(lds + 34816);
    {
        const float gn0 = P.sgu_norm_g[g * 128 + 2 * lane], gn1 = P.sgu_norm_g[g * 128 + 2 * lane + 1];
        float v0[16], v1[16];
#pragma unroll
        for (int qq = 0; qq < 16; ++qq) { const unsigned w = *(const unsigned*)(zb + (grow0 + 16 * wave + qq) * DINP + C_SV + g * 128 + 2 * lane);
            const float a = gelu_tanh(bflo(w)), b = gelu_tanh(bfhi(w)); const float r = rsqrtf(wave_sum(a * a + b * b) * (1.f / 128.f) + EPS); v0[qq] = a * r * gn0; v1[qq] = b * r * gn1; }
        v4u o;
        o.x = pk2(v0[0], v0[1]); o.y = pk2(v0[2], v0[3]); o.z = pk2(v0[4], v0[5]); o.w = pk2(v0[6], v0[7]); *(LAS v4u*)(Vt + (2 * lane) * 136 + 16 * wave) = o;
        o.x = pk2(v0[8], v0[9]); o.y = pk2(v0[10], v0[11]); o.z = pk2(v0[12], v0[13]); o.w = pk2(v0[14], v0[15]); *(LAS v4u*)(Vt + (2 * lane) * 136 + 16 * wave + 8) = o;
        o.x = pk2(v1[0], v1[1]); o.y = pk2(v1[2], v1[3]); o.z = pk2(v1[4], v1[5]); o.w = pk2(v1[6], v1[7]); *(LAS v4u*)(Vt + (2 * lane + 1) * 136 + 16 * wave) = o;
        o.x = pk2(v1[8], v1[9]); o.y = pk2(v1[10], v1[11]); o.z = pk2(v1[12], v1[13]); o.w = pk2(v1[14], v1[15]); *(LAS v4u*)(Vt + (2 * lane + 1) * 136 + 16 * wave + 8) = o;
    }
    if (load_w) {
        const int p = tid >> 2, q0 = (tid & 3) * 32; const float* src = P.sgu_w + ((size_t)g * 128 + p) * 128 + q0;
#pragma unroll
        for (int j = 0; j < 4; ++j) { const f32x4 x0 = *(const f32x4*)(src + 8 * j), x1 = *(const f32x4*)(src + 8 * j + 4);
            v4u o; o.x = pk2(x0.x, x0.y); o.y = pk2(x0.z, x0.w); o.z = pk2(x1.x, x1.y); o.w = pk2(x1.z, x1.w); *(LAS v4u*)(Wl + p * 136 + q0 + 8 * j) = o; }
    }
    __syncthreads();
    {
        const int pt = wave >> 1, hh = lane >> 5, cl = lane & 31; LAS float* Ms = (LAS float*)(lds + 69632 + wave * 8704);
#pragma unroll
        for (int cc = 0; cc < 2; ++cc) { const int ct = 2 * (wave & 1) + cc; f32x16 acc = {};
            acc = mma_lds(lds + 32 * pt * 272, 272, lds + 34816 + 32 * ct * 272, 272, 8, lane, acc);
#pragma unroll
            for (int q = 0; q < 4; ++q) { const f32x4 bq = *(const f32x4*)(P.sgu_b + g * 128 + 32 * pt + 8 * q + 4 * hh);
#pragma unroll
                for (int e = 0; e < 4; ++e) Ms[(8 * q + 4 * hh + e) * 68 + 32 * cc + cl] = acc[4 * q + e] + bq[e]; } }
        LDS_WAIT(); asm volatile("" ::: "memory");
        const int row = lane >> 1, c0 = (lane & 1) * 32; const size_t grow = grow0 + 32 * pt + row; const int gcol = g * 128 + 64 * (wave & 1) + c0;
        const bf16* sup = zb + grow * DINP + C_SU + gcol; bf16* op = mix + grow * D + 1536 + gcol;
#pragma unroll
        for (int j = 0; j < 4; ++j) { const v4u su = *(const v4u*)(sup + 8 * j); const f32x4 m0 = *(const LAS f32x4*)(Ms + row * 68 + c0 + 8 * j), m1 = *(const LAS f32x4*)(Ms + row * 68 + c0 + 8 * j + 4);
            v4u o; o.x = pk2(gelu_tanh(bflo(su.x)) * m0.x, gelu_tanh(bfhi(su.x)) * m0.y); o.y = pk2(gelu_tanh(bflo(su.y)) * m0.z, gelu_tanh(bfhi(su.y)) * m0.w);
            o.z = pk2(gelu_tanh(bflo(su.z)) * m1.x, gelu_tanh(bfhi(su.z)) * m1.y); o.w = pk2(gelu_tanh(bflo(su.w)) * m1.z, gelu_tanh(bfhi(su.w)) * m1.w);
            *(v4u*)(op + 8 * j) = o; }
    }
    __syncthreads();
}

__device__ __forceinline__ void rope_item(bf16* zb, const float* ropet, int ri, int lane, int wave) {
    asm volatile("" : "+v"(lane));
    const int hf = (lane >> 4) & 1, ip = (lane & 15) * 2;
#pragma unroll 1
    for (int t4 = 0; t4 < 8; t4 += 4) {
        unsigned wa[4][5], wb[4][5]; f32x2 cs[4], sn[4]; bf16* pp[4];
#pragma unroll
        for (int u = 0; u < 4; ++u) { const int tl = ri * 64 + wave * 8 + t4 + u, t = tl & 2047; pp[u] = zb + (size_t)(NCTX + tl) * DINP + 64 * hf + ip;
            cs[u] = *(const f32x2*)(ropet + t * 64 + 32 * hf + ip); sn[u] = *(const f32x2*)(ropet + 131072 + t * 64 + 32 * hf + ip);
#pragma unroll
            for (int ps = 0; ps < 5; ++ps) { const int hv = ps * 2 + (lane >> 5); const bf16* p = pp[u] + (hv < 8 ? C_AQ + hv * 128 : C_AK + (hv - 8) * 128); wa[u][ps] = *(const unsigned*)p; wb[u][ps] = *(const unsigned*)(p + 32); } }
#pragma unroll
        for (int u = 0; u < 4; ++u)
#pragma unroll
            for (int ps = 0; ps < 5; ++ps) { const int hv = ps * 2 + (lane >> 5); bf16* p = pp[u] + (hv < 8 ? C_AQ + hv * 128 : C_AK + (hv - 8) * 128);
                const float a0 = bflo(wa[u][ps]), a1 = bfhi(wa[u][ps]), b0 = bflo(wb[u][ps]), b1 = bfhi(wb[u][ps]);
                *(unsigned*)p = pk2(a0 * cs[u].x - b0 * sn[u].x, a1 * cs[u].y - b1 * sn[u].y); *(unsigned*)(p + 32) = pk2(b0 * cs[u].x + a0 * sn[u].x, b1 * cs[u].y + a1 * sn[u].y); }
    }
}

constexpr int SC_BUF = 58368;
__device__ __forceinline__ void glds16(const void* g, ldsp l) { __builtin_amdgcn_global_load_lds((const unsigned*)g, (LAS unsigned*)l, 16, 0, 0); }
__device__ __forceinline__ void scan_dma4(const unsigned char* blk, int dir, ldsp buf, int lane, int lw) {
    const unsigned lo = (unsigned)lane * 16u;
#pragma unroll
    for (int i = 0; i < 15; ++i) { const int k = lw + 4 * i;
        if (i < 14 || lw == 0) { const unsigned char* ub = blk + (size_t)k * 1024 + (k >= 32 ? 16384 + dir * (int)DN_DIRSZ : 0); glds16(ub + lo, buf + k * 1024); } }
}
__device__ __forceinline__ void scan_chain(const unsigned char* dn, const float* state0, float* state_out, float* odir, ldsp lds, int isctx, int b, int h, int dir, int lane, int wave) {
    asm volatile("" : "+v"(lane));
    const int hh = lane >> 5, cl = lane & 31; const int nch = isctx ? 4 : 32; const int gch0 = isctx ? b * 4 : 64 + b * 32;
#define BLKOF(n) (dn + (size_t)((gch0 + (dir ? nch - 1 - (n) : (n))) * 4 + h) * DN_BLK)
    if (wave >= 4) {
        scan_dma4(BLKOF(0), dir, lds, lane, wave - 4);
#pragma unroll 1
        for (int n = 0; n < nch; ++n) {
            VM_WAIT(); __builtin_amdgcn_s_barrier(); asm volatile("" ::: "memory");
            if (n + 1 < nch) scan_dma4(BLKOF(n + 1), dir, lds + ((n + 1) & 1) * SC_BUF, lane, wave - 4);
        }
        VM_WAIT(); __builtin_amdgcn_s_barrier(); asm volatile("" ::: "memory");
        return;
    }
    const int es = wave;
    f32x16 S[4];
#pragma unroll
    for (int db = 0; db < 4; ++db) S[db] = f32x16{};
    if (state0) { const float* sp = state0 + (4 * hh) * 128 + 32 * es + cl;
#pragma unroll
        for (int db = 0; db < 4; ++db)
#pragma unroll
            for (int r = 0; r < 16; ++r) S[db][r] = sp[(32 * db + (r & 3) + 8 * (r >> 2)) * 128]; }
#define UPTR(n) (BLKOF(n) + DN_DIR0 + dir * DN_DIRSZ + (es * 2) * 1024 + lane * 16)
    bf16x8 Un[2][2];
    { const unsigned char* up = UPTR(0);
#pragma unroll
      for (int ct = 0; ct < 2; ++ct) { Un[ct][0] = *(const bf16x8*)(up + ct * 8192); Un[ct][1] = *(const bf16x8*)(up + ct * 8192 + 1024); } }
#define SBAR_() __builtin_amdgcn_sched_barrier(0)
#pragma unroll 1
    for (int n = 0; n < nch; ++n) {
        VM_WAIT(); __builtin_amdgcn_s_barrier(); asm volatile("" ::: "memory");
        f32x16 vn[2];
#pragma unroll
        for (int ct = 0; ct < 2; ++ct) { const v4u a = __builtin_bit_cast(v4u, Un[ct][0]), c = __builtin_bit_cast(v4u, Un[ct][1]);
          vn[ct][0] = bflo(a.x); vn[ct][1] = bfhi(a.x); vn[ct][2] = bflo(a.y); vn[ct][3] = bfhi(a.y); vn[ct][4] = bflo(a.z); vn[ct][5] = bfhi(a.z); vn[ct][6] = bflo(a.w); vn[ct][7] = bfhi(a.w);
          vn[ct][8] = bflo(c.x); vn[ct][9] = bfhi(c.x); vn[ct][10] = bflo(c.y); vn[ct][11] = bfhi(c.y); vn[ct][12] = bflo(c.z); vn[ct][13] = bfhi(c.z); vn[ct][14] = bflo(c.w); vn[ct][15] = bfhi(c.w); }
        if (n + 1 < nch) { const unsigned char* up = UPTR(n + 1);
#pragma unroll
            for (int ct = 0; ct < 2; ++ct) { Un[ct][0] = *(const bf16x8*)(up + ct * 8192); Un[ct][1] = *(const bf16x8*)(up + ct * 8192 + 1024); } }
        ldsp buf = lds + (n & 1) * SC_BUF; ldsp fl = buf + lane * 16;
        bf16x8 Sb[4][2];
#pragma unroll
        for (int db = 0; db < 4; ++db) { Sb[db][0] = pack8<0>(S[db]); Sb[db][1] = pack8<1>(S[db]); }
        f32x16 oa[2];
#pragma unroll
        for (int ct = 0; ct < 2; ++ct) {
            bf16x8 Anw[8], Aq[8];
#pragma unroll
            for (int k = 0; k < 8; ++k) { Anw[k] = *(const LAS bf16x8*)(fl + 32768 + (((k >> 1) * 2 + ct) * 2 + (k & 1)) * 1024); Aq[k] = *(const LAS bf16x8*)(fl + ((ct * 4 + (k >> 1)) * 2 + (k & 1)) * 1024); }
            oa[ct] = f32x16{};
            LDS_WAIT(); SBAR_();
#pragma unroll
            for (int k = 0; k < 8; ++k) { vn[ct] = __builtin_amdgcn_mfma_f32_32x32x16_bf16(Anw[k], Sb[k >> 1][k & 1], vn[ct], 0, 0, 0); oa[ct] = __builtin_amdgcn_mfma_f32_32x32x16_bf16(Aq[k], Sb[k >> 1][k & 1], oa[ct], 0, 0, 0); }
            SBAR_();
        }
        bf16x8 V1[2][2], V2[2][2];
        { const float gl = *(const LAS float*)(buf + 57344 + 512);
#pragma unroll
          for (int ct = 0; ct < 2; ++ct) { const LAS float* egl = (const LAS float*)(buf + 57344 + 256) + 32 * ct + 4 * hh; const LAS float* eg = (const LAS float*)(buf + 57344) + 32 * ct + 4 * hh;
            f32x16 vs;
#pragma unroll
            for (int q = 0; q < 4; ++q) { const f32x4 e = *(const LAS f32x4*)(egl + 8 * q), g = *(const LAS f32x4*)(eg + 8 * q);
                vs[4 * q] = vn[ct][4 * q] * e.x; vs[4 * q + 1] = vn[ct][4 * q + 1] * e.y; vs[4 * q + 2] = vn[ct][4 * q + 2] * e.z; vs[4 * q + 3] = vn[ct][4 * q + 3] * e.w;
                oa[ct][4 * q] *= g.x; oa[ct][4 * q + 1] *= g.y; oa[ct][4 * q + 2] *= g.z; oa[ct][4 * q + 3] *= g.w; }
            V1[ct][0] = pack8<0>(vn[ct]); V1[ct][1] = pack8<1>(vn[ct]); V2[ct][0] = pack8<0>(vs); V2[ct][1] = pack8<1>(vs); }
#pragma unroll
          for (int db = 0; db < 4; ++db)
#pragma unroll
              for (int r = 0; r < 16; ++r) S[db][r] *= gl; }
        SBAR_();
        { bf16x8 Aqk[8];
#pragma unroll
          for (int k = 0; k < 8; ++k) Aqk[k] = *(const LAS bf16x8*)(fl + 49152 + k * 1024);
          LDS_WAIT(); SBAR_();
#pragma unroll
          for (int cb = 0; cb < 2; ++cb)
#pragma unroll
              for (int s = 0; s < 2; ++s) { oa[0] = __builtin_amdgcn_mfma_f32_32x32x16_bf16(Aqk[(cb * 2 + 0) * 2 + s], V1[cb][s], oa[0], 0, 0, 0); oa[1] = __builtin_amdgcn_mfma_f32_32x32x16_bf16(Aqk[(cb * 2 + 1) * 2 + s], V1[cb][s], oa[1], 0, 0, 0); }
          SBAR_(); }
#pragma unroll
        for (int half = 0; half < 2; ++half) { bf16x8 Akt[8];
#pragma unroll
            for (int k = 0; k < 8; ++k) Akt[k] = *(const LAS bf16x8*)(fl + 16384 + (half * 8 + k) * 1024);
            LDS_WAIT(); SBAR_();
#pragma unroll
            for (int k = 0; k < 4; ++k) { S[2 * half] = __builtin_amdgcn_mfma_f32_32x32x16_bf16(Akt[k], V2[k >> 1][k & 1], S[2 * half], 0, 0, 0);
                S[2 * half + 1] = __builtin_amdgcn_mfma_f32_32x32x16_bf16(Akt[4 + k], V2[k >> 1][k & 1], S[2 * half + 1], 0, 0, 0); }
            SBAR_(); }
        { const int pc = dir ? nch - 1 - n : n;
#pragma unroll
          for (int ct = 0; ct < 2; ++ct) { unsigned ob = (unsigned)((((gch0 + pc) * 64 + 32 * ct + 4 * hh) * 512 + h * 128 + 32 * es + cl) * 4); asm volatile("" : "+v"(ob));
#pragma unroll
              for (int r = 0; r < 16; ++r) *(float*)((char*)odir + (ob + (unsigned)(((r & 3) + 8 * (r >> 2)) * 2048))) = oa[ct][r]; } }
    }
#undef SBAR_
    if (state_out) {
#pragma unroll
        for (int db = 0; db < 4; ++db)
#pragma unroll
            for (int r = 0; r < 16; ++r) state_out[(size_t)(32 * db + crow(r, hh)) * 128 + 32 * es + cl] = S[db][r];
    }
    VM_WAIT(); LDS_WAIT(); __builtin_amdgcn_s_barrier(); asm volatile("" ::: "memory");
#undef BLKOF
#undef UPTR
}


#define KSWZ(row, colB) ((row) * 256 + ((colB) ^ (((row) & 7) << 4)))
#define SBAR() __builtin_amdgcn_sched_barrier(0)
__device__ __forceinline__ int v_st(int k, int c) { const int kk = (k & ~0xC) | ((k & 4) << 1) | ((k & 8) >> 1); return ((kk >> 3) * 4 + (c >> 5)) * 512 + ((kk & 7) * 32 + (c & 31)) * 2; }
__device__ __forceinline__ int v_rd_base(int lane) { return ((lane & 3) << 3) | (((lane >> 2) & 3) << 6) | (((lane >> 4) & 1) << 5) | (((lane >> 5) & 1) << 8); }
constexpr int v_rd_off(int d0, int ks, int half) { return d0 * 512 + ks * 4096 + half * 2048; }
template <int OFF> __device__ __forceinline__ s16x4 tr_read(int vb) { s16x4 r; asm volatile("ds_read_b64_tr_b16 %0, %1 offset:%2" : "=&v"(r) : "v"(vb), "i"(OFF) : "memory"); return r; }
template <int D0> __device__ __forceinline__ void pv_one(f32x16& od, int vb, bf16x8 pa0, bf16x8 pa1, bf16x8 pa2, bf16x8 pa3) {
    const s16x4 l0 = tr_read<v_rd_off(D0, 0, 0)>(vb), h0 = tr_read<v_rd_off(D0, 0, 1)>(vb), l1 = tr_read<v_rd_off(D0, 1, 0)>(vb), h1 = tr_read<v_rd_off(D0, 1, 1)>(vb);
    const s16x4 l2 = tr_read<v_rd_off(D0, 2, 0)>(vb), h2 = tr_read<v_rd_off(D0, 2, 1)>(vb), l3 = tr_read<v_rd_off(D0, 3, 0)>(vb), h3 = tr_read<v_rd_off(D0, 3, 1)>(vb);
    asm volatile("s_waitcnt lgkmcnt(0)" ::: "memory"); SBAR();
#define PKV(L, H) (bf16x8){L[0], L[1], L[2], L[3], H[0], H[1], H[2], H[3]}
    od = __builtin_amdgcn_mfma_f32_32x32x16_bf16(pa0, PKV(l0, h0), od, 0, 0, 0);
    od = __builtin_amdgcn_mfma_f32_32x32x16_bf16(pa1, PKV(l1, h1), od, 0, 0, 0);
    od = __builtin_amdgcn_mfma_f32_32x32x16_bf16(pa2, PKV(l2, h2), od, 0, 0, 0);
    od = __builtin_amdgcn_mfma_f32_32x32x16_bf16(pa3, PKV(l3, h3), od, 0, 0, 0);
#undef PKV
}
__device__ __forceinline__ void qkt(f32x16& p0, f32x16& p1, ldsp Ks, const bf16x8* qr, int r32, int hi) {
    p0 = f32x16{}; p1 = f32x16{};
#pragma unroll
    for (int d0 = 0; d0 < 8; ++d0) { const int cb = (d0 * 16 + hi * 8) * 2;
        const bf16x8 b0 = *(const LAS bf16x8*)(Ks + KSWZ(r32, cb)); const bf16x8 b1 = *(const LAS bf16x8*)(Ks + KSWZ(32 + r32, cb));
        p0 = __builtin_amdgcn_mfma_f32_32x32x16_bf16(b0, qr[d0], p0, 0, 0, 0); p1 = __builtin_amdgcn_mfma_f32_32x32x16_bf16(b1, qr[d0], p1, 0, 0, 0); }
}
struct AttnP { const bf16* zb; const bf16* ck; const bf16* cv; bf16* mix; const float* sink; int l; };
__device__ __forceinline__ void attn_unit(const AttnP& A, ldsp lds, int u, int tid, int lane, int wave) {
    asm volatile("" : "+v"(tid), "+v"(lane));
    constexpr float C = 0.08838834764831845f * 1.4426950408889634f;
    const int r32 = lane & 31, hi = lane >> 5;
    const bool lat = u < 512; int b, head, q0, T; size_t rowbase;
    if (lat) { q0 = (u & 7) * 256; head = (u >> 3) & 7; b = u >> 6; rowbase = NCTX + (size_t)b * 2048; T = 2048; }
    else { const int uu = u - 512; head = uu & 7; b = uu >> 3; q0 = 0; rowbase = (size_t)b * 256; T = 256; }
    const int kvh = head >> 2, nct = lat ? 8 : 0;
    const int ws = lat ? max(0, q0 - 128) / 64 : 0, we = lat ? min(T, q0 + 384) / 64 : 4, NT = nct + (we - ws);
    const int qw = q0 + 32 * wave;
    ldsp V_lds = lds, K_lds = lds + 32768; LAS float* al = (LAS float*)(lds + 65536) + wave * 64;
    bf16x8 qr[8];
    { const bf16* Qw = A.zb + (rowbase + qw + r32) * DINP + C_AQ + head * 128 + hi * 8;
#pragma unroll
      for (int d0 = 0; d0 < 8; ++d0) qr[d0] = *(const bf16x8*)(Qw + d0 * 16); }
    float m_reg = A.sink[head] * 1.4426950408889634f, l_reg = 1.f; f32x16 o[4] = {};
    const int sr = tid >> 4, sc = (tid & 15) * 8, vst0 = v_st(sr, sc), vst1 = v_st(32 + sr, sc);
    const int vb0 = (int)(unsigned)(size_t)V_lds + v_rd_base(lane);
    bf16x8 ks0, ks1, vs0, vs1;
#define ALOAD(j) do { const bf16 *kp, *vp; size_t st; if ((j) < nct) { kp = A.ck + ((size_t)(b * 4 + A.l) * 512 + (j) * 64) * 256 + kvh * 128; vp = A.cv + ((size_t)(b * 4 + A.l) * 512 + (j) * 64) * 256 + kvh * 128; st = 256; } \
        else { const size_t r0 = rowbase + (size_t)(ws + (j) - nct) * 64; kp = A.zb + r0 * DINP + C_AK + kvh * 128; vp = A.zb + r0 * DINP + C_AV + kvh * 128; st = DINP; } \
        ks0 = *(const bf16x8*)(kp + sr * st + sc); ks1 = *(const bf16x8*)(kp + (32 + sr) * st + sc); vs0 = *(const bf16x8*)(vp + sr * st + sc); vs1 = *(const bf16x8*)(vp + (32 + sr) * st + sc); } while (0)
#define AWRITE(bb) do { *(LAS bf16x8*)(V_lds + (bb) * 16384 + vst0) = vs0; *(LAS bf16x8*)(V_lds + (bb) * 16384 + vst1) = vs1; \
        *(LAS bf16x8*)(K_lds + (bb) * 16384 + KSWZ(sr, sc * 2)) = ks0; *(LAS bf16x8*)(K_lds + (bb) * 16384 + KSWZ(32 + sr, sc * 2)) = ks1; } while (0)
    ALOAD(0); AWRITE(0); __syncthreads();
#pragma unroll 1
    for (int j = 0; j < NT; ++j) {
        if (j + 1 < NT) ALOAD(j + 1);
        bool active = true, needmask = false; int kpos0 = 0;
        if (lat && j >= nct) { kpos0 = (ws + j - nct) * 64; active = (kpos0 + 63 >= qw - 128) && (kpos0 <= qw + 31 + 128); needmask = !((kpos0 >= qw + 31 - 128) && (kpos0 + 63 <= qw + 128)); }
        if (active) {
            f32x16 p0, p1;
            qkt(p0, p1, K_lds + (j & 1) * 16384, qr, r32, hi);
            if (needmask) { const int q = qw + r32;
#pragma unroll
                for (int r = 0; r < 16; ++r) { const int k0 = kpos0 + crow(r, hi) - q, k1 = k0 + 32; if (k0 > 128 || k0 < -128) p0[r] = -1e30f; if (k1 > 128 || k1 < -128) p1[r] = -1e30f; } }
            float pmax = p0[0];
#pragma unroll
            for (int r = 1; r < 16; ++r) pmax = fmaxf(pmax, p0[r]);
#pragma unroll
            for (int r = 0; r < 16; ++r) pmax = fmaxf(pmax, p1[r]);
            { auto rr = __builtin_amdgcn_permlane32_swap(__float_as_uint(pmax), __float_as_uint(pmax), false, false); pmax = fmaxf(__uint_as_float(rr[0]), __uint_as_float(rr[1])); }
            float mn = m_reg, alpha = 1.f;
            if (!__all(pmax * C - m_reg <= 11.5f)) { mn = fmaxf(m_reg, pmax * C); alpha = __builtin_amdgcn_exp2f(m_reg - mn); m_reg = mn; }
            float ps = 0.f;
#pragma unroll
            for (int r = 0; r < 16; ++r) { p0[r] = __builtin_amdgcn_exp2f(fmaf(p0[r], C, -mn)); p1[r] = __builtin_amdgcn_exp2f(fmaf(p1[r], C, -mn)); ps += p0[r] + p1[r]; }
            { auto rr = __builtin_amdgcn_permlane32_swap(__float_as_uint(ps), __float_as_uint(ps), false, false); ps = __uint_as_float(rr[0]) + __uint_as_float(rr[1]); }
            l_reg = l_reg * alpha + ps;
            if (__any(alpha < 1.f)) { if (hi == 0) al[r32] = alpha; LDS_WAIT();
#pragma unroll
                for (int d = 0; d < 4; ++d)
#pragma unroll
                    for (int r = 0; r < 16; ++r) o[d][r] *= al[crow(r, hi)]; }
            bf16x8 pa0, pa1, pa2, pa3;
#define PK4(P, BASE, OUT) do { unsigned a0 = pk2(P[BASE + 0], P[BASE + 1]), a1 = pk2(P[BASE + 2], P[BASE + 3]); unsigned b0 = pk2(P[BASE + 4], P[BASE + 5]), b1 = pk2(P[BASE + 6], P[BASE + 7]); \
    auto r0 = __builtin_amdgcn_permlane32_swap(a0, b0, false, false); auto r1 = __builtin_amdgcn_permlane32_swap(a1, b1, false, false); \
    v4u w = {r0[0], r1[0], r0[1], r1[1]}; OUT = __builtin_bit_cast(bf16x8, w); } while (0)
            PK4(p0, 0, pa0); PK4(p0, 8, pa1); PK4(p1, 0, pa2); PK4(p1, 8, pa3);
#undef PK4
            const int vb = vb0 + (j & 1) * 16384;
            pv_one<0>(o[0], vb, pa0, pa1, pa2, pa3); pv_one<1>(o[1], vb, pa0, pa1, pa2, pa3); pv_one<2>(o[2], vb, pa0, pa1, pa2, pa3); pv_one<3>(o[3], vb, pa0, pa1, pa2, pa3);
        }
        if (j + 1 < NT) AWRITE((j + 1) & 1);
        __syncthreads();
    }
#undef ALOAD
#undef AWRITE
    if (hi == 0) al[r32] = l_reg; LDS_WAIT();
    bf16* Ow = A.mix + (rowbase + qw) * D + head * 128 + r32;
#pragma unroll
    for (int r = 0; r < 16; ++r) { const int orow = crow(r, hi); const float rl = __builtin_amdgcn_rcpf(al[orow]);
#pragma unroll
        for (int d0 = 0; d0 < 4; ++d0) Ow[(size_t)orow * D + d0 * 32] = (bf16)(pk2(o[d0][r] * rl, 0.f) & 0xffffu); }
}

#ifndef PROBE_DUP
#define PROBE_DUP 0
#endif
#ifndef PROBE_T
#define PROBE_T 0
#endif
__device__ __forceinline__ int lane_l() { int t; asm volatile("v_mbcnt_lo_u32_b32 %0, -1, 0\n\tv_mbcnt_hi_u32_b32 %0, -1, %0" : "=v"(t)); return t; }
struct Args { const float* in[24]; float* out; unsigned char* ws; int ph_lo, ph_hi; };
constexpr int NPH = 31;
__global__ void __launch_bounds__(NWAVES * 64, 2) fwd(Args args) {
    extern __shared__ __attribute__((aligned(16))) unsigned char lds_raw[];
    ldsp lds = (ldsp)lds_raw;
    volatile LAS unsigned* MISC = (volatile LAS unsigned*)(lds + LDSCTL_OFF);
    const int wave = __builtin_amdgcn_readfirstlane((int)threadIdx.x >> 6), G = gridDim.x;
#define tid ((wave << 6) | lane_l())
#define lane lane_l()
    unsigned char* ws = args.ws; unsigned* ctl = (unsigned*)(ws + WS_CTL);
    for (int u = tid; u < (LDS_BYTES - LDSCTL_OFF) / 4; u += NWAVES * 64) MISC[u] = 0u;
    __syncthreads();
    const int lo = args.ph_lo, hi = args.ph_hi; const bool multi = (hi - lo) > 1;
    XcdBarrier bar; bar.bar = ctl + CW_BAR; bar.x = 0; bar.st = nullptr; bar.t0 = false;
    if (multi) bar = xcd_barrier_post(ctl + CW_BAR, MISC + 8);
#define IN(k) (lo <= (k) && (k) < hi)
    unsigned long long tacc_ = 0, t0_ = 0;
#define PH_T0(bit) do { if (PROBE_T & (bit)) t0_ = __builtin_amdgcn_s_memrealtime(); } while (0)
#define PH_T1(bit) do { if (PROBE_T & (bit)) tacc_ += __builtin_amdgcn_s_memrealtime() - t0_; } while (0)
#define DUPBAR() do { if (multi) { XcdBarrier b2_ = bar; b2_.t0 = (wave == 0) && (lane_l() == 0); asm volatile("" : "+s"(b2_.bar)); xcd_barrier(b2_); } } while (0)
#if PROBE_DUP & 512
#define SEAM(k) do { if (IN(k) && IN((k) + 1)) { XcdBarrier b2_ = bar; b2_.t0 = (wave == 0) && (lane_l() == 0); asm volatile("" : "+s"(b2_.bar)); xcd_barrier(b2_); xcd_barrier(b2_); } } while (0)
#else
#define SEAM(k) do { if (IN(k) && IN((k) + 1)) { XcdBarrier b2_ = bar; b2_.t0 = (wave == 0) && (lane_l() == 0); asm volatile("" : "+s"(b2_.bar)); xcd_barrier(b2_); } } while (0)
#endif
    const float *x_prompt = args.in[0], *x_sample = args.in[1], *cache_k = args.in[2], *cache_v = args.in[3], *state_delta = args.in[4], *c_in = args.in[5], *c_ctx = args.in[6];
    const float *norm1_g = args.in[7], *w_mod = args.in[8], *b_mod = args.in[9], *w_in = args.in[10], *conv_w = args.in[11], *attn_sink = args.in[12], *dn_a_log = args.in[13], *dn_dt_bias = args.in[14];
    const float *dn_norm_g = args.in[15], *sgu_norm_g = args.in[16], *sgu_w = args.in[17], *sgu_b = args.in[18], *w_out = args.in[19], *norm2_g = args.in[20], *w_ff1 = args.in[21], *w_ff2 = args.in[22], *final_norm_g = args.in[23];
    float* out = args.out;
    float* MOD = (float*)(ws + WS_MOD); bf16* XB = (bf16*)(ws + WS_X); bf16* HB = (bf16*)(ws + WS_HB); bf16* ZB = (bf16*)(ws + WS_ZB); bf16* FB = ZB; bf16* XA = (bf16*)(ws + WS_XA);
    float* ODIR = (float*)(ws + WS_ODIR); unsigned char* DN = ws + WS_DN; unsigned long long* SSQ = (unsigned long long*)(ws + WS_SSQ); const float* BW = (const float*)(ws + WS_BW);

    PH_T0(1);
    if (IN(0)) {
        P0Args pa{c_in, c_ctx, norm1_g, norm2_g, w_mod, b_mod, w_in, w_out, w_ff1, w_ff2, cache_k, cache_v, ws};
        p0_prologue(pa, lds, ctl + CW_ATT + 64 * 16, MISC, tid, lane, wave, G);
        __syncthreads();
#if PROBE_DUP & 4
        p0_prologue(pa, lds, ctl + CW_ATT + 64 * 17, MISC, tid, lane, wave, G); __syncthreads();
#endif
    }
    SEAM(0); PH_T1(1); PH_T0(2);
    if (IN(1)) {
        p0b_bias(ws, lds, tid, lane, wave, G);
        norm_phase<false>(x_prompt, x_sample, MOD + 1 * 2048, XB, XA, SSQ, nullptr, lane, wave, G);
    }
    SEAM(1); PH_T1(2);
#pragma unroll 1
    for (int l = 0; l < DEPTH; ++l) {
        const int pb = 2 + 7 * l;
        const float* modl = MOD + (size_t)l * 9 * 12288;
        if (l == 0) PH_T0(4);
        if (IN(pb + 0)) {
            const bf16* gA = XA; const bf16* gB = (const bf16*)(ws + WS_WIN) + (size_t)l * DINP * 2048; asm volatile("" : "+s"(gA), "+s"(gB));
            pg8::Gemm g{gA, gB, M, DINP, 2048}; pg8::StaticOrder S; S.init(M, DINP, G, (int)blockIdx.x);
            pg8::EpiZ E{ZB, DINP, out + O_K + (size_t)l * 65536, out + O_V + (size_t)l * 65536, SSQ + (size_t)(2 * l) * M, BW + (size_t)l * BW_L};
            pg8::gemm_phase<pg8::EpiZ, pg8::StaticOrder, true, true>(lds, g, S, E, wave);
        }
        SEAM(pb + 0); PH_T1(4); PH_T0(8);
        LayerP LP{conv_w + (size_t)l * 5 * 1536, dn_a_log + l * 8, dn_dt_bias + l * 8, dn_norm_g + l * 128, sgu_norm_g + l * 512, sgu_w + (size_t)l * 4 * 128 * 128, sgu_b + l * 512, attn_sink + l * 8};
        if (IN(pb + 1)) {
            int wg_ = -1;
            for (int it = blockIdx.x; it < 1280 + 640 + 256; it += G) {
                if (it < 1280) dn_prep_unit(LP, ZB, DN, lds, it >> 2, it & 3, tid, lane, wave);
                else if (it < 1920) { const int g_ = (it - 1280) & 3; sgu_unit(LP, ZB, HB, lds, (it - 1280) >> 2, g_, g_ != wg_, tid, lane, wave); wg_ = g_; }
                else if (G == 256 && it >= 2048) {   }
                else rope_item(ZB, (const float*)(ws + WS_ROPE), it - 1920, lane, wave);
            }
            if (G == 256 && (int)blockIdx.x >= 128) rope_item(ZB, (const float*)(ws + WS_ROPE), 128 + ((int)blockIdx.x - 128), lane, wave);
        }
#if PROBE_DUP & 16
        if (IN(pb + 1)) { DUPBAR();
            for (int it = blockIdx.x; it < 1280 + 640; it += G) {
                if (it < 1280) dn_prep_unit(LP, ZB, DN, lds, it >> 2, it & 3, tid, lane, wave);
                else sgu_unit(LP, ZB, HB, lds, (it - 1280) >> 2, (it - 1280) & 3, true, tid, lane, wave);
            } }
#endif
#if PROBE_DUP & 32
        if (IN(pb + 1)) { DUPBAR(); for (int it = blockIdx.x; it < 1280; it += G) dn_prep_unit(LP, ZB, DN, lds, it >> 2, it & 3, tid, lane, wave); }
#endif
        SEAM(pb + 1); PH_T1(8); PH_T0(16);
        if (IN(pb + 2)) {
            for (int cu = blockIdx.x; cu < 192; cu += G) {
                const bool isctx = cu >= 64; const int cc = isctx ? cu - 64 : cu; const int b = cc >> 3, h = (cc >> 1) & 3, dir = cc & 1;
                const float* s0 = isctx ? nullptr : state_delta + ((((size_t)b * 4 + l) * 2 + dir) * 4 + h) * 16384;
                float* so = isctx ? out + O_DELTA + ((((size_t)b * 4 + l) * 2 + dir) * 4 + h) * 16384 : nullptr;
                scan_chain(DN, s0, so, ODIR + (size_t)dir * M * 512, lds, isctx ? 1 : 0, b, h, dir, lane, wave);
            }
            AttnP AP{ZB, (const bf16*)(ws + WS_CK), (const bf16*)(ws + WS_CV), HB, LP.sink, l};
            for (;;) {
                if (tid == 0) MISC[0] = atomicAdd(ctl + CW_ATT + 64 * l, 1u);
                __syncthreads(); const int u = (int)MISC[0]; __syncthreads();
                if (u >= 640) break;
                attn_unit(AP, lds, u, tid, lane, wave);
            }
        }
#if PROBE_DUP & 128
        if (IN(pb + 2)) { DUPBAR();
            for (int cu = blockIdx.x; cu < 192; cu += G) {
                const bool isctx = cu >= 64; const int cc = isctx ? cu - 64 : cu; const int b = cc >> 3, h = (cc >> 1) & 3, dir = cc & 1;
                const float* s0 = isctx ? nullptr : state_delta + ((((size_t)b * 4 + l) * 2 + dir) * 4 + h) * 16384;
                float* so = isctx ? out + O_DELTA + ((((size_t)b * 4 + l) * 2 + dir) * 4 + h) * 16384 : nullptr;
                scan_chain(DN, s0, so, ODIR + (size_t)dir * M * 512, lds, isctx ? 1 : 0, b, h, dir, lane, wave);
            } }
#endif
#if PROBE_DUP & 256
        if (IN(pb + 2)) { DUPBAR();
            AttnP AP{ZB, (const bf16*)(ws + WS_CK), (const bf16*)(ws + WS_CV), HB, LP.sink, l};
            for (;;) {
                if (tid == 0) MISC[0] = atomicAdd(ctl + CW_ATT + 64 * (l + 4), 1u);
                __syncthreads(); const int u = (int)MISC[0]; __syncthreads();
                if (u >= 640) break;
                attn_unit(AP, lds, u, tid, lane, wave);
            } }
#endif
#if PROBE_DUP & 2
        if (IN(pb + 2)) { DUPBAR();
            for (int cu = blockIdx.x; cu < 192; cu += G) {
                const bool isctx = cu >= 64; const int cc = isctx ? cu - 64 : cu; const int b = cc >> 3, h = (cc >> 1) & 3, dir = cc & 1;
                const float* s0 = isctx ? nullptr : state_delta + ((((size_t)b * 4 + l) * 2 + dir) * 4 + h) * 16384;
                float* so = isctx ? out + O_DELTA + ((((size_t)b * 4 + l) * 2 + dir) * 4 + h) * 16384 : nullptr;
                scan_chain(DN, s0, so, ODIR + (size_t)dir * M * 512, lds, isctx ? 1 : 0, b, h, dir, lane, wave);
            }
            AttnP AP{ZB, (const bf16*)(ws + WS_CK), (const bf16*)(ws + WS_CV), HB, LP.sink, l};
            for (;;) {
                if (tid == 0) MISC[0] = atomicAdd(ctl + CW_ATT + 64 * (l + 4), 1u);
                __syncthreads(); const int u = (int)MISC[0]; __syncthreads();
                if (u >= 640) break;
                attn_unit(AP, lds, u, tid, lane, wave);
            } }
#endif
        SEAM(pb + 2); PH_T1(16); PH_T0(32);
        if (IN(pb + 3)) {
            const int ln = lane_l();
            const float gn0 = LP.dn_norm_g[2 * ln], gn1 = LP.dn_norm_g[2 * ln + 1];
            for (int it0 = blockIdx.x * NWAVES + wave; it0 < M * 4; it0 += 4 * G * NWAVES) {
                f32x2 a[4], b2[4]; unsigned z[4];
#pragma unroll
                for (int u = 0; u < 4; ++u) { const int it = it0 + u * G * NWAVES; const size_t row = it >> 2; const int hh = it & 3;
                    a[u] = *(const f32x2*)(ODIR + row * 512 + hh * 128 + 2 * ln); b2[u] = *(const f32x2*)(ODIR + (size_t)M * 512 + row * 512 + hh * 128 + 2 * ln); z[u] = *(const unsigned*)(ZB + row * DINP + C_DZ + hh * 128 + 2 * ln); }
#pragma unroll
                for (int u = 0; u < 4; ++u) { const int it = it0 + u * G * NWAVES; const size_t row = it >> 2; const int hh = it & 3;
                    const float o0 = a[u].x + b2[u].x, o1 = a[u].y + b2[u].y; const float r = rsqrtf(wave_sum(o0 * o0 + o1 * o1) * (1.f / 128.f) + EPS);
                    *(unsigned*)(HB + row * D + 1024 + hh * 128 + 2 * ln) = pk2(o0 * r * gn0 * silu_f(bflo(z[u])), o1 * r * gn1 * silu_f(bfhi(z[u]))); }
            }
        }
        SEAM(pb + 3); PH_T1(32); PH_T0(64);
        if (IN(pb + 4)) {
            const bf16* gA = HB; const bf16* gB = (const bf16*)(ws + WS_WOUT) + (size_t)l * 2048 * 2048; asm volatile("" : "+s"(gA), "+s"(gB));
            pg8::Gemm g{gA, gB, M, 2048, 2048};
            pg8::EpiRes E{XB, modl + 2 * 2048, modl + 4 * 2048, XA, SSQ + (size_t)(2 * l + 1) * M};
            pg8::StaticOrder S; S.init(M, 2048, G, (int)blockIdx.x, 4);
            pg8::gemm_phase<pg8::EpiRes, pg8::StaticOrder, true, true>(lds, g, S, E, wave);
        }
        SEAM(pb + 4); PH_T1(64); PH_T0(128);
        if (IN(pb + 5)) {
            const bf16* gA = XA; const bf16* gB = (const bf16*)(ws + WS_WFF1) + (size_t)l * DFF * 2048; asm volatile("" : "+s"(gA), "+s"(gB));
            pg8::Gemm g{gA, gB, M, DFF, 2048}; pg8::StaticOrder S; S.init(M, DFF, G, (int)blockIdx.x);
            pg8::EpiRelu2 E{FB, DFF, SSQ + (size_t)(2 * l + 1) * M, BW + (size_t)l * BW_L + 9 * DINP};
            pg8::gemm_phase<pg8::EpiRelu2, pg8::StaticOrder, true, true>(lds, g, S, E, wave);
        }
        SEAM(pb + 5); PH_T1(128); PH_T0(256);
        if (IN(pb + 6)) {
            const bf16* gA = FB; const bf16* gB = (const bf16*)(ws + WS_WFF2) + (size_t)l * 2048 * DFF; asm volatile("" : "+s"(gA), "+s"(gB));
            pg8::Gemm g{gA, gB, M, 2048, DFF};
            pg8::EpiRes E{XB, modl + 5 * 2048, l + 1 < DEPTH ? modl + 9 * 12288 + 1 * 2048 : nullptr, XA, SSQ + (size_t)(2 * l + 2) * M};
            pg8::StaticOrder S; S.init(M, 2048, G, (int)blockIdx.x, 4);
            pg8::gemm_phase<pg8::EpiRes, pg8::StaticOrder, true, true>(lds, g, S, E, wave);
        }
        SEAM(pb + 6); PH_T1(256); PH_T0(4);
    }
    PH_T0(512);
    if (IN(30)) norm_phase<true>(nullptr, nullptr, final_norm_g, XB, nullptr, nullptr, out + O_Y, lane, wave, G);
    PH_T1(512);
    if (PROBE_T && blockIdx.x == 0) { const unsigned long long te_ = __builtin_amdgcn_s_memrealtime() + 4ull * tacc_; while (__builtin_amdgcn_s_memrealtime() < te_) __builtin_amdgcn_s_sleep(64); }
#undef IN
#undef SEAM
#undef DUPBAR
#undef tid
#undef lane
}

#ifndef MK_ONE_LAUNCH
#define MK_ONE_LAUNCH 1
#endif
extern "C" void kernel_launch(void* const* d_in, const int* in_sizes, int n_in, void* d_out, int out_size, void* d_ws, size_t ws_size, hipStream_t stream) {
    static int grid = 0;
    if (grid == 0) {
        if (n_in != 24 || (size_t)out_size != O_END || ws_size < WS_END) { fprintf(stderr, "kernel_launch: unexpected shapes: n_in %d out %d ws %zu (need %zu)\n", n_in, out_size, ws_size, (size_t)WS_END); grid = -1; return; }
        int dev = 0, cus = 0, per_cu = 0;
        if (hipGetDevice(&dev) != hipSuccess || hipDeviceGetAttribute(&cus, hipDeviceAttributeMultiprocessorCount, dev) != hipSuccess) { grid = -1; return; }
        if (hipFuncSetAttribute((const void*)fwd, hipFuncAttributeMaxDynamicSharedMemorySize, LDS_BYTES) != hipSuccess) { fprintf(stderr, "kernel_launch: hipFuncSetAttribute failed\n"); grid = -1; return; }
        if (hipOccupancyMaxActiveBlocksPerMultiprocessor(&per_cu, (const void*)fwd, NWAVES * 64, LDS_BYTES) != hipSuccess || per_cu < 1) fprintf(stderr, "kernel_launch: occupancy query reports %d\n", per_cu);
        (void)hipGetLastError();
        grid = cus;
    }
    if (grid < 0) return;
    (void)hipMemsetAsync((char*)d_ws + WS_CTL, 0, CTL_ZERO_BYTES, stream);
    (void)hipMemsetAsync((char*)d_ws + WS_SSQ, 0, (size_t)9 * M * 8, stream);
    for (int l = 0; l < DEPTH; ++l) (void)hipMemsetAsync((char*)d_ws + WS_WIN + ((size_t)l * DINP + 4640) * 2048 * 2, 0, (size_t)(DINP - 4640) * 2048 * 2, stream);
    Args a{};
    for (int i = 0; i < 24; ++i) a.in[i] = (const float*)d_in[i];
    a.out = (float*)d_out; a.ws = (unsigned char*)d_ws;
#if MK_ONE_LAUNCH
    a.ph_lo = 0; a.ph_hi = NPH;
    hipLaunchKernelGGL(fwd, dim3(grid), dim3(NWAVES * 64), LDS_BYTES, stream, a);
#else
    for (int p = 0; p < NPH; ++p) { a.ph_lo = p; a.ph_hi = p + 1; hipLaunchKernelGGL(fwd, dim3(grid), dim3(NWAVES * 64), LDS_BYTES, stream, a); }
#endif
    const hipError_t le = hipPeekAtLastError();
    if (le != hipSuccess) fprintf(stderr, "kernel_launch: launch failed: %s\n", hipGetErrorName(le));
}
```
